# Optimizing an MI355X kernel written in HIP

```python
import math
import jax, jax.numpy as jnp
from jax import lax
import numpy as np

D_MODEL = 1024
BATCH = 4
SEQ = 8192
DEPTH = 1

PLE_DIM = 256
D_FF = 2816
MB_HEADS = 8
MB_HEAD_DIM = 64
MB_WIDTH = MB_HEADS * MB_HEAD_DIM
MB_BLOCK = 256
MB_TOPK = 3
MB_QCHUNK = 64
HG_HEADS = 4
HG_DK = 128
HG_DV = 128
HG_KEY_WIDTH = HG_HEADS * HG_DK
HG_WIDTH = HG_HEADS * HG_DV
HG_CHUNK = 64
REL_BUCKETS = 32
REL_MAX_EXACT = REL_BUCKETS // 2
REL_MAX_DIST = 128
SPLIT_SIZES = (MB_WIDTH, MB_WIDTH, MB_WIDTH, HG_KEY_WIDTH, HG_KEY_WIDTH, HG_WIDTH, HG_WIDTH, D_MODEL, D_MODEL)
IN_COLS = 3 * MB_WIDTH + 2 * HG_KEY_WIDTH + 2 * HG_WIDTH + 2 * D_MODEL
N_NORMS = 7
EPS = 1e-6

kernel_name = "moba_hgrn2_gated_hybrid_macaron"


def rmsnorm(x, w):
    xf = x.astype(jnp.float32)
    y = xf * lax.rsqrt(jnp.mean(xf * xf, axis=-1, keepdims=True) + EPS)
    return y.astype(x.dtype) * w


def swiglu(x, w_gu, w_down):
    g, u = jnp.split(x @ w_gu, 2, axis=-1)
    return (jax.nn.silu(g) * u) @ w_down


def rel_bucket(n):
    n = jnp.maximum(n, 0)
    nf = jnp.maximum(n, 1).astype(jnp.float32)
    large = REL_MAX_EXACT + (jnp.log(nf / REL_MAX_EXACT) / math.log(REL_MAX_DIST / REL_MAX_EXACT)
                             * (REL_BUCKETS - REL_MAX_EXACT)).astype(jnp.int32)
    large = jnp.minimum(large, REL_BUCKETS - 1)
    return jnp.where(n < REL_MAX_EXACT, n, large)


def moba_attention(q, k, v, rel_table):
    B, S, H, Dh = q.shape
    nb = -(-S // MB_BLOCK)
    s_pad = nb * MB_BLOCK
    pad = ((0, 0), (0, s_pad - S), (0, 0), (0, 0))
    q = jnp.pad(q, pad).transpose(0, 2, 1, 3)
    k = jnp.pad(k, pad).transpose(0, 2, 1, 3)
    v = jnp.pad(v, pad).transpose(0, 2, 1, 3)
    kb = k.reshape(B, H, nb, MB_BLOCK, Dh)
    vb = v.reshape(B, H, nb, MB_BLOCK, Dh)
    scale = Dh ** -0.5

    kmean = jnp.mean(kb.astype(jnp.float32), axis=3)
    gate = jnp.einsum('bhtd,bhnd->bhtn', q.astype(jnp.float32), kmean)
    pos = jnp.arange(s_pad)
    own = pos // MB_BLOCK
    past = jnp.arange(nb)[None, :] < own[:, None]
    gate = jnp.where(past[None, None], gate, -jnp.inf)
    kk = min(MB_TOPK, nb)
    _, top_idx = lax.top_k(gate, kk)
    valid = jnp.arange(kk)[None, :] < own[:, None]

    nq = s_pad // MB_QCHUNK
    qc = q.reshape(B, H, nq, MB_QCHUNK, Dh).transpose(2, 0, 1, 3, 4)
    idxc = top_idx.reshape(B, H, nq, MB_QCHUNK, kk).transpose(2, 0, 1, 3, 4)
    validc = valid.reshape(nq, MB_QCHUNK, kk)
    chunk_ids = jnp.arange(nq)
    bidx = jnp.arange(B)[:, None, None, None]
    hidx = jnp.arange(H)[None, :, None, None]
    hsel = jnp.arange(H)[None, :, None, None, None]
    blk_off = jnp.arange(MB_BLOCK)

    def step(args):
        qi, ii, vi, c = args
        qpos = c * MB_QCHUNK + jnp.arange(MB_QCHUNK)
        blk = (c * MB_QCHUNK) // MB_BLOCK
        k_own = lax.dynamic_index_in_dim(kb, blk, axis=2, keepdims=False)
        v_own = lax.dynamic_index_in_dim(vb, blk, axis=2, keepdims=False)
        dist_own = qpos[:, None] - (blk * MB_BLOCK + blk_off)[None, :]
        bias_own = jnp.moveaxis(rel_table[rel_bucket(dist_own)], -1, 0)[None]
        s_own = jnp.einsum('bhqd,bhkd->bhqk', qi, k_own).astype(jnp.float32) * scale + bias_own
        s_own = jnp.where((dist_own >= 0)[None, None], s_own, -jnp.inf)
        k_sel = kb[bidx, hidx, ii]
        v_sel = vb[bidx, hidx, ii]
        kpos_sel = ii[..., None] * MB_BLOCK + blk_off
        dist_sel = qpos[None, None, :, None, None] - kpos_sel
        bias_sel = rel_table[rel_bucket(dist_sel), hsel]
        s_sel = jnp.einsum('bhqd,bhqjkd->bhqjk', qi, k_sel).astype(jnp.float32) * scale + bias_sel
        s_sel = jnp.where(vi[None, None, :, :, None], s_sel, -jnp.inf)
        s = jnp.concatenate([s_own, s_sel.reshape(B, H, MB_QCHUNK, kk * MB_BLOCK)], axis=-1)
        w = jax.nn.softmax(s, axis=-1)
        w_own = w[..., :MB_BLOCK].astype(v.dtype)
        w_sel = w[..., MB_BLOCK:].reshape(B, H, MB_QCHUNK, kk, MB_BLOCK).astype(v.dtype)
        return (jnp.einsum('bhqk,bhkd->bhqd', w_own, v_own)
                + jnp.einsum('bhqjk,bhqjkd->bhqd', w_sel, v_sel))

    out = lax.map(step, (qc, idxc, validc, chunk_ids))
    out = out.transpose(1, 0, 3, 2, 4).reshape(B, s_pad, H, Dh)[:, :S]
    return out.reshape(B, S, H * Dh)


def hgrn2_scan(q, k, v, logf):
    B, S, H, DK = q.shape
    DV = v.shape[-1]
    n = S // HG_CHUNK

    def to_chunks(a):
        return a.astype(jnp.float32).reshape(B, n, HG_CHUNK, H, a.shape[-1]).transpose(1, 0, 3, 2, 4)

    qc, kc, vc, fc = to_chunks(q), to_chunks(k), to_chunks(v), to_chunks(logf)
    causal = jnp.tril(jnp.ones((HG_CHUNK, HG_CHUNK), dtype=bool))

    def step(state, xs):
        qi, ki, vi, fi = xs
        b = jnp.cumsum(fi, axis=2)
        o_inter = jnp.einsum('bhck,bhkv->bhcv', qi * jnp.exp(b), state)
        diff = b[:, :, :, None, :] - b[:, :, None, :, :]
        decay = jnp.exp(jnp.where(causal[None, None, :, :, None], diff, -jnp.inf))
        attn = jnp.einsum('bhtk,bhsk,bhtsk->bhts', qi, ki, decay)
        o_intra = jnp.einsum('bhts,bhsv->bhtv', attn, vi)
        b_last = b[:, :, -1:, :]
        new_state = (state * jnp.exp(b_last[:, :, 0, :, None])
                     + jnp.einsum('bhsk,bhsv->bhkv', ki * jnp.exp(b_last - b), vi))
        return new_state, o_inter + o_intra

    state0 = jnp.zeros((B, H, DK, DV), jnp.float32)
    _, ys = lax.scan(step, state0, (qc, kc, vc, fc))
    return ys.transpose(1, 0, 3, 2, 4).reshape(B, S, H, DV).astype(q.dtype)


def setup_inputs(seed: int = 0) -> dict:
    key = jax.random.key(seed)
    ks = jax.random.split(key, 16)
    f32 = jnp.float32

    def nrm(k, shape, scale):
        return jax.random.normal(k, shape, f32) * scale

    return {
        "x": nrm(ks[0], (BATCH, SEQ, D_MODEL), 1.0),
        "p": nrm(ks[1], (DEPTH, BATCH, SEQ, PLE_DIM), 1.0),
        "w_ffn1_gu": nrm(ks[2], (DEPTH, D_MODEL, 2 * D_FF), D_MODEL ** -0.5),
        "w_ffn1_down": nrm(ks[3], (DEPTH, D_FF, D_MODEL), D_FF ** -0.5),
        "w_in": nrm(ks[4], (DEPTH, D_MODEL, IN_COLS), D_MODEL ** -0.5),
        "w_branch_a": nrm(ks[5], (DEPTH, MB_WIDTH, D_MODEL), MB_WIDTH ** -0.5),
        "w_branch_b": nrm(ks[6], (DEPTH, HG_WIDTH, D_MODEL), HG_WIDTH ** -0.5),
        "w_out": nrm(ks[7], (DEPTH, D_MODEL, D_MODEL), D_MODEL ** -0.5),
        "w_ffn2_gu": nrm(ks[8], (DEPTH, D_MODEL, 2 * D_FF), D_MODEL ** -0.5),
        "w_ffn2_down": nrm(ks[9], (DEPTH, D_FF, D_MODEL), D_FF ** -0.5),
        "w_ple": nrm(ks[10], (DEPTH, PLE_DIM, D_MODEL), PLE_DIM ** -0.5),
        "w_ple_gate": nrm(ks[11], (DEPTH, D_MODEL, D_MODEL), D_MODEL ** -0.5),
        "norm_gains": 1.0 + nrm(ks[12], (DEPTH, N_NORMS, D_MODEL), 0.1),
        "hg_norm_w": 1.0 + nrm(ks[13], (DEPTH, HG_DV), 0.1),
        "lb_param": nrm(ks[14], (DEPTH + 1, HG_KEY_WIDTH), 0.5),
        "rel_table": nrm(ks[15], (REL_BUCKETS, MB_HEADS), 0.5),
    }


def reference(x, p, w_ffn1_gu, w_ffn1_down, w_in, w_branch_a, w_branch_b, w_out,
              w_ffn2_gu, w_ffn2_down, w_ple, w_ple_gate, norm_gains, hg_norm_w,
              lb_param, rel_table):
    B, S, _ = x.shape
    offsets = np.cumsum(SPLIT_SIZES)[:-1].tolist()
    lbs = jnp.cumsum(jax.nn.softmax(lb_param.astype(jnp.float32), axis=0), axis=0)
    h = x
    for i in range(DEPTH):
        g = norm_gains[i]
        h = h + 0.5 * rmsnorm(swiglu(rmsnorm(h, g[0]), w_ffn1_gu[i], w_ffn1_down[i]), g[1])

        u = rmsnorm(h, g[2])
        z = u @ w_in[i]
        mq, mk, mv, hq, hf, hi, hg, ga, gb = jnp.split(z, offsets, axis=-1)

        o_a = moba_attention(mq.reshape(B, S, MB_HEADS, MB_HEAD_DIM),
                             mk.reshape(B, S, MB_HEADS, MB_HEAD_DIM),
                             mv.reshape(B, S, MB_HEADS, MB_HEAD_DIM), rel_table)

        lb = lbs[i].reshape(HG_HEADS, HG_DK)
        f = lb + (1.0 - lb) * jax.nn.sigmoid(hf.astype(jnp.float32).reshape(B, S, HG_HEADS, HG_DK))
        logf = jnp.log(f)
        k_in = (1.0 - f).astype(x.dtype)
        o_b = hgrn2_scan(jax.nn.silu(hq).reshape(B, S, HG_HEADS, HG_DK), k_in,
                         hi.reshape(B, S, HG_HEADS, HG_DV), logf)
        o_b = rmsnorm(o_b, hg_norm_w[i]).reshape(B, S, HG_WIDTH) * jax.nn.silu(hg)

        merged = (jax.nn.sigmoid(ga) * (o_a @ w_branch_a[i])
                  + jax.nn.sigmoid(gb) * (o_b @ w_branch_b[i]))
        h = h + rmsnorm(merged @ w_out[i], g[3])

        h = h + 0.5 * rmsnorm(swiglu(rmsnorm(h, g[4]), w_ffn2_gu[i], w_ffn2_down[i]), g[5])

        e = p[i] @ w_ple[i]
        h = h + rmsnorm(jax.nn.sigmoid(h @ w_ple_gate[i]) * e, g[6])
    return h
```

```cpp
#include <hip/hip_runtime.h>
#include <cstdio>
#include <cstdint>
namespace pg8 {
#define PG8_LAS __attribute__((address_space(3)))
typedef unsigned short bf16_t;
typedef short bf16x8 __attribute__((ext_vector_type(8)));
typedef float f32x4 __attribute__((ext_vector_type(4)));
typedef unsigned u32x4 __attribute__((ext_vector_type(4)));
constexpr int BM = 256, BK = 64, HALF = 128, HTB = HALF * BK * 2  , STAGE_BYTES = 8 * HTB, NXCD = 8, WGM = 8;

__host__ __device__ __forceinline__ int lds_byte(int r, int c) { const int st = (r >> 4) * 2 + (c >> 5), rr = r & 15, cc = c & 31, ob = rr * 64 + cc * 2; return st * 1024 + (ob ^ (((ob >> 9) & 1) << 5)); }
__host__ __device__ __forceinline__ void stage_rc(int b, int& R, int& C) { const int st = b / 1024, sb = b % 1024, swz = sb ^ (((sb >> 9) & 1) << 5); R = (st >> 1) * 16 + swz / 64; C = (st & 1) * 32 + (swz % 64) / 2; }
__host__ __device__ __forceinline__ int perm32(int rho) { const int n = rho >> 4, i = rho & 15; return 8 * (i >> 2) + 4 * n + (i & 3); }

struct Unit { int pm, pn; };
struct Gemm { const bf16_t* A; const bf16_t* Bt; int M, N, K; };

struct StaticOrder {
    int nM, nN, nwg, G, c;
    __host__ __device__ void init(int M, int N, int G_, int c_) { nM = M / BM; nN = N / BM; nwg = nM * nN; G = G_; c = c_; }
    __host__ __device__ bool next(int i, Unit& u) const {
        const long L = (long)i * G + c; if (L >= nwg) return false;
        int wgid = (int)L; { const int q = nwg / NXCD, r = nwg % NXCD, xcd = wgid % NXCD, off = wgid / NXCD; wgid = (xcd < r ? xcd * (q + 1) : r * (q + 1) + (xcd - r) * q) + off; }
        const int nig = WGM * nN, gid = wgid / nig, fm = gid * WGM, gsz = (nM - fm) < WGM ? (nM - fm) : WGM;
        u.pm = fm + ((wgid % nig) % gsz); u.pn = (wgid % nig) / gsz; return true;
    }
    __device__ __forceinline__ void a_ready(const Unit&) const {}
    __device__ __forceinline__ void done(const Unit&) const {}
};

typedef float f32x2_t __attribute__((ext_vector_type(2))); typedef __bf16 bf16x2_t __attribute__((ext_vector_type(2)));
__device__ __forceinline__ unsigned cvt_pk_bf16(float lo, float hi) { f32x2_t v = {lo, hi}; bf16x2_t b = __builtin_convertvector(v, bf16x2_t); return __builtin_bit_cast(unsigned, b); }
__device__ __forceinline__ float sigm(float x) { return __builtin_amdgcn_rcpf(1.0f + __builtin_amdgcn_exp2f(-1.4426950408889634f * x)); }
__device__ __forceinline__ float bf_lo(unsigned w) { return __uint_as_float(w << 16); }
__device__ __forceinline__ float bf_hi(unsigned w) { return __uint_as_float(w & 0xffff0000u); }
__device__ __forceinline__ void unpack8(const u32x4 w, float (&o)[8]) { o[0] = bf_lo(w.x); o[1] = bf_hi(w.x); o[2] = bf_lo(w.y); o[3] = bf_hi(w.y); o[4] = bf_lo(w.z); o[5] = bf_hi(w.z); o[6] = bf_lo(w.w); o[7] = bf_hi(w.w); }
__device__ __forceinline__ u32x4 pack8(const float (&o)[8]) { u32x4 w; w.x = cvt_pk_bf16(o[0], o[1]); w.y = cvt_pk_bf16(o[2], o[3]); w.z = cvt_pk_bf16(o[4], o[5]); w.w = cvt_pk_bf16(o[6], o[7]); return w; }

struct EpiGU {
    static constexpr bool PERM = true, AFTER_DRAIN = false;
    bf16_t* H; int ldh;
    __device__ __forceinline__ void operator()(const f32x4 (&acc)[2][2][4][2], const Unit& u, int wr, int wc, int fr, int fq) const {
        const int row0 = u.pm * BM + wr * 64 + fr, col0 = u.pn * HALF + wc * 32 + 8 * fq;
#pragma unroll
        for (int ai = 0; ai < 2; ++ai)
#pragma unroll
            for (int m = 0; m < 4; ++m) { bf16_t* rowp = H + (size_t)(row0 + ai * HALF + m * 16) * ldh + col0;
                const f32x4 g0 = acc[ai][0][m][0], g1 = acc[ai][0][m][1], u0 = acc[ai][1][m][0], u1 = acc[ai][1][m][1]; float o[8];
#pragma unroll
                for (int j = 0; j < 4; ++j) { o[j] = g0[j] * sigm(g0[j]) * u0[j]; o[4 + j] = g1[j] * sigm(g1[j]) * u1[j]; }
                *(u32x4*)rowp = pack8(o); }
    }
};
struct EpiF32 {
    static constexpr bool PERM = false, AFTER_DRAIN = false;
    float* C; int ldc;
    __device__ __forceinline__ void operator()(const f32x4 (&acc)[2][2][4][2], const Unit& u, int wr, int wc, int fr, int fq) const {
        const int row0 = u.pm * BM + wr * 64 + fr, col0 = u.pn * BM + wc * 32 + 4 * fq;
#pragma unroll
        for (int ai = 0; ai < 2; ++ai)
#pragma unroll
            for (int m = 0; m < 4; ++m) { float* rowp = C + (size_t)(row0 + ai * HALF + m * 16) * ldc + col0;
#pragma unroll
                for (int bj = 0; bj < 2; ++bj)
#pragma unroll
                    for (int n = 0; n < 2; ++n) *(f32x4*)(rowp + bj * HALF + n * 16) = acc[ai][bj][m][n]; }
    }
};
struct EpiIN {
    static constexpr bool PERM = true, AFTER_DRAIN = false;
    bf16_t *Q, *K, *V, *HQ, *KIN, *HI, *HG, *SA, *SB; const float* LB; float* KMEAN;
    template <int MODE> __device__ __forceinline__ void body(const f32x4 (&acc)[2][2][4][2], bf16_t* base, int ldc, int row0, int cbase, int pm, int fr) const {
        float lbv[2][8]; float ks[2][8];
#pragma unroll
        for (int bj = 0; bj < 2; ++bj)
#pragma unroll
            for (int j = 0; j < 8; ++j) { lbv[bj][j] = (MODE == 2) ? (1.0f - LB[cbase + bj * HALF + j]) : 0.f; ks[bj][j] = 0.f; }
#pragma unroll
        for (int ai = 0; ai < 2; ++ai)
#pragma unroll
            for (int m = 0; m < 4; ++m) { bf16_t* rowp = base + (size_t)(row0 + ai * HALF + m * 16) * ldc + cbase;
#pragma unroll
                for (int bj = 0; bj < 2; ++bj) { const f32x4 v0 = acc[ai][bj][m][0], v1 = acc[ai][bj][m][1]; float o[8];
#pragma unroll
                    for (int j = 0; j < 4; ++j) { o[j] = v0[j]; o[4 + j] = v1[j]; }
#pragma unroll
                    for (int j = 0; j < 8; ++j) {
                        if (MODE == 1) o[j] = o[j] * sigm(o[j]);
                        if (MODE == 2) o[j] = lbv[bj][j] * sigm(-o[j]);
                        if (MODE == 3) o[j] = sigm(o[j]);
                        if (MODE == 4) ks[bj][j] += o[j]; }
                    *(u32x4*)(rowp + bj * HALF) = pack8(o); } }
        if (MODE == 4) {
#pragma unroll
            for (int bj = 0; bj < 2; ++bj)
#pragma unroll
                for (int j = 0; j < 8; ++j) { float s = ks[bj][j]; s += __shfl_xor(s, 1); s += __shfl_xor(s, 2); s += __shfl_xor(s, 4); s += __shfl_xor(s, 8);
                    if (fr == 0) atomicAdd(KMEAN + (size_t)pm * 512 + cbase + bj * HALF + j, s); }
        }
    }
    __device__ __forceinline__ void operator()(const f32x4 (&acc)[2][2][4][2], const Unit& u, int wr, int wc, int fr, int fq) const {
        const int pn = u.pn, row0 = u.pm * BM + wr * 64 + fr, cw = wc * 32 + 8 * fq;
        if (pn < 2)       body<0>(acc, Q,   512,  row0, (pn)      * BM + cw, u.pm, fr);
        else if (pn < 4)  body<4>(acc, K,   512,  row0, (pn - 2)  * BM + cw, u.pm, fr);
        else if (pn < 6)  body<0>(acc, V,   512,  row0, (pn - 4)  * BM + cw, u.pm, fr);
        else if (pn < 8)  body<1>(acc, HQ,  512,  row0, (pn - 6)  * BM + cw, u.pm, fr);
        else if (pn < 10) body<2>(acc, KIN, 512,  row0, (pn - 8)  * BM + cw, u.pm, fr);
        else if (pn < 12) body<0>(acc, HI,  512,  row0, (pn - 10) * BM + cw, u.pm, fr);
        else if (pn < 14) body<1>(acc, HG,  512,  row0, (pn - 12) * BM + cw, u.pm, fr);
        else if (pn < 18) body<3>(acc, SA,  1024, row0, (pn - 14) * BM + cw, u.pm, fr);
        else              body<3>(acc, SB,  1024, row0, (pn - 18) * BM + cw, u.pm, fr);
    }
};
template <int MODE> struct EpiMix {
    static constexpr bool PERM = true, AFTER_DRAIN = false;
    bf16_t* T; const bf16_t* S2; int ldc;
    __device__ __forceinline__ void operator()(const f32x4 (&acc)[2][2][4][2], const Unit& u, int wr, int wc, int fr, int fq) const {
        const int row0 = u.pm * BM + wr * 64 + fr, col0 = u.pn * BM + wc * 32 + 8 * fq;
#pragma unroll
        for (int ai = 0; ai < 2; ++ai)
#pragma unroll
            for (int m = 0; m < 4; ++m) { const size_t off = (size_t)(row0 + ai * HALF + m * 16) * ldc + col0;
#pragma unroll
                for (int bj = 0; bj < 2; ++bj) { const f32x4 v0 = acc[ai][bj][m][0], v1 = acc[ai][bj][m][1]; float o[8];
#pragma unroll
                    for (int j = 0; j < 4; ++j) { o[j] = v0[j]; o[4 + j] = v1[j]; }
                    if (MODE == 1) { float t[8]; unpack8(*(const u32x4*)(T + off + bj * HALF), t);
#pragma unroll
                        for (int j = 0; j < 8; ++j) o[j] = t[j] * o[j]; }
                    if (MODE == 2) { float t[8], s[8]; unpack8(*(const u32x4*)(T + off + bj * HALF), t); unpack8(*(const u32x4*)(S2 + off + bj * HALF), s);
#pragma unroll
                        for (int j = 0; j < 8; ++j) o[j] = t[j] + s[j] * o[j]; }
                    *(u32x4*)(T + off + bj * HALF) = pack8(o); } }
    }
};
struct EpiPleB {
    static constexpr bool PERM = true, AFTER_DRAIN = false;
    const bf16_t* E; float* Y; int ldc;
    __device__ __forceinline__ void operator()(const f32x4 (&acc)[2][2][4][2], const Unit& u, int wr, int wc, int fr, int fq) const {
        const int row0 = u.pm * BM + wr * 64 + fr, col0 = u.pn * BM + wc * 32 + 8 * fq;
#pragma unroll
        for (int ai = 0; ai < 2; ++ai)
#pragma unroll
            for (int m = 0; m < 4; ++m) { const size_t off = (size_t)(row0 + ai * HALF + m * 16) * ldc + col0;
#pragma unroll
                for (int bj = 0; bj < 2; ++bj) { const f32x4 v0 = acc[ai][bj][m][0], v1 = acc[ai][bj][m][1]; float e[8]; unpack8(*(const u32x4*)(E + off + bj * HALF), e);
                    f32x4 o0, o1;
#pragma unroll
                    for (int j = 0; j < 4; ++j) { o0[j] = sigm(v0[j]) * e[j]; o1[j] = sigm(v1[j]) * e[4 + j]; }
                    *(f32x4*)(Y + off + bj * HALF) = o0; *(f32x4*)(Y + off + bj * HALF + 4) = o1; } }
    }
};

template <class Epi, class Sched, bool ALIGN_EPI = false, bool SP2 = false>
__device__ __forceinline__ void gemm_phase(PG8_LAS unsigned char* lds, const Gemm g, const Sched& S, const Epi& E) {
    int tid_ = threadIdx.x; asm volatile("" : "+v"(tid_));
    const int tid = tid_, wid = __builtin_amdgcn_readfirstlane(tid >> 6), lane = tid & 63, wr = wid >> 2, wc = wid & 3, fr = lane & 15, fq = lane >> 4;
    int K_ = g.K; asm volatile("" : "+s"(K_));
    const int K = K_, nt = K / BK;
    unsigned voffA[2], voffB[2];
#pragma unroll
    for (int i = 0; i < 2; ++i) { int R, C; stage_rc(tid * 16 + i * 8192, R, C); const int Rb = Epi::PERM ? ((R & ~31) + perm32(R & 31)) : R;
        voffA[i] = (unsigned)(R * K + C) * 2u; voffB[i] = (unsigned)(Rb * K + C) * 2u; }
    const size_t kstep = (size_t)(BK * 2);
    const size_t hstep = (size_t)HALF * K * 2;
    const size_t tstep = 2 * hstep;
    const unsigned ldsw = (unsigned)wid * 1024u;
    const int aoff = lds_byte(wr * 64 + fr, fq * 8), boff = lds_byte(wc * 32 + fr, fq * 8);
#define PG8_SA(b, h) (((b) * 2 + (h)) * HTB)
#define PG8_SB(b, h) ((4 + (b) * 2 + (h)) * HTB)
#define PG8_STAGE(bufoff, gbase, voff) do { _Pragma("unroll") for (int _i = 0; _i < 2; ++_i) \
        __builtin_amdgcn_global_load_lds((const unsigned*)((const char*)(gbase) + (voff)[_i]), (PG8_LAS unsigned*)(lds + (bufoff) + ldsw + _i * 8192), 16, 0, 0); } while (0)
#define PG8_LDA(dst, b, h) do { _Pragma("unroll") for (int m = 0; m < 4; ++m) _Pragma("unroll") for (int k = 0; k < 2; ++k) dst[m][k] = *(const PG8_LAS bf16x8*)(lds + PG8_SA(b, h) + aoff + m * 2048 + k * 1024); } while (0)
#define PG8_LDB(dst, b, h) do { _Pragma("unroll") for (int n = 0; n < 2; ++n) _Pragma("unroll") for (int k = 0; k < 2; ++k) dst[n][k] = *(const PG8_LAS bf16x8*)(lds + PG8_SB(b, h) + boff + n * 2048 + k * 1024); } while (0)
#define PG8_MMA(ai, bj, At, Bt) do { __builtin_amdgcn_s_setprio(1); _Pragma("unroll") for (int m = 0; m < 4; ++m) _Pragma("unroll") for (int n = 0; n < 2; ++n) _Pragma("unroll") for (int k = 0; k < 2; ++k) \
        acc[ai][bj][m][n] = __builtin_amdgcn_mfma_f32_16x16x32_bf16(Bt[n][k], At[m][k], acc[ai][bj][m][n], 0, 0, 0); __builtin_amdgcn_s_setprio(0); } while (0)
#define PG8_WAIT_V(n) asm volatile("s_waitcnt vmcnt(" #n ")" ::: "memory")
#define PG8_WAIT_L(n) asm volatile("s_waitcnt lgkmcnt(" #n ")" ::: "memory")
#define PG8_BAR __builtin_amdgcn_s_barrier()
#define PG8_SCHED __builtin_amdgcn_sched_barrier(0)
    Unit cur, nxt; int ui = 0;
    if (!S.next(0, cur)) return;
    f32x4 acc[2][2][4][2];
#pragma unroll
    for (int a = 0; a < 2; ++a)
#pragma unroll
        for (int b = 0; b < 2; ++b)
#pragma unroll
            for (int m = 0; m < 4; ++m)
#pragma unroll
                for (int n = 0; n < 2; ++n) acc[a][b][m][n] = (f32x4){0.f, 0.f, 0.f, 0.f};
    bf16x8 At[4][2], B0[2][2], B1[2][2];
    const char* cA = (const char*)g.A + (size_t)cur.pm * tstep; const char* cB = (const char*)g.Bt + (size_t)cur.pn * tstep;
    S.a_ready(cur);
    if constexpr (SP2) {
        PG8_STAGE(PG8_SB(0, 0), cB, voffB); PG8_STAGE(PG8_SB(0, 1), cB + hstep, voffB); PG8_STAGE(PG8_SA(0, 0), cA, voffA); PG8_STAGE(PG8_SA(0, 1), cA + hstep, voffA);
        if (wr == 1) PG8_BAR;
        PG8_WAIT_V(2); PG8_BAR;
        PG8_STAGE(PG8_SB(1, 0), cB + kstep, voffB); PG8_STAGE(PG8_SA(1, 0), cA + kstep, voffA); PG8_STAGE(PG8_SB(1, 1), cB + hstep + kstep, voffB);
        PG8_WAIT_V(6); PG8_BAR;
    } else {
        PG8_STAGE(PG8_SB(0, 0), cB, voffB); PG8_STAGE(PG8_SA(0, 0), cA, voffA); PG8_STAGE(PG8_SB(0, 1), cB + hstep, voffB); PG8_STAGE(PG8_SA(0, 1), cA + hstep, voffA);
        if (wr == 1) PG8_BAR;
        PG8_WAIT_V(4); PG8_BAR;
        PG8_STAGE(PG8_SB(1, 0), cB + kstep, voffB); PG8_STAGE(PG8_SA(1, 0), cA + kstep, voffA); PG8_STAGE(PG8_SB(1, 1), cB + hstep + kstep, voffB);
        PG8_WAIT_V(6); PG8_BAR;
    }
    for (;;) {
        const bool has_next = S.next(ui + 1, nxt);
        const char* nA = has_next ? (const char*)g.A + (size_t)nxt.pm * tstep : cA; const char* nB = has_next ? (const char*)g.Bt + (size_t)nxt.pn * tstep : cB;
        for (int t = 0; t < nt; t += 2) {
            const bool last = (t == nt - 2);
            const char* a1 = cA + (size_t)(t + 1) * kstep;
            const char* a2 = last ? nA : cA + (size_t)(t + 2) * kstep; const char* b2 = last ? nB : cB + (size_t)(t + 2) * kstep;
            const char* a3 = a2 + kstep; const char* b3 = b2 + kstep;
            if (last && has_next) S.a_ready(nxt);
            if constexpr (SP2) {
            PG8_LDB(B0, 0, 0); PG8_LDB(B1, 0, 1); PG8_SCHED; PG8_LDA(At, 0, 0); PG8_STAGE(PG8_SA(1, 1), a1 + hstep, voffA);
            PG8_WAIT_V(8); PG8_WAIT_L(0); PG8_BAR; PG8_MMA(0, 0, At, B0); PG8_MMA(0, 1, At, B1); PG8_BAR; PG8_SCHED;
            PG8_LDA(At, 0, 1); PG8_STAGE(PG8_SB(0, 0), b2, voffB); PG8_STAGE(PG8_SB(0, 1), b2 + hstep, voffB); PG8_STAGE(PG8_SA(0, 0), a2, voffA);
            PG8_WAIT_V(8); PG8_WAIT_L(0); PG8_BAR; PG8_MMA(1, 0, At, B0); PG8_MMA(1, 1, At, B1); PG8_BAR; PG8_SCHED;
            PG8_LDB(B0, 1, 0); PG8_LDB(B1, 1, 1); PG8_SCHED; PG8_LDA(At, 1, 0); PG8_STAGE(PG8_SA(0, 1), a2 + hstep, voffA);
            PG8_WAIT_V(8); PG8_WAIT_L(0); PG8_BAR; PG8_MMA(0, 0, At, B0); PG8_MMA(0, 1, At, B1); PG8_BAR; PG8_SCHED;
            PG8_LDA(At, 1, 1); PG8_STAGE(PG8_SB(1, 0), b3, voffB); PG8_STAGE(PG8_SB(1, 1), b3 + hstep, voffB); PG8_STAGE(PG8_SA(1, 0), a3, voffA);
            PG8_WAIT_V(8); PG8_WAIT_L(0); PG8_BAR; PG8_MMA(1, 0, At, B0); PG8_MMA(1, 1, At, B1); PG8_BAR; PG8_SCHED;
            } else {
            PG8_LDB(B0, 0, 0); PG8_SCHED; PG8_LDA(At, 0, 0); PG8_STAGE(PG8_SA(1, 1), a1 + hstep, voffA);
            PG8_WAIT_L(8); PG8_BAR; PG8_WAIT_L(0); PG8_MMA(0, 0, At, B0); PG8_BAR; PG8_SCHED;
            PG8_LDB(B1, 0, 1); PG8_STAGE(PG8_SB(0, 0), b2, voffB);
            PG8_BAR; PG8_WAIT_L(0); PG8_MMA(0, 1, At, B1); PG8_BAR;
            PG8_LDA(At, 0, 1); PG8_STAGE(PG8_SA(0, 0), a2, voffA);
            PG8_BAR; PG8_WAIT_L(0); PG8_MMA(1, 0, At, B0); PG8_BAR; PG8_SCHED;
            PG8_STAGE(PG8_SB(0, 1), b2 + hstep, voffB);
            PG8_WAIT_V(6); PG8_BAR; PG8_MMA(1, 1, At, B1); PG8_BAR;
            PG8_LDB(B0, 1, 0); PG8_SCHED; PG8_LDA(At, 1, 0); PG8_STAGE(PG8_SA(0, 1), a2 + hstep, voffA);
            PG8_WAIT_L(8); PG8_BAR; PG8_WAIT_L(0); PG8_MMA(0, 0, At, B0); PG8_BAR; PG8_SCHED;
            PG8_LDB(B1, 1, 1); PG8_STAGE(PG8_SB(1, 0), b3, voffB);
            PG8_BAR; PG8_WAIT_L(0); PG8_MMA(0, 1, At, B1); PG8_BAR;
            PG8_LDA(At, 1, 1); PG8_STAGE(PG8_SA(1, 0), a3, voffA);
            PG8_BAR; PG8_WAIT_L(0); PG8_MMA(1, 0, At, B0); PG8_BAR; PG8_SCHED;
            PG8_STAGE(PG8_SB(1, 1), b3 + hstep, voffB);
            PG8_WAIT_V(6); PG8_BAR; PG8_MMA(1, 1, At, B1); PG8_BAR;
            }
        }
        if constexpr (ALIGN_EPI) { if (wr == 0) PG8_BAR; }
        if constexpr (!Epi::AFTER_DRAIN) { E(acc, cur, wr, wc, fr, fq); S.done(cur); }
        if (!has_next) break;
#pragma unroll
        for (int a = 0; a < 2; ++a)
#pragma unroll
            for (int b = 0; b < 2; ++b)
#pragma unroll
                for (int m = 0; m < 4; ++m)
#pragma unroll
                    for (int n = 0; n < 2; ++n) acc[a][b][m][n] = (f32x4){0.f, 0.f, 0.f, 0.f};
        cur = nxt; cA = nA; cB = nB; ++ui;
        if constexpr (ALIGN_EPI) { if (wr == 1) PG8_BAR; }
    }
    PG8_WAIT_V(0);
    if constexpr (!ALIGN_EPI) { if (wr == 0) PG8_BAR; }
    PG8_BAR;
    if constexpr (Epi::AFTER_DRAIN) { E.fused(acc, cur, wr, wc, fr, fq, lds, wid, lane); S.done(cur); }
#undef PG8_SA
#undef PG8_SB
#undef PG8_STAGE
#undef PG8_LDA
#undef PG8_LDB
#undef PG8_MMA
#undef PG8_WAIT_V
#undef PG8_WAIT_L
#undef PG8_BAR
#undef PG8_SCHED
}
}
#ifndef PG8_SP2
#define PG8_SP2 true
#endif
#ifndef PG8_ALIGN
#define PG8_ALIGN true
#endif
constexpr int NWAVES = 8;
constexpr int BATCH = 4, SEQ = 8192, D = 1024, FF = 2816, NGU = 2 * FF, NIN = 5632, PLE = 256;
constexpr int M = BATCH * SEQ;
constexpr int MBH = 8, MBD = 64, MBW = 512, MBB = 256, NBLK = SEQ / MBB;
constexpr int HGH = 4, HGD_ = 128, HGW = 512, HGC = 256, HGNC = SEQ / HGC;
constexpr float EPS = 1e-6f;
constexpr size_t MiB = 1u << 20;
constexpr size_t WS_CTL = 0, CTL_ZERO_BYTES = 1 * MiB;
constexpr size_t WS_KMEAN = 512 * 1024;
constexpr size_t WS_LB = 768 * 1024, WS_BIAST = 772 * 1024;
constexpr size_t WS_WGU1 = 1 * MiB, WS_WD1 = 12 * MiB, WS_WIN = WS_WD1 + 5632 * 1024, WS_WA = WS_WIN + 11 * MiB, WS_WB = WS_WA + 1 * MiB, WS_WOUT = WS_WB + 1 * MiB,
                 WS_WGU2 = WS_WOUT + 2 * MiB, WS_WD2 = WS_WGU2 + 11 * MiB, WS_WPLE = WS_WD2 + 5632 * 1024, WS_WPG = WS_WPLE + 512 * 1024, WS_HGD = WS_WPG + 2 * MiB;
constexpr size_t WS_A = 52 * MiB;
constexpr size_t WS_Q = WS_A, WS_K = WS_A + 32 * MiB, WS_V = WS_A + 64 * MiB, WS_HQ = WS_A + 96 * MiB, WS_HI = WS_A + 128 * MiB;
constexpr size_t WS_HS = 212 * MiB;
constexpr size_t WS_PB = 228 * MiB;
constexpr size_t WS_SB = 244 * MiB;
constexpr size_t WS_TOP = 308 * MiB;
constexpr size_t WS_B = 320 * MiB;
constexpr size_t WS_KIN = WS_B, WS_HG = WS_B + 32 * MiB, WS_SA = WS_B + 64 * MiB;
constexpr size_t WS_C = 448 * MiB;
constexpr size_t WS_OA = WS_C, WS_OB = WS_C + 32 * MiB;
constexpr size_t WS_END = 512 * MiB;
static_assert(WS_HGD + 256 * 1024 <= WS_A, "weights region");
constexpr int CW_TMO = 0, CW_CODE = 1, CW_BAR = 4096;
constexpr int RING_OFF = 0, RING_BYTES = 131072, LDSCTL_OFF = RING_BYTES, MISC_OFF = LDSCTL_OFF + 320, LDS_BYTES = 147456;
#define GAS __attribute__((address_space(1)))
#define LAS __attribute__((address_space(3)))
typedef unsigned short bf16;
typedef unsigned v4u __attribute__((ext_vector_type(4)));
typedef unsigned v2u __attribute__((ext_vector_type(2)));
typedef float f32x4 __attribute__((ext_vector_type(4)));
typedef GAS unsigned gu32;
#define RLX_AGENT __ATOMIC_RELAXED, __HIP_MEMORY_SCOPE_AGENT
#define LDS_WAIT() asm volatile("s_waitcnt lgkmcnt(0)" ::: "memory")
#define VM_WAIT() asm volatile("s_waitcnt vmcnt(0)" ::: "memory")
__device__ __forceinline__ unsigned f2bf(float f) { unsigned u = __builtin_bit_cast(unsigned, f); return (u + 0x7fffu + ((u >> 16) & 1u)) >> 16; }
__device__ __forceinline__ unsigned pk2(float lo, float hi) { return f2bf(lo) | (f2bf(hi) << 16); }
__device__ __forceinline__ float bflo(unsigned w) { return __uint_as_float(w << 16); }
__device__ __forceinline__ float bfhi(unsigned w) { return __uint_as_float(w & 0xffff0000u); }
__device__ __forceinline__ float wave_sum(float v) {
#pragma unroll
    for (int o = 1; o < 64; o <<= 1) v += __shfl_xor(v, o);
    return v;
}
__device__ __forceinline__ float wave_max(float v) {
#pragma unroll
    for (int o = 1; o < 64; o <<= 1) v = fmaxf(v, __shfl_xor(v, o));
    return v;
}
#define XB_TMO      128
#define XB_XCNT(j)  (256  + 64 * (j))
#define XB_XSUB(j)  (1280 + 64 * (j))
#define XB_XGEN(j)  (2304 + 64 * (j))
#define XB_TOP      3328
#define XB_TOPGEN   3392
#define XCD_BAR_WORDS 3456
#define XB_SPIN_CAP (1u << 18)

__device__ __forceinline__ unsigned xb_ld(unsigned* p)              { return __hip_atomic_load(p, __ATOMIC_RELAXED, __HIP_MEMORY_SCOPE_AGENT); }
__device__ __forceinline__ unsigned xb_add(unsigned* p, unsigned v) { return __hip_atomic_fetch_add(p, v, __ATOMIC_RELAXED, __HIP_MEMORY_SCOPE_AGENT); }
__device__ __forceinline__ unsigned xb_xcc_id() { return (unsigned)__builtin_amdgcn_s_getreg((3 << 11) | 20) & 0xFu; }
#define XB_SPIN(cond, bar) do { unsigned _sp = 0; while (cond) { __builtin_amdgcn_s_sleep(1); \
    if ((++_sp & 255u) == 0u) { if (xb_ld(&(bar)[XB_TMO])) break; if (_sp > XB_SPIN_CAP) { atomicAdd(&(bar)[XB_TMO], 1u); break; } } } } while (0)

struct XcdBarrier {
    unsigned* bar; unsigned x;
    volatile LAS unsigned* st;
};

__device__ __forceinline__ XcdBarrier xcd_barrier_post(unsigned* bar, volatile LAS unsigned* st) {
    XcdBarrier b; b.bar = bar; b.x = xb_xcc_id(); b.st = st;
    if (threadIdx.x == 0) (void)xb_add(&bar[XB_XCNT(b.x)], 1u);
    return b;
}
__device__ __forceinline__ void xcd_barrier_complete(unsigned* bar, unsigned x, unsigned& nloc, unsigned& nx) {
    const unsigned G = gridDim.x * gridDim.y * gridDim.z;
    unsigned sum, cnt, mine, sp = 0u;
    for (;;) {
        sum = 0u; cnt = 0u; mine = 0u;
#pragma unroll
        for (unsigned j = 0; j < 16; ++j) { const unsigned c = xb_ld(&bar[XB_XCNT(j)]); sum += c; cnt += (c > 0u) ? 1u : 0u; mine = (j == x) ? c : mine; }
        if (sum == G) break;
        __builtin_amdgcn_s_sleep(1);
        if ((++sp & 255u) == 0u) { if (xb_ld(&bar[XB_TMO])) break; if (sp > XB_SPIN_CAP) { atomicAdd(&bar[XB_TMO], 1u); break; } }
    }
    nloc = mine > 0u ? mine : 1u; nx = cnt > 0u ? cnt : 1u;
}

__device__ __forceinline__ void xcd_barrier(const XcdBarrier& b) {
    asm volatile("s_waitcnt vmcnt(0)" ::: "memory");
    __syncthreads();
    if (threadIdx.x == 0) {
        unsigned* bar = b.bar;
        __builtin_amdgcn_s_waitcnt(0);
        unsigned nloc = b.st[0], nx = b.st[1];
        if (nloc == 0u) { xcd_barrier_complete(bar, b.x, nloc, nx); b.st[0] = nloc; b.st[1] = nx; }
        const unsigned old = xb_add(&bar[XB_XSUB(b.x)], 1u);
        const unsigned gen = old / nloc;
        if (old + 1u == (gen + 1u) * nloc) {
            __builtin_amdgcn_fence(__ATOMIC_RELEASE, "agent");
            asm volatile("s_waitcnt vmcnt(0)" ::: "memory");
            const unsigned og = xb_add(&bar[XB_TOP], 1u);
            const unsigned tg = og / nx;
            if (og + 1u == (tg + 1u) * nx) xb_add(&bar[XB_TOPGEN], 1u);
            else XB_SPIN(xb_ld(&bar[XB_TOPGEN]) == tg, bar);
            __builtin_amdgcn_fence(__ATOMIC_ACQUIRE, "agent");
            xb_add(&bar[XB_XGEN(b.x)], 1u);
            asm volatile("s_waitcnt vmcnt(0)" ::: "memory");
        } else {
            XB_SPIN(xb_ld(&bar[XB_XGEN(b.x)]) == gen, bar);
            __builtin_amdgcn_fence(__ATOMIC_ACQUIRE, "agent");
            asm volatile("s_waitcnt vmcnt(0)" ::: "memory");
        }
    }
    __syncthreads();
}
__device__ __forceinline__ void p0_transpose_item(const float* W, int K, int N, bf16* WT, const float* gain, int mode, LAS float* scr, int item, int lane) {
    const int nblk = N / 32, kb = item / nblk, nb = item % nblk, k0 = 64 * kb, n0 = 32 * nb;
#pragma unroll 8
    for (int i = 0; i < 32; ++i) { const int kk = 2 * i + (lane >> 5); float w = W[(size_t)(k0 + kk) * N + n0 + (lane & 31)]; if (gain) w *= gain[k0 + kk]; scr[kk * 33 + (lane & 31)] = w; }
    LDS_WAIT(); asm volatile("" ::: "memory");
    int rbase = n0;
    if (mode == 1) { if (n0 < FF) rbase = (n0 / 128) * 256 + (n0 % 128); else { const int j = n0 - FF; rbase = (j / 128) * 256 + 128 + (j % 128); } }
    const int c = lane & 7;
#pragma unroll
    for (int j = 0; j < 4; ++j) { const int n = (lane >> 3) + 8 * j; const LAS float* s = scr + (8 * c) * 33 + n;
        v4u o; o.x = pk2(s[0 * 33], s[1 * 33]); o.y = pk2(s[2 * 33], s[3 * 33]); o.z = pk2(s[4 * 33], s[5 * 33]); o.w = pk2(s[6 * 33], s[7 * 33]);
        *(GAS v4u*)(WT + (size_t)(rbase + n) * K + k0 + 8 * c) = o; }
    LDS_WAIT(); asm volatile("" ::: "memory");
}
__device__ __forceinline__ void rms_row_to_bf16(const float* xrow, bf16* orow, int lane) {
    const GAS f32x4* xr = (const GAS f32x4*)xrow + lane;
    f32x4 v[4]; float s = 0.f;
#pragma unroll
    for (int j = 0; j < 4; ++j) { v[j] = xr[64 * j]; s += (v[j].x * v[j].x + v[j].y * v[j].y) + (v[j].z * v[j].z + v[j].w * v[j].w); }
    const float rstd = 1.f / sqrtf(wave_sum(s) * (1.f / D) + EPS);
    GAS unsigned long long* o8 = (GAS unsigned long long*)orow + lane;
#pragma unroll
    for (int j = 0; j < 4; ++j) o8[64 * j] = (unsigned long long)pk2(v[j].x * rstd, v[j].y * rstd) | ((unsigned long long)pk2(v[j].z * rstd, v[j].w * rstd) << 32);
}
struct Ptrs {
    const float *x, *p, *w_gu1, *w_d1, *w_in, *w_a, *w_b, *w_out, *w_gu2, *w_d2, *w_ple, *w_pg, *gains, *hgw, *lbp, *rel;
    float* out; unsigned char* ws;
};
__device__ __forceinline__ void p0_prologue(const Ptrs P, LAS unsigned char* lds, int gw, int NGW, int wave, int lane) {
    LAS float* scr = (LAS float*)(lds + RING_OFF + wave * 16384);
    unsigned char* ws = P.ws;
    constexpr int I_GU = (D / 64) * (NGU / 32), I_D = (FF / 64) * (D / 32), I_IN = (D / 64) * (NIN / 32), I_AB = (512 / 64) * (D / 32), I_O = (D / 64) * (D / 32), I_PLE = (PLE / 64) * (D / 32);
    constexpr int NITEMS = 2 * I_GU + 2 * I_D + I_IN + 2 * I_AB + 2 * I_O + I_PLE;
    for (int it = gw; it < NITEMS; it += NGW) {
        int r = it;
        if (r < I_GU) { p0_transpose_item(P.w_gu1, D, NGU, (bf16*)(ws + WS_WGU1), P.gains + 0 * D, 1, scr, r, lane); continue; } r -= I_GU;
        if (r < I_GU) { p0_transpose_item(P.w_gu2, D, NGU, (bf16*)(ws + WS_WGU2), P.gains + 4 * D, 1, scr, r, lane); continue; } r -= I_GU;
        if (r < I_IN) { p0_transpose_item(P.w_in, D, NIN, (bf16*)(ws + WS_WIN), P.gains + 2 * D, 0, scr, r, lane); continue; } r -= I_IN;
        if (r < I_D)  { p0_transpose_item(P.w_d1, FF, D, (bf16*)(ws + WS_WD1), nullptr, 0, scr, r, lane); continue; } r -= I_D;
        if (r < I_D)  { p0_transpose_item(P.w_d2, FF, D, (bf16*)(ws + WS_WD2), nullptr, 0, scr, r, lane); continue; } r -= I_D;
        if (r < I_AB) { p0_transpose_item(P.w_a, 512, D, (bf16*)(ws + WS_WA), nullptr, 0, scr, r, lane); continue; } r -= I_AB;
        if (r < I_AB) { p0_transpose_item(P.w_b, 512, D, (bf16*)(ws + WS_WB), nullptr, 0, scr, r, lane); continue; } r -= I_AB;
        if (r < I_O)  { p0_transpose_item(P.w_out, D, D, (bf16*)(ws + WS_WOUT), nullptr, 0, scr, r, lane); continue; } r -= I_O;
        if (r < I_O)  { p0_transpose_item(P.w_pg, D, D, (bf16*)(ws + WS_WPG), nullptr, 0, scr, r, lane); continue; } r -= I_O;
        p0_transpose_item(P.w_ple, PLE, D, (bf16*)(ws + WS_WPLE), nullptr, 0, scr, r, lane);
    }
    for (int m = gw; m < M; m += NGW) rms_row_to_bf16(P.x + (size_t)m * D, (bf16*)(ws + WS_C) + (size_t)m * D, lane);
    const int gt = gw * 64 + lane;
    if (gt < 512) { const float a = P.lbp[gt], b = P.lbp[512 + gt]; const float mx = fmaxf(a, b); const float ea = expf(a - mx), eb = expf(b - mx); ((float*)(ws + WS_LB))[gt] = ea / (ea + eb); }
    if (gt >= 1024 && gt < 2048) { const int h = (gt - 1024) >> 7, d = (gt - 1024) & 127; int bk;
        if (d < 16) bk = d; else { bk = 16 + (int)(logf((float)d / 16.0f) / logf(8.0f) * 16.0f); if (bk > 31) bk = 31; }
        ((float*)(ws + WS_BIAST))[h * 128 + d] = P.rel[bk * 8 + h]; }
}
template <int MODE> __device__ __forceinline__ void rowwise_phase(int gw, int NGW, int lane, const float* hin, const float* Y, const float* gain, float coef, float* hout, bf16* xn) {
    f32x4 g[4];
#pragma unroll
    for (int j = 0; j < 4; ++j) g[j] = ((const f32x4*)gain)[lane + 64 * j] * coef;
    for (int m = gw; m < M; m += NGW) {
        const GAS f32x4* yr = (const GAS f32x4*)(Y + (size_t)m * D) + lane; const GAS f32x4* hr = (const GAS f32x4*)(hin + (size_t)m * D) + lane;
        f32x4 y[4], h[4]; float s = 0.f;
#pragma unroll
        for (int j = 0; j < 4; ++j) { y[j] = yr[64 * j]; h[j] = hr[64 * j]; s += (y[j].x * y[j].x + y[j].y * y[j].y) + (y[j].z * y[j].z + y[j].w * y[j].w); }
        const float rstd = 1.f / sqrtf(wave_sum(s) * (1.f / D) + EPS);
        float s2 = 0.f;
#pragma unroll
        for (int j = 0; j < 4; ++j) { h[j] = h[j] + (g[j] * y[j]) * rstd; s2 += (h[j].x * h[j].x + h[j].y * h[j].y) + (h[j].z * h[j].z + h[j].w * h[j].w); }
        GAS f32x4* ho = (GAS f32x4*)(hout + (size_t)m * D) + lane;
#pragma unroll
        for (int j = 0; j < 4; ++j) ho[64 * j] = h[j];
        if (MODE != 0) {
            float r2 = 1.f;
            if (MODE == 1) r2 = 1.f / sqrtf(wave_sum(s2) * (1.f / D) + EPS);
            GAS unsigned long long* o8 = (GAS unsigned long long*)(xn + (size_t)m * D) + lane;
#pragma unroll
            for (int j = 0; j < 4; ++j) o8[64 * j] = (unsigned long long)pk2(h[j].x * r2, h[j].y * r2) | ((unsigned long long)pk2(h[j].z * r2, h[j].w * r2) << 32);
        }
    }
}
__device__ __forceinline__ void moba_gating_phase(LAS unsigned char* lds, int vcu, int G, int tid, const bf16* Q, const float* KMEAN, unsigned* TOP) {
    LAS float* km = (LAS float*)lds;
    for (int unit = vcu; unit < BATCH * NBLK * 4; unit += G) {
        const int hp = unit & 3, i = (unit >> 2) & 31, b = unit >> 7;
        __syncthreads();
        for (int e = tid; e < i * 128; e += 512) { const int j = e >> 7, c = e & 127; km[e] = KMEAN[(size_t)(b * NBLK + j) * 512 + hp * 128 + c] * (1.0f / 256.0f); }
        __syncthreads();
        const int hh = tid >> 8, ql = tid & 255, m = b * SEQ + i * MBB + ql, h = 2 * hp + hh;
        float q[64];
        { const v4u* qp = (const v4u*)(Q + (size_t)m * MBW + h * MBD);
#pragma unroll
          for (int c = 0; c < 8; ++c) { const v4u w = qp[c]; q[8 * c + 0] = bflo(w.x); q[8 * c + 1] = bfhi(w.x); q[8 * c + 2] = bflo(w.y); q[8 * c + 3] = bfhi(w.y); q[8 * c + 4] = bflo(w.z); q[8 * c + 5] = bfhi(w.z); q[8 * c + 6] = bflo(w.w); q[8 * c + 7] = bfhi(w.w); } }
        float v0 = -INFINITY, v1 = -INFINITY, v2 = -INFINITY; int i0 = 0, i1 = 0, i2 = 0;
        for (int j = 0; j < i; ++j) {
            const LAS f32x4* kp = (const LAS f32x4*)(km + j * 128 + hh * 64); float s = 0.f;
#pragma unroll
            for (int c = 0; c < 16; ++c) { const f32x4 kv = kp[c]; s += q[4 * c] * kv.x; s += q[4 * c + 1] * kv.y; s += q[4 * c + 2] * kv.z; s += q[4 * c + 3] * kv.w; }
            if (s > v0) { v2 = v1; i2 = i1; v1 = v0; i1 = i0; v0 = s; i0 = j; }
            else if (s > v1) { v2 = v1; i2 = i1; v1 = s; i1 = j; }
            else if (s > v2) { v2 = s; i2 = j; }
        }
        const int nv = i < 3 ? i : 3;
        TOP[(size_t)m * 8 + h] = (unsigned)i0 | ((unsigned)i1 << 8) | ((unsigned)i2 << 16) | ((unsigned)nv << 24);
    }
    __syncthreads();
}
__device__ __forceinline__ void moba_attn_simple_phase(LAS unsigned char* lds, int gw, int NGW, int wave, int lane, const bf16* Q, const bf16* K, const bf16* V, const unsigned* TOP, const float* BIAST, bf16* OA) {
    LAS float* pl = (LAS float*)lds + wave * 1024;
    for (int pair = gw; pair < M * MBH; pair += NGW) {
        const int m = pair >> 3, h = pair & 7, b = m >> 13, t = m & (SEQ - 1), own = t >> 8;
        const unsigned top = TOP[pair]; const int nv = (int)(top >> 24);
        float q[64];
        { const v4u* qp = (const v4u*)(Q + (size_t)m * MBW + h * MBD);
#pragma unroll
          for (int c = 0; c < 8; ++c) { const v4u w = qp[c]; q[8 * c + 0] = bflo(w.x); q[8 * c + 1] = bfhi(w.x); q[8 * c + 2] = bflo(w.y); q[8 * c + 3] = bfhi(w.y); q[8 * c + 4] = bflo(w.z); q[8 * c + 5] = bfhi(w.z); q[8 * c + 6] = bflo(w.w); q[8 * c + 7] = bfhi(w.w); } }
        float sc[16]; float mx = -INFINITY;
#pragma unroll
        for (int s = 0; s < 4; ++s) {
            const bool vs = (s == 0) || (s - 1 < nv);
            const int blk = (s == 0) ? own : (int)((top >> (8 * ((s + 3) & 3))) & 0xffu);
#pragma unroll
            for (int kk = 0; kk < 4; ++kk) {
                const int key = blk * MBB + kk * 64 + lane; float val = -INFINITY;
                if (vs && (s != 0 || key <= t)) {
                    const v4u* kp = (const v4u*)(K + (size_t)(b * SEQ + key) * MBW + h * MBD); float dot = 0.f;
#pragma unroll
                    for (int c = 0; c < 8; ++c) { const v4u w = kp[c]; dot += q[8 * c + 0] * bflo(w.x); dot += q[8 * c + 1] * bfhi(w.x); dot += q[8 * c + 2] * bflo(w.y); dot += q[8 * c + 3] * bfhi(w.y);
                        dot += q[8 * c + 4] * bflo(w.z); dot += q[8 * c + 5] * bfhi(w.z); dot += q[8 * c + 6] * bflo(w.w); dot += q[8 * c + 7] * bfhi(w.w); }
                    int dist = t - key; if (dist > 127) dist = 127;
                    val = dot * 0.125f + BIAST[h * 128 + dist];
                }
                sc[s * 4 + kk] = val; mx = fmaxf(mx, val);
            }
        }
        mx = wave_max(mx);
        float l = 0.f;
#pragma unroll
        for (int i = 0; i < 16; ++i) { const float pv = (sc[i] == -INFINITY) ? 0.f : __expf(sc[i] - mx); l += pv; pl[i * 64 + lane] = pv; }
        l = wave_sum(l);
        LDS_WAIT(); asm volatile("" ::: "memory");
        float o = 0.f;
#pragma unroll
        for (int s = 0; s < 4; ++s) {
            const bool vs = (s == 0) || (s - 1 < nv);
            const int blk = (s == 0) ? own : (int)((top >> (8 * ((s + 3) & 3))) & 0xffu);
            if (vs) {
                const bf16* vp = V + (size_t)(b * SEQ + blk * MBB) * MBW + h * MBD + lane;
#pragma unroll 8
                for (int k2 = 0; k2 < MBB; ++k2) { const float pv = pl[s * 256 + k2]; o += pv * __uint_as_float((unsigned)vp[(size_t)k2 * MBW] << 16); }
            }
        }
        OA[(size_t)m * MBW + h * MBD + lane] = (bf16)f2bf(o / l);
        LDS_WAIT(); asm volatile("" ::: "memory");
    }
}
__device__ __forceinline__ void hgrn_stage_tile(LAS float* dst, const bf16* src, int m0, int h, int tid) {
    const int tok = tid >> 4, ch8 = (tid & 15) * 8; const v4u w = *(const v4u*)(src + (size_t)(m0 + tok) * HGW + h * HGD_ + ch8);
    LAS f32x4* d = (LAS f32x4*)(dst + tok * 128 + ch8);
    d[0] = (f32x4){bflo(w.x), bfhi(w.x), bflo(w.y), bfhi(w.y)}; d[1] = (f32x4){bflo(w.z), bfhi(w.z), bflo(w.w), bfhi(w.w)};
}
template <int STEP> __device__ __forceinline__ void hgrn_chunk_phase(LAS unsigned char* lds, int vcu, int G, int tid, int wave, int lane, const bf16* KIN, const bf16* HI, const bf16* HQ, const bf16* HG, const float* hgw, float* HS, float* HGD, bf16* OB) {
    LAS float* kt = (LAS float*)lds; LAS float* vt = kt + 4096; LAS float* qt = vt + 4096; LAS float* ot = qt + 4096;
    const int v = tid >> 2, ks = tid & 3;
    for (int unit = vcu; unit < BATCH * HGH * HGNC; unit += G) {
        const int c = unit & 31, bh = unit >> 5, b = bh >> 2, h = bh & 3, m0 = b * SEQ + c * HGC;
        f32x4 S[8]; float Dk = 1.f;
        if (STEP == 1) {
#pragma unroll
            for (int j = 0; j < 8; ++j) S[j] = (f32x4){0.f, 0.f, 0.f, 0.f};
        } else {
#pragma unroll
            for (int j = 0; j < 8; ++j) S[j] = *(const f32x4*)(HS + (size_t)unit * 16384 + v * 128 + 16 * j + 4 * ks);
        }
        for (int tile = 0; tile < 8; ++tile) {
            __syncthreads();
            hgrn_stage_tile(kt, KIN, m0 + tile * 32, h, tid); hgrn_stage_tile(vt, HI, m0 + tile * 32, h, tid);
            if (STEP == 3) hgrn_stage_tile(qt, HQ, m0 + tile * 32, h, tid);
            __syncthreads();
            if (STEP == 1 && tid < 128) { for (int t = 0; t < 32; ++t) Dk *= (1.0f - kt[t * 128 + tid]); }
            for (int t = 0; t < 32; ++t) {
                const float vv = vt[t * 128 + v]; float op = 0.f;
#pragma unroll
                for (int j = 0; j < 8; ++j) { const f32x4 k4 = *(const LAS f32x4*)(kt + t * 128 + 16 * j + 4 * ks);
                    S[j] = (1.0f - k4) * S[j] + k4 * vv;
                    if (STEP == 3) { const f32x4 q4 = *(const LAS f32x4*)(qt + t * 128 + 16 * j + 4 * ks); op += (S[j].x * q4.x + S[j].y * q4.y) + (S[j].z * q4.z + S[j].w * q4.w); } }
                if (STEP == 3) { op += __shfl_xor(op, 1); op += __shfl_xor(op, 2); if (ks == 0) ot[t * 128 + v] = op; }
            }
            if (STEP == 3) {
                __syncthreads();
#pragma unroll
                for (int tt = 0; tt < 4; ++tt) { const int tok = wave * 4 + tt, m = m0 + tile * 32 + tok;
                    const float a = ot[tok * 128 + lane], b2 = ot[tok * 128 + 64 + lane];
                    const float r = 1.f / sqrtf(wave_sum(a * a + b2 * b2) * (1.f / 128.f) + EPS);
                    const bf16* gp = HG + (size_t)m * HGW + h * HGD_; bf16* op2 = OB + (size_t)m * HGW + h * HGD_;
                    op2[lane] = (bf16)f2bf(a * r * hgw[lane] * __uint_as_float((unsigned)gp[lane] << 16));
                    op2[64 + lane] = (bf16)f2bf(b2 * r * hgw[64 + lane] * __uint_as_float((unsigned)gp[64 + lane] << 16)); }
            }
        }
        if (STEP == 1) {
#pragma unroll
            for (int j = 0; j < 8; ++j) *(f32x4*)(HS + (size_t)unit * 16384 + v * 128 + 16 * j + 4 * ks) = S[j];
            if (tid < 128) HGD[unit * 128 + tid] = Dk;
        }
    }
    __syncthreads();
}
__device__ __forceinline__ void hgrn_scan_phase(int gtid, int gthreads, float* HS, const float* HGD) {
    for (int idx = gtid; idx < BATCH * HGH * 16384; idx += gthreads) {
        const int bh = idx >> 14, e = idx & 16383, k = e & 127; float s = 0.f;
        float tmp[HGNC];
#pragma unroll
        for (int c = 0; c < HGNC; ++c) tmp[c] = HS[(size_t)(bh * HGNC + c) * 16384 + e];
#pragma unroll
        for (int c = 0; c < HGNC; ++c) { HS[(size_t)(bh * HGNC + c) * 16384 + e] = s; s = HGD[(bh * HGNC + c) * 128 + k] * s + tmp[c]; }
    }
}
struct Args { const float* in[16]; float* out; unsigned char* ws; unsigned mask, pad; };
__global__ void __launch_bounds__(NWAVES * 64, 2) mk_fwd(Args args) {
    extern __shared__ __attribute__((aligned(16))) unsigned char lds_raw[];
    LAS unsigned char* lds = (LAS unsigned char*)lds_raw;
    volatile LAS unsigned* MISC = (volatile LAS unsigned*)(lds + MISC_OFF);
    const int G = gridDim.x, bx = blockIdx.x;
    unsigned char* ws = args.ws;
    gu32* ctl = (gu32*)(ws + WS_CTL);
    for (int u = threadIdx.x; u < (LDS_BYTES - LDSCTL_OFF) / 4; u += NWAVES * 64) ((LAS unsigned*)(lds + LDSCTL_OFF))[u] = 0u;
    __syncthreads();
    XcdBarrier bar = xcd_barrier_post((unsigned*)(ctl + CW_BAR), MISC + 8);
#define GRID_BAR() xcd_barrier(bar)
#define PH(k) if ((args.mask >> (k)) & 1u)
#define COORDS() int tid = threadIdx.x; asm volatile("" : "+v"(tid)); const int lane = tid & 63, wave = __builtin_amdgcn_readfirstlane(tid >> 6); \
    const int vcu = (G % 8 == 0) ? (bx % 8) * (G / 8) + bx / 8 : bx; const int gw = vcu * NWAVES + wave, NGW = G * NWAVES; (void)lane; (void)gw; (void)NGW; (void)vcu
#define MKP() Ptrs P; P.x = args.in[0]; P.p = args.in[1]; P.w_gu1 = args.in[2]; P.w_d1 = args.in[3]; P.w_in = args.in[4]; P.w_a = args.in[5]; P.w_b = args.in[6]; P.w_out = args.in[7]; \
    P.w_gu2 = args.in[8]; P.w_d2 = args.in[9]; P.w_ple = args.in[10]; P.w_pg = args.in[11]; P.gains = args.in[12]; P.hgw = args.in[13]; P.lbp = args.in[14]; P.rel = args.in[15]; P.out = args.out; P.ws = args.ws
#define XN ((bf16*)(ws + WS_C))
#define Hb ((bf16*)(ws + WS_A))
#define Fb ((float*)(ws + WS_B))
#define Yb ((float*)(ws + WS_A))
#define Qb ((bf16*)(ws + WS_Q))
#define Kb ((bf16*)(ws + WS_K))
#define Vb ((bf16*)(ws + WS_V))
#define HQb ((bf16*)(ws + WS_HQ))
#define HIb ((bf16*)(ws + WS_HI))
#define KINb ((bf16*)(ws + WS_KIN))
#define HGb ((bf16*)(ws + WS_HG))
#define SAb ((bf16*)(ws + WS_SA))
#define SBb ((bf16*)(ws + WS_SB))
#define OAb ((bf16*)(ws + WS_OA))
#define OBb ((bf16*)(ws + WS_OB))
#define PBb ((bf16*)(ws + WS_PB))
#define Eb ((bf16*)(ws + WS_A))
#define KMEAN ((float*)(ws + WS_KMEAN))
#define LBt ((float*)(ws + WS_LB))
#define BIAST ((float*)(ws + WS_BIAST))
#define HS ((float*)(ws + WS_HS))
#define HGD ((float*)(ws + WS_HGD))
#define TOP ((unsigned*)(ws + WS_TOP))

    PH(0) { COORDS(); MKP(); p0_prologue(P, lds, gw, NGW, wave, lane); }
    GRID_BAR();
    PH(1) { pg8::Gemm g{XN, (const bf16*)(ws + WS_WGU1), M, NGU, D}; pg8::StaticOrder S; S.init(M, NGU, G, bx); pg8::EpiGU E{Hb, FF};
      pg8::gemm_phase<pg8::EpiGU, pg8::StaticOrder, PG8_ALIGN, PG8_SP2>(lds + RING_OFF, g, S, E); }
    GRID_BAR();
    PH(2) { pg8::Gemm g{Hb, (const bf16*)(ws + WS_WD1), M, D, FF}; pg8::StaticOrder S; S.init(M, D, G, bx); pg8::EpiF32 E{Fb, D};
      pg8::gemm_phase<pg8::EpiF32, pg8::StaticOrder, PG8_ALIGN, PG8_SP2>(lds + RING_OFF, g, S, E); }
    GRID_BAR();
    PH(3) { COORDS(); rowwise_phase<1>(gw, NGW, lane, args.in[0], Fb, args.in[12] + 1 * D, 0.5f, args.out, XN); }
    GRID_BAR();
    PH(4) { pg8::Gemm g{XN, (const bf16*)(ws + WS_WIN), M, NIN, D}; pg8::StaticOrder S; S.init(M, NIN, G, bx); pg8::EpiIN E{Qb, Kb, Vb, HQb, KINb, HIb, HGb, SAb, SBb, LBt, KMEAN};
      pg8::gemm_phase<pg8::EpiIN, pg8::StaticOrder, PG8_ALIGN, PG8_SP2>(lds + RING_OFF, g, S, E); }
    GRID_BAR();
    PH(5) { COORDS(); moba_gating_phase(lds, vcu, G, tid, Qb, KMEAN, TOP);
            hgrn_chunk_phase<1>(lds, vcu, G, tid, wave, lane, KINb, HIb, HQb, HGb, args.in[13], HS, HGD, OBb); }
    GRID_BAR();
    PH(6) { COORDS(); hgrn_scan_phase(vcu * NWAVES * 64 + tid, G * NWAVES * 64, HS, HGD);
            moba_attn_simple_phase(lds, gw, NGW, wave, lane, Qb, Kb, Vb, TOP, BIAST, OAb); }
    GRID_BAR();
    PH(7) { COORDS(); hgrn_chunk_phase<3>(lds, vcu, G, tid, wave, lane, KINb, HIb, HQb, HGb, args.in[13], HS, HGD, OBb); }
    GRID_BAR();
    PH(8) { pg8::Gemm g{OAb, (const bf16*)(ws + WS_WA), M, D, 512}; pg8::StaticOrder S; S.init(M, D, G, bx); pg8::EpiMix<1> E{SAb, nullptr, D};
      pg8::gemm_phase<pg8::EpiMix<1>, pg8::StaticOrder, PG8_ALIGN, PG8_SP2>(lds + RING_OFF, g, S, E); }
    PH(8) { pg8::Gemm g{OBb, (const bf16*)(ws + WS_WB), M, D, 512}; pg8::StaticOrder S; S.init(M, D, G, bx); pg8::EpiMix<2> E{SAb, SBb, D};
      pg8::gemm_phase<pg8::EpiMix<2>, pg8::StaticOrder, PG8_ALIGN, PG8_SP2>(lds + RING_OFF, g, S, E); }
    GRID_BAR();
    PH(9) { pg8::Gemm g{SAb, (const bf16*)(ws + WS_WOUT), M, D, D}; pg8::StaticOrder S; S.init(M, D, G, bx); pg8::EpiF32 E{Yb, D};
      pg8::gemm_phase<pg8::EpiF32, pg8::StaticOrder, PG8_ALIGN, PG8_SP2>(lds + RING_OFF, g, S, E); }
    GRID_BAR();
    PH(10) { COORDS(); rowwise_phase<1>(gw, NGW, lane, args.out, Yb, args.in[12] + 3 * D, 1.0f, args.out, XN); }
    GRID_BAR();
    PH(11) { pg8::Gemm g{XN, (const bf16*)(ws + WS_WGU2), M, NGU, D}; pg8::StaticOrder S; S.init(M, NGU, G, bx); pg8::EpiGU E{Hb, FF};
      pg8::gemm_phase<pg8::EpiGU, pg8::StaticOrder, PG8_ALIGN, PG8_SP2>(lds + RING_OFF, g, S, E); }
    GRID_BAR();
    PH(12) { pg8::Gemm g{Hb, (const bf16*)(ws + WS_WD2), M, D, FF}; pg8::StaticOrder S; S.init(M, D, G, bx); pg8::EpiF32 E{Fb, D};
      pg8::gemm_phase<pg8::EpiF32, pg8::StaticOrder, PG8_ALIGN, PG8_SP2>(lds + RING_OFF, g, S, E); }
    GRID_BAR();
    PH(13) { COORDS(); rowwise_phase<2>(gw, NGW, lane, args.out, Fb, args.in[12] + 5 * D, 0.5f, args.out, XN);
        const float* pp = args.in[1];
        for (int i = gw * 64 + lane; i < M * PLE / 8; i += NGW * 64) { const f32x4 a = ((const f32x4*)pp)[2 * i], b = ((const f32x4*)pp)[2 * i + 1];
            v4u o; o.x = pk2(a.x, a.y); o.y = pk2(a.z, a.w); o.z = pk2(b.x, b.y); o.w = pk2(b.z, b.w); ((v4u*)PBb)[i] = o; } }
    GRID_BAR();
    PH(14) { pg8::Gemm g{PBb, (const bf16*)(ws + WS_WPLE), M, D, PLE}; pg8::StaticOrder S; S.init(M, D, G, bx); pg8::EpiMix<0> E{Eb, nullptr, D};
      pg8::gemm_phase<pg8::EpiMix<0>, pg8::StaticOrder, PG8_ALIGN, PG8_SP2>(lds + RING_OFF, g, S, E); }
    PH(14) { pg8::Gemm g{XN, (const bf16*)(ws + WS_WPG), M, D, D}; pg8::StaticOrder S; S.init(M, D, G, bx); pg8::EpiPleB E{Eb, Fb, D};
      pg8::gemm_phase<pg8::EpiPleB, pg8::StaticOrder, PG8_ALIGN, PG8_SP2>(lds + RING_OFF, g, S, E); }
    GRID_BAR();
    PH(15) { COORDS(); rowwise_phase<0>(gw, NGW, lane, args.out, Fb, args.in[12] + 6 * D, 1.0f, args.out, nullptr); }
}

extern "C" void kernel_launch(void* const* d_in, const int* in_sizes, int n_in, void* d_out, int out_size, void* d_ws, size_t ws_size, hipStream_t stream) {
    static int grid = 0;
    if (grid == 0) {
        if (n_in != 16 || in_sizes[0] != M * D || out_size != M * D || ws_size < WS_END) { fprintf(stderr, "kernel_launch: unexpected shapes: n_in %d in0 %d out %d ws %zu; nothing launched\n", n_in, n_in > 0 ? in_sizes[0] : -1, out_size, ws_size); grid = -1; return; }
        int dev = 0, cus = 0;
        if (hipGetDevice(&dev) != hipSuccess || hipDeviceGetAttribute(&cus, hipDeviceAttributeMultiprocessorCount, dev) != hipSuccess) { fprintf(stderr, "kernel_launch: device query failed\n"); grid = -1; return; }
        if (hipFuncSetAttribute((const void*)mk_fwd, hipFuncAttributeMaxDynamicSharedMemorySize, LDS_BYTES) != hipSuccess) { fprintf(stderr, "kernel_launch: hipFuncSetAttribute failed\n"); grid = -1; return; }
        int per_cu = 0;
        if (hipOccupancyMaxActiveBlocksPerMultiprocessor(&per_cu, (const void*)mk_fwd, NWAVES * 64, LDS_BYTES) != hipSuccess || per_cu < 1) fprintf(stderr, "kernel_launch: note: occupancy query reports %d\n", per_cu);
        (void)hipGetLastError();
        grid = cus;
    }
    if (grid < 0) return;
    if (hipMemsetAsync((char*)d_ws + WS_CTL, 0, CTL_ZERO_BYTES, stream) != hipSuccess) { fprintf(stderr, "kernel_launch: memset failed\n"); return; }
    Args a{};
    for (int i = 0; i < 16; ++i) a.in[i] = (const float*)d_in[i];
    a.out = (float*)d_out; a.ws = (unsigned char*)d_ws; a.mask = 0xffffffffu; a.pad = 0u;
    hipLaunchKernelGGL(mk_fwd, dim3(grid), dim3(NWAVES * 64), LDS_BYTES, stream, a);
    const hipError_t le = hipPeekAtLastError();
    if (le != hipSuccess) fprintf(stderr, "kernel_launch: launch failed: %s\n", hipGetErrorName(le));
}
```

```cpp
#include <hip/hip_runtime.h>
#include <cstdio>
#include <cstdint>
namespace pg8 {
#define PG8_LAS __attribute__((address_space(3)))
typedef unsigned short bf16_t;
typedef short bf16x8 __attribute__((ext_vector_type(8)));
typedef float f32x4 __attribute__((ext_vector_type(4)));
typedef unsigned u32x4 __attribute__((ext_vector_type(4)));
constexpr int BM = 256, BK = 64, HALF = 128, HTB = HALF * BK * 2  , STAGE_BYTES = 8 * HTB, NXCD = 8, WGM = 8;

__host__ __device__ __forceinline__ int lds_byte(int r, int c) { const int st = (r >> 4) * 2 + (c >> 5), rr = r & 15, cc = c & 31, ob = rr * 64 + cc * 2; return st * 1024 + (ob ^ (((ob >> 9) & 1) << 5)); }
__host__ __device__ __forceinline__ void stage_rc(int b, int& R, int& C) { const int st = b / 1024, sb = b % 1024, swz = sb ^ (((sb >> 9) & 1) << 5); R = (st >> 1) * 16 + swz / 64; C = (st & 1) * 32 + (swz % 64) / 2; }
__host__ __device__ __forceinline__ int perm32(int rho) { const int n = rho >> 4, i = rho & 15; return 8 * (i >> 2) + 4 * n + (i & 3); }

struct Unit { int pm, pn; };
struct Gemm { const bf16_t* A; const bf16_t* Bt; int M, N, K; };

struct StaticOrder {
    int nM, nN, nwg, G, c;
    __host__ __device__ void init(int M, int N, int G_, int c_) { nM = M / BM; nN = N / BM; nwg = nM * nN; G = G_; c = c_; }
    __host__ __device__ bool next(int i, Unit& u) const {
        const long L = (long)i * G + c; if (L >= nwg) return false;
        int wgid = (int)L; { const int q = nwg / NXCD, r = nwg % NXCD, xcd = wgid % NXCD, off = wgid / NXCD; wgid = (xcd < r ? xcd * (q + 1) : r * (q + 1) + (xcd - r) * q) + off; }
        const int nig = WGM * nN, gid = wgid / nig, fm = gid * WGM, gsz = (nM - fm) < WGM ? (nM - fm) : WGM;
        u.pm = fm + ((wgid % nig) % gsz); u.pn = (wgid % nig) / gsz; return true;
    }
    __device__ __forceinline__ void a_ready(const Unit&) const {}
    __device__ __forceinline__ void done(const Unit&) const {}
};

typedef float f32x2_t __attribute__((ext_vector_type(2))); typedef __bf16 bf16x2_t __attribute__((ext_vector_type(2)));
__device__ __forceinline__ unsigned cvt_pk_bf16(float lo, float hi) { f32x2_t v = {lo, hi}; bf16x2_t b = __builtin_convertvector(v, bf16x2_t); return __builtin_bit_cast(unsigned, b); }
__device__ __forceinline__ float sigm(float x) { return __builtin_amdgcn_rcpf(1.0f + __builtin_amdgcn_exp2f(-1.4426950408889634f * x)); }
__device__ __forceinline__ float bf_lo(unsigned w) { return __uint_as_float(w << 16); }
__device__ __forceinline__ float bf_hi(unsigned w) { return __uint_as_float(w & 0xffff0000u); }
__device__ __forceinline__ void unpack8(const u32x4 w, float (&o)[8]) { o[0] = bf_lo(w.x); o[1] = bf_hi(w.x); o[2] = bf_lo(w.y); o[3] = bf_hi(w.y); o[4] = bf_lo(w.z); o[5] = bf_hi(w.z); o[6] = bf_lo(w.w); o[7] = bf_hi(w.w); }
__device__ __forceinline__ u32x4 pack8(const float (&o)[8]) { u32x4 w; w.x = cvt_pk_bf16(o[0], o[1]); w.y = cvt_pk_bf16(o[2], o[3]); w.z = cvt_pk_bf16(o[4], o[5]); w.w = cvt_pk_bf16(o[6], o[7]); return w; }

struct EpiGU {
    static constexpr bool PERM = true, AFTER_DRAIN = false;
    bf16_t* H; int ldh;
    __device__ __forceinline__ void operator()(const f32x4 (&acc)[2][2][4][2], const Unit& u, int wr, int wc, int fr, int fq) const {
        const int row0 = u.pm * BM + wr * 64 + fr, col0 = u.pn * HALF + wc * 32 + 8 * fq;
#pragma unroll
        for (int ai = 0; ai < 2; ++ai)
#pragma unroll
            for (int m = 0; m < 4; ++m) { bf16_t* rowp = H + (size_t)(row0 + ai * HALF + m * 16) * ldh + col0;
                const f32x4 g0 = acc[ai][0][m][0], g1 = acc[ai][0][m][1], u0 = acc[ai][1][m][0], u1 = acc[ai][1][m][1]; float o[8];
#pragma unroll
                for (int j = 0; j < 4; ++j) { o[j] = g0[j] * sigm(g0[j]) * u0[j]; o[4 + j] = g1[j] * sigm(g1[j]) * u1[j]; }
                *(u32x4*)rowp = pack8(o); }
    }
};
struct EpiF32 {
    static constexpr bool PERM = false, AFTER_DRAIN = false;
    float* C; int ldc;
    __device__ __forceinline__ void operator()(const f32x4 (&acc)[2][2][4][2], const Unit& u, int wr, int wc, int fr, int fq) const {
        const int row0 = u.pm * BM + wr * 64 + fr, col0 = u.pn * BM + wc * 32 + 4 * fq;
#pragma unroll
        for (int ai = 0; ai < 2; ++ai)
#pragma unroll
            for (int m = 0; m < 4; ++m) { float* rowp = C + (size_t)(row0 + ai * HALF + m * 16) * ldc + col0;
#pragma unroll
                for (int bj = 0; bj < 2; ++bj)
#pragma unroll
                    for (int n = 0; n < 2; ++n) *(f32x4*)(rowp + bj * HALF + n * 16) = acc[ai][bj][m][n]; }
    }
};
struct EpiIN {
    static constexpr bool PERM = true, AFTER_DRAIN = false;
    bf16_t *Q, *K, *HQ, *KIN, *HI, *HG, *SA, *SB; const float* LB; float* KMEAN;
    template <int MODE> __device__ __forceinline__ void body(const f32x4 (&acc)[2][2][4][2], bf16_t* base, int ldc, int row0, int cbase, int pm, int fr) const {
        float lbv[2][8]; float ks[2][8];
#pragma unroll
        for (int bj = 0; bj < 2; ++bj)
#pragma unroll
            for (int j = 0; j < 8; ++j) { lbv[bj][j] = (MODE == 2) ? (1.0f - LB[cbase + bj * HALF + j]) : 0.f; ks[bj][j] = 0.f; }
#pragma unroll
        for (int ai = 0; ai < 2; ++ai)
#pragma unroll
            for (int m = 0; m < 4; ++m) { bf16_t* rowp = base + (size_t)(row0 + ai * HALF + m * 16) * ldc + cbase;
#pragma unroll
                for (int bj = 0; bj < 2; ++bj) { const f32x4 v0 = acc[ai][bj][m][0], v1 = acc[ai][bj][m][1]; float o[8];
#pragma unroll
                    for (int j = 0; j < 4; ++j) { o[j] = v0[j]; o[4 + j] = v1[j]; }
#pragma unroll
                    for (int j = 0; j < 8; ++j) {
                        if (MODE == 1) o[j] = o[j] * sigm(o[j]);
                        if (MODE == 2) o[j] = lbv[bj][j] * sigm(-o[j]);
                        if (MODE == 3) o[j] = sigm(o[j]);
                        if (MODE == 4) ks[bj][j] += o[j]; }
                    *(u32x4*)(rowp + bj * HALF) = pack8(o); } }
        if (MODE == 4) {
#pragma unroll
            for (int bj = 0; bj < 2; ++bj)
#pragma unroll
                for (int j = 0; j < 8; ++j) { float s = ks[bj][j]; s += __shfl_xor(s, 1); s += __shfl_xor(s, 2); s += __shfl_xor(s, 4); s += __shfl_xor(s, 8);
                    if (fr == 0) atomicAdd(KMEAN + (size_t)pm * 512 + cbase + bj * HALF + j, s); }
        }
    }
    __device__ __forceinline__ void operator()(const f32x4 (&acc)[2][2][4][2], const Unit& u, int wr, int wc, int fr, int fq) const {
        const int pn = u.pn, row0 = u.pm * BM + wr * 64 + fr, cw = wc * 32 + 8 * fq;
        if (pn < 2)       body<0>(acc, Q,   512,  row0, (pn)      * BM + cw, u.pm, fr);
        else if (pn < 4)  body<4>(acc, K,   512,  row0, (pn - 2)  * BM + cw, u.pm, fr);
        else if (pn < 6)  body<1>(acc, HQ,  512,  row0, (pn - 4)  * BM + cw, u.pm, fr);
        else if (pn < 8)  body<2>(acc, KIN, 512,  row0, (pn - 6)  * BM + cw, u.pm, fr);
        else if (pn < 10) body<0>(acc, HI,  512,  row0, (pn - 8)  * BM + cw, u.pm, fr);
        else if (pn < 12) body<1>(acc, HG,  512,  row0, (pn - 10) * BM + cw, u.pm, fr);
        else if (pn < 16) body<3>(acc, SA,  1024, row0, (pn - 12) * BM + cw, u.pm, fr);
        else              body<3>(acc, SB,  1024, row0, (pn - 16) * BM + cw, u.pm, fr);
    }
};
template <int MODE> struct EpiMix {
    static constexpr bool PERM = true, AFTER_DRAIN = false;
    bf16_t* T; const bf16_t* S2; int ldc;
    __device__ __forceinline__ void operator()(const f32x4 (&acc)[2][2][4][2], const Unit& u, int wr, int wc, int fr, int fq) const {
        const int row0 = u.pm * BM + wr * 64 + fr, col0 = u.pn * BM + wc * 32 + 8 * fq;
#pragma unroll
        for (int ai = 0; ai < 2; ++ai)
#pragma unroll
            for (int m = 0; m < 4; ++m) { const size_t off = (size_t)(row0 + ai * HALF + m * 16) * ldc + col0;
#pragma unroll
                for (int bj = 0; bj < 2; ++bj) { const f32x4 v0 = acc[ai][bj][m][0], v1 = acc[ai][bj][m][1]; float o[8];
#pragma unroll
                    for (int j = 0; j < 4; ++j) { o[j] = v0[j]; o[4 + j] = v1[j]; }
                    if (MODE == 1) { float t[8]; unpack8(*(const u32x4*)(T + off + bj * HALF), t);
#pragma unroll
                        for (int j = 0; j < 8; ++j) o[j] = t[j] * o[j]; }
                    if (MODE == 2) { float t[8], s[8]; unpack8(*(const u32x4*)(T + off + bj * HALF), t); unpack8(*(const u32x4*)(S2 + off + bj * HALF), s);
#pragma unroll
                        for (int j = 0; j < 8; ++j) o[j] = t[j] + s[j] * o[j]; }
                    *(u32x4*)(T + off + bj * HALF) = pack8(o); } }
    }
};
struct EpiPleB {
    static constexpr bool PERM = true, AFTER_DRAIN = false;
    const bf16_t* E; float* Y; int ldc;
    __device__ __forceinline__ void operator()(const f32x4 (&acc)[2][2][4][2], const Unit& u, int wr, int wc, int fr, int fq) const {
        const int row0 = u.pm * BM + wr * 64 + fr, col0 = u.pn * BM + wc * 32 + 8 * fq;
#pragma unroll
        for (int ai = 0; ai < 2; ++ai)
#pragma unroll
            for (int m = 0; m < 4; ++m) { const size_t off = (size_t)(row0 + ai * HALF + m * 16) * ldc + col0;
#pragma unroll
                for (int bj = 0; bj < 2; ++bj) { const f32x4 v0 = acc[ai][bj][m][0], v1 = acc[ai][bj][m][1]; float e[8]; unpack8(*(const u32x4*)(E + off + bj * HALF), e);
                    f32x4 o0, o1;
#pragma unroll
                    for (int j = 0; j < 4; ++j) { o0[j] = sigm(v0[j]) * e[j]; o1[j] = sigm(v1[j]) * e[4 + j]; }
                    *(f32x4*)(Y + off + bj * HALF) = o0; *(f32x4*)(Y + off + bj * HALF + 4) = o1; } }
    }
};

template <class Epi, class Sched, bool ALIGN_EPI = false, bool SP2 = false>
__device__ __forceinline__ void gemm_phase(PG8_LAS unsigned char* lds, const Gemm g, const Sched& S, const Epi& E) {
    int tid_ = threadIdx.x; asm volatile("" : "+v"(tid_));
    const int tid = tid_, wid = __builtin_amdgcn_readfirstlane(tid >> 6), lane = tid & 63, wr = wid >> 2, wc = wid & 3, fr = lane & 15, fq = lane >> 4;
    int K_ = g.K; asm volatile("" : "+s"(K_));
    const int K = K_, nt = K / BK;
    unsigned voffA[2], voffB[2];
#pragma unroll
    for (int i = 0; i < 2; ++i) { int R, C; stage_rc(tid * 16 + i * 8192, R, C); const int Rb = Epi::PERM ? ((R & ~31) + perm32(R & 31)) : R;
        voffA[i] = (unsigned)(R * K + C) * 2u; voffB[i] = (unsigned)(Rb * K + C) * 2u; }
    const size_t kstep = (size_t)(BK * 2);
    const size_t hstep = (size_t)HALF * K * 2;
    const size_t tstep = 2 * hstep;
    const unsigned ldsw = (unsigned)wid * 1024u;
    const int aoff = lds_byte(wr * 64 + fr, fq * 8), boff = lds_byte(wc * 32 + fr, fq * 8);
#define PG8_SA(b, h) (((b) * 2 + (h)) * HTB)
#define PG8_SB(b, h) ((4 + (b) * 2 + (h)) * HTB)
#define PG8_STAGE(bufoff, gbase, voff) do { _Pragma("unroll") for (int _i = 0; _i < 2; ++_i) \
        __builtin_amdgcn_global_load_lds((const unsigned*)((const char*)(gbase) + (voff)[_i]), (PG8_LAS unsigned*)(lds + (bufoff) + ldsw + _i * 8192), 16, 0, 0); } while (0)
#define PG8_LDA(dst, b, h) do { _Pragma("unroll") for (int m = 0; m < 4; ++m) _Pragma("unroll") for (int k = 0; k < 2; ++k) dst[m][k] = *(const PG8_LAS bf16x8*)(lds + PG8_SA(b, h) + aoff + m * 2048 + k * 1024); } while (0)
#define PG8_LDB(dst, b, h) do { _Pragma("unroll") for (int n = 0; n < 2; ++n) _Pragma("unroll") for (int k = 0; k < 2; ++k) dst[n][k] = *(const PG8_LAS bf16x8*)(lds + PG8_SB(b, h) + boff + n * 2048 + k * 1024); } while (0)
#define PG8_MMA(ai, bj, At, Bt) do { __builtin_amdgcn_s_setprio(1); _Pragma("unroll") for (int m = 0; m < 4; ++m) _Pragma("unroll") for (int n = 0; n < 2; ++n) _Pragma("unroll") for (int k = 0; k < 2; ++k) \
        acc[ai][bj][m][n] = __builtin_amdgcn_mfma_f32_16x16x32_bf16(Bt[n][k], At[m][k], acc[ai][bj][m][n], 0, 0, 0); __builtin_amdgcn_s_setprio(0); } while (0)
#define PG8_WAIT_V(n) asm volatile("s_waitcnt vmcnt(" #n ")" ::: "memory")
#define PG8_WAIT_L(n) asm volatile("s_waitcnt lgkmcnt(" #n ")" ::: "memory")
#define PG8_BAR __builtin_amdgcn_s_barrier()
#define PG8_SCHED __builtin_amdgcn_sched_barrier(0)
    Unit cur, nxt; int ui = 0;
    if (!S.next(0, cur)) return;
    f32x4 acc[2][2][4][2];
#pragma unroll
    for (int a = 0; a < 2; ++a)
#pragma unroll
        for (int b = 0; b < 2; ++b)
#pragma unroll
            for (int m = 0; m < 4; ++m)
#pragma unroll
                for (int n = 0; n < 2; ++n) acc[a][b][m][n] = (f32x4){0.f, 0.f, 0.f, 0.f};
    bf16x8 At[4][2], B0[2][2], B1[2][2];
    const char* cA = (const char*)g.A + (size_t)cur.pm * tstep; const char* cB = (const char*)g.Bt + (size_t)cur.pn * tstep;
    S.a_ready(cur);
    if constexpr (SP2) {
        PG8_STAGE(PG8_SB(0, 0), cB, voffB); PG8_STAGE(PG8_SB(0, 1), cB + hstep, voffB); PG8_STAGE(PG8_SA(0, 0), cA, voffA); PG8_STAGE(PG8_SA(0, 1), cA + hstep, voffA);
        if (wr == 1) PG8_BAR;
        PG8_WAIT_V(2); PG8_BAR;
        PG8_STAGE(PG8_SB(1, 0), cB + kstep, voffB); PG8_STAGE(PG8_SA(1, 0), cA + kstep, voffA); PG8_STAGE(PG8_SB(1, 1), cB + hstep + kstep, voffB);
        PG8_WAIT_V(6); PG8_BAR;
    } else {
        PG8_STAGE(PG8_SB(0, 0), cB, voffB); PG8_STAGE(PG8_SA(0, 0), cA, voffA); PG8_STAGE(PG8_SB(0, 1), cB + hstep, voffB); PG8_STAGE(PG8_SA(0, 1), cA + hstep, voffA);
        if (wr == 1) PG8_BAR;
        PG8_WAIT_V(4); PG8_BAR;
        PG8_STAGE(PG8_SB(1, 0), cB + kstep, voffB); PG8_STAGE(PG8_SA(1, 0), cA + kstep, voffA); PG8_STAGE(PG8_SB(1, 1), cB + hstep + kstep, voffB);
        PG8_WAIT_V(6); PG8_BAR;
    }
    for (;;) {
        const bool has_next = S.next(ui + 1, nxt);
        const char* nA = has_next ? (const char*)g.A + (size_t)nxt.pm * tstep : cA; const char* nB = has_next ? (const char*)g.Bt + (size_t)nxt.pn * tstep : cB;
        for (int t = 0; t < nt; t += 2) {
            const bool last = (t == nt - 2);
            const char* a1 = cA + (size_t)(t + 1) * kstep;
            const char* a2 = last ? nA : cA + (size_t)(t + 2) * kstep; const char* b2 = last ? nB : cB + (size_t)(t + 2) * kstep;
            const char* a3 = a2 + kstep; const char* b3 = b2 + kstep;
            if (last && has_next) S.a_ready(nxt);
            if constexpr (SP2) {
            PG8_LDB(B0, 0, 0); PG8_LDB(B1, 0, 1); PG8_SCHED; PG8_LDA(At, 0, 0); PG8_STAGE(PG8_SA(1, 1), a1 + hstep, voffA);
            PG8_WAIT_V(8); PG8_WAIT_L(0); PG8_BAR; PG8_MMA(0, 0, At, B0); PG8_MMA(0, 1, At, B1); PG8_BAR; PG8_SCHED;
            PG8_LDA(At, 0, 1); PG8_STAGE(PG8_SB(0, 0), b2, voffB); PG8_STAGE(PG8_SB(0, 1), b2 + hstep, voffB); PG8_STAGE(PG8_SA(0, 0), a2, voffA);
            PG8_WAIT_V(8); PG8_WAIT_L(0); PG8_BAR; PG8_MMA(1, 0, At, B0); PG8_MMA(1, 1, At, B1); PG8_BAR; PG8_SCHED;
            PG8_LDB(B0, 1, 0); PG8_LDB(B1, 1, 1); PG8_SCHED; PG8_LDA(At, 1, 0); PG8_STAGE(PG8_SA(0, 1), a2 + hstep, voffA);
            PG8_WAIT_V(8); PG8_WAIT_L(0); PG8_BAR; PG8_MMA(0, 0, At, B0); PG8_MMA(0, 1, At, B1); PG8_BAR; PG8_SCHED;
            PG8_LDA(At, 1, 1); PG8_STAGE(PG8_SB(1, 0), b3, voffB); PG8_STAGE(PG8_SB(1, 1), b3 + hstep, voffB); PG8_STAGE(PG8_SA(1, 0), a3, voffA);
            PG8_WAIT_V(8); PG8_WAIT_L(0); PG8_BAR; PG8_MMA(1, 0, At, B0); PG8_MMA(1, 1, At, B1); PG8_BAR; PG8_SCHED;
            } else {
            PG8_LDB(B0, 0, 0); PG8_SCHED; PG8_LDA(At, 0, 0); PG8_STAGE(PG8_SA(1, 1), a1 + hstep, voffA);
            PG8_WAIT_L(8); PG8_BAR; PG8_WAIT_L(0); PG8_MMA(0, 0, At, B0); PG8_BAR; PG8_SCHED;
            PG8_LDB(B1, 0, 1); PG8_STAGE(PG8_SB(0, 0), b2, voffB);
            PG8_BAR; PG8_WAIT_L(0); PG8_MMA(0, 1, At, B1); PG8_BAR;
            PG8_LDA(At, 0, 1); PG8_STAGE(PG8_SA(0, 0), a2, voffA);
            PG8_BAR; PG8_WAIT_L(0); PG8_MMA(1, 0, At, B0); PG8_BAR; PG8_SCHED;
            PG8_STAGE(PG8_SB(0, 1), b2 + hstep, voffB);
            PG8_WAIT_V(6); PG8_BAR; PG8_MMA(1, 1, At, B1); PG8_BAR;
            PG8_LDB(B0, 1, 0); PG8_SCHED; PG8_LDA(At, 1, 0); PG8_STAGE(PG8_SA(0, 1), a2 + hstep, voffA);
            PG8_WAIT_L(8); PG8_BAR; PG8_WAIT_L(0); PG8_MMA(0, 0, At, B0); PG8_BAR; PG8_SCHED;
            PG8_LDB(B1, 1, 1); PG8_STAGE(PG8_SB(1, 0), b3, voffB);
            PG8_BAR; PG8_WAIT_L(0); PG8_MMA(0, 1, At, B1); PG8_BAR;
            PG8_LDA(At, 1, 1); PG8_STAGE(PG8_SA(1, 0), a3, voffA);
            PG8_BAR; PG8_WAIT_L(0); PG8_MMA(1, 0, At, B0); PG8_BAR; PG8_SCHED;
            PG8_STAGE(PG8_SB(1, 1), b3 + hstep, voffB);
            PG8_WAIT_V(6); PG8_BAR; PG8_MMA(1, 1, At, B1); PG8_BAR;
            }
        }
        if constexpr (ALIGN_EPI) { if (wr == 0) PG8_BAR; }
        if constexpr (!Epi::AFTER_DRAIN) { E(acc, cur, wr, wc, fr, fq); S.done(cur); }
        if (!has_next) break;
#pragma unroll
        for (int a = 0; a < 2; ++a)
#pragma unroll
            for (int b = 0; b < 2; ++b)
#pragma unroll
                for (int m = 0; m < 4; ++m)
#pragma unroll
                    for (int n = 0; n < 2; ++n) acc[a][b][m][n] = (f32x4){0.f, 0.f, 0.f, 0.f};
        cur = nxt; cA = nA; cB = nB; ++ui;
        if constexpr (ALIGN_EPI) { if (wr == 1) PG8_BAR; }
    }
    PG8_WAIT_V(0);
    if constexpr (!ALIGN_EPI) { if (wr == 0) PG8_BAR; }
    PG8_BAR;
    if constexpr (Epi::AFTER_DRAIN) { E.fused(acc, cur, wr, wc, fr, fq, lds, wid, lane); S.done(cur); }
#undef PG8_SA
#undef PG8_SB
#undef PG8_STAGE
#undef PG8_LDA
#undef PG8_LDB
#undef PG8_MMA
#undef PG8_WAIT_V
#undef PG8_WAIT_L
#undef PG8_BAR
#undef PG8_SCHED
}
}
#ifndef PG8_SP2
#define PG8_SP2 true
#endif
#ifndef PG8_ALIGN
#define PG8_ALIGN true
#endif
constexpr int NWAVES = 8;
constexpr int BATCH = 4, SEQ = 8192, D = 1024, FF = 2816, NGU = 2 * FF, NIN = 5632, PLE = 256;
constexpr int M = BATCH * SEQ;
constexpr int MBH = 8, MBD = 64, MBW = 512, MBB = 256, NBLK = SEQ / MBB;
constexpr int HGH = 4, HGD_ = 128, HGW = 512, HGC = 256, HGNC = SEQ / HGC;
constexpr float EPS = 1e-6f;
constexpr size_t MiB = 1u << 20;
constexpr size_t WS_CTL = 0, CTL_ZERO_BYTES = 1 * MiB;
constexpr size_t WS_KMEAN = 512 * 1024;
constexpr size_t WS_LB = 768 * 1024, WS_BIAST = 772 * 1024;
constexpr size_t WS_WGU1 = 1 * MiB, WS_WD1 = 12 * MiB, WS_WIN = WS_WD1 + 5632 * 1024, WS_WA = WS_WIN + 11 * MiB, WS_WB = WS_WA + 1 * MiB, WS_WOUT = WS_WB + 1 * MiB,
                 WS_WGU2 = WS_WOUT + 2 * MiB, WS_WD2 = WS_WGU2 + 11 * MiB, WS_WPLE = WS_WD2 + 5632 * 1024, WS_WPG = WS_WPLE + 512 * 1024, WS_HGD = WS_WPG + 2 * MiB;
constexpr size_t WS_CNT = 256 * 1024;
constexpr size_t WS_A = 52 * MiB;
constexpr size_t WS_Q = WS_A, WS_K = WS_A + 32 * MiB, WS_VT = WS_A + 64 * MiB, WS_HQ = WS_A + 96 * MiB, WS_HI = WS_A + 128 * MiB;
constexpr size_t WS_LIST = 212 * MiB;
constexpr size_t WS_PB = 228 * MiB;
constexpr size_t WS_SB = 228 * MiB;
constexpr size_t WS_PML = 292 * MiB;
constexpr size_t WS_B = 320 * MiB;
constexpr size_t WS_KIN = WS_B, WS_HG = WS_B + 32 * MiB, WS_SA = WS_B + 64 * MiB;
constexpr size_t WS_C = 448 * MiB;
constexpr size_t WS_HS = WS_C, WS_OA = WS_C, WS_OB = WS_C + 32 * MiB;
constexpr size_t WS_PO0 = WS_HQ, WS_PO1 = WS_HI, WS_PO2 = WS_KIN, WS_PO3 = WS_HG;
constexpr size_t WS_END = 512 * MiB;
static_assert(WS_HGD + 256 * 1024 <= WS_A, "weights region");
constexpr int LIST_PER_BH = 126976;
constexpr int CW_TMO = 0, CW_CODE = 1, CW_BAR = 4096;
constexpr int RING_OFF = 0, RING_BYTES = 131072, LDSCTL_OFF = RING_BYTES, MISC_OFF = LDSCTL_OFF + 320, LDS_BYTES = 147456;
#define GAS __attribute__((address_space(1)))
#define LAS __attribute__((address_space(3)))
typedef unsigned short bf16;
typedef unsigned v4u __attribute__((ext_vector_type(4)));
typedef unsigned v2u __attribute__((ext_vector_type(2)));
typedef float f32x4 __attribute__((ext_vector_type(4)));
typedef GAS unsigned gu32;
#define RLX_AGENT __ATOMIC_RELAXED, __HIP_MEMORY_SCOPE_AGENT
#define LDS_WAIT() asm volatile("s_waitcnt lgkmcnt(0)" ::: "memory")
#define VM_WAIT() asm volatile("s_waitcnt vmcnt(0)" ::: "memory")
__device__ __forceinline__ unsigned f2bf(float f) { unsigned u = __builtin_bit_cast(unsigned, f); return (u + 0x7fffu + ((u >> 16) & 1u)) >> 16; }
__device__ __forceinline__ unsigned pk2(float lo, float hi) { return f2bf(lo) | (f2bf(hi) << 16); }
__device__ __forceinline__ float bflo(unsigned w) { return __uint_as_float(w << 16); }
__device__ __forceinline__ float bfhi(unsigned w) { return __uint_as_float(w & 0xffff0000u); }
__device__ __forceinline__ float wave_sum(float v) {
#pragma unroll
    for (int o = 1; o < 64; o <<= 1) v += __shfl_xor(v, o);
    return v;
}
__device__ __forceinline__ float wave_max(float v) {
#pragma unroll
    for (int o = 1; o < 64; o <<= 1) v = fmaxf(v, __shfl_xor(v, o));
    return v;
}
#define XB_TMO      128
#define XB_XCNT(j)  (256  + 64 * (j))
#define XB_XSUB(j)  (1280 + 64 * (j))
#define XB_XGEN(j)  (2304 + 64 * (j))
#define XB_TOP      3328
#define XB_TOPGEN   3392
#define XCD_BAR_WORDS 3456
#define XB_SPIN_CAP (1u << 18)

__device__ __forceinline__ unsigned xb_ld(unsigned* p)              { return __hip_atomic_load(p, __ATOMIC_RELAXED, __HIP_MEMORY_SCOPE_AGENT); }
__device__ __forceinline__ unsigned xb_add(unsigned* p, unsigned v) { return __hip_atomic_fetch_add(p, v, __ATOMIC_RELAXED, __HIP_MEMORY_SCOPE_AGENT); }
__device__ __forceinline__ unsigned xb_xcc_id() { return (unsigned)__builtin_amdgcn_s_getreg((3 << 11) | 20) & 0xFu; }
#define XB_SPIN(cond, bar) do { unsigned _sp = 0; while (cond) { __builtin_amdgcn_s_sleep(1); \
    if ((++_sp & 255u) == 0u) { if (xb_ld(&(bar)[XB_TMO])) break; if (_sp > XB_SPIN_CAP) { atomicAdd(&(bar)[XB_TMO], 1u); break; } } } } while (0)

struct XcdBarrier {
    unsigned* bar; unsigned x;
    volatile LAS unsigned* st;
};

__device__ __forceinline__ XcdBarrier xcd_barrier_post(unsigned* bar, volatile LAS unsigned* st) {
    XcdBarrier b; b.bar = bar; b.x = xb_xcc_id(); b.st = st;
    if (threadIdx.x == 0) (void)xb_add(&bar[XB_XCNT(b.x)], 1u);
    return b;
}
__device__ __forceinline__ void xcd_barrier_complete(unsigned* bar, unsigned x, unsigned& nloc, unsigned& nx) {
    const unsigned G = gridDim.x * gridDim.y * gridDim.z;
    unsigned sum, cnt, mine, sp = 0u;
    for (;;) {
        sum = 0u; cnt = 0u; mine = 0u;
#pragma unroll
        for (unsigned j = 0; j < 16; ++j) { const unsigned c = xb_ld(&bar[XB_XCNT(j)]); sum += c; cnt += (c > 0u) ? 1u : 0u; mine = (j == x) ? c : mine; }
        if (sum == G) break;
        __builtin_amdgcn_s_sleep(1);
        if ((++sp & 255u) == 0u) { if (xb_ld(&bar[XB_TMO])) break; if (sp > XB_SPIN_CAP) { atomicAdd(&bar[XB_TMO], 1u); break; } }
    }
    nloc = mine > 0u ? mine : 1u; nx = cnt > 0u ? cnt : 1u;
}

__device__ __forceinline__ void xcd_barrier(const XcdBarrier& b) {
    asm volatile("s_waitcnt vmcnt(0)" ::: "memory");
    __syncthreads();
    if (threadIdx.x == 0) {
        unsigned* bar = b.bar;
        __builtin_amdgcn_s_waitcnt(0);
        unsigned nloc = b.st[0], nx = b.st[1];
        if (nloc == 0u) { xcd_barrier_complete(bar, b.x, nloc, nx); b.st[0] = nloc; b.st[1] = nx; }
        const unsigned old = xb_add(&bar[XB_XSUB(b.x)], 1u);
        const unsigned gen = old / nloc;
        if (old + 1u == (gen + 1u) * nloc) {
            __builtin_amdgcn_fence(__ATOMIC_RELEASE, "agent");
            asm volatile("s_waitcnt vmcnt(0)" ::: "memory");
            const unsigned og = xb_add(&bar[XB_TOP], 1u);
            const unsigned tg = og / nx;
            if (og + 1u == (tg + 1u) * nx) xb_add(&bar[XB_TOPGEN], 1u);
            else XB_SPIN(xb_ld(&bar[XB_TOPGEN]) == tg, bar);
            __builtin_amdgcn_fence(__ATOMIC_ACQUIRE, "agent");
            xb_add(&bar[XB_XGEN(b.x)], 1u);
            asm volatile("s_waitcnt vmcnt(0)" ::: "memory");
        } else {
            XB_SPIN(xb_ld(&bar[XB_XGEN(b.x)]) == gen, bar);
            __builtin_amdgcn_fence(__ATOMIC_ACQUIRE, "agent");
            asm volatile("s_waitcnt vmcnt(0)" ::: "memory");
        }
    }
    __syncthreads();
}
__device__ __forceinline__ void p0_transpose_item(const float* W, int K, int N, bf16* WT, const float* gain, int mode, LAS float* scr, int item, int lane) {
    const int nblk = N / 32, kb = item / nblk, nb = item % nblk, k0 = 64 * kb, n0 = 32 * nb;
#pragma unroll 8
    for (int i = 0; i < 32; ++i) { const int kk = 2 * i + (lane >> 5); float w = W[(size_t)(k0 + kk) * N + n0 + (lane & 31)]; if (gain) w *= gain[k0 + kk]; scr[kk * 33 + (lane & 31)] = w; }
    LDS_WAIT(); asm volatile("" ::: "memory");
    int rbase = n0;
    if (mode == 1) { if (n0 < FF) rbase = (n0 / 128) * 256 + (n0 % 128); else { const int j = n0 - FF; rbase = (j / 128) * 256 + 128 + (j % 128); } }
    if (mode == 2) { if (n0 >= 1024 && n0 < 1536) rbase = 5120 + (n0 - 1024); else if (n0 >= 1536) rbase = n0 - 512; }
    const int c = lane & 7;
#pragma unroll
    for (int j = 0; j < 4; ++j) { const int n = (lane >> 3) + 8 * j; const LAS float* s = scr + (8 * c) * 33 + n;
        v4u o; o.x = pk2(s[0 * 33], s[1 * 33]); o.y = pk2(s[2 * 33], s[3 * 33]); o.z = pk2(s[4 * 33], s[5 * 33]); o.w = pk2(s[6 * 33], s[7 * 33]);
        *(GAS v4u*)(WT + (size_t)(rbase + n) * K + k0 + 8 * c) = o; }
    LDS_WAIT(); asm volatile("" ::: "memory");
}
__device__ __forceinline__ void rms_row_to_bf16(const float* xrow, bf16* orow, int lane) {
    const GAS f32x4* xr = (const GAS f32x4*)xrow + lane;
    f32x4 v[4]; float s = 0.f;
#pragma unroll
    for (int j = 0; j < 4; ++j) { v[j] = xr[64 * j]; s += (v[j].x * v[j].x + v[j].y * v[j].y) + (v[j].z * v[j].z + v[j].w * v[j].w); }
    const float rstd = 1.f / sqrtf(wave_sum(s) * (1.f / D) + EPS);
    GAS unsigned long long* o8 = (GAS unsigned long long*)orow + lane;
#pragma unroll
    for (int j = 0; j < 4; ++j) o8[64 * j] = (unsigned long long)pk2(v[j].x * rstd, v[j].y * rstd) | ((unsigned long long)pk2(v[j].z * rstd, v[j].w * rstd) << 32);
}
struct Ptrs {
    const float *x, *p, *w_gu1, *w_d1, *w_in, *w_a, *w_b, *w_out, *w_gu2, *w_d2, *w_ple, *w_pg, *gains, *hgw, *lbp, *rel;
    float* out; unsigned char* ws;
};
__device__ __forceinline__ void p0_prologue(const Ptrs P, LAS unsigned char* lds, int gw, int NGW, int wave, int lane) {
    LAS float* scr = (LAS float*)(lds + RING_OFF + wave * 16384);
    unsigned char* ws = P.ws;
    constexpr int I_GU = (D / 64) * (NGU / 32), I_D = (FF / 64) * (D / 32), I_IN = (D / 64) * (NIN / 32), I_AB = (512 / 64) * (D / 32), I_O = (D / 64) * (D / 32), I_PLE = (PLE / 64) * (D / 32);
    constexpr int NITEMS = 2 * I_GU + 2 * I_D + I_IN + 2 * I_AB + 2 * I_O + I_PLE;
    for (int it = gw; it < NITEMS; it += NGW) {
        int r = it;
        if (r < I_GU) { p0_transpose_item(P.w_gu1, D, NGU, (bf16*)(ws + WS_WGU1), P.gains + 0 * D, 1, scr, r, lane); continue; } r -= I_GU;
        if (r < I_GU) { p0_transpose_item(P.w_gu2, D, NGU, (bf16*)(ws + WS_WGU2), P.gains + 4 * D, 1, scr, r, lane); continue; } r -= I_GU;
        if (r < I_IN) { p0_transpose_item(P.w_in, D, NIN, (bf16*)(ws + WS_WIN), P.gains + 2 * D, 2, scr, r, lane); continue; } r -= I_IN;
        if (r < I_D)  { p0_transpose_item(P.w_d1, FF, D, (bf16*)(ws + WS_WD1), nullptr, 0, scr, r, lane); continue; } r -= I_D;
        if (r < I_D)  { p0_transpose_item(P.w_d2, FF, D, (bf16*)(ws + WS_WD2), nullptr, 0, scr, r, lane); continue; } r -= I_D;
        if (r < I_AB) { p0_transpose_item(P.w_a, 512, D, (bf16*)(ws + WS_WA), nullptr, 0, scr, r, lane); continue; } r -= I_AB;
        if (r < I_AB) { p0_transpose_item(P.w_b, 512, D, (bf16*)(ws + WS_WB), nullptr, 0, scr, r, lane); continue; } r -= I_AB;
        if (r < I_O)  { p0_transpose_item(P.w_out, D, D, (bf16*)(ws + WS_WOUT), nullptr, 0, scr, r, lane); continue; } r -= I_O;
        if (r < I_O)  { p0_transpose_item(P.w_pg, D, D, (bf16*)(ws + WS_WPG), nullptr, 0, scr, r, lane); continue; } r -= I_O;
        p0_transpose_item(P.w_ple, PLE, D, (bf16*)(ws + WS_WPLE), nullptr, 0, scr, r, lane);
    }
    for (int m = gw; m < M; m += NGW) rms_row_to_bf16(P.x + (size_t)m * D, (bf16*)(ws + WS_C) + (size_t)m * D, lane);
    const int gt = gw * 64 + lane;
    if (gt < 512) { const float a = P.lbp[gt], b = P.lbp[512 + gt]; const float mx = fmaxf(a, b); const float ea = expf(a - mx), eb = expf(b - mx); ((float*)(ws + WS_LB))[gt] = ea / (ea + eb); }
    if (gt >= 1024 && gt < 2048) { const int h = (gt - 1024) >> 7, d = (gt - 1024) & 127; int bk;
        if (d < 16) bk = d; else { bk = 16 + (int)(logf((float)d / 16.0f) / logf(8.0f) * 16.0f); if (bk > 31) bk = 31; }
        ((float*)(ws + WS_BIAST))[h * 128 + d] = P.rel[bk * 8 + h]; }
}
template <int MODE> __device__ __forceinline__ void rowwise_phase(int gw, int NGW, int lane, const float* hin, const float* Y, const float* gain, float coef, float* hout, bf16* xn) {
    f32x4 g[4];
#pragma unroll
    for (int j = 0; j < 4; ++j) g[j] = ((const f32x4*)gain)[lane + 64 * j] * coef;
    for (int m = gw; m < M; m += NGW) {
        const GAS f32x4* yr = (const GAS f32x4*)(Y + (size_t)m * D) + lane; const GAS f32x4* hr = (const GAS f32x4*)(hin + (size_t)m * D) + lane;
        f32x4 y[4], h[4]; float s = 0.f;
#pragma unroll
        for (int j = 0; j < 4; ++j) { y[j] = yr[64 * j]; h[j] = hr[64 * j]; s += (y[j].x * y[j].x + y[j].y * y[j].y) + (y[j].z * y[j].z + y[j].w * y[j].w); }
        const float rstd = 1.f / sqrtf(wave_sum(s) * (1.f / D) + EPS);
        float s2 = 0.f;
#pragma unroll
        for (int j = 0; j < 4; ++j) { h[j] = h[j] + (g[j] * y[j]) * rstd; s2 += (h[j].x * h[j].x + h[j].y * h[j].y) + (h[j].z * h[j].z + h[j].w * h[j].w); }
        GAS f32x4* ho = (GAS f32x4*)(hout + (size_t)m * D) + lane;
#pragma unroll
        for (int j = 0; j < 4; ++j) ho[64 * j] = h[j];
        if (MODE != 0) {
            float r2 = 1.f;
            if (MODE == 1) r2 = 1.f / sqrtf(wave_sum(s2) * (1.f / D) + EPS);
            GAS unsigned long long* o8 = (GAS unsigned long long*)(xn + (size_t)m * D) + lane;
#pragma unroll
            for (int j = 0; j < 4; ++j) o8[64 * j] = (unsigned long long)pk2(h[j].x * r2, h[j].y * r2) | ((unsigned long long)pk2(h[j].z * r2, h[j].w * r2) << 32);
        }
    }
}
__device__ __forceinline__ int moba_list_base(int bh, int j) { return bh * LIST_PER_BH + 256 * (31 * j - (j * (j - 1)) / 2); }
__device__ __forceinline__ void moba_gating_phase(LAS unsigned char* lds, int vcu, int G, int tid, const bf16* Q, const float* KMEAN, unsigned* CNT, unsigned* LIST) {
    LAS float* km = (LAS float*)lds;
    const int lane = tid & 63;
    for (int unit = vcu; unit < BATCH * NBLK * 4; unit += G) {
        const int hp = unit & 3, i = (unit >> 2) & 31, b = unit >> 7;
        __syncthreads();
        for (int e = tid; e < i * 128; e += 512) { const int j = e >> 7, c = e & 127; km[e] = KMEAN[(size_t)(b * NBLK + j) * 512 + hp * 128 + c] * (1.0f / 256.0f); }
        __syncthreads();
        const int hh = __builtin_amdgcn_readfirstlane(tid >> 8), ql = tid & 255, m = b * SEQ + i * MBB + ql, h = 2 * hp + hh;
        float q[64];
        { const v4u* qp = (const v4u*)(Q + (size_t)m * MBW + h * MBD);
#pragma unroll
          for (int c = 0; c < 8; ++c) { const v4u w = qp[c]; q[8 * c + 0] = bflo(w.x); q[8 * c + 1] = bfhi(w.x); q[8 * c + 2] = bflo(w.y); q[8 * c + 3] = bfhi(w.y); q[8 * c + 4] = bflo(w.z); q[8 * c + 5] = bfhi(w.z); q[8 * c + 6] = bflo(w.w); q[8 * c + 7] = bfhi(w.w); } }
        float v0 = -INFINITY, v1 = -INFINITY, v2 = -INFINITY; int i0 = -1, i1 = -1, i2 = -1;
        for (int j = 0; j < i; ++j) {
            const LAS f32x4* kp = (const LAS f32x4*)(km + j * 128 + hh * 64); float s = 0.f;
#pragma unroll
            for (int c = 0; c < 16; ++c) { const f32x4 kv = kp[c]; s += q[4 * c] * kv.x; s += q[4 * c + 1] * kv.y; s += q[4 * c + 2] * kv.z; s += q[4 * c + 3] * kv.w; }
            if (s > v0) { v2 = v1; i2 = i1; v1 = v0; i1 = i0; v0 = s; i0 = j; }
            else if (s > v1) { v2 = v1; i2 = i1; v1 = s; i1 = j; }
            else if (s > v2) { v2 = s; i2 = j; }
        }
        const int bh = b * 8 + h; const unsigned tl = (unsigned)(i * MBB + ql); const unsigned long long lt = (1ull << lane) - 1ull;
        for (int j = 0; j < i; ++j) {
            const unsigned long long m0 = __ballot(i0 == j), m1 = __ballot(i1 == j), m2 = __ballot(i2 == j);
            const int c0 = __popcll(m0), c1 = __popcll(m1), c2 = __popcll(m2), tot = c0 + c1 + c2;
            if (tot) {
                unsigned base = 0u; if (lane == 0) base = atomicAdd(CNT + bh * 32 + j, (unsigned)tot);
                base = (unsigned)__builtin_amdgcn_readfirstlane((int)base);
                unsigned* L = LIST + moba_list_base(bh, j) + base;
                if (i0 == j) L[__popcll(m0 & lt)] = tl;
                if (i1 == j) L[c0 + __popcll(m1 & lt)] = tl | (1u << 13);
                if (i2 == j) L[c0 + c1 + __popcll(m2 & lt)] = tl | (2u << 13);
            }
        }
    }
    __syncthreads();
}
typedef float f32x16 __attribute__((ext_vector_type(16)));
typedef short bf16x8v __attribute__((ext_vector_type(8)));
typedef short s16x4v __attribute__((ext_vector_type(4)));
constexpr int IT_KS = 0, IT_VS = 32768, IT_VROW = 520, IT_TB = IT_VS + 64 * IT_VROW  , IT_INFO = IT_TB + 8 * 128 * 4  ;
__device__ __forceinline__ int crow16(int r, int hi) { return (r & 3) + 8 * (r >> 2) + 4 * hi; }
template <bool GENERAL> __device__ __forceinline__ void moba_item_half(f32x16 (&st)[4], int half, int ntile, int hi, int dq, float c1, float c0, const LAS float* tb,
                                                                      float& mrun, float& lrun, f32x16 (&o)[2], const LAS unsigned char* vs, int r32) {
    float mloc = -INFINITY;
#pragma unroll
    for (int t4 = 0; t4 < 4; ++t4) { const int kt = half * 4 + t4;
        if (kt < ntile) {
#pragma unroll
            for (int r = 0; r < 16; ++r) { float x;
                if (GENERAL) { const int dist = dq - (32 * kt + crow16(r, hi)); const int di = dist > 113 ? 113 : (dist < 0 ? 0 : dist); x = st[t4][r] * c1 + tb[di]; if (dist < 0) x = -INFINITY; }
                else x = st[t4][r] * c1 + c0;
                st[t4][r] = x; mloc = fmaxf(mloc, x); }
        }
    }
    mloc = fmaxf(mloc, __shfl_xor(mloc, 32));
    const float mnew = fmaxf(mrun, mloc);
    const float alpha = __builtin_amdgcn_exp2f(mrun - mnew);
    float ls = 0.f;
#pragma unroll
    for (int t4 = 0; t4 < 4; ++t4) { const int kt = half * 4 + t4;
        if (kt < ntile) {
#pragma unroll
            for (int r = 0; r < 16; ++r) { const float pv = __builtin_amdgcn_exp2f(st[t4][r] - mnew); st[t4][r] = pv; ls += pv; }
        }
    }
    ls += __shfl_xor(ls, 32);
    lrun = lrun * alpha + ls; mrun = mnew;
#pragma unroll
    for (int d = 0; d < 2; ++d)
#pragma unroll
        for (int r = 0; r < 16; ++r) o[d][r] *= alpha;
#pragma unroll
    for (int t4 = 0; t4 < 4; ++t4) { const int kt = half * 4 + t4;
        if (kt < ntile) {
#pragma unroll
            for (int s = 0; s < 2; ++s) {
                bf16x8v pf; { unsigned w0 = pg8::cvt_pk_bf16(st[t4][8 * s + 0], st[t4][8 * s + 1]), w1 = pg8::cvt_pk_bf16(st[t4][8 * s + 2], st[t4][8 * s + 3]), w2 = pg8::cvt_pk_bf16(st[t4][8 * s + 4], st[t4][8 * s + 5]), w3 = pg8::cvt_pk_bf16(st[t4][8 * s + 6], st[t4][8 * s + 7]);
                    v4u w = {w0, w1, w2, w3}; pf = __builtin_bit_cast(bf16x8v, w); }
#pragma unroll
                for (int d = 0; d < 2; ++d) {
                    const LAS unsigned char* vp = vs + (32 * d + r32) * IT_VROW + (32 * kt + 16 * s + 4 * hi) * 2;
                    const s16x4v lo = *(const LAS s16x4v*)vp, hi4 = *(const LAS s16x4v*)(vp + 16);
                    const bf16x8v va = {lo[0], lo[1], lo[2], lo[3], hi4[0], hi4[1], hi4[2], hi4[3]};
                    o[d] = __builtin_amdgcn_mfma_f32_32x32x16_bf16(va, pf, o[d], 0, 0, 0);
                }
                asm volatile("" ::: "memory");
            }
        }
    }
}
__device__ __forceinline__ void moba_items_phase(LAS unsigned char* lds, int vcu, int G, int tid_in, int wave, int lane, const bf16* Q, const bf16* K, const bf16* VT, const unsigned* CNT, const unsigned* LIST,
                                                 const float* BIAST, bf16* PO0, bf16* PO1, bf16* PO2, bf16* PO3, float* PML) {
    const int r32 = lane & 31, hi = lane >> 5; int tid = tid_in;
    LAS unsigned char* ks = lds + IT_KS; LAS unsigned char* vs = lds + IT_VS; LAS float* tball = (LAS float*)(lds + IT_TB); volatile LAS int* info = (volatile LAS int*)(lds + IT_INFO);
    __syncthreads();
    for (int e = tid; e < 8 * 128; e += 512) tball[e] = BIAST[e] * 1.4426950408889634f;
    if (wave == 0) {
        int loc[16]; int s = 0;
#pragma unroll
        for (int e = 0; e < 16; ++e) { const int n = (int)CNT[16 * lane + e]; loc[e] = 1 + ((n + 255) >> 8); s += loc[e]; }
        int incl = s;
#pragma unroll
        for (int o = 1; o < 64; o <<= 1) { const int t = __shfl_up(incl, o); if (lane >= o) incl += t; }
        const int excl = incl - s, total = __shfl(incl, 63);
        const int c0 = (int)(((long)vcu * total) / G), c1 = (int)(((long)(vcu + 1) * total) / G);
        if (c0 >= excl && c0 < incl) { int acc = excl; bool done = false;
#pragma unroll
            for (int e = 0; e < 16; ++e) { if (!done && c0 < acc + loc[e]) { info[0] = 16 * lane + e; info[1] = c0 - acc; done = true; } acc += loc[e]; } }
        if (lane == 0) info[2] = c1 - c0;
    }
    __syncthreads();
    int li = __builtin_amdgcn_readfirstlane(info[0]), k = __builtin_amdgcn_readfirstlane(info[1]); const int nchunk = __builtin_amdgcn_readfirstlane(info[2]);
    int loaded = -1;
    for (int c = 0; c < nchunk; ++c) {
        const int b = li >> 8, h = (li >> 5) & 7, j = li & 31; const int n = __builtin_amdgcn_readfirstlane((int)CNT[li]);
        if (li != loaded) {
            __syncthreads();
            asm volatile("" : "+v"(tid));
#pragma unroll
            for (int r = 0; r < 4; ++r) { const int idx = tid + 512 * r, key = idx >> 3, ch = idx & 7;
                const v4u w = *(const v4u*)(K + (size_t)(b * SEQ + j * MBB + key) * MBW + h * MBD + ch * 8);
                *(LAS v4u*)(ks + key * 128 + ((ch ^ ((key >> 1) & 7)) * 16)) = w; }
#pragma unroll
            for (int r = 0; r < 4; ++r) { const int idx = tid + 512 * r, d = idx >> 5, ch = idx & 31;
                const v4u w = *(const v4u*)(VT + (size_t)(h * MBD + d) * M + b * SEQ + j * MBB + ch * 8);
                LAS v2u* dst = (LAS v2u*)(vs + d * IT_VROW + ch * 16); dst[0] = (v2u){w.x, w.y}; dst[1] = (v2u){w.z, w.w}; }
            __syncthreads();
            loaded = li;
        }
        const bool own = (k == 0); const int item = own ? wave : (k - 1) * 8 + wave; const int start = item * 32;
        if (own || start < n) {
            int tl, rank;
            if (own) { tl = j * MBB + start + r32; rank = 3; }
            else { int idx = start + r32; if (idx >= n) idx = n - 1; const unsigned e = LIST[moba_list_base(b * 8 + h, j) + idx]; tl = (int)(e & 8191u); rank = (int)(e >> 13); }
            const bool valid = own || (start + r32 < n);
            const int qin = tl & 255, bd = (tl >> 8) - j, dq = bd * 256 + qin;
            const bool general = own || (__ballot(bd == 1 && qin < 112) != 0ull);
            const int ntile = own ? (wave + 1) : 8;
            const LAS float* tb = tball + h * 128;
            const float c1 = 0.125f * 1.4426950408889634f, c0 = tb[113];
            bf16x8v qf[4];
            { const bf16* qp = Q + (size_t)(b * SEQ + tl) * MBW + h * MBD + 8 * hi;
#pragma unroll
              for (int s = 0; s < 4; ++s) qf[s] = *(const bf16x8v*)(qp + 16 * s); }
            float mrun = -INFINITY, lrun = 0.f; f32x16 o[2];
#pragma unroll
            for (int d = 0; d < 2; ++d)
#pragma unroll
                for (int r = 0; r < 16; ++r) o[d][r] = 0.f;
#pragma unroll
            for (int half = 0; half < 2; ++half) {
                if (half * 4 < ntile) {
                    f32x16 st[4];
#pragma unroll
                    for (int t4 = 0; t4 < 4; ++t4) { const int kt = half * 4 + t4;
#pragma unroll
                        for (int r = 0; r < 16; ++r) st[t4][r] = 0.f;
                        if (kt < ntile) { const int key = 32 * kt + r32;
#pragma unroll
                            for (int s = 0; s < 4; ++s) { const bf16x8v ka = *(const LAS bf16x8v*)(ks + key * 128 + (((2 * s + hi) ^ ((key >> 1) & 7)) * 16));
                                st[t4] = __builtin_amdgcn_mfma_f32_32x32x16_bf16(ka, qf[s], st[t4], 0, 0, 0); } }
                        asm volatile("" ::: "memory");
                    }
                    if (general) moba_item_half<true>(st, half, ntile, hi, dq, c1, c0, tb, mrun, lrun, o, vs, r32);
                    else         moba_item_half<false>(st, half, ntile, hi, dq, c1, c0, tb, mrun, lrun, o, vs, r32);
                }
            }
            if (valid) {
                const size_t pair = (size_t)(b * SEQ + tl) * 8 + h; const float linv = 1.0f / lrun;
                bf16* po = (rank == 0 ? PO0 : rank == 1 ? PO1 : rank == 2 ? PO2 : PO3) + pair * 64;
#pragma unroll
                for (int d = 0; d < 2; ++d)
#pragma unroll
                    for (int g4 = 0; g4 < 4; ++g4) { v2u w; w.x = pg8::cvt_pk_bf16(o[d][4 * g4] * linv, o[d][4 * g4 + 1] * linv); w.y = pg8::cvt_pk_bf16(o[d][4 * g4 + 2] * linv, o[d][4 * g4 + 3] * linv);
                        *(v2u*)(po + 32 * d + 8 * g4 + 4 * hi) = w; }
                if (hi == 0) { float* pm = PML + ((size_t)rank * (M * 8) + pair) * 2; pm[0] = mrun; pm[1] = lrun; }
            }
        }
        if (k + 1 < 1 + ((n + 255) >> 8)) ++k; else { ++li; k = 0; }
    }
    __syncthreads();
}
__device__ __forceinline__ void moba_combine_phase(int gtid, int gthreads, const bf16* PO0, const bf16* PO1, const bf16* PO2, const bf16* PO3, const float* PML, bf16* OA) {
    for (int idx = gtid; idx < M * 8 * 8; idx += gthreads) {
        const int pair = idx >> 3, c8 = idx & 7, m = pair >> 3, own = (m & (SEQ - 1)) >> 8, nv = own < 3 ? own : 3;
        float mm[4], ll[4];
#pragma unroll
        for (int r = 0; r < 4; ++r) { const bool v = (r == 3) || (r < nv); const float* pm = PML + ((size_t)r * (M * 8) + pair) * 2; mm[r] = v ? pm[0] : -INFINITY; ll[r] = v ? pm[1] : 0.f; }
        const float mx = fmaxf(fmaxf(mm[0], mm[1]), fmaxf(mm[2], mm[3]));
        float w[4], ws = 0.f;
#pragma unroll
        for (int r = 0; r < 4; ++r) { w[r] = ll[r] * __builtin_amdgcn_exp2f(mm[r] - mx); ws += w[r]; }
        const float inv = 1.0f / ws; float acc[8];
#pragma unroll
        for (int e = 0; e < 8; ++e) acc[e] = 0.f;
#pragma unroll
        for (int r = 0; r < 4; ++r) { const bool v = (r == 3) || (r < nv);
            if (v) { const bf16* po = (r == 0 ? PO0 : r == 1 ? PO1 : r == 2 ? PO2 : PO3) + (size_t)pair * 64 + c8 * 8; const v4u x = *(const v4u*)po; const float wr = w[r] * inv;
                acc[0] += wr * bflo(x.x); acc[1] += wr * bfhi(x.x); acc[2] += wr * bflo(x.y); acc[3] += wr * bfhi(x.y); acc[4] += wr * bflo(x.z); acc[5] += wr * bfhi(x.z); acc[6] += wr * bflo(x.w); acc[7] += wr * bfhi(x.w); } }
        v4u o; o.x = pk2(acc[0], acc[1]); o.y = pk2(acc[2], acc[3]); o.z = pk2(acc[4], acc[5]); o.w = pk2(acc[6], acc[7]);
        *(v4u*)(OA + (size_t)pair * 64 + c8 * 8) = o;
    }
}
__device__ __forceinline__ void hgrn_stage_tile(LAS float* dst, const bf16* src, int m0, int h, int tid) {
    const int tok = tid >> 4, ch8 = (tid & 15) * 8; const v4u w = *(const v4u*)(src + (size_t)(m0 + tok) * HGW + h * HGD_ + ch8);
    LAS f32x4* d = (LAS f32x4*)(dst + tok * 128 + ch8);
    d[0] = (f32x4){bflo(w.x), bfhi(w.x), bflo(w.y), bfhi(w.y)}; d[1] = (f32x4){bflo(w.z), bfhi(w.z), bflo(w.w), bfhi(w.w)};
}
template <int STEP> __device__ __forceinline__ void hgrn_chunk_phase(LAS unsigned char* lds, int vcu, int G, int tid, int wave, int lane, const bf16* KIN, const bf16* HI, const bf16* HQ, const bf16* HG, const float* hgw, float* HS, float* HGD, bf16* OB) {
    LAS float* kt = (LAS float*)lds; LAS float* vt = kt + 4096; LAS float* qt = vt + 4096; LAS float* ot = qt + 4096;
    const int v = tid >> 2, ks = tid & 3;
    for (int unit = vcu; unit < BATCH * HGH * HGNC; unit += G) {
        const int c = unit & 31, bh = unit >> 5, b = bh >> 2, h = bh & 3, m0 = b * SEQ + c * HGC;
        f32x4 S[8]; float Dk = 1.f;
        if (STEP == 1) {
#pragma unroll
            for (int j = 0; j < 8; ++j) S[j] = (f32x4){0.f, 0.f, 0.f, 0.f};
        } else {
#pragma unroll
            for (int j = 0; j < 8; ++j) S[j] = *(const f32x4*)(HS + (size_t)unit * 16384 + v * 128 + 16 * j + 4 * ks);
        }
        for (int tile = 0; tile < 8; ++tile) {
            __syncthreads();
            hgrn_stage_tile(kt, KIN, m0 + tile * 32, h, tid); hgrn_stage_tile(vt, HI, m0 + tile * 32, h, tid);
            if (STEP == 3) hgrn_stage_tile(qt, HQ, m0 + tile * 32, h, tid);
            __syncthreads();
            if (STEP == 1 && tid < 128) { for (int t = 0; t < 32; ++t) Dk *= (1.0f - kt[t * 128 + tid]); }
            for (int t = 0; t < 32; ++t) {
                const float vv = vt[t * 128 + v]; float op = 0.f;
#pragma unroll
                for (int j = 0; j < 8; ++j) { const f32x4 k4 = *(const LAS f32x4*)(kt + t * 128 + 16 * j + 4 * ks);
                    S[j] = (1.0f - k4) * S[j] + k4 * vv;
                    if (STEP == 3) { const f32x4 q4 = *(const LAS f32x4*)(qt + t * 128 + 16 * j + 4 * ks); op += (S[j].x * q4.x + S[j].y * q4.y) + (S[j].z * q4.z + S[j].w * q4.w); } }
                if (STEP == 3) { op += __shfl_xor(op, 1); op += __shfl_xor(op, 2); if (ks == 0) ot[t * 128 + v] = op; }
            }
            if (STEP == 3) {
                __syncthreads();
#pragma unroll
                for (int tt = 0; tt < 4; ++tt) { const int tok = wave * 4 + tt, m = m0 + tile * 32 + tok;
                    const float a = ot[tok * 128 + lane], b2 = ot[tok * 128 + 64 + lane];
                    const float r = 1.f / sqrtf(wave_sum(a * a + b2 * b2) * (1.f / 128.f) + EPS);
                    const bf16* gp = HG + (size_t)m * HGW + h * HGD_; bf16* op2 = OB + (size_t)m * HGW + h * HGD_;
                    op2[lane] = (bf16)f2bf(a * r * hgw[lane] * __uint_as_float((unsigned)gp[lane] << 16));
                    op2[64 + lane] = (bf16)f2bf(b2 * r * hgw[64 + lane] * __uint_as_float((unsigned)gp[64 + lane] << 16)); }
            }
        }
        if (STEP == 1) {
#pragma unroll
            for (int j = 0; j < 8; ++j) *(f32x4*)(HS + (size_t)unit * 16384 + v * 128 + 16 * j + 4 * ks) = S[j];
            if (tid < 128) HGD[unit * 128 + tid] = Dk;
        }
    }
    __syncthreads();
}
__device__ __forceinline__ void hgrn_scan_phase(int gtid, int gthreads, float* HS, const float* HGD) {
    for (int idx = gtid; idx < BATCH * HGH * 16384; idx += gthreads) {
        const int bh = idx >> 14, e = idx & 16383, k = e & 127; float s = 0.f;
        float tmp[HGNC];
#pragma unroll
        for (int c = 0; c < HGNC; ++c) tmp[c] = HS[(size_t)(bh * HGNC + c) * 16384 + e];
#pragma unroll
        for (int c = 0; c < HGNC; ++c) { HS[(size_t)(bh * HGNC + c) * 16384 + e] = s; s = HGD[(bh * HGNC + c) * 128 + k] * s + tmp[c]; }
    }
}
struct Args { const float* in[16]; float* out; unsigned char* ws; unsigned mask, pad; };
__global__ void __launch_bounds__(NWAVES * 64, 2) mk_fwd(Args args) {
    extern __shared__ __attribute__((aligned(16))) unsigned char lds_raw[];
    LAS unsigned char* lds = (LAS unsigned char*)lds_raw;
    volatile LAS unsigned* MISC = (volatile LAS unsigned*)(lds + MISC_OFF);
    const int G = gridDim.x, bx = blockIdx.x;
    unsigned char* ws = args.ws;
    gu32* ctl = (gu32*)(ws + WS_CTL);
    for (int u = threadIdx.x; u < (LDS_BYTES - LDSCTL_OFF) / 4; u += NWAVES * 64) ((LAS unsigned*)(lds + LDSCTL_OFF))[u] = 0u;
    __syncthreads();
    XcdBarrier bar = xcd_barrier_post((unsigned*)(ctl + CW_BAR), MISC + 8);
#define GRID_BAR() xcd_barrier(bar)
#define PH(k) if ((args.mask >> (k)) & 1u)
#define COORDS() int tid = threadIdx.x; asm volatile("" : "+v"(tid)); const int lane = tid & 63, wave = __builtin_amdgcn_readfirstlane(tid >> 6); \
    const int vcu = (G % 8 == 0) ? (bx % 8) * (G / 8) + bx / 8 : bx; const int gw = vcu * NWAVES + wave, NGW = G * NWAVES; (void)lane; (void)gw; (void)NGW; (void)vcu
#define MKP() Ptrs P; P.x = args.in[0]; P.p = args.in[1]; P.w_gu1 = args.in[2]; P.w_d1 = args.in[3]; P.w_in = args.in[4]; P.w_a = args.in[5]; P.w_b = args.in[6]; P.w_out = args.in[7]; \
    P.w_gu2 = args.in[8]; P.w_d2 = args.in[9]; P.w_ple = args.in[10]; P.w_pg = args.in[11]; P.gains = args.in[12]; P.hgw = args.in[13]; P.lbp = args.in[14]; P.rel = args.in[15]; P.out = args.out; P.ws = args.ws
#define XN ((bf16*)(ws + WS_C))
#define Hb ((bf16*)(ws + WS_A))
#define Fb ((float*)(ws + WS_B))
#define Yb ((float*)(ws + WS_A))
#define Qb ((bf16*)(ws + WS_Q))
#define Kb ((bf16*)(ws + WS_K))
#define VTb ((bf16*)(ws + WS_VT))
#define HQb ((bf16*)(ws + WS_HQ))
#define HIb ((bf16*)(ws + WS_HI))
#define KINb ((bf16*)(ws + WS_KIN))
#define HGb ((bf16*)(ws + WS_HG))
#define SAb ((bf16*)(ws + WS_SA))
#define SBb ((bf16*)(ws + WS_SB))
#define OAb ((bf16*)(ws + WS_OA))
#define OBb ((bf16*)(ws + WS_OB))
#define PBb ((bf16*)(ws + WS_PB))
#define Eb ((bf16*)(ws + WS_A))
#define KMEAN ((float*)(ws + WS_KMEAN))
#define LBt ((float*)(ws + WS_LB))
#define BIAST ((float*)(ws + WS_BIAST))
#define HS ((float*)(ws + WS_HS))
#define HGD ((float*)(ws + WS_HGD))
#define CNTb ((unsigned*)(ws + WS_CNT))
#define LISTb ((unsigned*)(ws + WS_LIST))
#define PO0b ((bf16*)(ws + WS_PO0))
#define PO1b ((bf16*)(ws + WS_PO1))
#define PO2b ((bf16*)(ws + WS_PO2))
#define PO3b ((bf16*)(ws + WS_PO3))
#define PMLb ((float*)(ws + WS_PML))

    PH(0) { COORDS(); MKP(); p0_prologue(P, lds, gw, NGW, wave, lane); }
    GRID_BAR();
    PH(1) { pg8::Gemm g{XN, (const bf16*)(ws + WS_WGU1), M, NGU, D}; pg8::StaticOrder S; S.init(M, NGU, G, bx); pg8::EpiGU E{Hb, FF};
      pg8::gemm_phase<pg8::EpiGU, pg8::StaticOrder, PG8_ALIGN, PG8_SP2>(lds + RING_OFF, g, S, E); }
    GRID_BAR();
    PH(2) { pg8::Gemm g{Hb, (const bf16*)(ws + WS_WD1), M, D, FF}; pg8::StaticOrder S; S.init(M, D, G, bx); pg8::EpiF32 E{Fb, D};
      pg8::gemm_phase<pg8::EpiF32, pg8::StaticOrder, PG8_ALIGN, PG8_SP2>(lds + RING_OFF, g, S, E); }
    GRID_BAR();
    PH(3) { COORDS(); rowwise_phase<1>(gw, NGW, lane, args.in[0], Fb, args.in[12] + 1 * D, 0.5f, args.out, XN); }
    GRID_BAR();
    PH(4) { pg8::Gemm g{XN, (const bf16*)(ws + WS_WIN), M, NIN - 512, D}; pg8::StaticOrder S; S.init(M, NIN - 512, G, bx); pg8::EpiIN E{Qb, Kb, HQb, KINb, HIb, HGb, SAb, SBb, LBt, KMEAN};
      pg8::gemm_phase<pg8::EpiIN, pg8::StaticOrder, PG8_ALIGN, PG8_SP2>(lds + RING_OFF, g, S, E); }
    PH(4) { pg8::Gemm g{(const bf16*)(ws + WS_WIN) + (size_t)(NIN - 512) * D, XN, 512, M, D}; pg8::StaticOrder S; S.init(512, M, G, bx); pg8::EpiMix<0> E{VTb, nullptr, M};
      pg8::gemm_phase<pg8::EpiMix<0>, pg8::StaticOrder, PG8_ALIGN, PG8_SP2>(lds + RING_OFF, g, S, E); }
    GRID_BAR();
    PH(5) { COORDS(); moba_gating_phase(lds, vcu, G, tid, Qb, KMEAN, CNTb, LISTb);
            hgrn_chunk_phase<1>(lds, vcu, G, tid, wave, lane, KINb, HIb, HQb, HGb, args.in[13], HS, HGD, OBb); }
    GRID_BAR();
    PH(6) { COORDS(); hgrn_scan_phase(vcu * NWAVES * 64 + tid, G * NWAVES * 64, HS, HGD); }
    GRID_BAR();
    PH(7) { COORDS(); hgrn_chunk_phase<3>(lds, vcu, G, tid, wave, lane, KINb, HIb, HQb, HGb, args.in[13], HS, HGD, OBb); }
    GRID_BAR();
    PH(16) { COORDS(); moba_items_phase(lds, vcu, G, tid, wave, lane, Qb, Kb, VTb, CNTb, LISTb, BIAST, PO0b, PO1b, PO2b, PO3b, PMLb); }
    GRID_BAR();
    PH(17) { COORDS(); moba_combine_phase(vcu * NWAVES * 64 + tid, G * NWAVES * 64, PO0b, PO1b, PO2b, PO3b, PMLb, OAb); }
    GRID_BAR();
    PH(8) { pg8::Gemm g{OAb, (const bf16*)(ws + WS_WA), M, D, 512}; pg8::StaticOrder S; S.init(M, D, G, bx); pg8::EpiMix<1> E{SAb, nullptr, D};
      pg8::gemm_phase<pg8::EpiMix<1>, pg8::StaticOrder, PG8_ALIGN, PG8_SP2>(lds + RING_OFF, g, S, E); }
    PH(8) { pg8::Gemm g{OBb, (const bf16*)(ws + WS_WB), M, D, 512}; pg8::StaticOrder S; S.init(M, D, G, bx); pg8::EpiMix<2> E{SAb, SBb, D};
      pg8::gemm_phase<pg8::EpiMix<2>, pg8::StaticOrder, PG8_ALIGN, PG8_SP2>(lds + RING_OFF, g, S, E); }
    GRID_BAR();
    PH(9) { pg8::Gemm g{SAb, (const bf16*)(ws + WS_WOUT), M, D, D}; pg8::StaticOrder S; S.init(M, D, G, bx); pg8::EpiF32 E{Yb, D};
      pg8::gemm_phase<pg8::EpiF32, pg8::StaticOrder, PG8_ALIGN, PG8_SP2>(lds + RING_OFF, g, S, E); }
    GRID_BAR();
    PH(10) { COORDS(); rowwise_phase<1>(gw, NGW, lane, args.out, Yb, args.in[12] + 3 * D, 1.0f, args.out, XN); }
    GRID_BAR();
    PH(11) { pg8::Gemm g{XN, (const bf16*)(ws + WS_WGU2), M, NGU, D}; pg8::StaticOrder S; S.init(M, NGU, G, bx); pg8::EpiGU E{Hb, FF};
      pg8::gemm_phase<pg8::EpiGU, pg8::StaticOrder, PG8_ALIGN, PG8_SP2>(lds + RING_OFF, g, S, E); }
    GRID_BAR();
    PH(12) { pg8::Gemm g{Hb, (const bf16*)(ws + WS_WD2), M, D, FF}; pg8::StaticOrder S; S.init(M, D, G, bx); pg8::EpiF32 E{Fb, D};
      pg8::gemm_phase<pg8::EpiF32, pg8::StaticOrder, PG8_ALIGN, PG8_SP2>(lds + RING_OFF, g, S, E); }
    GRID_BAR();
    PH(13) { COORDS(); rowwise_phase<2>(gw, NGW, lane, args.out, Fb, args.in[12] + 5 * D, 0.5f, args.out, XN);
        const float* pp = args.in[1];
        for (int i = gw * 64 + lane; i < M * PLE / 8; i += NGW * 64) { const f32x4 a = ((const f32x4*)pp)[2 * i], b = ((const f32x4*)pp)[2 * i + 1];
            v4u o; o.x = pk2(a.x, a.y); o.y = pk2(a.z, a.w); o.z = pk2(b.x, b.y); o.w = pk2(b.z, b.w); ((v4u*)PBb)[i] = o; } }
    GRID_BAR();
    PH(14) { pg8::Gemm g{PBb, (const bf16*)(ws + WS_WPLE), M, D, PLE}; pg8::StaticOrder S; S.init(M, D, G, bx); pg8::EpiMix<0> E{Eb, nullptr, D};
      pg8::gemm_phase<pg8::EpiMix<0>, pg8::StaticOrder, PG8_ALIGN, PG8_SP2>(lds + RING_OFF, g, S, E); }
    PH(14) { pg8::Gemm g{XN, (const bf16*)(ws + WS_WPG), M, D, D}; pg8::StaticOrder S; S.init(M, D, G, bx); pg8::EpiPleB E{Eb, Fb, D};
      pg8::gemm_phase<pg8::EpiPleB, pg8::StaticOrder, PG8_ALIGN, PG8_SP2>(lds + RING_OFF, g, S, E); }
    GRID_BAR();
    PH(15) { COORDS(); rowwise_phase<0>(gw, NGW, lane, args.out, Fb, args.in[12] + 6 * D, 1.0f, args.out, nullptr); }
}

extern "C" void kernel_launch(void* const* d_in, const int* in_sizes, int n_in, void* d_out, int out_size, void* d_ws, size_t ws_size, hipStream_t stream) {
    static int grid = 0;
    if (grid == 0) {
        if (n_in != 16 || in_sizes[0] != M * D || out_size != M * D || ws_size < WS_END) { fprintf(stderr, "kernel_launch: unexpected shapes: n_in %d in0 %d out %d ws %zu; nothing launched\n", n_in, n_in > 0 ? in_sizes[0] : -1, out_size, ws_size); grid = -1; return; }
        int dev = 0, cus = 0;
        if (hipGetDevice(&dev) != hipSuccess || hipDeviceGetAttribute(&cus, hipDeviceAttributeMultiprocessorCount, dev) != hipSuccess) { fprintf(stderr, "kernel_launch: device query failed\n"); grid = -1; return; }
        if (hipFuncSetAttribute((const void*)mk_fwd, hipFuncAttributeMaxDynamicSharedMemorySize, LDS_BYTES) != hipSuccess) { fprintf(stderr, "kernel_launch: hipFuncSetAttribute failed\n"); grid = -1; return; }
        int per_cu = 0;
        if (hipOccupancyMaxActiveBlocksPerMultiprocessor(&per_cu, (const void*)mk_fwd, NWAVES * 64, LDS_BYTES) != hipSuccess || per_cu < 1) fprintf(stderr, "kernel_launch: note: occupancy query reports %d\n", per_cu);
        (void)hipGetLastError();
        grid = cus;
    }
    if (grid < 0) return;
    if (hipMemsetAsync((char*)d_ws + WS_CTL, 0, CTL_ZERO_BYTES, stream) != hipSuccess) { fprintf(stderr, "kernel_launch: memset failed\n"); return; }
    Args a{};
    for (int i = 0; i < 16; ++i) a.in[i] = (const float*)d_in[i];
    a.out = (float*)d_out; a.ws = (unsigned char*)d_ws; a.mask = 0xffffffffu; a.pad = 0u;
    hipLaunchKernelGGL(mk_fwd, dim3(grid), dim3(NWAVES * 64), LDS_BYTES, stream, a);
    const hipError_t le = hipPeekAtLastError();
    if (le != hipSuccess) fprintf(stderr, "kernel_launch: launch failed: %s\n", hipGetErrorName(le));
}
```

```cpp
#include <hip/hip_runtime.h>
#include <cstdio>
#include <cstdint>
namespace pg8 {
#define PG8_LAS __attribute__((address_space(3)))
typedef unsigned short bf16_t;
typedef short bf16x8 __attribute__((ext_vector_type(8)));
typedef float f32x4 __attribute__((ext_vector_type(4)));
typedef unsigned u32x4 __attribute__((ext_vector_type(4)));
constexpr int BM = 256, BK = 64, HALF = 128, HTB = HALF * BK * 2  , STAGE_BYTES = 8 * HTB, NXCD = 8, WGM = 8;

__host__ __device__ __forceinline__ int lds_byte(int r, int c) { const int st = (r >> 4) * 2 + (c >> 5), rr = r & 15, cc = c & 31, ob = rr * 64 + cc * 2; return st * 1024 + (ob ^ (((ob >> 9) & 1) << 5)); }
__host__ __device__ __forceinline__ void stage_rc(int b, int& R, int& C) { const int st = b / 1024, sb = b % 1024, swz = sb ^ (((sb >> 9) & 1) << 5); R = (st >> 1) * 16 + swz / 64; C = (st & 1) * 32 + (swz % 64) / 2; }
__host__ __device__ __forceinline__ int perm32(int rho) { const int n = rho >> 4, i = rho & 15; return 8 * (i >> 2) + 4 * n + (i & 3); }

struct Unit { int pm, pn; };
struct Gemm { const bf16_t* A; const bf16_t* Bt; int M, N, K; };

struct StaticOrder {
    int nM, nN, nwg, G, c;
    __host__ __device__ void init(int M, int N, int G_, int c_) { nM = M / BM; nN = N / BM; nwg = nM * nN; G = G_; c = c_; }
    __host__ __device__ bool next(int i, Unit& u) const {
        const long L = (long)i * G + c; if (L >= nwg) return false;
        int wgid = (int)L; { const int q = nwg / NXCD, r = nwg % NXCD, xcd = wgid % NXCD, off = wgid / NXCD; wgid = (xcd < r ? xcd * (q + 1) : r * (q + 1) + (xcd - r) * q) + off; }
        const int nig = WGM * nN, gid = wgid / nig, fm = gid * WGM, gsz = (nM - fm) < WGM ? (nM - fm) : WGM;
        u.pm = fm + ((wgid % nig) % gsz); u.pn = (wgid % nig) / gsz; return true;
    }
    __device__ __forceinline__ void a_ready(const Unit&) const {}
    __device__ __forceinline__ void done(const Unit&) const {}
};

typedef float f32x2_t __attribute__((ext_vector_type(2))); typedef __bf16 bf16x2_t __attribute__((ext_vector_type(2)));
__device__ __forceinline__ unsigned cvt_pk_bf16(float lo, float hi) { f32x2_t v = {lo, hi}; bf16x2_t b = __builtin_convertvector(v, bf16x2_t); return __builtin_bit_cast(unsigned, b); }
__device__ __forceinline__ float sigm(float x) { return __builtin_amdgcn_rcpf(1.0f + __builtin_amdgcn_exp2f(-1.4426950408889634f * x)); }
__device__ __forceinline__ float bf_lo(unsigned w) { return __uint_as_float(w << 16); }
__device__ __forceinline__ float bf_hi(unsigned w) { return __uint_as_float(w & 0xffff0000u); }
__device__ __forceinline__ void unpack8(const u32x4 w, float (&o)[8]) { o[0] = bf_lo(w.x); o[1] = bf_hi(w.x); o[2] = bf_lo(w.y); o[3] = bf_hi(w.y); o[4] = bf_lo(w.z); o[5] = bf_hi(w.z); o[6] = bf_lo(w.w); o[7] = bf_hi(w.w); }
__device__ __forceinline__ u32x4 pack8(const float (&o)[8]) { u32x4 w; w.x = cvt_pk_bf16(o[0], o[1]); w.y = cvt_pk_bf16(o[2], o[3]); w.z = cvt_pk_bf16(o[4], o[5]); w.w = cvt_pk_bf16(o[6], o[7]); return w; }

struct EpiGU {
    static constexpr bool PERM = true, AFTER_DRAIN = false;
    bf16_t* H; int ldh;
    __device__ __forceinline__ void operator()(const f32x4 (&acc)[2][2][4][2], const Unit& u, int wr, int wc, int fr, int fq) const {
        const int row0 = u.pm * BM + wr * 64 + fr, col0 = u.pn * HALF + wc * 32 + 8 * fq;
#pragma unroll
        for (int ai = 0; ai < 2; ++ai)
#pragma unroll
            for (int m = 0; m < 4; ++m) { bf16_t* rowp = H + (size_t)(row0 + ai * HALF + m * 16) * ldh + col0;
                const f32x4 g0 = acc[ai][0][m][0], g1 = acc[ai][0][m][1], u0 = acc[ai][1][m][0], u1 = acc[ai][1][m][1]; float o[8];
#pragma unroll
                for (int j = 0; j < 4; ++j) { o[j] = g0[j] * sigm(g0[j]) * u0[j]; o[4 + j] = g1[j] * sigm(g1[j]) * u1[j]; }
                *(u32x4*)rowp = pack8(o); }
    }
};
struct EpiF32 {
    static constexpr bool PERM = false, AFTER_DRAIN = false;
    float* C; int ldc;
    __device__ __forceinline__ void operator()(const f32x4 (&acc)[2][2][4][2], const Unit& u, int wr, int wc, int fr, int fq) const {
        const int row0 = u.pm * BM + wr * 64 + fr, col0 = u.pn * BM + wc * 32 + 4 * fq;
#pragma unroll
        for (int ai = 0; ai < 2; ++ai)
#pragma unroll
            for (int m = 0; m < 4; ++m) { float* rowp = C + (size_t)(row0 + ai * HALF + m * 16) * ldc + col0;
#pragma unroll
                for (int bj = 0; bj < 2; ++bj)
#pragma unroll
                    for (int n = 0; n < 2; ++n) *(f32x4*)(rowp + bj * HALF + n * 16) = acc[ai][bj][m][n]; }
    }
};
struct EpiIN {
    static constexpr bool PERM = true, AFTER_DRAIN = false;
    bf16_t *Q, *K, *HQ, *KIN, *HI, *HG, *SA, *SB; const float* LB; float* KMEAN;
    template <int MODE> __device__ __forceinline__ void body(const f32x4 (&acc)[2][2][4][2], bf16_t* base, int ldc, int row0, int cbase, int pm, int fr) const {
        float lbv[2][8]; float ks[2][8];
#pragma unroll
        for (int bj = 0; bj < 2; ++bj)
#pragma unroll
            for (int j = 0; j < 8; ++j) { lbv[bj][j] = (MODE == 2) ? (1.0f - LB[cbase + bj * HALF + j]) : 0.f; ks[bj][j] = 0.f; }
#pragma unroll
        for (int ai = 0; ai < 2; ++ai)
#pragma unroll
            for (int m = 0; m < 4; ++m) { bf16_t* rowp = base + (size_t)(row0 + ai * HALF + m * 16) * ldc + cbase;
#pragma unroll
                for (int bj = 0; bj < 2; ++bj) { const f32x4 v0 = acc[ai][bj][m][0], v1 = acc[ai][bj][m][1]; float o[8];
#pragma unroll
                    for (int j = 0; j < 4; ++j) { o[j] = v0[j]; o[4 + j] = v1[j]; }
#pragma unroll
                    for (int j = 0; j < 8; ++j) {
                        if (MODE == 1) o[j] = o[j] * sigm(o[j]);
                        if (MODE == 2) o[j] = lbv[bj][j] * sigm(-o[j]);
                        if (MODE == 3) o[j] = sigm(o[j]);
                        if (MODE == 4) ks[bj][j] += o[j]; }
                    *(u32x4*)(rowp + bj * HALF) = pack8(o); } }
        if (MODE == 4) {
#pragma unroll
            for (int bj = 0; bj < 2; ++bj)
#pragma unroll
                for (int j = 0; j < 8; ++j) { float s = ks[bj][j]; s += __shfl_xor(s, 1); s += __shfl_xor(s, 2); s += __shfl_xor(s, 4); s += __shfl_xor(s, 8);
                    if (fr == 0) atomicAdd(KMEAN + (size_t)pm * 512 + cbase + bj * HALF + j, s); }
        }
    }
    __device__ __forceinline__ void operator()(const f32x4 (&acc)[2][2][4][2], const Unit& u, int wr, int wc, int fr, int fq) const {
        const int pn = u.pn, row0 = u.pm * BM + wr * 64 + fr, cw = wc * 32 + 8 * fq;
        if (pn < 2)       body<0>(acc, Q,   512,  row0, (pn)      * BM + cw, u.pm, fr);
        else if (pn < 4)  body<4>(acc, K,   512,  row0, (pn - 2)  * BM + cw, u.pm, fr);
        else if (pn < 6)  body<1>(acc, HQ,  512,  row0, (pn - 4)  * BM + cw, u.pm, fr);
        else if (pn < 8)  body<2>(acc, KIN, 512,  row0, (pn - 6)  * BM + cw, u.pm, fr);
        else if (pn < 10) body<0>(acc, HI,  512,  row0, (pn - 8)  * BM + cw, u.pm, fr);
        else if (pn < 12) body<1>(acc, HG,  512,  row0, (pn - 10) * BM + cw, u.pm, fr);
        else if (pn < 16) body<3>(acc, SA,  1024, row0, (pn - 12) * BM + cw, u.pm, fr);
        else              body<3>(acc, SB,  1024, row0, (pn - 16) * BM + cw, u.pm, fr);
    }
};
template <int MODE> struct EpiMix {
    static constexpr bool PERM = true, AFTER_DRAIN = false;
    bf16_t* T; const bf16_t* S2; int ldc;
    __device__ __forceinline__ void operator()(const f32x4 (&acc)[2][2][4][2], const Unit& u, int wr, int wc, int fr, int fq) const {
        const int row0 = u.pm * BM + wr * 64 + fr, col0 = u.pn * BM + wc * 32 + 8 * fq;
#pragma unroll
        for (int ai = 0; ai < 2; ++ai)
#pragma unroll
            for (int m = 0; m < 4; ++m) { const size_t off = (size_t)(row0 + ai * HALF + m * 16) * ldc + col0;
#pragma unroll
                for (int bj = 0; bj < 2; ++bj) { const f32x4 v0 = acc[ai][bj][m][0], v1 = acc[ai][bj][m][1]; float o[8];
#pragma unroll
                    for (int j = 0; j < 4; ++j) { o[j] = v0[j]; o[4 + j] = v1[j]; }
                    if (MODE == 1) { float t[8]; unpack8(*(const u32x4*)(T + off + bj * HALF), t);
#pragma unroll
                        for (int j = 0; j < 8; ++j) o[j] = t[j] * o[j]; }
                    if (MODE == 2) { float t[8], s[8]; unpack8(*(const u32x4*)(T + off + bj * HALF), t); unpack8(*(const u32x4*)(S2 + off + bj * HALF), s);
#pragma unroll
                        for (int j = 0; j < 8; ++j) o[j] = t[j] + s[j] * o[j]; }
                    *(u32x4*)(T + off + bj * HALF) = pack8(o); } }
    }
};
struct EpiPleB {
    static constexpr bool PERM = true, AFTER_DRAIN = false;
    const bf16_t* E; float* Y; int ldc;
    __device__ __forceinline__ void operator()(const f32x4 (&acc)[2][2][4][2], const Unit& u, int wr, int wc, int fr, int fq) const {
        const int row0 = u.pm * BM + wr * 64 + fr, col0 = u.pn * BM + wc * 32 + 8 * fq;
#pragma unroll
        for (int ai = 0; ai < 2; ++ai)
#pragma unroll
            for (int m = 0; m < 4; ++m) { const size_t off = (size_t)(row0 + ai * HALF + m * 16) * ldc + col0;
#pragma unroll
                for (int bj = 0; bj < 2; ++bj) { const f32x4 v0 = acc[ai][bj][m][0], v1 = acc[ai][bj][m][1]; float e[8]; unpack8(*(const u32x4*)(E + off + bj * HALF), e);
                    f32x4 o0, o1;
#pragma unroll
                    for (int j = 0; j < 4; ++j) { o0[j] = sigm(v0[j]) * e[j]; o1[j] = sigm(v1[j]) * e[4 + j]; }
                    *(f32x4*)(Y + off + bj * HALF) = o0; *(f32x4*)(Y + off + bj * HALF + 4) = o1; } }
    }
};

template <class Epi, class Sched, bool ALIGN_EPI = false, bool SP2 = false>
__device__ __forceinline__ void gemm_phase(PG8_LAS unsigned char* lds, const Gemm g, const Sched& S, const Epi& E) {
    int tid_ = threadIdx.x; asm volatile("" : "+v"(tid_));
    const int tid = tid_, wid = __builtin_amdgcn_readfirstlane(tid >> 6), lane = tid & 63, wr = wid >> 2, wc = wid & 3, fr = lane & 15, fq = lane >> 4;
    int K_ = g.K; asm volatile("" : "+s"(K_));
    const int K = K_, nt = K / BK;
    unsigned voffA[2], voffB[2];
#pragma unroll
    for (int i = 0; i < 2; ++i) { int R, C; stage_rc(tid * 16 + i * 8192, R, C); const int Rb = Epi::PERM ? ((R & ~31) + perm32(R & 31)) : R;
        voffA[i] = (unsigned)(R * K + C) * 2u; voffB[i] = (unsigned)(Rb * K + C) * 2u; }
    const size_t kstep = (size_t)(BK * 2);
    const size_t hstep = (size_t)HALF * K * 2;
    const size_t tstep = 2 * hstep;
    const unsigned ldsw = (unsigned)wid * 1024u;
    const int aoff = lds_byte(wr * 64 + fr, fq * 8), boff = lds_byte(wc * 32 + fr, fq * 8);
#define PG8_SA(b, h) (((b) * 2 + (h)) * HTB)
#define PG8_SB(b, h) ((4 + (b) * 2 + (h)) * HTB)
#define PG8_STAGE(bufoff, gbase, voff) do { _Pragma("unroll") for (int _i = 0; _i < 2; ++_i) \
        __builtin_amdgcn_global_load_lds((const unsigned*)((const char*)(gbase) + (voff)[_i]), (PG8_LAS unsigned*)(lds + (bufoff) + ldsw + _i * 8192), 16, 0, 0); } while (0)
#define PG8_LDA(dst, b, h) do { _Pragma("unroll") for (int m = 0; m < 4; ++m) _Pragma("unroll") for (int k = 0; k < 2; ++k) dst[m][k] = *(const PG8_LAS bf16x8*)(lds + PG8_SA(b, h) + aoff + m * 2048 + k * 1024); } while (0)
#define PG8_LDB(dst, b, h) do { _Pragma("unroll") for (int n = 0; n < 2; ++n) _Pragma("unroll") for (int k = 0; k < 2; ++k) dst[n][k] = *(const PG8_LAS bf16x8*)(lds + PG8_SB(b, h) + boff + n * 2048 + k * 1024); } while (0)
#define PG8_MMA(ai, bj, At, Bt) do { __builtin_amdgcn_s_setprio(1); _Pragma("unroll") for (int m = 0; m < 4; ++m) _Pragma("unroll") for (int n = 0; n < 2; ++n) _Pragma("unroll") for (int k = 0; k < 2; ++k) \
        acc[ai][bj][m][n] = __builtin_amdgcn_mfma_f32_16x16x32_bf16(Bt[n][k], At[m][k], acc[ai][bj][m][n], 0, 0, 0); __builtin_amdgcn_s_setprio(0); } while (0)
#define PG8_WAIT_V(n) asm volatile("s_waitcnt vmcnt(" #n ")" ::: "memory")
#define PG8_WAIT_L(n) asm volatile("s_waitcnt lgkmcnt(" #n ")" ::: "memory")
#define PG8_BAR __builtin_amdgcn_s_barrier()
#define PG8_SCHED __builtin_amdgcn_sched_barrier(0)
    Unit cur, nxt; int ui = 0;
    if (!S.next(0, cur)) return;
    f32x4 acc[2][2][4][2];
#pragma unroll
    for (int a = 0; a < 2; ++a)
#pragma unroll
        for (int b = 0; b < 2; ++b)
#pragma unroll
            for (int m = 0; m < 4; ++m)
#pragma unroll
                for (int n = 0; n < 2; ++n) acc[a][b][m][n] = (f32x4){0.f, 0.f, 0.f, 0.f};
    bf16x8 At[4][2], B0[2][2], B1[2][2];
    const char* cA = (const char*)g.A + (size_t)cur.pm * tstep; const char* cB = (const char*)g.Bt + (size_t)cur.pn * tstep;
    S.a_ready(cur);
    if constexpr (SP2) {
        PG8_STAGE(PG8_SB(0, 0), cB, voffB); PG8_STAGE(PG8_SB(0, 1), cB + hstep, voffB); PG8_STAGE(PG8_SA(0, 0), cA, voffA); PG8_STAGE(PG8_SA(0, 1), cA + hstep, voffA);
        if (wr == 1) PG8_BAR;
        PG8_WAIT_V(2); PG8_BAR;
        PG8_STAGE(PG8_SB(1, 0), cB + kstep, voffB); PG8_STAGE(PG8_SA(1, 0), cA + kstep, voffA); PG8_STAGE(PG8_SB(1, 1), cB + hstep + kstep, voffB);
        PG8_WAIT_V(6); PG8_BAR;
    } else {
        PG8_STAGE(PG8_SB(0, 0), cB, voffB); PG8_STAGE(PG8_SA(0, 0), cA, voffA); PG8_STAGE(PG8_SB(0, 1), cB + hstep, voffB); PG8_STAGE(PG8_SA(0, 1), cA + hstep, voffA);
        if (wr == 1) PG8_BAR;
        PG8_WAIT_V(4); PG8_BAR;
        PG8_STAGE(PG8_SB(1, 0), cB + kstep, voffB); PG8_STAGE(PG8_SA(1, 0), cA + kstep, voffA); PG8_STAGE(PG8_SB(1, 1), cB + hstep + kstep, voffB);
        PG8_WAIT_V(6); PG8_BAR;
    }
    for (;;) {
        const bool has_next = S.next(ui + 1, nxt);
        const char* nA = has_next ? (const char*)g.A + (size_t)nxt.pm * tstep : cA; const char* nB = has_next ? (const char*)g.Bt + (size_t)nxt.pn * tstep : cB;
        for (int t = 0; t < nt; t += 2) {
            const bool last = (t == nt - 2);
            const char* a1 = cA + (size_t)(t + 1) * kstep;
            const char* a2 = last ? nA : cA + (size_t)(t + 2) * kstep; const char* b2 = last ? nB : cB + (size_t)(t + 2) * kstep;
            const char* a3 = a2 + kstep; const char* b3 = b2 + kstep;
            if (last && has_next) S.a_ready(nxt);
            if constexpr (SP2) {
            PG8_LDB(B0, 0, 0); PG8_LDB(B1, 0, 1); PG8_SCHED; PG8_LDA(At, 0, 0); PG8_STAGE(PG8_SA(1, 1), a1 + hstep, voffA);
            PG8_WAIT_V(8); PG8_WAIT_L(0); PG8_BAR; PG8_MMA(0, 0, At, B0); PG8_MMA(0, 1, At, B1); PG8_BAR; PG8_SCHED;
            PG8_LDA(At, 0, 1); PG8_STAGE(PG8_SB(0, 0), b2, voffB); PG8_STAGE(PG8_SB(0, 1), b2 + hstep, voffB); PG8_STAGE(PG8_SA(0, 0), a2, voffA);
            PG8_WAIT_V(8); PG8_WAIT_L(0); PG8_BAR; PG8_MMA(1, 0, At, B0); PG8_MMA(1, 1, At, B1); PG8_BAR; PG8_SCHED;
            PG8_LDB(B0, 1, 0); PG8_LDB(B1, 1, 1); PG8_SCHED; PG8_LDA(At, 1, 0); PG8_STAGE(PG8_SA(0, 1), a2 + hstep, voffA);
            PG8_WAIT_V(8); PG8_WAIT_L(0); PG8_BAR; PG8_MMA(0, 0, At, B0); PG8_MMA(0, 1, At, B1); PG8_BAR; PG8_SCHED;
            PG8_LDA(At, 1, 1); PG8_STAGE(PG8_SB(1, 0), b3, voffB); PG8_STAGE(PG8_SB(1, 1), b3 + hstep, voffB); PG8_STAGE(PG8_SA(1, 0), a3, voffA);
            PG8_WAIT_V(8); PG8_WAIT_L(0); PG8_BAR; PG8_MMA(1, 0, At, B0); PG8_MMA(1, 1, At, B1); PG8_BAR; PG8_SCHED;
            } else {
            PG8_LDB(B0, 0, 0); PG8_SCHED; PG8_LDA(At, 0, 0); PG8_STAGE(PG8_SA(1, 1), a1 + hstep, voffA);
            PG8_WAIT_L(8); PG8_BAR; PG8_WAIT_L(0); PG8_MMA(0, 0, At, B0); PG8_BAR; PG8_SCHED;
            PG8_LDB(B1, 0, 1); PG8_STAGE(PG8_SB(0, 0), b2, voffB);
            PG8_BAR; PG8_WAIT_L(0); PG8_MMA(0, 1, At, B1); PG8_BAR;
            PG8_LDA(At, 0, 1); PG8_STAGE(PG8_SA(0, 0), a2, voffA);
            PG8_BAR; PG8_WAIT_L(0); PG8_MMA(1, 0, At, B0); PG8_BAR; PG8_SCHED;
            PG8_STAGE(PG8_SB(0, 1), b2 + hstep, voffB);
            PG8_WAIT_V(6); PG8_BAR; PG8_MMA(1, 1, At, B1); PG8_BAR;
            PG8_LDB(B0, 1, 0); PG8_SCHED; PG8_LDA(At, 1, 0); PG8_STAGE(PG8_SA(0, 1), a2 + hstep, voffA);
            PG8_WAIT_L(8); PG8_BAR; PG8_WAIT_L(0); PG8_MMA(0, 0, At, B0); PG8_BAR; PG8_SCHED;
            PG8_LDB(B1, 1, 1); PG8_STAGE(PG8_SB(1, 0), b3, voffB);
            PG8_BAR; PG8_WAIT_L(0); PG8_MMA(0, 1, At, B1); PG8_BAR;
            PG8_LDA(At, 1, 1); PG8_STAGE(PG8_SA(1, 0), a3, voffA);
            PG8_BAR; PG8_WAIT_L(0); PG8_MMA(1, 0, At, B0); PG8_BAR; PG8_SCHED;
            PG8_STAGE(PG8_SB(1, 1), b3 + hstep, voffB);
            PG8_WAIT_V(6); PG8_BAR; PG8_MMA(1, 1, At, B1); PG8_BAR;
            }
        }
        if constexpr (ALIGN_EPI) { if (wr == 0) PG8_BAR; }
        if constexpr (!Epi::AFTER_DRAIN) { E(acc, cur, wr, wc, fr, fq); S.done(cur); }
        if (!has_next) break;
#pragma unroll
        for (int a = 0; a < 2; ++a)
#pragma unroll
            for (int b = 0; b < 2; ++b)
#pragma unroll
                for (int m = 0; m < 4; ++m)
#pragma unroll
                    for (int n = 0; n < 2; ++n) acc[a][b][m][n] = (f32x4){0.f, 0.f, 0.f, 0.f};
        cur = nxt; cA = nA; cB = nB; ++ui;
        if constexpr (ALIGN_EPI) { if (wr == 1) PG8_BAR; }
    }
    PG8_WAIT_V(0);
    if constexpr (!ALIGN_EPI) { if (wr == 0) PG8_BAR; }
    PG8_BAR;
    if constexpr (Epi::AFTER_DRAIN) { E.fused(acc, cur, wr, wc, fr, fq, lds, wid, lane); S.done(cur); }
#undef PG8_SA
#undef PG8_SB
#undef PG8_STAGE
#undef PG8_LDA
#undef PG8_LDB
#undef PG8_MMA
#undef PG8_WAIT_V
#undef PG8_WAIT_L
#undef PG8_BAR
#undef PG8_SCHED
}
}
#ifndef PG8_SP2
#define PG8_SP2 true
#endif
#ifndef PG8_ALIGN
#define PG8_ALIGN true
#endif
constexpr int NWAVES = 8;
constexpr int BATCH = 4, SEQ = 8192, D = 1024, FF = 2816, NGU = 2 * FF, NIN = 5632, PLE = 256;
constexpr int M = BATCH * SEQ;
constexpr int MBH = 8, MBD = 64, MBW = 512, MBB = 256, NBLK = SEQ / MBB;
constexpr int HGH = 4, HGD_ = 128, HGW = 512, HGC = 256, HGNC = SEQ / HGC;
constexpr float EPS = 1e-6f;
constexpr size_t MiB = 1u << 20;
constexpr size_t WS_CTL = 0, CTL_ZERO_BYTES = 1 * MiB;
constexpr size_t WS_KMEAN = 512 * 1024;
constexpr size_t WS_LB = 768 * 1024, WS_BIAST = 772 * 1024;
constexpr size_t WS_WGU1 = 1 * MiB, WS_WD1 = 12 * MiB, WS_WIN = WS_WD1 + 5632 * 1024, WS_WA = WS_WIN + 11 * MiB, WS_WB = WS_WA + 1 * MiB, WS_WOUT = WS_WB + 1 * MiB,
                 WS_WGU2 = WS_WOUT + 2 * MiB, WS_WD2 = WS_WGU2 + 11 * MiB, WS_WPLE = WS_WD2 + 5632 * 1024, WS_WPG = WS_WPLE + 512 * 1024, WS_HGD = WS_WPG + 2 * MiB;
constexpr size_t WS_CNT = 256 * 1024;
constexpr size_t WS_A = 52 * MiB;
constexpr size_t WS_Q = WS_A, WS_K = WS_A + 32 * MiB, WS_VT = WS_A + 64 * MiB, WS_HQ = WS_A + 96 * MiB, WS_HI = WS_A + 128 * MiB;
constexpr size_t WS_LIST = 212 * MiB;
constexpr size_t WS_PB = 228 * MiB;
constexpr size_t WS_SB = 228 * MiB;
constexpr size_t WS_PML = 292 * MiB;
constexpr size_t WS_B = 320 * MiB;
constexpr size_t WS_KIN = WS_B, WS_HG = WS_B + 32 * MiB, WS_SA = WS_B + 64 * MiB;
constexpr size_t WS_C = 448 * MiB;
constexpr size_t WS_HS = WS_C, WS_OA = WS_C, WS_OB = WS_C + 32 * MiB;
constexpr size_t WS_PO0 = WS_HQ, WS_PO1 = WS_HI, WS_PO2 = WS_KIN, WS_PO3 = WS_HG;
constexpr size_t WS_END = 512 * MiB;
static_assert(WS_HGD + 256 * 1024 <= WS_A, "weights region");
constexpr int LIST_PER_BH = 126976;
constexpr int CW_TMO = 0, CW_CODE = 1, CW_BAR = 4096;
constexpr int RING_OFF = 0, RING_BYTES = 131072, LDSCTL_OFF = RING_BYTES, MISC_OFF = LDSCTL_OFF + 320, LDS_BYTES = 147456;
#define GAS __attribute__((address_space(1)))
#define LAS __attribute__((address_space(3)))
typedef unsigned short bf16;
typedef unsigned v4u __attribute__((ext_vector_type(4)));
typedef unsigned v2u __attribute__((ext_vector_type(2)));
typedef float f32x4 __attribute__((ext_vector_type(4)));
typedef GAS unsigned gu32;
#define RLX_AGENT __ATOMIC_RELAXED, __HIP_MEMORY_SCOPE_AGENT
#define LDS_WAIT() asm volatile("s_waitcnt lgkmcnt(0)" ::: "memory")
#define VM_WAIT() asm volatile("s_waitcnt vmcnt(0)" ::: "memory")
__device__ __forceinline__ unsigned f2bf(float f) { unsigned u = __builtin_bit_cast(unsigned, f); return (u + 0x7fffu + ((u >> 16) & 1u)) >> 16; }
__device__ __forceinline__ unsigned pk2(float lo, float hi) { return f2bf(lo) | (f2bf(hi) << 16); }
__device__ __forceinline__ float bflo(unsigned w) { return __uint_as_float(w << 16); }
__device__ __forceinline__ float bfhi(unsigned w) { return __uint_as_float(w & 0xffff0000u); }
__device__ __forceinline__ float wave_sum(float v) {
#pragma unroll
    for (int o = 1; o < 64; o <<= 1) v += __shfl_xor(v, o);
    return v;
}
__device__ __forceinline__ float wave_max(float v) {
#pragma unroll
    for (int o = 1; o < 64; o <<= 1) v = fmaxf(v, __shfl_xor(v, o));
    return v;
}
#define XB_TMO      128
#define XB_XCNT(j)  (256  + 64 * (j))
#define XB_XSUB(j)  (1280 + 64 * (j))
#define XB_XGEN(j)  (2304 + 64 * (j))
#define XB_TOP      3328
#define XB_TOPGEN   3392
#define XCD_BAR_WORDS 3456
#define XB_SPIN_CAP (1u << 18)

__device__ __forceinline__ unsigned xb_ld(unsigned* p)              { return __hip_atomic_load(p, __ATOMIC_RELAXED, __HIP_MEMORY_SCOPE_AGENT); }
__device__ __forceinline__ unsigned xb_add(unsigned* p, unsigned v) { return __hip_atomic_fetch_add(p, v, __ATOMIC_RELAXED, __HIP_MEMORY_SCOPE_AGENT); }
__device__ __forceinline__ unsigned xb_xcc_id() { return (unsigned)__builtin_amdgcn_s_getreg((3 << 11) | 20) & 0xFu; }
#define XB_SPIN(cond, bar) do { unsigned _sp = 0; while (cond) { __builtin_amdgcn_s_sleep(1); \
    if ((++_sp & 255u) == 0u) { if (xb_ld(&(bar)[XB_TMO])) break; if (_sp > XB_SPIN_CAP) { atomicAdd(&(bar)[XB_TMO], 1u); break; } } } } while (0)

struct XcdBarrier {
    unsigned* bar; unsigned x;
    volatile LAS unsigned* st;
};

__device__ __forceinline__ XcdBarrier xcd_barrier_post(unsigned* bar, volatile LAS unsigned* st) {
    XcdBarrier b; b.bar = bar; b.x = xb_xcc_id(); b.st = st;
    if (threadIdx.x == 0) (void)xb_add(&bar[XB_XCNT(b.x)], 1u);
    return b;
}
__device__ __forceinline__ void xcd_barrier_complete(unsigned* bar, unsigned x, unsigned& nloc, unsigned& nx) {
    const unsigned G = gridDim.x * gridDim.y * gridDim.z;
    unsigned sum, cnt, mine, sp = 0u;
    for (;;) {
        sum = 0u; cnt = 0u; mine = 0u;
#pragma unroll
        for (unsigned j = 0; j < 16; ++j) { const unsigned c = xb_ld(&bar[XB_XCNT(j)]); sum += c; cnt += (c > 0u) ? 1u : 0u; mine = (j == x) ? c : mine; }
        if (sum == G) break;
        __builtin_amdgcn_s_sleep(1);
        if ((++sp & 255u) == 0u) { if (xb_ld(&bar[XB_TMO])) break; if (sp > XB_SPIN_CAP) { atomicAdd(&bar[XB_TMO], 1u); break; } }
    }
    nloc = mine > 0u ? mine : 1u; nx = cnt > 0u ? cnt : 1u;
}

__device__ __forceinline__ void xcd_barrier(const XcdBarrier& b) {
    asm volatile("s_waitcnt vmcnt(0)" ::: "memory");
    __syncthreads();
    if (threadIdx.x == 0) {
        unsigned* bar = b.bar;
        __builtin_amdgcn_s_waitcnt(0);
        unsigned nloc = b.st[0], nx = b.st[1];
        if (nloc == 0u) { xcd_barrier_complete(bar, b.x, nloc, nx); b.st[0] = nloc; b.st[1] = nx; }
        const unsigned old = xb_add(&bar[XB_XSUB(b.x)], 1u);
        const unsigned gen = old / nloc;
        if (old + 1u == (gen + 1u) * nloc) {
            __builtin_amdgcn_fence(__ATOMIC_RELEASE, "agent");
            asm volatile("s_waitcnt vmcnt(0)" ::: "memory");
            const unsigned og = xb_add(&bar[XB_TOP], 1u);
            const unsigned tg = og / nx;
            if (og + 1u == (tg + 1u) * nx) xb_add(&bar[XB_TOPGEN], 1u);
            else XB_SPIN(xb_ld(&bar[XB_TOPGEN]) == tg, bar);
            __builtin_amdgcn_fence(__ATOMIC_ACQUIRE, "agent");
            xb_add(&bar[XB_XGEN(b.x)], 1u);
            asm volatile("s_waitcnt vmcnt(0)" ::: "memory");
        } else {
            XB_SPIN(xb_ld(&bar[XB_XGEN(b.x)]) == gen, bar);
            __builtin_amdgcn_fence(__ATOMIC_ACQUIRE, "agent");
            asm volatile("s_waitcnt vmcnt(0)" ::: "memory");
        }
    }
    __syncthreads();
}
__device__ __forceinline__ void p0_transpose_item(const float* W, int K, int N, bf16* WT, const float* gain, int mode, LAS float* scr, int item, int lane) {
    const int nblk = N / 32, kb = item / nblk, nb = item % nblk, k0 = 64 * kb, n0 = 32 * nb;
#pragma unroll 8
    for (int i = 0; i < 32; ++i) { const int kk = 2 * i + (lane >> 5); float w = W[(size_t)(k0 + kk) * N + n0 + (lane & 31)]; if (gain) w *= gain[k0 + kk]; scr[kk * 33 + (lane & 31)] = w; }
    LDS_WAIT(); asm volatile("" ::: "memory");
    int rbase = n0;
    if (mode == 1) { if (n0 < FF) rbase = (n0 / 128) * 256 + (n0 % 128); else { const int j = n0 - FF; rbase = (j / 128) * 256 + 128 + (j % 128); } }
    if (mode == 2) { if (n0 >= 1024 && n0 < 1536) rbase = 5120 + (n0 - 1024); else if (n0 >= 1536) rbase = n0 - 512; }
    const int c = lane & 7;
#pragma unroll
    for (int j = 0; j < 4; ++j) { const int n = (lane >> 3) + 8 * j; const LAS float* s = scr + (8 * c) * 33 + n;
        v4u o; o.x = pk2(s[0 * 33], s[1 * 33]); o.y = pk2(s[2 * 33], s[3 * 33]); o.z = pk2(s[4 * 33], s[5 * 33]); o.w = pk2(s[6 * 33], s[7 * 33]);
        *(GAS v4u*)(WT + (size_t)(rbase + n) * K + k0 + 8 * c) = o; }
    LDS_WAIT(); asm volatile("" ::: "memory");
}
__device__ __forceinline__ void rms_row_to_bf16(const float* xrow, bf16* orow, int lane) {
    const GAS f32x4* xr = (const GAS f32x4*)xrow + lane;
    f32x4 v[4]; float s = 0.f;
#pragma unroll
    for (int j = 0; j < 4; ++j) { v[j] = xr[64 * j]; s += (v[j].x * v[j].x + v[j].y * v[j].y) + (v[j].z * v[j].z + v[j].w * v[j].w); }
    const float rstd = 1.f / sqrtf(wave_sum(s) * (1.f / D) + EPS);
    GAS unsigned long long* o8 = (GAS unsigned long long*)orow + lane;
#pragma unroll
    for (int j = 0; j < 4; ++j) o8[64 * j] = (unsigned long long)pk2(v[j].x * rstd, v[j].y * rstd) | ((unsigned long long)pk2(v[j].z * rstd, v[j].w * rstd) << 32);
}
struct Ptrs {
    const float *x, *p, *w_gu1, *w_d1, *w_in, *w_a, *w_b, *w_out, *w_gu2, *w_d2, *w_ple, *w_pg, *gains, *hgw, *lbp, *rel;
    float* out; unsigned char* ws;
};
__device__ __forceinline__ void p0_prologue(const Ptrs P, LAS unsigned char* lds, int gw, int NGW, int wave, int lane) {
    LAS float* scr = (LAS float*)(lds + RING_OFF + wave * 16384);
    unsigned char* ws = P.ws;
    constexpr int I_GU = (D / 64) * (NGU / 32), I_D = (FF / 64) * (D / 32), I_IN = (D / 64) * (NIN / 32), I_AB = (512 / 64) * (D / 32), I_O = (D / 64) * (D / 32), I_PLE = (PLE / 64) * (D / 32);
    constexpr int NITEMS = 2 * I_GU + 2 * I_D + I_IN + 2 * I_AB + 2 * I_O + I_PLE;
    for (int it = gw; it < NITEMS; it += NGW) {
        int r = it;
        if (r < I_GU) { p0_transpose_item(P.w_gu1, D, NGU, (bf16*)(ws + WS_WGU1), P.gains + 0 * D, 1, scr, r, lane); continue; } r -= I_GU;
        if (r < I_GU) { p0_transpose_item(P.w_gu2, D, NGU, (bf16*)(ws + WS_WGU2), P.gains + 4 * D, 1, scr, r, lane); continue; } r -= I_GU;
        if (r < I_IN) { p0_transpose_item(P.w_in, D, NIN, (bf16*)(ws + WS_WIN), P.gains + 2 * D, 2, scr, r, lane); continue; } r -= I_IN;
        if (r < I_D)  { p0_transpose_item(P.w_d1, FF, D, (bf16*)(ws + WS_WD1), nullptr, 0, scr, r, lane); continue; } r -= I_D;
        if (r < I_D)  { p0_transpose_item(P.w_d2, FF, D, (bf16*)(ws + WS_WD2), nullptr, 0, scr, r, lane); continue; } r -= I_D;
        if (r < I_AB) { p0_transpose_item(P.w_a, 512, D, (bf16*)(ws + WS_WA), nullptr, 0, scr, r, lane); continue; } r -= I_AB;
        if (r < I_AB) { p0_transpose_item(P.w_b, 512, D, (bf16*)(ws + WS_WB), nullptr, 0, scr, r, lane); continue; } r -= I_AB;
        if (r < I_O)  { p0_transpose_item(P.w_out, D, D, (bf16*)(ws + WS_WOUT), nullptr, 0, scr, r, lane); continue; } r -= I_O;
        if (r < I_O)  { p0_transpose_item(P.w_pg, D, D, (bf16*)(ws + WS_WPG), nullptr, 0, scr, r, lane); continue; } r -= I_O;
        p0_transpose_item(P.w_ple, PLE, D, (bf16*)(ws + WS_WPLE), nullptr, 0, scr, r, lane);
    }
    for (int m = gw; m < M; m += NGW) rms_row_to_bf16(P.x + (size_t)m * D, (bf16*)(ws + WS_C) + (size_t)m * D, lane);
    const int gt = gw * 64 + lane;
    if (gt < 512) { const float a = P.lbp[gt], b = P.lbp[512 + gt]; const float mx = fmaxf(a, b); const float ea = expf(a - mx), eb = expf(b - mx); ((float*)(ws + WS_LB))[gt] = ea / (ea + eb); }
    if (gt >= 1024 && gt < 2048) { const int h = (gt - 1024) >> 7, d = (gt - 1024) & 127; int bk;
        if (d < 16) bk = d; else { bk = 16 + (int)(logf((float)d / 16.0f) / logf(8.0f) * 16.0f); if (bk > 31) bk = 31; }
        ((float*)(ws + WS_BIAST))[h * 128 + d] = P.rel[bk * 8 + h]; }
}
template <int MODE> __device__ __forceinline__ void rowwise_phase(int gw, int NGW, int lane, const float* hin, const float* Y, const float* gain, float coef, float* hout, bf16* xn) {
    f32x4 g[4];
#pragma unroll
    for (int j = 0; j < 4; ++j) g[j] = ((const f32x4*)gain)[lane + 64 * j] * coef;
    for (int m = gw; m < M; m += NGW) {
        const GAS f32x4* yr = (const GAS f32x4*)(Y + (size_t)m * D) + lane; const GAS f32x4* hr = (const GAS f32x4*)(hin + (size_t)m * D) + lane;
        f32x4 y[4], h[4]; float s = 0.f;
#pragma unroll
        for (int j = 0; j < 4; ++j) { y[j] = yr[64 * j]; h[j] = hr[64 * j]; s += (y[j].x * y[j].x + y[j].y * y[j].y) + (y[j].z * y[j].z + y[j].w * y[j].w); }
        const float rstd = 1.f / sqrtf(wave_sum(s) * (1.f / D) + EPS);
        float s2 = 0.f;
#pragma unroll
        for (int j = 0; j < 4; ++j) { h[j] = h[j] + (g[j] * y[j]) * rstd; s2 += (h[j].x * h[j].x + h[j].y * h[j].y) + (h[j].z * h[j].z + h[j].w * h[j].w); }
        GAS f32x4* ho = (GAS f32x4*)(hout + (size_t)m * D) + lane;
#pragma unroll
        for (int j = 0; j < 4; ++j) ho[64 * j] = h[j];
        if (MODE != 0) {
            float r2 = 1.f;
            if (MODE == 1) r2 = 1.f / sqrtf(wave_sum(s2) * (1.f / D) + EPS);
            GAS unsigned long long* o8 = (GAS unsigned long long*)(xn + (size_t)m * D) + lane;
#pragma unroll
            for (int j = 0; j < 4; ++j) o8[64 * j] = (unsigned long long)pk2(h[j].x * r2, h[j].y * r2) | ((unsigned long long)pk2(h[j].z * r2, h[j].w * r2) << 32);
        }
    }
}
__device__ __forceinline__ int moba_list_base(int bh, int j) { return bh * LIST_PER_BH + 256 * (31 * j - (j * (j - 1)) / 2); }
__device__ __forceinline__ void moba_gating_phase(LAS unsigned char* lds, int vcu, int G, int tid, const bf16* Q, const float* KMEAN, unsigned* CNT, unsigned* LIST) {
    LAS float* km = (LAS float*)lds;
    const int lane = tid & 63;
    for (int unit = vcu; unit < BATCH * NBLK * 4; unit += G) {
        const int hp = unit & 3, i = (unit >> 2) & 31, b = unit >> 7;
        __syncthreads();
        for (int e = tid; e < i * 128; e += 512) { const int j = e >> 7, c = e & 127; km[e] = KMEAN[(size_t)(b * NBLK + j) * 512 + hp * 128 + c] * (1.0f / 256.0f); }
        __syncthreads();
        const int hh = __builtin_amdgcn_readfirstlane(tid >> 8), ql = tid & 255, m = b * SEQ + i * MBB + ql, h = 2 * hp + hh;
        float q[64];
        { const v4u* qp = (const v4u*)(Q + (size_t)m * MBW + h * MBD);
#pragma unroll
          for (int c = 0; c < 8; ++c) { const v4u w = qp[c]; q[8 * c + 0] = bflo(w.x); q[8 * c + 1] = bfhi(w.x); q[8 * c + 2] = bflo(w.y); q[8 * c + 3] = bfhi(w.y); q[8 * c + 4] = bflo(w.z); q[8 * c + 5] = bfhi(w.z); q[8 * c + 6] = bflo(w.w); q[8 * c + 7] = bfhi(w.w); } }
        float v0 = -INFINITY, v1 = -INFINITY, v2 = -INFINITY; int i0 = -1, i1 = -1, i2 = -1;
        for (int j = 0; j < i; ++j) {
            const LAS f32x4* kp = (const LAS f32x4*)(km + j * 128 + hh * 64); float s = 0.f;
#pragma unroll
            for (int c = 0; c < 16; ++c) { const f32x4 kv = kp[c]; s += q[4 * c] * kv.x; s += q[4 * c + 1] * kv.y; s += q[4 * c + 2] * kv.z; s += q[4 * c + 3] * kv.w; }
            if (s > v0) { v2 = v1; i2 = i1; v1 = v0; i1 = i0; v0 = s; i0 = j; }
            else if (s > v1) { v2 = v1; i2 = i1; v1 = s; i1 = j; }
            else if (s > v2) { v2 = s; i2 = j; }
        }
        const int bh = b * 8 + h; const unsigned tl = (unsigned)(i * MBB + ql); const unsigned long long lt = (1ull << lane) - 1ull;
        for (int j = 0; j < i; ++j) {
            const unsigned long long m0 = __ballot(i0 == j), m1 = __ballot(i1 == j), m2 = __ballot(i2 == j);
            const int c0 = __popcll(m0), c1 = __popcll(m1), c2 = __popcll(m2), tot = c0 + c1 + c2;
            if (tot) {
                unsigned base = 0u; if (lane == 0) base = atomicAdd(CNT + bh * 32 + j, (unsigned)tot);
                base = (unsigned)__builtin_amdgcn_readfirstlane((int)base);
                unsigned* L = LIST + moba_list_base(bh, j) + base;
                if (i0 == j) L[__popcll(m0 & lt)] = tl;
                if (i1 == j) L[c0 + __popcll(m1 & lt)] = tl | (1u << 13);
                if (i2 == j) L[c0 + c1 + __popcll(m2 & lt)] = tl | (2u << 13);
            }
        }
    }
    __syncthreads();
}
typedef float f32x16 __attribute__((ext_vector_type(16)));
typedef short bf16x8v __attribute__((ext_vector_type(8)));
typedef short s16x4v __attribute__((ext_vector_type(4)));
constexpr int IT_KS = 0, IT_VS = 32768, IT_VROW = 520, IT_TB = IT_VS + 64 * IT_VROW  , IT_INFO = IT_TB + 8 * 128 * 4  ;
__device__ __forceinline__ int crow16(int r, int hi) { return (r & 3) + 8 * (r >> 2) + 4 * hi; }
template <bool GENERAL> __device__ __forceinline__ void moba_item_half(f32x16 (&st)[4], int half, int ntile, int hi, int dq, float c1, float c0, const LAS float* tb,
                                                                      float& mrun, float& lrun, f32x16 (&o)[2], const LAS unsigned char* vs, int r32) {
    float mloc = -INFINITY;
#pragma unroll
    for (int t4 = 0; t4 < 4; ++t4) { const int kt = half * 4 + t4;
        if (kt < ntile) {
#pragma unroll
            for (int r = 0; r < 16; ++r) { float x;
                if (GENERAL) { const int dist = dq - (32 * kt + crow16(r, hi)); const int di = dist > 113 ? 113 : (dist < 0 ? 0 : dist); x = st[t4][r] * c1 + tb[di]; if (dist < 0) x = -INFINITY; }
                else x = st[t4][r] * c1 + c0;
                st[t4][r] = x; mloc = fmaxf(mloc, x); }
        }
    }
    mloc = fmaxf(mloc, __shfl_xor(mloc, 32));
    const float mnew = fmaxf(mrun, mloc);
    const float alpha = __builtin_amdgcn_exp2f(mrun - mnew);
    float ls = 0.f;
#pragma unroll
    for (int t4 = 0; t4 < 4; ++t4) { const int kt = half * 4 + t4;
        if (kt < ntile) {
#pragma unroll
            for (int r = 0; r < 16; ++r) { const float pv = __builtin_amdgcn_exp2f(st[t4][r] - mnew); st[t4][r] = pv; ls += pv; }
        }
    }
    ls += __shfl_xor(ls, 32);
    lrun = lrun * alpha + ls; mrun = mnew;
#pragma unroll
    for (int d = 0; d < 2; ++d)
#pragma unroll
        for (int r = 0; r < 16; ++r) o[d][r] *= alpha;
#pragma unroll
    for (int t4 = 0; t4 < 4; ++t4) { const int kt = half * 4 + t4;
        if (kt < ntile) {
#pragma unroll
            for (int s = 0; s < 2; ++s) {
                bf16x8v pf; { unsigned w0 = pg8::cvt_pk_bf16(st[t4][8 * s + 0], st[t4][8 * s + 1]), w1 = pg8::cvt_pk_bf16(st[t4][8 * s + 2], st[t4][8 * s + 3]), w2 = pg8::cvt_pk_bf16(st[t4][8 * s + 4], st[t4][8 * s + 5]), w3 = pg8::cvt_pk_bf16(st[t4][8 * s + 6], st[t4][8 * s + 7]);
                    v4u w = {w0, w1, w2, w3}; pf = __builtin_bit_cast(bf16x8v, w); }
#pragma unroll
                for (int d = 0; d < 2; ++d) {
                    const LAS unsigned char* vp = vs + (32 * d + r32) * IT_VROW + (32 * kt + 16 * s + 4 * hi) * 2;
                    const s16x4v lo = *(const LAS s16x4v*)vp, hi4 = *(const LAS s16x4v*)(vp + 16);
                    const bf16x8v va = {lo[0], lo[1], lo[2], lo[3], hi4[0], hi4[1], hi4[2], hi4[3]};
                    o[d] = __builtin_amdgcn_mfma_f32_32x32x16_bf16(va, pf, o[d], 0, 0, 0);
                }
                asm volatile("" ::: "memory");
            }
        }
    }
}
__device__ __forceinline__ void moba_items_phase(LAS unsigned char* lds, int vcu, int G, int tid_in, int wave, int lane, const bf16* Q, const bf16* K, const bf16* VT, const unsigned* CNT, const unsigned* LIST,
                                                 const float* BIAST, bf16* PO0, bf16* PO1, bf16* PO2, bf16* PO3, float* PML) {
    const int r32 = lane & 31, hi = lane >> 5; int tid = tid_in;
    LAS unsigned char* ks = lds + IT_KS; LAS unsigned char* vs = lds + IT_VS; LAS float* tball = (LAS float*)(lds + IT_TB); volatile LAS int* info = (volatile LAS int*)(lds + IT_INFO);
    __syncthreads();
    for (int e = tid; e < 8 * 128; e += 512) tball[e] = BIAST[e] * 1.4426950408889634f;
    if (wave == 0) {
        int loc[16]; int s = 0;
#pragma unroll
        for (int e = 0; e < 16; ++e) { const int n = (int)CNT[16 * lane + e]; loc[e] = 1 + ((n + 255) >> 8); s += loc[e]; }
        int incl = s;
#pragma unroll
        for (int o = 1; o < 64; o <<= 1) { const int t = __shfl_up(incl, o); if (lane >= o) incl += t; }
        const int excl = incl - s, total = __shfl(incl, 63);
        const int c0 = (int)(((long)vcu * total) / G), c1 = (int)(((long)(vcu + 1) * total) / G);
        if (c0 >= excl && c0 < incl) { int acc = excl; bool done = false;
#pragma unroll
            for (int e = 0; e < 16; ++e) { if (!done && c0 < acc + loc[e]) { info[0] = 16 * lane + e; info[1] = c0 - acc; done = true; } acc += loc[e]; } }
        if (lane == 0) info[2] = c1 - c0;
    }
    __syncthreads();
    int li = __builtin_amdgcn_readfirstlane(info[0]), k = __builtin_amdgcn_readfirstlane(info[1]); const int nchunk = __builtin_amdgcn_readfirstlane(info[2]);
    int loaded = -1;
    for (int c = 0; c < nchunk; ++c) {
        const int b = li >> 8, h = (li >> 5) & 7, j = li & 31; const int n = __builtin_amdgcn_readfirstlane((int)CNT[li]);
        if (li != loaded) {
            __syncthreads();
            asm volatile("" : "+v"(tid));
#pragma unroll
            for (int r = 0; r < 4; ++r) { const int idx = tid + 512 * r, key = idx >> 3, ch = idx & 7;
                const v4u w = *(const v4u*)(K + (size_t)(b * SEQ + j * MBB + key) * MBW + h * MBD + ch * 8);
                *(LAS v4u*)(ks + key * 128 + ((ch ^ ((key >> 1) & 7)) * 16)) = w; }
#pragma unroll
            for (int r = 0; r < 4; ++r) { const int idx = tid + 512 * r, d = idx >> 5, ch = idx & 31;
                const v4u w = *(const v4u*)(VT + (size_t)(h * MBD + d) * M + b * SEQ + j * MBB + ch * 8);
                LAS v2u* dst = (LAS v2u*)(vs + d * IT_VROW + ch * 16); dst[0] = (v2u){w.x, w.y}; dst[1] = (v2u){w.z, w.w}; }
            __syncthreads();
            loaded = li;
        }
        const bool own = (k == 0); const int item = own ? wave : (k - 1) * 8 + wave; const int start = item * 32;
        if (own || start < n) {
            int tl, rank;
            if (own) { tl = j * MBB + start + r32; rank = 3; }
            else { int idx = start + r32; if (idx >= n) idx = n - 1; const unsigned e = LIST[moba_list_base(b * 8 + h, j) + idx]; tl = (int)(e & 8191u); rank = (int)(e >> 13); }
            const bool valid = own || (start + r32 < n);
            const int qin = tl & 255, bd = (tl >> 8) - j, dq = bd * 256 + qin;
            const bool general = own || (__ballot(bd == 1 && qin < 112) != 0ull);
            const int ntile = own ? (wave + 1) : 8;
            const LAS float* tb = tball + h * 128;
            const float c1 = 0.125f * 1.4426950408889634f, c0 = tb[113];
            bf16x8v qf[4];
            { const bf16* qp = Q + (size_t)(b * SEQ + tl) * MBW + h * MBD + 8 * hi;
#pragma unroll
              for (int s = 0; s < 4; ++s) qf[s] = *(const bf16x8v*)(qp + 16 * s); }
            float mrun = -INFINITY, lrun = 0.f; f32x16 o[2];
#pragma unroll
            for (int d = 0; d < 2; ++d)
#pragma unroll
                for (int r = 0; r < 16; ++r) o[d][r] = 0.f;
#pragma unroll
            for (int half = 0; half < 2; ++half) {
                if (half * 4 < ntile) {
                    f32x16 st[4];
#pragma unroll
                    for (int t4 = 0; t4 < 4; ++t4) { const int kt = half * 4 + t4;
#pragma unroll
                        for (int r = 0; r < 16; ++r) st[t4][r] = 0.f;
                        if (kt < ntile) { const int key = 32 * kt + r32;
#pragma unroll
                            for (int s = 0; s < 4; ++s) { const bf16x8v ka = *(const LAS bf16x8v*)(ks + key * 128 + (((2 * s + hi) ^ ((key >> 1) & 7)) * 16));
                                st[t4] = __builtin_amdgcn_mfma_f32_32x32x16_bf16(ka, qf[s], st[t4], 0, 0, 0); } }
                        asm volatile("" ::: "memory");
                    }
                    if (general) moba_item_half<true>(st, half, ntile, hi, dq, c1, c0, tb, mrun, lrun, o, vs, r32);
                    else         moba_item_half<false>(st, half, ntile, hi, dq, c1, c0, tb, mrun, lrun, o, vs, r32);
                }
            }
            if (valid) {
                const size_t pair = (size_t)(b * SEQ + tl) * 8 + h; const float linv = 1.0f / lrun;
                bf16* po = (rank == 0 ? PO0 : rank == 1 ? PO1 : rank == 2 ? PO2 : PO3) + pair * 64;
#pragma unroll
                for (int d = 0; d < 2; ++d)
#pragma unroll
                    for (int g4 = 0; g4 < 4; ++g4) { v2u w; w.x = pg8::cvt_pk_bf16(o[d][4 * g4] * linv, o[d][4 * g4 + 1] * linv); w.y = pg8::cvt_pk_bf16(o[d][4 * g4 + 2] * linv, o[d][4 * g4 + 3] * linv);
                        *(v2u*)(po + 32 * d + 8 * g4 + 4 * hi) = w; }
                if (hi == 0) { float* pm = PML + ((size_t)rank * (M * 8) + pair) * 2; pm[0] = mrun; pm[1] = lrun; }
            }
        }
        if (k + 1 < 1 + ((n + 255) >> 8)) ++k; else { ++li; k = 0; }
    }
    __syncthreads();
}
__device__ __forceinline__ void moba_combine_phase(int gtid, int gthreads, const bf16* PO0, const bf16* PO1, const bf16* PO2, const bf16* PO3, const float* PML, bf16* OA) {
    for (int idx = gtid; idx < M * 8 * 8; idx += gthreads) {
        const int pair = idx >> 3, c8 = idx & 7, m = pair >> 3, own = (m & (SEQ - 1)) >> 8, nv = own < 3 ? own : 3;
        float mm[4], ll[4];
#pragma unroll
        for (int r = 0; r < 4; ++r) { const bool v = (r == 3) || (r < nv); const float* pm = PML + ((size_t)r * (M * 8) + pair) * 2; mm[r] = v ? pm[0] : -INFINITY; ll[r] = v ? pm[1] : 0.f; }
        const float mx = fmaxf(fmaxf(mm[0], mm[1]), fmaxf(mm[2], mm[3]));
        float w[4], ws = 0.f;
#pragma unroll
        for (int r = 0; r < 4; ++r) { w[r] = ll[r] * __builtin_amdgcn_exp2f(mm[r] - mx); ws += w[r]; }
        const float inv = 1.0f / ws; float acc[8];
#pragma unroll
        for (int e = 0; e < 8; ++e) acc[e] = 0.f;
#pragma unroll
        for (int r = 0; r < 4; ++r) { const bool v = (r == 3) || (r < nv);
            if (v) { const bf16* po = (r == 0 ? PO0 : r == 1 ? PO1 : r == 2 ? PO2 : PO3) + (size_t)pair * 64 + c8 * 8; const v4u x = *(const v4u*)po; const float wr = w[r] * inv;
                acc[0] += wr * bflo(x.x); acc[1] += wr * bfhi(x.x); acc[2] += wr * bflo(x.y); acc[3] += wr * bfhi(x.y); acc[4] += wr * bflo(x.z); acc[5] += wr * bfhi(x.z); acc[6] += wr * bflo(x.w); acc[7] += wr * bfhi(x.w); } }
        v4u o; o.x = pk2(acc[0], acc[1]); o.y = pk2(acc[2], acc[3]); o.z = pk2(acc[4], acc[5]); o.w = pk2(acc[6], acc[7]);
        *(v4u*)(OA + (size_t)pair * 64 + c8 * 8) = o;
    }
}
constexpr int HL_QN = 0, HL_KN = 8704, HL_KT = 17408, HL_VT = 27648, HL_SB = 37888, HL_GT = 72704, HL_DD = 74752, HL_EM = 75264, HL_SSQ = 75776, HL_END = 76288;
constexpr int HL_QP = 272, HL_TP = 80;
__device__ __forceinline__ float bf1(bf16 x) { return __uint_as_float((unsigned)x << 16); }
template <int STEP> __device__ __forceinline__ void hgrn_mfma_phase(LAS unsigned char* lds, int vcu, int G, int tid, int wave, int lane, const bf16* KIN, const bf16* HI, const bf16* HQ, const bf16* HG, const float* hgw, float* HS, float* HGD, bf16* OB) {
    const int r32 = lane & 31, hi = lane >> 5, ch = tid & 127, tg = __builtin_amdgcn_readfirstlane(tid >> 7);
    LAS float* gt = (LAS float*)(lds + HL_GT); LAS float* dd = (LAS float*)(lds + HL_DD); LAS float* em = (LAS float*)(lds + HL_EM); LAS float* ssq = (LAS float*)(lds + HL_SSQ);
    for (int unit = vcu; unit < BATCH * HGH * HGNC; unit += G) {
        const int c = unit & 31, bh = unit >> 5, b = bh >> 2, h = bh & 3, m0 = b * SEQ + c * HGC;
        f32x16 S[4]; float Dk = 1.f;
        const int skt = (STEP == 1) ? (wave >> 1) : (wave - 4), svt0 = (STEP == 1) ? 2 * (wave & 1) : 0; constexpr int NST = (STEP == 1) ? 2 : 4;
#pragma unroll
        for (int i = 0; i < 4; ++i)
#pragma unroll
            for (int r = 0; r < 16; ++r) S[i][r] = 0.f;
        if (STEP == 3 && wave >= 4) {
#pragma unroll
            for (int i = 0; i < 4; ++i)
#pragma unroll
                for (int r = 0; r < 16; ++r) S[i][r] = HS[(size_t)unit * 16384 + (32 * skt + crow16(r, hi)) * 128 + 32 * (svt0 + i) + r32];
        }
        for (int slab = 0; slab < 8; ++slab) {
            const int ms = m0 + slab * 32;
            float kin[8], qq[8]; unsigned short vv[8];
#pragma unroll
            for (int e = 0; e < 8; ++e) { const size_t idx = (size_t)(ms + tg * 8 + e) * HGW + h * HGD_ + ch; kin[e] = bf1(KIN[idx]); vv[e] = HI[idx]; qq[e] = (STEP == 3) ? bf1(HQ[idx]) : 0.f; }
            float cs[8]; float run = 0.f;
#pragma unroll
            for (int e = 0; e < 8; ++e) { run += __builtin_amdgcn_logf(fmaxf(1.0f - kin[e], 5.9604645e-8f)); cs[e] = run; }
            gt[tg * 128 + ch] = run;
            __syncthreads();
            const float g0 = gt[ch], g1 = gt[128 + ch], g2 = gt[256 + ch], g3 = gt[384 + ch];
            const float bmid = g0 + g1, bend = bmid + g2 + g3, pre = (tg == 0) ? 0.f : (tg == 1) ? g0 : (tg == 2) ? bmid : bmid + g2;
            { float kh[8];
#pragma unroll
              for (int e = 0; e < 8; ++e) kh[e] = kin[e] * __builtin_amdgcn_exp2f(bend - (pre + cs[e]));
              v4u w; w.x = pg8::cvt_pk_bf16(kh[0], kh[1]); w.y = pg8::cvt_pk_bf16(kh[2], kh[3]); w.z = pg8::cvt_pk_bf16(kh[4], kh[5]); w.w = pg8::cvt_pk_bf16(kh[6], kh[7]);
              *(LAS v4u*)(lds + HL_KT + ch * HL_TP + tg * 16) = w;
              v4u x; x.x = (unsigned)vv[0] | ((unsigned)vv[1] << 16); x.y = (unsigned)vv[2] | ((unsigned)vv[3] << 16); x.z = (unsigned)vv[4] | ((unsigned)vv[5] << 16); x.w = (unsigned)vv[6] | ((unsigned)vv[7] << 16);
              *(LAS v4u*)(lds + HL_VT + ch * HL_TP + tg * 16) = x; }
            if (STEP == 3) {
#pragma unroll
                for (int e = 0; e < 8; ++e) { const float bs = pre + cs[e]; const int tok = tg * 8 + e;
                    const float kt_ = kin[e] * __builtin_amdgcn_exp2f(fminf(bmid - bs, 100.f)), qt_ = qq[e] * __builtin_amdgcn_exp2f(fminf(bs - bmid, 100.f));
                    *(LAS unsigned short*)(lds + HL_KN + tok * HL_QP + ch * 2) = (unsigned short)f2bf(kt_);
                    *(LAS unsigned short*)(lds + HL_QN + tok * HL_QP + ch * 2) = (unsigned short)f2bf(qt_); }
            }
            if (tg == 0) { const float de = __builtin_amdgcn_exp2f(bend); dd[ch] = de; em[ch] = __builtin_amdgcn_exp2f(bmid); Dk *= de; }
            __syncthreads();
            if (STEP == 3) {
                if (wave >= 4) {
#pragma unroll
                    for (int i = 0; i < 4; ++i)
#pragma unroll
                        for (int g4 = 0; g4 < 4; ++g4) { const int k0 = 32 * skt + 8 * g4 + 4 * hi; const f32x4 e4 = *(const LAS f32x4*)(em + k0);
                            v2u w; w.x = pg8::cvt_pk_bf16(S[i][4 * g4] * e4.x, S[i][4 * g4 + 1] * e4.y); w.y = pg8::cvt_pk_bf16(S[i][4 * g4 + 2] * e4.z, S[i][4 * g4 + 3] * e4.w);
                            *(LAS v2u*)(lds + HL_SB + (32 * (svt0 + i) + r32) * HL_QP + k0 * 2) = w; }
                }
                __syncthreads();
            }
            f32x16 O;
            if (STEP == 3 && wave < 4) {
                const int vt = wave;
                bf16x8v qf[8]; f32x16 X;
#pragma unroll
                for (int r = 0; r < 16; ++r) { X[r] = 0.f; O[r] = 0.f; }
#pragma unroll
                for (int ks = 0; ks < 8; ++ks) { qf[ks] = *(const LAS bf16x8v*)(lds + HL_QN + r32 * HL_QP + (16 * ks + 8 * hi) * 2);
                    const bf16x8v kf = *(const LAS bf16x8v*)(lds + HL_KN + r32 * HL_QP + (16 * ks + 8 * hi) * 2);
                    X = __builtin_amdgcn_mfma_f32_32x32x16_bf16(kf, qf[ks], X, 0, 0, 0); }
#pragma unroll
                for (int r = 0; r < 16; ++r) if (crow16(r, hi) > r32) X[r] = 0.f;
#pragma unroll
                for (int k2 = 0; k2 < 2; ++k2) {
                    v4u w; w.x = pg8::cvt_pk_bf16(X[8 * k2 + 0], X[8 * k2 + 1]); w.y = pg8::cvt_pk_bf16(X[8 * k2 + 2], X[8 * k2 + 3]); w.z = pg8::cvt_pk_bf16(X[8 * k2 + 4], X[8 * k2 + 5]); w.w = pg8::cvt_pk_bf16(X[8 * k2 + 6], X[8 * k2 + 7]);
                    const bf16x8v xf = __builtin_bit_cast(bf16x8v, w);
                    const LAS unsigned char* vp = lds + HL_VT + (32 * vt + r32) * HL_TP + (16 * k2 + 4 * hi) * 2;
                    const s16x4v lo = *(const LAS s16x4v*)vp, hi4 = *(const LAS s16x4v*)(vp + 16);
                    const bf16x8v va = {lo[0], lo[1], lo[2], lo[3], hi4[0], hi4[1], hi4[2], hi4[3]};
                    O = __builtin_amdgcn_mfma_f32_32x32x16_bf16(va, xf, O, 0, 0, 0); }
#pragma unroll
                for (int ks = 0; ks < 8; ++ks) { const bf16x8v sa = *(const LAS bf16x8v*)(lds + HL_SB + (32 * vt + r32) * HL_QP + (16 * ks + 8 * hi) * 2);
                    O = __builtin_amdgcn_mfma_f32_32x32x16_bf16(sa, qf[ks], O, 0, 0, 0); }
                float sq = 0.f;
#pragma unroll
                for (int r = 0; r < 16; ++r) sq += O[r] * O[r];
                sq += __shfl_xor(sq, 32);
                if (hi == 0) ssq[vt * 32 + r32] = sq;
            }
            if (STEP == 1 || wave >= 4) {
#pragma unroll
                for (int i = 0; i < NST; ++i) {
#pragma unroll
                    for (int g4 = 0; g4 < 4; ++g4) { const f32x4 d4 = *(const LAS f32x4*)(dd + 32 * skt + 8 * g4 + 4 * hi);
                        S[i][4 * g4] *= d4.x; S[i][4 * g4 + 1] *= d4.y; S[i][4 * g4 + 2] *= d4.z; S[i][4 * g4 + 3] *= d4.w; }
#pragma unroll
                    for (int k2 = 0; k2 < 2; ++k2) { const bf16x8v ka = *(const LAS bf16x8v*)(lds + HL_KT + (32 * skt + r32) * HL_TP + (16 * k2 + 8 * hi) * 2);
                        const bf16x8v vb = *(const LAS bf16x8v*)(lds + HL_VT + (32 * (svt0 + i) + r32) * HL_TP + (16 * k2 + 8 * hi) * 2);
                        S[i] = __builtin_amdgcn_mfma_f32_32x32x16_bf16(ka, vb, S[i], 0, 0, 0); }
                }
            }
            __syncthreads();
            if (STEP == 3 && wave < 4) {
                const int vt = wave; const float tot = ssq[r32] + ssq[32 + r32] + ssq[64 + r32] + ssq[96 + r32];
                const float rstd = 1.f / sqrtf(tot * (1.f / 128.f) + EPS); const size_t mrow = (size_t)(ms + r32) * HGW + h * HGD_;
#pragma unroll
                for (int g4 = 0; g4 < 4; ++g4) { const int v0 = 32 * vt + 8 * g4 + 4 * hi; const f32x4 w4 = *(const f32x4*)(hgw + v0); const v2u gg = *(const v2u*)(HG + mrow + v0);
                    v2u o; o.x = pg8::cvt_pk_bf16(O[4 * g4] * rstd * w4.x * bflo(gg.x), O[4 * g4 + 1] * rstd * w4.y * bfhi(gg.x)); o.y = pg8::cvt_pk_bf16(O[4 * g4 + 2] * rstd * w4.z * bflo(gg.y), O[4 * g4 + 3] * rstd * w4.w * bfhi(gg.y));
                    *(v2u*)(OB + mrow + v0) = o; }
            }
        }
        if (STEP == 1) {
#pragma unroll
            for (int i = 0; i < 2; ++i)
#pragma unroll
                for (int r = 0; r < 16; ++r) HS[(size_t)unit * 16384 + (32 * skt + crow16(r, hi)) * 128 + 32 * (svt0 + i) + r32] = S[i][r];
            if (tid < 128) HGD[unit * 128 + tid] = Dk;
        }
    }
    __syncthreads();
}
__device__ __forceinline__ void hgrn_scan_phase(int gtid, int gthreads, float* HS, const float* HGD) {
    for (int idx = gtid; idx < BATCH * HGH * 16384; idx += gthreads) {
        const int bh = idx >> 14, e = idx & 16383, k = e >> 7; float s = 0.f;
        float tmp[HGNC];
#pragma unroll
        for (int c = 0; c < HGNC; ++c) tmp[c] = HS[(size_t)(bh * HGNC + c) * 16384 + e];
#pragma unroll
        for (int c = 0; c < HGNC; ++c) { HS[(size_t)(bh * HGNC + c) * 16384 + e] = s; s = HGD[(bh * HGNC + c) * 128 + k] * s + tmp[c]; }
    }
}
#ifndef REP_MASK
#define REP_MASK 0u
#endif
struct Args { const float* in[16]; float* out; unsigned char* ws; unsigned mask, rep; };
__global__ void __launch_bounds__(NWAVES * 64, 2) mk_fwd(Args args) {
    extern __shared__ __attribute__((aligned(16))) unsigned char lds_raw[];
    LAS unsigned char* lds = (LAS unsigned char*)lds_raw;
    volatile LAS unsigned* MISC = (volatile LAS unsigned*)(lds + MISC_OFF);
    const int G = gridDim.x, bx = blockIdx.x;
    unsigned char* ws = args.ws;
    gu32* ctl = (gu32*)(ws + WS_CTL);
    for (int u = threadIdx.x; u < (LDS_BYTES - LDSCTL_OFF) / 4; u += NWAVES * 64) ((LAS unsigned*)(lds + LDSCTL_OFF))[u] = 0u;
    __syncthreads();
    XcdBarrier bar = xcd_barrier_post((unsigned*)(ctl + CW_BAR), MISC + 8);
#define GRID_BAR() xcd_barrier(bar)
#define PH(k) for (int rep_ = ((args.mask >> (k)) & 1u) + ((args.rep >> (k)) & 1u); rep_ > 0; --rep_)
#define COORDS() int tid = threadIdx.x; asm volatile("" : "+v"(tid)); const int lane = tid & 63, wave = __builtin_amdgcn_readfirstlane(tid >> 6); \
    const int vcu = (G % 8 == 0) ? (bx % 8) * (G / 8) + bx / 8 : bx; const int gw = vcu * NWAVES + wave, NGW = G * NWAVES; (void)lane; (void)gw; (void)NGW; (void)vcu
#define MKP() Ptrs P; P.x = args.in[0]; P.p = args.in[1]; P.w_gu1 = args.in[2]; P.w_d1 = args.in[3]; P.w_in = args.in[4]; P.w_a = args.in[5]; P.w_b = args.in[6]; P.w_out = args.in[7]; \
    P.w_gu2 = args.in[8]; P.w_d2 = args.in[9]; P.w_ple = args.in[10]; P.w_pg = args.in[11]; P.gains = args.in[12]; P.hgw = args.in[13]; P.lbp = args.in[14]; P.rel = args.in[15]; P.out = args.out; P.ws = args.ws
#define XN ((bf16*)(ws + WS_C))
#define Hb ((bf16*)(ws + WS_A))
#define Fb ((float*)(ws + WS_B))
#define Yb ((float*)(ws + WS_A))
#define Qb ((bf16*)(ws + WS_Q))
#define Kb ((bf16*)(ws + WS_K))
#define VTb ((bf16*)(ws + WS_VT))
#define HQb ((bf16*)(ws + WS_HQ))
#define HIb ((bf16*)(ws + WS_HI))
#define KINb ((bf16*)(ws + WS_KIN))
#define HGb ((bf16*)(ws + WS_HG))
#define SAb ((bf16*)(ws + WS_SA))
#define SBb ((bf16*)(ws + WS_SB))
#define OAb ((bf16*)(ws + WS_OA))
#define OBb ((bf16*)(ws + WS_OB))
#define PBb ((bf16*)(ws + WS_PB))
#define Eb ((bf16*)(ws + WS_A))
#define KMEAN ((float*)(ws + WS_KMEAN))
#define LBt ((float*)(ws + WS_LB))
#define BIAST ((float*)(ws + WS_BIAST))
#define HS ((float*)(ws + WS_HS))
#define HGD ((float*)(ws + WS_HGD))
#define CNTb ((unsigned*)(ws + WS_CNT))
#define LISTb ((unsigned*)(ws + WS_LIST))
#define PO0b ((bf16*)(ws + WS_PO0))
#define PO1b ((bf16*)(ws + WS_PO1))
#define PO2b ((bf16*)(ws + WS_PO2))
#define PO3b ((bf16*)(ws + WS_PO3))
#define PMLb ((float*)(ws + WS_PML))

    PH(0) { COORDS(); MKP(); p0_prologue(P, lds, gw, NGW, wave, lane); }
    GRID_BAR();
    PH(1) { pg8::Gemm g{XN, (const bf16*)(ws + WS_WGU1), M, NGU, D}; pg8::StaticOrder S; S.init(M, NGU, G, bx); pg8::EpiGU E{Hb, FF};
      pg8::gemm_phase<pg8::EpiGU, pg8::StaticOrder, PG8_ALIGN, PG8_SP2>(lds + RING_OFF, g, S, E); }
    GRID_BAR();
    PH(2) { pg8::Gemm g{Hb, (const bf16*)(ws + WS_WD1), M, D, FF}; pg8::StaticOrder S; S.init(M, D, G, bx); pg8::EpiF32 E{Fb, D};
      pg8::gemm_phase<pg8::EpiF32, pg8::StaticOrder, PG8_ALIGN, PG8_SP2>(lds + RING_OFF, g, S, E); }
    GRID_BAR();
    PH(3) { COORDS(); rowwise_phase<1>(gw, NGW, lane, args.in[0], Fb, args.in[12] + 1 * D, 0.5f, args.out, XN); }
    GRID_BAR();
    PH(4) { pg8::Gemm g{XN, (const bf16*)(ws + WS_WIN), M, NIN - 512, D}; pg8::StaticOrder S; S.init(M, NIN - 512, G, bx); pg8::EpiIN E{Qb, Kb, HQb, KINb, HIb, HGb, SAb, SBb, LBt, KMEAN};
      pg8::gemm_phase<pg8::EpiIN, pg8::StaticOrder, PG8_ALIGN, PG8_SP2>(lds + RING_OFF, g, S, E); }
    PH(4) { pg8::Gemm g{(const bf16*)(ws + WS_WIN) + (size_t)(NIN - 512) * D, XN, 512, M, D}; pg8::StaticOrder S; S.init(512, M, G, bx); pg8::EpiMix<0> E{VTb, nullptr, M};
      pg8::gemm_phase<pg8::EpiMix<0>, pg8::StaticOrder, PG8_ALIGN, PG8_SP2>(lds + RING_OFF, g, S, E); }
    GRID_BAR();
    PH(5) { COORDS(); moba_gating_phase(lds, vcu, G, tid, Qb, KMEAN, CNTb, LISTb); }
    PH(18) { COORDS(); hgrn_mfma_phase<1>(lds, vcu, G, tid, wave, lane, KINb, HIb, HQb, HGb, args.in[13], HS, HGD, OBb); }
    GRID_BAR();
    PH(6) { COORDS(); hgrn_scan_phase(vcu * NWAVES * 64 + tid, G * NWAVES * 64, HS, HGD); }
    GRID_BAR();
    PH(7) { COORDS(); hgrn_mfma_phase<3>(lds, vcu, G, tid, wave, lane, KINb, HIb, HQb, HGb, args.in[13], HS, HGD, OBb); }
    GRID_BAR();
    PH(16) { COORDS(); moba_items_phase(lds, vcu, G, tid, wave, lane, Qb, Kb, VTb, CNTb, LISTb, BIAST, PO0b, PO1b, PO2b, PO3b, PMLb); }
    GRID_BAR();
    PH(17) { COORDS(); moba_combine_phase(vcu * NWAVES * 64 + tid, G * NWAVES * 64, PO0b, PO1b, PO2b, PO3b, PMLb, OAb); }
    GRID_BAR();
    PH(8) { pg8::Gemm g{OAb, (const bf16*)(ws + WS_WA), M, D, 512}; pg8::StaticOrder S; S.init(M, D, G, bx); pg8::EpiMix<1> E{SAb, nullptr, D};
      pg8::gemm_phase<pg8::EpiMix<1>, pg8::StaticOrder, PG8_ALIGN, PG8_SP2>(lds + RING_OFF, g, S, E); }
    PH(8) { pg8::Gemm g{OBb, (const bf16*)(ws + WS_WB), M, D, 512}; pg8::StaticOrder S; S.init(M, D, G, bx); pg8::EpiMix<2> E{SAb, SBb, D};
      pg8::gemm_phase<pg8::EpiMix<2>, pg8::StaticOrder, PG8_ALIGN, PG8_SP2>(lds + RING_OFF, g, S, E); }
    GRID_BAR();
    PH(9) { pg8::Gemm g{SAb, (const bf16*)(ws + WS_WOUT), M, D, D}; pg8::StaticOrder S; S.init(M, D, G, bx); pg8::EpiF32 E{Yb, D};
      pg8::gemm_phase<pg8::EpiF32, pg8::StaticOrder, PG8_ALIGN, PG8_SP2>(lds + RING_OFF, g, S, E); }
    GRID_BAR();
    PH(10) { COORDS(); rowwise_phase<1>(gw, NGW, lane, args.out, Yb, args.in[12] + 3 * D, 1.0f, args.out, XN); }
    GRID_BAR();
    PH(11) { pg8::Gemm g{XN, (const bf16*)(ws + WS_WGU2), M, NGU, D}; pg8::StaticOrder S; S.init(M, NGU, G, bx); pg8::EpiGU E{Hb, FF};
      pg8::gemm_phase<pg8::EpiGU, pg8::StaticOrder, PG8_ALIGN, PG8_SP2>(lds + RING_OFF, g, S, E); }
    GRID_BAR();
    PH(12) { pg8::Gemm g{Hb, (const bf16*)(ws + WS_WD2), M, D, FF}; pg8::StaticOrder S; S.init(M, D, G, bx); pg8::EpiF32 E{Fb, D};
      pg8::gemm_phase<pg8::EpiF32, pg8::StaticOrder, PG8_ALIGN, PG8_SP2>(lds + RING_OFF, g, S, E); }
    GRID_BAR();
    PH(13) { COORDS(); rowwise_phase<2>(gw, NGW, lane, args.out, Fb, args.in[12] + 5 * D, 0.5f, args.out, XN);
        const float* pp = args.in[1];
        for (int i = gw * 64 + lane; i < M * PLE / 8; i += NGW * 64) { const f32x4 a = ((const f32x4*)pp)[2 * i], b = ((const f32x4*)pp)[2 * i + 1];
            v4u o; o.x = pk2(a.x, a.y); o.y = pk2(a.z, a.w); o.z = pk2(b.x, b.y); o.w = pk2(b.z, b.w); ((v4u*)PBb)[i] = o; } }
    GRID_BAR();
    PH(14) { pg8::Gemm g{PBb, (const bf16*)(ws + WS_WPLE), M, D, PLE}; pg8::StaticOrder S; S.init(M, D, G, bx); pg8::EpiMix<0> E{Eb, nullptr, D};
      pg8::gemm_phase<pg8::EpiMix<0>, pg8::StaticOrder, PG8_ALIGN, PG8_SP2>(lds + RING_OFF, g, S, E); }
    PH(14) { pg8::Gemm g{XN, (const bf16*)(ws + WS_WPG), M, D, D}; pg8::StaticOrder S; S.init(M, D, G, bx); pg8::EpiPleB E{Eb, Fb, D};
      pg8::gemm_phase<pg8::EpiPleB, pg8::StaticOrder, PG8_ALIGN, PG8_SP2>(lds + RING_OFF, g, S, E); }
    GRID_BAR();
    PH(15) { COORDS(); rowwise_phase<0>(gw, NGW, lane, args.out, Fb, args.in[12] + 6 * D, 1.0f, args.out, nullptr); }
}

extern "C" void kernel_launch(void* const* d_in, const int* in_sizes, int n_in, void* d_out, int out_size, void* d_ws, size_t ws_size, hipStream_t stream) {
    static int grid = 0;
    if (grid == 0) {
        if (n_in != 16 || in_sizes[0] != M * D || out_size != M * D || ws_size < WS_END) { fprintf(stderr, "kernel_launch: unexpected shapes: n_in %d in0 %d out %d ws %zu; nothing launched\n", n_in, n_in > 0 ? in_sizes[0] : -1, out_size, ws_size); grid = -1; return; }
        int dev = 0, cus = 0;
        if (hipGetDevice(&dev) != hipSuccess || hipDeviceGetAttribute(&cus, hipDeviceAttributeMultiprocessorCount, dev) != hipSuccess) { fprintf(stderr, "kernel_launch: device query failed\n"); grid = -1; return; }
        if (hipFuncSetAttribute((const void*)mk_fwd, hipFuncAttributeMaxDynamicSharedMemorySize, LDS_BYTES) != hipSuccess) { fprintf(stderr, "kernel_launch: hipFuncSetAttribute failed\n"); grid = -1; return; }
        int per_cu = 0;
        if (hipOccupancyMaxActiveBlocksPerMultiprocessor(&per_cu, (const void*)mk_fwd, NWAVES * 64, LDS_BYTES) != hipSuccess || per_cu < 1) fprintf(stderr, "kernel_launch: note: occupancy query reports %d\n", per_cu);
        (void)hipGetLastError();
        grid = cus;
    }
    if (grid < 0) return;
    if (hipMemsetAsync((char*)d_ws + WS_CTL, 0, CTL_ZERO_BYTES, stream) != hipSuccess) { fprintf(stderr, "kernel_launch: memset failed\n"); return; }
    Args a{};
    for (int i = 0; i < 16; ++i) a.in[i] = (const float*)d_in[i];
    a.out = (float*)d_out; a.ws = (unsigned char*)d_ws; a.mask = 0xffffffffu; a.rep = REP_MASK;
    hipLaunchKernelGGL(mk_fwd, dim3(grid), dim3(NWAVES * 64), LDS_BYTES, stream, a);
    const hipError_t le = hipPeekAtLastError();
    if (le != hipSuccess) fprintf(stderr, "kernel_launch: launch failed: %s\n", hipGetErrorName(le));
}
```

```cpp
#include <hip/hip_runtime.h>
#include <cstdio>
#include <cstdint>
namespace pg8 {
#define PG8_LAS __attribute__((address_space(3)))
typedef unsigned short bf16_t;
typedef short bf16x8 __attribute__((ext_vector_type(8)));
typedef float f32x4 __attribute__((ext_vector_type(4)));
typedef unsigned u32x4 __attribute__((ext_vector_type(4)));
constexpr int BM = 256, BK = 64, HALF = 128, HTB = HALF * BK * 2  , STAGE_BYTES = 8 * HTB, NXCD = 8, WGM = 8;

__host__ __device__ __forceinline__ int lds_byte(int r, int c) { const int st = (r >> 4) * 2 + (c >> 5), rr = r & 15, cc = c & 31, ob = rr * 64 + cc * 2; return st * 1024 + (ob ^ (((ob >> 9) & 1) << 5)); }
__host__ __device__ __forceinline__ void stage_rc(int b, int& R, int& C) { const int st = b / 1024, sb = b % 1024, swz = sb ^ (((sb >> 9) & 1) << 5); R = (st >> 1) * 16 + swz / 64; C = (st & 1) * 32 + (swz % 64) / 2; }
__host__ __device__ __forceinline__ int perm32(int rho) { const int n = rho >> 4, i = rho & 15; return 8 * (i >> 2) + 4 * n + (i & 3); }

struct Unit { int pm, pn; };
struct Gemm { const bf16_t* A; const bf16_t* Bt; int M, N, K; };

struct StaticOrder {
    int nM, nN, nwg, G, c;
    __host__ __device__ void init(int M, int N, int G_, int c_) { nM = M / BM; nN = N / BM; nwg = nM * nN; G = G_; c = c_; }
    __host__ __device__ bool next(int i, Unit& u) const {
        const long L = (long)i * G + c; if (L >= nwg) return false;
        int wgid = (int)L; { const int q = nwg / NXCD, r = nwg % NXCD, xcd = wgid % NXCD, off = wgid / NXCD; wgid = (xcd < r ? xcd * (q + 1) : r * (q + 1) + (xcd - r) * q) + off; }
        const int nig = WGM * nN, gid = wgid / nig, fm = gid * WGM, gsz = (nM - fm) < WGM ? (nM - fm) : WGM;
        u.pm = fm + ((wgid % nig) % gsz); u.pn = (wgid % nig) / gsz; return true;
    }
    __device__ __forceinline__ void a_ready(const Unit&) const {}
    __device__ __forceinline__ void done(const Unit&) const {}
};

typedef float f32x2_t __attribute__((ext_vector_type(2))); typedef __bf16 bf16x2_t __attribute__((ext_vector_type(2)));
__device__ __forceinline__ unsigned cvt_pk_bf16(float lo, float hi) { f32x2_t v = {lo, hi}; bf16x2_t b = __builtin_convertvector(v, bf16x2_t); return __builtin_bit_cast(unsigned, b); }
__device__ __forceinline__ float sigm(float x) { return __builtin_amdgcn_rcpf(1.0f + __builtin_amdgcn_exp2f(-1.4426950408889634f * x)); }
__device__ __forceinline__ float bf_lo(unsigned w) { return __uint_as_float(w << 16); }
__device__ __forceinline__ float bf_hi(unsigned w) { return __uint_as_float(w & 0xffff0000u); }
__device__ __forceinline__ void unpack8(const u32x4 w, float (&o)[8]) { o[0] = bf_lo(w.x); o[1] = bf_hi(w.x); o[2] = bf_lo(w.y); o[3] = bf_hi(w.y); o[4] = bf_lo(w.z); o[5] = bf_hi(w.z); o[6] = bf_lo(w.w); o[7] = bf_hi(w.w); }
__device__ __forceinline__ u32x4 pack8(const float (&o)[8]) { u32x4 w; w.x = cvt_pk_bf16(o[0], o[1]); w.y = cvt_pk_bf16(o[2], o[3]); w.z = cvt_pk_bf16(o[4], o[5]); w.w = cvt_pk_bf16(o[6], o[7]); return w; }

struct EpiGU {
    static constexpr bool PERM = true, AFTER_DRAIN = false;
    bf16_t* H; int ldh;
    __device__ __forceinline__ void operator()(const f32x4 (&acc)[2][2][4][2], const Unit& u, int wr, int wc, int fr, int fq) const {
        const int row0 = u.pm * BM + wr * 64 + fr, col0 = u.pn * HALF + wc * 32 + 8 * fq;
#pragma unroll
        for (int ai = 0; ai < 2; ++ai)
#pragma unroll
            for (int m = 0; m < 4; ++m) { bf16_t* rowp = H + (size_t)(row0 + ai * HALF + m * 16) * ldh + col0;
                const f32x4 g0 = acc[ai][0][m][0], g1 = acc[ai][0][m][1], u0 = acc[ai][1][m][0], u1 = acc[ai][1][m][1]; float o[8];
#pragma unroll
                for (int j = 0; j < 4; ++j) { o[j] = g0[j] * sigm(g0[j]) * u0[j]; o[4 + j] = g1[j] * sigm(g1[j]) * u1[j]; }
                *(u32x4*)rowp = pack8(o); }
    }
};
struct EpiF32 {
    static constexpr bool PERM = false, AFTER_DRAIN = false;
    float* C; int ldc;
    __device__ __forceinline__ void operator()(const f32x4 (&acc)[2][2][4][2], const Unit& u, int wr, int wc, int fr, int fq) const {
        const int row0 = u.pm * BM + wr * 64 + fr, col0 = u.pn * BM + wc * 32 + 4 * fq;
#pragma unroll
        for (int ai = 0; ai < 2; ++ai)
#pragma unroll
            for (int m = 0; m < 4; ++m) { float* rowp = C + (size_t)(row0 + ai * HALF + m * 16) * ldc + col0;
#pragma unroll
                for (int bj = 0; bj < 2; ++bj)
#pragma unroll
                    for (int n = 0; n < 2; ++n) *(f32x4*)(rowp + bj * HALF + n * 16) = acc[ai][bj][m][n]; }
    }
};
struct EpiIN {
    static constexpr bool PERM = true, AFTER_DRAIN = false;
    bf16_t *Q, *K, *HQ, *KIN, *HI, *HG, *SA, *SB; const float* LB; float* KMEAN;
    template <int MODE> __device__ __forceinline__ void body(const f32x4 (&acc)[2][2][4][2], bf16_t* base, int ldc, int row0, int cbase, int pm, int fr) const {
        float lbv[2][8]; float ks[2][8];
#pragma unroll
        for (int bj = 0; bj < 2; ++bj)
#pragma unroll
            for (int j = 0; j < 8; ++j) { lbv[bj][j] = (MODE == 2) ? (1.0f - LB[cbase + bj * HALF + j]) : 0.f; ks[bj][j] = 0.f; }
#pragma unroll
        for (int ai = 0; ai < 2; ++ai)
#pragma unroll
            for (int m = 0; m < 4; ++m) { bf16_t* rowp = base + (size_t)(row0 + ai * HALF + m * 16) * ldc + cbase;
#pragma unroll
                for (int bj = 0; bj < 2; ++bj) { const f32x4 v0 = acc[ai][bj][m][0], v1 = acc[ai][bj][m][1]; float o[8];
#pragma unroll
                    for (int j = 0; j < 4; ++j) { o[j] = v0[j]; o[4 + j] = v1[j]; }
#pragma unroll
                    for (int j = 0; j < 8; ++j) {
                        if (MODE == 1) o[j] = o[j] * sigm(o[j]);
                        if (MODE == 2) o[j] = lbv[bj][j] * sigm(-o[j]);
                        if (MODE == 3) o[j] = sigm(o[j]);
                        if (MODE == 4) ks[bj][j] += o[j]; }
                    *(u32x4*)(rowp + bj * HALF) = pack8(o); } }
        if (MODE == 4) {
#pragma unroll
            for (int bj = 0; bj < 2; ++bj)
#pragma unroll
                for (int j = 0; j < 8; ++j) { float s = ks[bj][j]; s += __shfl_xor(s, 1); s += __shfl_xor(s, 2); s += __shfl_xor(s, 4); s += __shfl_xor(s, 8);
                    if (fr == 0) atomicAdd(KMEAN + (size_t)pm * 512 + cbase + bj * HALF + j, s); }
        }
    }
    __device__ __forceinline__ void operator()(const f32x4 (&acc)[2][2][4][2], const Unit& u, int wr, int wc, int fr, int fq) const {
        const int pn = u.pn, row0 = u.pm * BM + wr * 64 + fr, cw = wc * 32 + 8 * fq;
        if (pn < 2)       body<0>(acc, Q,   512,  row0, (pn)      * BM + cw, u.pm, fr);
        else if (pn < 4)  body<4>(acc, K,   512,  row0, (pn - 2)  * BM + cw, u.pm, fr);
        else if (pn < 6)  body<1>(acc, HQ,  512,  row0, (pn - 4)  * BM + cw, u.pm, fr);
        else if (pn < 8)  body<2>(acc, KIN, 512,  row0, (pn - 6)  * BM + cw, u.pm, fr);
        else if (pn < 10) body<0>(acc, HI,  512,  row0, (pn - 8)  * BM + cw, u.pm, fr);
        else if (pn < 12) body<1>(acc, HG,  512,  row0, (pn - 10) * BM + cw, u.pm, fr);
        else if (pn < 16) body<3>(acc, SA,  1024, row0, (pn - 12) * BM + cw, u.pm, fr);
        else              body<3>(acc, SB,  1024, row0, (pn - 16) * BM + cw, u.pm, fr);
    }
};
template <int MODE> struct EpiMix {
    static constexpr bool PERM = true, AFTER_DRAIN = false;
    bf16_t* T; const bf16_t* S2; int ldc;
    __device__ __forceinline__ void operator()(const f32x4 (&acc)[2][2][4][2], const Unit& u, int wr, int wc, int fr, int fq) const {
        const int row0 = u.pm * BM + wr * 64 + fr, col0 = u.pn * BM + wc * 32 + 8 * fq;
#pragma unroll
        for (int ai = 0; ai < 2; ++ai)
#pragma unroll
            for (int m = 0; m < 4; ++m) { const size_t off = (size_t)(row0 + ai * HALF + m * 16) * ldc + col0;
#pragma unroll
                for (int bj = 0; bj < 2; ++bj) { const f32x4 v0 = acc[ai][bj][m][0], v1 = acc[ai][bj][m][1]; float o[8];
#pragma unroll
                    for (int j = 0; j < 4; ++j) { o[j] = v0[j]; o[4 + j] = v1[j]; }
                    if (MODE == 1) { float t[8]; unpack8(*(const u32x4*)(T + off + bj * HALF), t);
#pragma unroll
                        for (int j = 0; j < 8; ++j) o[j] = t[j] * o[j]; }
                    if (MODE == 2) { float t[8], s[8]; unpack8(*(const u32x4*)(T + off + bj * HALF), t); unpack8(*(const u32x4*)(S2 + off + bj * HALF), s);
#pragma unroll
                        for (int j = 0; j < 8; ++j) o[j] = t[j] + s[j] * o[j]; }
                    *(u32x4*)(T + off + bj * HALF) = pack8(o); } }
    }
};
struct EpiPleB {
    static constexpr bool PERM = true, AFTER_DRAIN = false;
    const bf16_t* E; bf16_t* Y; int ldc;
    __device__ __forceinline__ void operator()(const f32x4 (&acc)[2][2][4][2], const Unit& u, int wr, int wc, int fr, int fq) const {
        const int row0 = u.pm * BM + wr * 64 + fr, col0 = u.pn * BM + wc * 32 + 8 * fq;
#pragma unroll
        for (int ai = 0; ai < 2; ++ai)
#pragma unroll
            for (int m = 0; m < 4; ++m) { const size_t off = (size_t)(row0 + ai * HALF + m * 16) * ldc + col0;
#pragma unroll
                for (int bj = 0; bj < 2; ++bj) { const f32x4 v0 = acc[ai][bj][m][0], v1 = acc[ai][bj][m][1]; float e[8], o[8]; unpack8(*(const u32x4*)(E + off + bj * HALF), e);
#pragma unroll
                    for (int j = 0; j < 4; ++j) { o[j] = sigm(v0[j]) * e[j]; o[4 + j] = sigm(v1[j]) * e[4 + j]; }
                    *(u32x4*)(Y + off + bj * HALF) = pack8(o); } }
    }
};

template <class Epi, class Sched, bool ALIGN_EPI = false, bool SP2 = false>
__device__ __forceinline__ void gemm_phase(PG8_LAS unsigned char* lds, const Gemm g, const Sched& S, const Epi& E) {
    int tid_ = threadIdx.x; asm volatile("" : "+v"(tid_));
    const int tid = tid_, wid = __builtin_amdgcn_readfirstlane(tid >> 6), lane = tid & 63, wr = wid >> 2, wc = wid & 3, fr = lane & 15, fq = lane >> 4;
    int K_ = g.K; asm volatile("" : "+s"(K_));
    const int K = K_, nt = K / BK;
    unsigned voffA[2], voffB[2];
#pragma unroll
    for (int i = 0; i < 2; ++i) { int R, C; stage_rc(tid * 16 + i * 8192, R, C); const int Rb = Epi::PERM ? ((R & ~31) + perm32(R & 31)) : R;
        voffA[i] = (unsigned)(R * K + C) * 2u; voffB[i] = (unsigned)(Rb * K + C) * 2u; }
    const size_t kstep = (size_t)(BK * 2);
    const size_t hstep = (size_t)HALF * K * 2;
    const size_t tstep = 2 * hstep;
    const unsigned ldsw = (unsigned)wid * 1024u;
    const int aoff = lds_byte(wr * 64 + fr, fq * 8), boff = lds_byte(wc * 32 + fr, fq * 8);
#define PG8_SA(b, h) (((b) * 2 + (h)) * HTB)
#define PG8_SB(b, h) ((4 + (b) * 2 + (h)) * HTB)
#define PG8_STAGE(bufoff, gbase, voff) do { _Pragma("unroll") for (int _i = 0; _i < 2; ++_i) \
        __builtin_amdgcn_global_load_lds((const unsigned*)((const char*)(gbase) + (voff)[_i]), (PG8_LAS unsigned*)(lds + (bufoff) + ldsw + _i * 8192), 16, 0, 0); } while (0)
#define PG8_LDA(dst, b, h) do { _Pragma("unroll") for (int m = 0; m < 4; ++m) _Pragma("unroll") for (int k = 0; k < 2; ++k) dst[m][k] = *(const PG8_LAS bf16x8*)(lds + PG8_SA(b, h) + aoff + m * 2048 + k * 1024); } while (0)
#define PG8_LDB(dst, b, h) do { _Pragma("unroll") for (int n = 0; n < 2; ++n) _Pragma("unroll") for (int k = 0; k < 2; ++k) dst[n][k] = *(const PG8_LAS bf16x8*)(lds + PG8_SB(b, h) + boff + n * 2048 + k * 1024); } while (0)
#define PG8_MMA(ai, bj, At, Bt) do { __builtin_amdgcn_s_setprio(1); _Pragma("unroll") for (int m = 0; m < 4; ++m) _Pragma("unroll") for (int n = 0; n < 2; ++n) _Pragma("unroll") for (int k = 0; k < 2; ++k) \
        acc[ai][bj][m][n] = __builtin_amdgcn_mfma_f32_16x16x32_bf16(Bt[n][k], At[m][k], acc[ai][bj][m][n], 0, 0, 0); __builtin_amdgcn_s_setprio(0); } while (0)
#define PG8_WAIT_V(n) asm volatile("s_waitcnt vmcnt(" #n ")" ::: "memory")
#define PG8_WAIT_L(n) asm volatile("s_waitcnt lgkmcnt(" #n ")" ::: "memory")
#define PG8_BAR __builtin_amdgcn_s_barrier()
#define PG8_SCHED __builtin_amdgcn_sched_barrier(0)
    Unit cur, nxt; int ui = 0;
    if (!S.next(0, cur)) return;
    f32x4 acc[2][2][4][2];
#pragma unroll
    for (int a = 0; a < 2; ++a)
#pragma unroll
        for (int b = 0; b < 2; ++b)
#pragma unroll
            for (int m = 0; m < 4; ++m)
#pragma unroll
                for (int n = 0; n < 2; ++n) acc[a][b][m][n] = (f32x4){0.f, 0.f, 0.f, 0.f};
    bf16x8 At[4][2], B0[2][2], B1[2][2];
    const char* cA = (const char*)g.A + (size_t)cur.pm * tstep; const char* cB = (const char*)g.Bt + (size_t)cur.pn * tstep;
    S.a_ready(cur);
    if constexpr (SP2) {
        PG8_STAGE(PG8_SB(0, 0), cB, voffB); PG8_STAGE(PG8_SB(0, 1), cB + hstep, voffB); PG8_STAGE(PG8_SA(0, 0), cA, voffA); PG8_STAGE(PG8_SA(0, 1), cA + hstep, voffA);
        if (wr == 1) PG8_BAR;
        PG8_WAIT_V(2); PG8_BAR;
        PG8_STAGE(PG8_SB(1, 0), cB + kstep, voffB); PG8_STAGE(PG8_SA(1, 0), cA + kstep, voffA); PG8_STAGE(PG8_SB(1, 1), cB + hstep + kstep, voffB);
        PG8_WAIT_V(6); PG8_BAR;
    } else {
        PG8_STAGE(PG8_SB(0, 0), cB, voffB); PG8_STAGE(PG8_SA(0, 0), cA, voffA); PG8_STAGE(PG8_SB(0, 1), cB + hstep, voffB); PG8_STAGE(PG8_SA(0, 1), cA + hstep, voffA);
        if (wr == 1) PG8_BAR;
        PG8_WAIT_V(4); PG8_BAR;
        PG8_STAGE(PG8_SB(1, 0), cB + kstep, voffB); PG8_STAGE(PG8_SA(1, 0), cA + kstep, voffA); PG8_STAGE(PG8_SB(1, 1), cB + hstep + kstep, voffB);
        PG8_WAIT_V(6); PG8_BAR;
    }
    for (;;) {
        const bool has_next = S.next(ui + 1, nxt);
        const char* nA = has_next ? (const char*)g.A + (size_t)nxt.pm * tstep : cA; const char* nB = has_next ? (const char*)g.Bt + (size_t)nxt.pn * tstep : cB;
        for (int t = 0; t < nt; t += 2) {
            const bool last = (t == nt - 2);
            const char* a1 = cA + (size_t)(t + 1) * kstep;
            const char* a2 = last ? nA : cA + (size_t)(t + 2) * kstep; const char* b2 = last ? nB : cB + (size_t)(t + 2) * kstep;
            const char* a3 = a2 + kstep; const char* b3 = b2 + kstep;
            if (last && has_next) S.a_ready(nxt);
            if constexpr (SP2) {
            PG8_LDB(B0, 0, 0); PG8_LDB(B1, 0, 1); PG8_SCHED; PG8_LDA(At, 0, 0); PG8_STAGE(PG8_SA(1, 1), a1 + hstep, voffA);
            PG8_WAIT_V(8); PG8_WAIT_L(0); PG8_BAR; PG8_MMA(0, 0, At, B0); PG8_MMA(0, 1, At, B1); PG8_BAR; PG8_SCHED;
            PG8_LDA(At, 0, 1); PG8_STAGE(PG8_SB(0, 0), b2, voffB); PG8_STAGE(PG8_SB(0, 1), b2 + hstep, voffB); PG8_STAGE(PG8_SA(0, 0), a2, voffA);
            PG8_WAIT_V(8); PG8_WAIT_L(0); PG8_BAR; PG8_MMA(1, 0, At, B0); PG8_MMA(1, 1, At, B1); PG8_BAR; PG8_SCHED;
            PG8_LDB(B0, 1, 0); PG8_LDB(B1, 1, 1); PG8_SCHED; PG8_LDA(At, 1, 0); PG8_STAGE(PG8_SA(0, 1), a2 + hstep, voffA);
            PG8_WAIT_V(8); PG8_WAIT_L(0); PG8_BAR; PG8_MMA(0, 0, At, B0); PG8_MMA(0, 1, At, B1); PG8_BAR; PG8_SCHED;
            PG8_LDA(At, 1, 1); PG8_STAGE(PG8_SB(1, 0), b3, voffB); PG8_STAGE(PG8_SB(1, 1), b3 + hstep, voffB); PG8_STAGE(PG8_SA(1, 0), a3, voffA);
            PG8_WAIT_V(8); PG8_WAIT_L(0); PG8_BAR; PG8_MMA(1, 0, At, B0); PG8_MMA(1, 1, At, B1); PG8_BAR; PG8_SCHED;
            } else {
            PG8_LDB(B0, 0, 0); PG8_SCHED; PG8_LDA(At, 0, 0); PG8_STAGE(PG8_SA(1, 1), a1 + hstep, voffA);
            PG8_WAIT_L(8); PG8_BAR; PG8_WAIT_L(0); PG8_MMA(0, 0, At, B0); PG8_BAR; PG8_SCHED;
            PG8_LDB(B1, 0, 1); PG8_STAGE(PG8_SB(0, 0), b2, voffB);
            PG8_BAR; PG8_WAIT_L(0); PG8_MMA(0, 1, At, B1); PG8_BAR;
            PG8_LDA(At, 0, 1); PG8_STAGE(PG8_SA(0, 0), a2, voffA);
            PG8_BAR; PG8_WAIT_L(0); PG8_MMA(1, 0, At, B0); PG8_BAR; PG8_SCHED;
            PG8_STAGE(PG8_SB(0, 1), b2 + hstep, voffB);
            PG8_WAIT_V(6); PG8_BAR; PG8_MMA(1, 1, At, B1); PG8_BAR;
            PG8_LDB(B0, 1, 0); PG8_SCHED; PG8_LDA(At, 1, 0); PG8_STAGE(PG8_SA(0, 1), a2 + hstep, voffA);
            PG8_WAIT_L(8); PG8_BAR; PG8_WAIT_L(0); PG8_MMA(0, 0, At, B0); PG8_BAR; PG8_SCHED;
            PG8_LDB(B1, 1, 1); PG8_STAGE(PG8_SB(1, 0), b3, voffB);
            PG8_BAR; PG8_WAIT_L(0); PG8_MMA(0, 1, At, B1); PG8_BAR;
            PG8_LDA(At, 1, 1); PG8_STAGE(PG8_SA(1, 0), a3, voffA);
            PG8_BAR; PG8_WAIT_L(0); PG8_MMA(1, 0, At, B0); PG8_BAR; PG8_SCHED;
            PG8_STAGE(PG8_SB(1, 1), b3 + hstep, voffB);
            PG8_WAIT_V(6); PG8_BAR; PG8_MMA(1, 1, At, B1); PG8_BAR;
            }
        }
        if constexpr (ALIGN_EPI) { if (wr == 0) PG8_BAR; }
        if constexpr (!Epi::AFTER_DRAIN) { E(acc, cur, wr, wc, fr, fq); S.done(cur); }
        if (!has_next) break;
#pragma unroll
        for (int a = 0; a < 2; ++a)
#pragma unroll
            for (int b = 0; b < 2; ++b)
#pragma unroll
                for (int m = 0; m < 4; ++m)
#pragma unroll
                    for (int n = 0; n < 2; ++n) acc[a][b][m][n] = (f32x4){0.f, 0.f, 0.f, 0.f};
        cur = nxt; cA = nA; cB = nB; ++ui;
        if constexpr (ALIGN_EPI) { if (wr == 1) PG8_BAR; }
    }
    PG8_WAIT_V(0);
    if constexpr (!ALIGN_EPI) { if (wr == 0) PG8_BAR; }
    PG8_BAR;
    if constexpr (Epi::AFTER_DRAIN) { E.fused(acc, cur, wr, wc, fr, fq, lds, wid, lane); S.done(cur); }
#undef PG8_SA
#undef PG8_SB
#undef PG8_STAGE
#undef PG8_LDA
#undef PG8_LDB
#undef PG8_MMA
#undef PG8_WAIT_V
#undef PG8_WAIT_L
#undef PG8_BAR
#undef PG8_SCHED
}
}
#ifndef PG8_SP2
#define PG8_SP2 true
#endif
#ifndef PG8_ALIGN
#define PG8_ALIGN true
#endif
constexpr int NWAVES = 8;
constexpr int BATCH = 4, SEQ = 8192, D = 1024, FF = 2816, NGU = 2 * FF, NIN = 5632, PLE = 256;
constexpr int M = BATCH * SEQ;
constexpr int MBH = 8, MBD = 64, MBW = 512, MBB = 256, NBLK = SEQ / MBB;
constexpr int HGH = 4, HGD_ = 128, HGW = 512, HGC = 256, HGNC = SEQ / HGC;
constexpr float EPS = 1e-6f;
constexpr size_t MiB = 1u << 20;
constexpr size_t WS_CTL = 0, CTL_ZERO_BYTES = 1 * MiB;
constexpr size_t WS_KMEAN = 512 * 1024;
constexpr size_t WS_LB = 768 * 1024, WS_BIAST = 772 * 1024;
constexpr size_t WS_WGU1 = 1 * MiB, WS_WD1 = 12 * MiB, WS_WIN = WS_WD1 + 5632 * 1024, WS_WA = WS_WIN + 11 * MiB, WS_WB = WS_WA + 1 * MiB, WS_WOUT = WS_WB + 1 * MiB,
                 WS_WGU2 = WS_WOUT + 2 * MiB, WS_WD2 = WS_WGU2 + 11 * MiB, WS_WPLE = WS_WD2 + 5632 * 1024, WS_WPG = WS_WPLE + 512 * 1024, WS_HGD = WS_WPG + 2 * MiB;
constexpr size_t WS_CNT = 256 * 1024;
constexpr size_t WS_A = 52 * MiB;
constexpr size_t WS_Q = WS_A, WS_K = WS_A + 32 * MiB, WS_VT = WS_A + 64 * MiB, WS_HQ = WS_A + 96 * MiB, WS_HI = WS_A + 128 * MiB;
constexpr size_t WS_LIST = 212 * MiB;
constexpr size_t WS_PB = 228 * MiB;
constexpr size_t WS_SB = 228 * MiB;
constexpr size_t WS_PML = 292 * MiB;
constexpr size_t WS_B = 320 * MiB;
constexpr size_t WS_KIN = WS_B, WS_HG = WS_B + 32 * MiB, WS_SA = WS_B + 64 * MiB;
constexpr size_t WS_C = 448 * MiB;
constexpr size_t WS_HS = WS_C, WS_OA = WS_C, WS_OB = WS_C + 32 * MiB;
constexpr size_t WS_PO0 = WS_HQ, WS_PO1 = WS_HI, WS_PO2 = WS_KIN, WS_PO3 = WS_HG;
constexpr size_t WS_END = 512 * MiB;
static_assert(WS_HGD + 256 * 1024 <= WS_A, "weights region");
constexpr int LIST_PER_BH = 126976;
constexpr int CW_TMO = 0, CW_CODE = 1, CW_BAR = 4096;
constexpr int RING_OFF = 0, RING_BYTES = 131072, LDSCTL_OFF = RING_BYTES, MISC_OFF = LDSCTL_OFF + 320, LDS_BYTES = 147456;
#define GAS __attribute__((address_space(1)))
#define LAS __attribute__((address_space(3)))
typedef unsigned short bf16;
typedef unsigned v4u __attribute__((ext_vector_type(4)));
typedef unsigned v2u __attribute__((ext_vector_type(2)));
typedef float f32x4 __attribute__((ext_vector_type(4)));
typedef GAS unsigned gu32;
#define RLX_AGENT __ATOMIC_RELAXED, __HIP_MEMORY_SCOPE_AGENT
#define LDS_WAIT() asm volatile("s_waitcnt lgkmcnt(0)" ::: "memory")
#define VM_WAIT() asm volatile("s_waitcnt vmcnt(0)" ::: "memory")
__device__ __forceinline__ unsigned f2bf(float f) { unsigned u = __builtin_bit_cast(unsigned, f); return (u + 0x7fffu + ((u >> 16) & 1u)) >> 16; }
__device__ __forceinline__ unsigned pk2(float lo, float hi) { return f2bf(lo) | (f2bf(hi) << 16); }
__device__ __forceinline__ float bflo(unsigned w) { return __uint_as_float(w << 16); }
__device__ __forceinline__ float bfhi(unsigned w) { return __uint_as_float(w & 0xffff0000u); }
__device__ __forceinline__ float wave_sum(float v) {
#pragma unroll
    for (int o = 1; o < 64; o <<= 1) v += __shfl_xor(v, o);
    return v;
}
__device__ __forceinline__ float wave_max(float v) {
#pragma unroll
    for (int o = 1; o < 64; o <<= 1) v = fmaxf(v, __shfl_xor(v, o));
    return v;
}
#define XB_TMO      128
#define XB_XCNT(j)  (256  + 64 * (j))
#define XB_XSUB(j)  (1280 + 64 * (j))
#define XB_XGEN(j)  (2304 + 64 * (j))
#define XB_TOP      3328
#define XB_TOPGEN   3392
#define XCD_BAR_WORDS 3456
#define XB_SPIN_CAP (1u << 18)

__device__ __forceinline__ unsigned xb_ld(unsigned* p)              { return __hip_atomic_load(p, __ATOMIC_RELAXED, __HIP_MEMORY_SCOPE_AGENT); }
__device__ __forceinline__ unsigned xb_add(unsigned* p, unsigned v) { return __hip_atomic_fetch_add(p, v, __ATOMIC_RELAXED, __HIP_MEMORY_SCOPE_AGENT); }
__device__ __forceinline__ unsigned xb_xcc_id() { return (unsigned)__builtin_amdgcn_s_getreg((3 << 11) | 20) & 0xFu; }
#define XB_SPIN(cond, bar) do { unsigned _sp = 0; while (cond) { __builtin_amdgcn_s_sleep(1); \
    if ((++_sp & 255u) == 0u) { if (xb_ld(&(bar)[XB_TMO])) break; if (_sp > XB_SPIN_CAP) { atomicAdd(&(bar)[XB_TMO], 1u); break; } } } } while (0)

struct XcdBarrier {
    unsigned* bar; unsigned x;
    volatile LAS unsigned* st;
};

__device__ __forceinline__ XcdBarrier xcd_barrier_post(unsigned* bar, volatile LAS unsigned* st) {
    XcdBarrier b; b.bar = bar; b.x = xb_xcc_id(); b.st = st;
    if (threadIdx.x == 0) (void)xb_add(&bar[XB_XCNT(b.x)], 1u);
    return b;
}
__device__ __forceinline__ void xcd_barrier_complete(unsigned* bar, unsigned x, unsigned& nloc, unsigned& nx) {
    const unsigned G = gridDim.x * gridDim.y * gridDim.z;
    unsigned sum, cnt, mine, sp = 0u;
    for (;;) {
        sum = 0u; cnt = 0u; mine = 0u;
#pragma unroll
        for (unsigned j = 0; j < 16; ++j) { const unsigned c = xb_ld(&bar[XB_XCNT(j)]); sum += c; cnt += (c > 0u) ? 1u : 0u; mine = (j == x) ? c : mine; }
        if (sum == G) break;
        __builtin_amdgcn_s_sleep(1);
        if ((++sp & 255u) == 0u) { if (xb_ld(&bar[XB_TMO])) break; if (sp > XB_SPIN_CAP) { atomicAdd(&bar[XB_TMO], 1u); break; } }
    }
    nloc = mine > 0u ? mine : 1u; nx = cnt > 0u ? cnt : 1u;
}

__device__ __forceinline__ void xcd_barrier(const XcdBarrier& b) {
    asm volatile("s_waitcnt vmcnt(0)" ::: "memory");
    __syncthreads();
    if (threadIdx.x == 0) {
        unsigned* bar = b.bar;
        __builtin_amdgcn_s_waitcnt(0);
        unsigned nloc = b.st[0], nx = b.st[1];
        if (nloc == 0u) { xcd_barrier_complete(bar, b.x, nloc, nx); b.st[0] = nloc; b.st[1] = nx; }
        const unsigned old = xb_add(&bar[XB_XSUB(b.x)], 1u);
        const unsigned gen = old / nloc;
        if (old + 1u == (gen + 1u) * nloc) {
            __builtin_amdgcn_fence(__ATOMIC_RELEASE, "agent");
            asm volatile("s_waitcnt vmcnt(0)" ::: "memory");
            const unsigned og = xb_add(&bar[XB_TOP], 1u);
            const unsigned tg = og / nx;
            if (og + 1u == (tg + 1u) * nx) xb_add(&bar[XB_TOPGEN], 1u);
            else XB_SPIN(xb_ld(&bar[XB_TOPGEN]) == tg, bar);
            __builtin_amdgcn_fence(__ATOMIC_ACQUIRE, "agent");
            xb_add(&bar[XB_XGEN(b.x)], 1u);
            asm volatile("s_waitcnt vmcnt(0)" ::: "memory");
        } else {
            XB_SPIN(xb_ld(&bar[XB_XGEN(b.x)]) == gen, bar);
            __builtin_amdgcn_fence(__ATOMIC_ACQUIRE, "agent");
            asm volatile("s_waitcnt vmcnt(0)" ::: "memory");
        }
    }
    __syncthreads();
}
__device__ __forceinline__ void p0_transpose_item(const float* W, int K, int N, bf16* WT, const float* gain, int mode, LAS float* scr, int item, int lane) {
    const int nblk = N / 32, kb = item / nblk, nb = item % nblk, k0 = 64 * kb, n0 = 32 * nb;
#pragma unroll 8
    for (int i = 0; i < 32; ++i) { const int kk = 2 * i + (lane >> 5); float w = W[(size_t)(k0 + kk) * N + n0 + (lane & 31)]; if (gain) w *= gain[k0 + kk]; scr[kk * 33 + (lane & 31)] = w; }
    LDS_WAIT(); asm volatile("" ::: "memory");
    int rbase = n0;
    if (mode == 1) { if (n0 < FF) rbase = (n0 / 128) * 256 + (n0 % 128); else { const int j = n0 - FF; rbase = (j / 128) * 256 + 128 + (j % 128); } }
    if (mode == 2) { if (n0 >= 1024 && n0 < 1536) rbase = 5120 + (n0 - 1024); else if (n0 >= 1536) rbase = n0 - 512; }
    const int c = lane & 7;
#pragma unroll
    for (int j = 0; j < 4; ++j) { const int n = (lane >> 3) + 8 * j; const LAS float* s = scr + (8 * c) * 33 + n;
        v4u o; o.x = pk2(s[0 * 33], s[1 * 33]); o.y = pk2(s[2 * 33], s[3 * 33]); o.z = pk2(s[4 * 33], s[5 * 33]); o.w = pk2(s[6 * 33], s[7 * 33]);
        *(GAS v4u*)(WT + (size_t)(rbase + n) * K + k0 + 8 * c) = o; }
    LDS_WAIT(); asm volatile("" ::: "memory");
}
__device__ __forceinline__ void rms_row_to_bf16(const float* xrow, bf16* orow, int lane) {
    const GAS f32x4* xr = (const GAS f32x4*)xrow + lane;
    f32x4 v[4]; float s = 0.f;
#pragma unroll
    for (int j = 0; j < 4; ++j) { v[j] = xr[64 * j]; s += (v[j].x * v[j].x + v[j].y * v[j].y) + (v[j].z * v[j].z + v[j].w * v[j].w); }
    const float rstd = 1.f / sqrtf(wave_sum(s) * (1.f / D) + EPS);
    GAS unsigned long long* o8 = (GAS unsigned long long*)orow + lane;
#pragma unroll
    for (int j = 0; j < 4; ++j) o8[64 * j] = (unsigned long long)pk2(v[j].x * rstd, v[j].y * rstd) | ((unsigned long long)pk2(v[j].z * rstd, v[j].w * rstd) << 32);
}
struct Ptrs {
    const float *x, *p, *w_gu1, *w_d1, *w_in, *w_a, *w_b, *w_out, *w_gu2, *w_d2, *w_ple, *w_pg, *gains, *hgw, *lbp, *rel;
    float* out; unsigned char* ws;
};
__device__ __forceinline__ void p0_prologue(const Ptrs P, LAS unsigned char* lds, int gw, int NGW, int wave, int lane) {
    LAS float* scr = (LAS float*)(lds + RING_OFF + wave * 16384);
    unsigned char* ws = P.ws;
    constexpr int I_GU = (D / 64) * (NGU / 32), I_D = (FF / 64) * (D / 32), I_IN = (D / 64) * (NIN / 32), I_AB = (512 / 64) * (D / 32), I_O = (D / 64) * (D / 32), I_PLE = (PLE / 64) * (D / 32);
    constexpr int NITEMS = 2 * I_GU + 2 * I_D + I_IN + 2 * I_AB + 2 * I_O + I_PLE;
    for (int it = gw; it < NITEMS; it += NGW) {
        int r = it;
        if (r < I_GU) { p0_transpose_item(P.w_gu1, D, NGU, (bf16*)(ws + WS_WGU1), P.gains + 0 * D, 1, scr, r, lane); continue; } r -= I_GU;
        if (r < I_GU) { p0_transpose_item(P.w_gu2, D, NGU, (bf16*)(ws + WS_WGU2), P.gains + 4 * D, 1, scr, r, lane); continue; } r -= I_GU;
        if (r < I_IN) { p0_transpose_item(P.w_in, D, NIN, (bf16*)(ws + WS_WIN), P.gains + 2 * D, 2, scr, r, lane); continue; } r -= I_IN;
        if (r < I_D)  { p0_transpose_item(P.w_d1, FF, D, (bf16*)(ws + WS_WD1), nullptr, 0, scr, r, lane); continue; } r -= I_D;
        if (r < I_D)  { p0_transpose_item(P.w_d2, FF, D, (bf16*)(ws + WS_WD2), nullptr, 0, scr, r, lane); continue; } r -= I_D;
        if (r < I_AB) { p0_transpose_item(P.w_a, 512, D, (bf16*)(ws + WS_WA), nullptr, 0, scr, r, lane); continue; } r -= I_AB;
        if (r < I_AB) { p0_transpose_item(P.w_b, 512, D, (bf16*)(ws + WS_WB), nullptr, 0, scr, r, lane); continue; } r -= I_AB;
        if (r < I_O)  { p0_transpose_item(P.w_out, D, D, (bf16*)(ws + WS_WOUT), nullptr, 0, scr, r, lane); continue; } r -= I_O;
        if (r < I_O)  { p0_transpose_item(P.w_pg, D, D, (bf16*)(ws + WS_WPG), nullptr, 0, scr, r, lane); continue; } r -= I_O;
        p0_transpose_item(P.w_ple, PLE, D, (bf16*)(ws + WS_WPLE), nullptr, 0, scr, r, lane);
    }
    for (int m = gw; m < M; m += NGW) rms_row_to_bf16(P.x + (size_t)m * D, (bf16*)(ws + WS_C) + (size_t)m * D, lane);
    const int gt = gw * 64 + lane;
    if (gt < 512) { const float a = P.lbp[gt], b = P.lbp[512 + gt]; const float mx = fmaxf(a, b); const float ea = expf(a - mx), eb = expf(b - mx); ((float*)(ws + WS_LB))[gt] = ea / (ea + eb); }
    if (gt >= 1024 && gt < 2048) { const int h = (gt - 1024) >> 7, d = (gt - 1024) & 127; int bk;
        if (d < 16) bk = d; else { bk = 16 + (int)(logf((float)d / 16.0f) / logf(8.0f) * 16.0f); if (bk > 31) bk = 31; }
        ((float*)(ws + WS_BIAST))[h * 128 + d] = P.rel[bk * 8 + h]; }
}
template <bool HIN_F32, int OMODE> __device__ __forceinline__ void rowwise_phase(int gw, int NGW, int lane, const void* hin, const bf16* Y, const float* gain, float coef, bf16* hb, bf16* xn, float* outf) {
    f32x4 g[4];
#pragma unroll
    for (int j = 0; j < 4; ++j) g[j] = ((const f32x4*)gain)[lane + 64 * j] * coef;
    for (int m = gw; m < M; m += NGW) {
        const GAS v2u* yr = (const GAS v2u*)(Y + (size_t)m * D) + lane;
        f32x4 y[4], h[4]; float s = 0.f;
#pragma unroll
        for (int j = 0; j < 4; ++j) { const v2u w = yr[64 * j]; y[j] = (f32x4){bflo(w.x), bfhi(w.x), bflo(w.y), bfhi(w.y)}; s += (y[j].x * y[j].x + y[j].y * y[j].y) + (y[j].z * y[j].z + y[j].w * y[j].w); }
        if (HIN_F32) { const GAS f32x4* hr = (const GAS f32x4*)((const float*)hin + (size_t)m * D) + lane;
#pragma unroll
            for (int j = 0; j < 4; ++j) h[j] = hr[64 * j]; }
        else { const GAS v2u* hr = (const GAS v2u*)((const bf16*)hin + (size_t)m * D) + lane;
#pragma unroll
            for (int j = 0; j < 4; ++j) { const v2u w = hr[64 * j]; h[j] = (f32x4){bflo(w.x), bfhi(w.x), bflo(w.y), bfhi(w.y)}; } }
        const float rstd = 1.f / sqrtf(wave_sum(s) * (1.f / D) + EPS);
        float s2 = 0.f;
#pragma unroll
        for (int j = 0; j < 4; ++j) { h[j] = h[j] + (g[j] * y[j]) * rstd; s2 += (h[j].x * h[j].x + h[j].y * h[j].y) + (h[j].z * h[j].z + h[j].w * h[j].w); }
        if (OMODE == 3) { GAS f32x4* ho = (GAS f32x4*)(outf + (size_t)m * D) + lane;
#pragma unroll
            for (int j = 0; j < 4; ++j) ho[64 * j] = h[j]; }
        if (OMODE == 1) { GAS v2u* ho = (GAS v2u*)(hb + (size_t)m * D) + lane;
#pragma unroll
            for (int j = 0; j < 4; ++j) ho[64 * j] = (v2u){pk2(h[j].x, h[j].y), pk2(h[j].z, h[j].w)}; }
        if (OMODE == 1 || OMODE == 2) {
            float r2 = 1.f;
            if (OMODE == 1) r2 = 1.f / sqrtf(wave_sum(s2) * (1.f / D) + EPS);
            GAS v2u* o8 = (GAS v2u*)(xn + (size_t)m * D) + lane;
#pragma unroll
            for (int j = 0; j < 4; ++j) o8[64 * j] = (v2u){pk2(h[j].x * r2, h[j].y * r2), pk2(h[j].z * r2, h[j].w * r2)};
        }
    }
}
__device__ __forceinline__ int moba_list_base(int bh, int j) { return bh * LIST_PER_BH + 256 * (31 * j - (j * (j - 1)) / 2); }
__device__ __forceinline__ void moba_gating_phase(LAS unsigned char* lds, int vcu, int G, int tid, const bf16* Q, const float* KMEAN, unsigned* CNT, unsigned* LIST) {
    LAS float* km = (LAS float*)lds;
    const int lane = tid & 63;
    for (int unit = vcu; unit < BATCH * NBLK * 4; unit += G) {
        const int hp = unit & 3, i = (unit >> 2) & 31, b = unit >> 7;
        __syncthreads();
        for (int e = tid; e < i * 128; e += 512) { const int j = e >> 7, c = e & 127; km[e] = KMEAN[(size_t)(b * NBLK + j) * 512 + hp * 128 + c] * (1.0f / 256.0f); }
        __syncthreads();
        const int hh = __builtin_amdgcn_readfirstlane(tid >> 8), ql = tid & 255, m = b * SEQ + i * MBB + ql, h = 2 * hp + hh;
        float q[64];
        { const v4u* qp = (const v4u*)(Q + (size_t)m * MBW + h * MBD);
#pragma unroll
          for (int c = 0; c < 8; ++c) { const v4u w = qp[c]; q[8 * c + 0] = bflo(w.x); q[8 * c + 1] = bfhi(w.x); q[8 * c + 2] = bflo(w.y); q[8 * c + 3] = bfhi(w.y); q[8 * c + 4] = bflo(w.z); q[8 * c + 5] = bfhi(w.z); q[8 * c + 6] = bflo(w.w); q[8 * c + 7] = bfhi(w.w); } }
        float v0 = -INFINITY, v1 = -INFINITY, v2 = -INFINITY; int i0 = -1, i1 = -1, i2 = -1;
        for (int j = 0; j < i; ++j) {
            const LAS f32x4* kp = (const LAS f32x4*)(km + j * 128 + hh * 64); float s = 0.f;
#pragma unroll
            for (int c = 0; c < 16; ++c) { const f32x4 kv = kp[c]; s += q[4 * c] * kv.x; s += q[4 * c + 1] * kv.y; s += q[4 * c + 2] * kv.z; s += q[4 * c + 3] * kv.w; }
            if (s > v0) { v2 = v1; i2 = i1; v1 = v0; i1 = i0; v0 = s; i0 = j; }
            else if (s > v1) { v2 = v1; i2 = i1; v1 = s; i1 = j; }
            else if (s > v2) { v2 = s; i2 = j; }
        }
        const int bh = b * 8 + h; const unsigned tl = (unsigned)(i * MBB + ql); const unsigned long long lt = (1ull << lane) - 1ull;
        for (int j = 0; j < i; ++j) {
            const unsigned long long m0 = __ballot(i0 == j), m1 = __ballot(i1 == j), m2 = __ballot(i2 == j);
            const int c0 = __popcll(m0), c1 = __popcll(m1), c2 = __popcll(m2), tot = c0 + c1 + c2;
            if (tot) {
                unsigned base = 0u; if (lane == 0) base = atomicAdd(CNT + bh * 32 + j, (unsigned)tot);
                base = (unsigned)__builtin_amdgcn_readfirstlane((int)base);
                unsigned* L = LIST + moba_list_base(bh, j) + base;
                if (i0 == j) L[__popcll(m0 & lt)] = tl;
                if (i1 == j) L[c0 + __popcll(m1 & lt)] = tl | (1u << 13);
                if (i2 == j) L[c0 + c1 + __popcll(m2 & lt)] = tl | (2u << 13);
            }
        }
    }
    __syncthreads();
}
typedef float f32x16 __attribute__((ext_vector_type(16)));
typedef short bf16x8v __attribute__((ext_vector_type(8)));
typedef short s16x4v __attribute__((ext_vector_type(4)));
constexpr int IT_KS = 0, IT_VS = 32768, IT_VROW = 520, IT_TB = IT_VS + 64 * IT_VROW  , IT_INFO = IT_TB + 8 * 128 * 4  ;
__device__ __forceinline__ int crow16(int r, int hi) { return (r & 3) + 8 * (r >> 2) + 4 * hi; }
template <bool GENERAL> __device__ __forceinline__ void moba_item_half(f32x16 (&st)[4], int half, int ntile, int hi, int dq, float c1, float c0, const LAS float* tb,
                                                                      float& mrun, float& lrun, f32x16 (&o)[2], const LAS unsigned char* vs, int r32) {
    float mloc = -INFINITY;
#pragma unroll
    for (int t4 = 0; t4 < 4; ++t4) { const int kt = half * 4 + t4;
        if (kt < ntile) {
#pragma unroll
            for (int r = 0; r < 16; ++r) { float x;
                if (GENERAL) { const int dist = dq - (32 * kt + crow16(r, hi)); const int di = dist > 113 ? 113 : (dist < 0 ? 0 : dist); x = st[t4][r] * c1 + tb[di]; if (dist < 0) x = -INFINITY; }
                else x = st[t4][r] * c1 + c0;
                st[t4][r] = x; mloc = fmaxf(mloc, x); }
        }
    }
    mloc = fmaxf(mloc, __shfl_xor(mloc, 32));
    const float mnew = fmaxf(mrun, mloc);
    const float alpha = __builtin_amdgcn_exp2f(mrun - mnew);
    float ls = 0.f;
#pragma unroll
    for (int t4 = 0; t4 < 4; ++t4) { const int kt = half * 4 + t4;
        if (kt < ntile) {
#pragma unroll
            for (int r = 0; r < 16; ++r) { const float pv = __builtin_amdgcn_exp2f(st[t4][r] - mnew); st[t4][r] = pv; ls += pv; }
        }
    }
    ls += __shfl_xor(ls, 32);
    lrun = lrun * alpha + ls; mrun = mnew;
#pragma unroll
    for (int d = 0; d < 2; ++d)
#pragma unroll
        for (int r = 0; r < 16; ++r) o[d][r] *= alpha;
#pragma unroll
    for (int t4 = 0; t4 < 4; ++t4) { const int kt = half * 4 + t4;
        if (kt < ntile) {
#pragma unroll
            for (int s = 0; s < 2; ++s) {
                bf16x8v pf; { unsigned w0 = pg8::cvt_pk_bf16(st[t4][8 * s + 0], st[t4][8 * s + 1]), w1 = pg8::cvt_pk_bf16(st[t4][8 * s + 2], st[t4][8 * s + 3]), w2 = pg8::cvt_pk_bf16(st[t4][8 * s + 4], st[t4][8 * s + 5]), w3 = pg8::cvt_pk_bf16(st[t4][8 * s + 6], st[t4][8 * s + 7]);
                    v4u w = {w0, w1, w2, w3}; pf = __builtin_bit_cast(bf16x8v, w); }
#pragma unroll
                for (int d = 0; d < 2; ++d) {
                    const LAS unsigned char* vp = vs + (32 * d + r32) * IT_VROW + (32 * kt + 16 * s + 4 * hi) * 2;
                    const s16x4v lo = *(const LAS s16x4v*)vp, hi4 = *(const LAS s16x4v*)(vp + 16);
                    const bf16x8v va = {lo[0], lo[1], lo[2], lo[3], hi4[0], hi4[1], hi4[2], hi4[3]};
                    o[d] = __builtin_amdgcn_mfma_f32_32x32x16_bf16(va, pf, o[d], 0, 0, 0);
                }
                asm volatile("" ::: "memory");
            }
        }
    }
}
__device__ __forceinline__ void moba_items_phase(LAS unsigned char* lds, int vcu, int G, int tid_in, int wave, int lane, const bf16* Q, const bf16* K, const bf16* VT, const unsigned* CNT, const unsigned* LIST,
                                                 const float* BIAST, bf16* PO0, bf16* PO1, bf16* PO2, bf16* PO3, float* PML) {
    const int r32 = lane & 31, hi = lane >> 5; int tid = tid_in;
    LAS unsigned char* ks = lds + IT_KS; LAS unsigned char* vs = lds + IT_VS; LAS float* tball = (LAS float*)(lds + IT_TB); volatile LAS int* info = (volatile LAS int*)(lds + IT_INFO);
    __syncthreads();
    for (int e = tid; e < 8 * 128; e += 512) tball[e] = BIAST[e] * 1.4426950408889634f;
    if (wave == 0) {
        int loc[16]; int s = 0;
#pragma unroll
        for (int e = 0; e < 16; ++e) { const int n = (int)CNT[16 * lane + e]; loc[e] = 1 + ((n + 255) >> 8); s += loc[e]; }
        int incl = s;
#pragma unroll
        for (int o = 1; o < 64; o <<= 1) { const int t = __shfl_up(incl, o); if (lane >= o) incl += t; }
        const int excl = incl - s, total = __shfl(incl, 63);
        const int c0 = (int)(((long)vcu * total) / G), c1 = (int)(((long)(vcu + 1) * total) / G);
        if (c0 >= excl && c0 < incl) { int acc = excl; bool done = false;
#pragma unroll
            for (int e = 0; e < 16; ++e) { if (!done && c0 < acc + loc[e]) { info[0] = 16 * lane + e; info[1] = c0 - acc; done = true; } acc += loc[e]; } }
        if (lane == 0) info[2] = c1 - c0;
    }
    __syncthreads();
    int li = __builtin_amdgcn_readfirstlane(info[0]), k = __builtin_amdgcn_readfirstlane(info[1]); const int nchunk = __builtin_amdgcn_readfirstlane(info[2]);
    int loaded = -1;
    for (int c = 0; c < nchunk; ++c) {
        const int b = li >> 8, h = (li >> 5) & 7, j = li & 31; const int n = __builtin_amdgcn_readfirstlane((int)CNT[li]);
        if (li != loaded) {
            __syncthreads();
            asm volatile("" : "+v"(tid));
#pragma unroll
            for (int r = 0; r < 4; ++r) { const int idx = tid + 512 * r, key = idx >> 3, ch = idx & 7;
                const v4u w = *(const v4u*)(K + (size_t)(b * SEQ + j * MBB + key) * MBW + h * MBD + ch * 8);
                *(LAS v4u*)(ks + key * 128 + ((ch ^ ((key >> 1) & 7)) * 16)) = w; }
#pragma unroll
            for (int r = 0; r < 4; ++r) { const int idx = tid + 512 * r, d = idx >> 5, ch = idx & 31;
                const v4u w = *(const v4u*)(VT + (size_t)(h * MBD + d) * M + b * SEQ + j * MBB + ch * 8);
                LAS v2u* dst = (LAS v2u*)(vs + d * IT_VROW + ch * 16); dst[0] = (v2u){w.x, w.y}; dst[1] = (v2u){w.z, w.w}; }
            __syncthreads();
            loaded = li;
        }
        const bool own = (k == 0); const int item = own ? wave : (k - 1) * 8 + wave; const int start = item * 32;
        if (own || start < n) {
            int tl, rank;
            if (own) { tl = j * MBB + start + r32; rank = 3; }
            else { int idx = start + r32; if (idx >= n) idx = n - 1; const unsigned e = LIST[moba_list_base(b * 8 + h, j) + idx]; tl = (int)(e & 8191u); rank = (int)(e >> 13); }
            const bool valid = own || (start + r32 < n);
            const int qin = tl & 255, bd = (tl >> 8) - j, dq = bd * 256 + qin;
            const bool general = own || (__ballot(bd == 1 && qin < 112) != 0ull);
            const int ntile = own ? (wave + 1) : 8;
            const LAS float* tb = tball + h * 128;
            const float c1 = 0.125f * 1.4426950408889634f, c0 = tb[113];
            bf16x8v qf[4];
            { const bf16* qp = Q + (size_t)(b * SEQ + tl) * MBW + h * MBD + 8 * hi;
#pragma unroll
              for (int s = 0; s < 4; ++s) qf[s] = *(const bf16x8v*)(qp + 16 * s); }
            float mrun = -INFINITY, lrun = 0.f; f32x16 o[2];
#pragma unroll
            for (int d = 0; d < 2; ++d)
#pragma unroll
                for (int r = 0; r < 16; ++r) o[d][r] = 0.f;
#pragma unroll
            for (int half = 0; half < 2; ++half) {
                if (half * 4 < ntile) {
                    f32x16 st[4];
#pragma unroll
                    for (int t4 = 0; t4 < 4; ++t4) { const int kt = half * 4 + t4;
#pragma unroll
                        for (int r = 0; r < 16; ++r) st[t4][r] = 0.f;
                        if (kt < ntile) { const int key = 32 * kt + r32;
#pragma unroll
                            for (int s = 0; s < 4; ++s) { const bf16x8v ka = *(const LAS bf16x8v*)(ks + key * 128 + (((2 * s + hi) ^ ((key >> 1) & 7)) * 16));
                                st[t4] = __builtin_amdgcn_mfma_f32_32x32x16_bf16(ka, qf[s], st[t4], 0, 0, 0); } }
                        asm volatile("" ::: "memory");
                    }
                    if (general) moba_item_half<true>(st, half, ntile, hi, dq, c1, c0, tb, mrun, lrun, o, vs, r32);
                    else         moba_item_half<false>(st, half, ntile, hi, dq, c1, c0, tb, mrun, lrun, o, vs, r32);
                }
            }
            if (valid) {
                const size_t pair = (size_t)(b * SEQ + tl) * 8 + h; const float linv = 1.0f / lrun;
                bf16* po = (rank == 0 ? PO0 : rank == 1 ? PO1 : rank == 2 ? PO2 : PO3) + pair * 64;
#pragma unroll
                for (int d = 0; d < 2; ++d)
#pragma unroll
                    for (int g4 = 0; g4 < 4; ++g4) { v2u w; w.x = pg8::cvt_pk_bf16(o[d][4 * g4] * linv, o[d][4 * g4 + 1] * linv); w.y = pg8::cvt_pk_bf16(o[d][4 * g4 + 2] * linv, o[d][4 * g4 + 3] * linv);
                        *(v2u*)(po + 32 * d + 8 * g4 + 4 * hi) = w; }
                if (hi == 0) { float* pm = PML + ((size_t)rank * (M * 8) + pair) * 2; pm[0] = mrun; pm[1] = lrun; }
            }
        }
        if (k + 1 < 1 + ((n + 255) >> 8)) ++k; else { ++li; k = 0; }
    }
    __syncthreads();
}
__device__ __forceinline__ void moba_combine_phase(int gtid, int gthreads, const bf16* PO0, const bf16* PO1, const bf16* PO2, const bf16* PO3, const float* PML, bf16* OA) {
    for (int idx = gtid; idx < M * 8 * 8; idx += gthreads) {
        const int pair = idx >> 3, c8 = idx & 7, m = pair >> 3, own = (m & (SEQ - 1)) >> 8, nv = own < 3 ? own : 3;
        float mm[4], ll[4];
#pragma unroll
        for (int r = 0; r < 4; ++r) { const bool v = (r == 3) || (r < nv); const float* pm = PML + ((size_t)r * (M * 8) + pair) * 2; mm[r] = v ? pm[0] : -INFINITY; ll[r] = v ? pm[1] : 0.f; }
        const float mx = fmaxf(fmaxf(mm[0], mm[1]), fmaxf(mm[2], mm[3]));
        float w[4], ws = 0.f;
#pragma unroll
        for (int r = 0; r < 4; ++r) { w[r] = ll[r] * __builtin_amdgcn_exp2f(mm[r] - mx); ws += w[r]; }
        const float inv = 1.0f / ws; float acc[8];
#pragma unroll
        for (int e = 0; e < 8; ++e) acc[e] = 0.f;
#pragma unroll
        for (int r = 0; r < 4; ++r) { const bool v = (r == 3) || (r < nv);
            if (v) { const bf16* po = (r == 0 ? PO0 : r == 1 ? PO1 : r == 2 ? PO2 : PO3) + (size_t)pair * 64 + c8 * 8; const v4u x = *(const v4u*)po; const float wr = w[r] * inv;
                acc[0] += wr * bflo(x.x); acc[1] += wr * bfhi(x.x); acc[2] += wr * bflo(x.y); acc[3] += wr * bfhi(x.y); acc[4] += wr * bflo(x.z); acc[5] += wr * bfhi(x.z); acc[6] += wr * bflo(x.w); acc[7] += wr * bfhi(x.w); } }
        v4u o; o.x = pk2(acc[0], acc[1]); o.y = pk2(acc[2], acc[3]); o.z = pk2(acc[4], acc[5]); o.w = pk2(acc[6], acc[7]);
        *(v4u*)(OA + (size_t)pair * 64 + c8 * 8) = o;
    }
}
constexpr int HL_QN = 0, HL_KN = 8704, HL_KT = 17408, HL_VT = 27648, HL_SB = 37888, HL_GT = 72704, HL_DD = 74752, HL_EM = 75264, HL_SSQ = 75776, HL_END = 76288;
constexpr int HL_QP = 272, HL_TP = 80;
__device__ __forceinline__ float bf1(bf16 x) { return __uint_as_float((unsigned)x << 16); }
template <int STEP> __device__ __forceinline__ void hgrn_mfma_phase(LAS unsigned char* lds, int vcu, int G, int tid, int wave, int lane, const bf16* KIN, const bf16* HI, const bf16* HQ, const bf16* HG, const float* hgw, float* HS, float* HGD, bf16* OB) {
    const int r32 = lane & 31, hi = lane >> 5, ch = tid & 127, tg = __builtin_amdgcn_readfirstlane(tid >> 7);
    LAS float* gt = (LAS float*)(lds + HL_GT); LAS float* dd = (LAS float*)(lds + HL_DD); LAS float* em = (LAS float*)(lds + HL_EM); LAS float* ssq = (LAS float*)(lds + HL_SSQ);
    for (int unit = vcu; unit < BATCH * HGH * HGNC; unit += G) {
        const int c = unit & 31, bh = unit >> 5, b = bh >> 2, h = bh & 3, m0 = b * SEQ + c * HGC;
        f32x16 S[4]; float Dk = 1.f;
        const int skt = (STEP == 1) ? (wave >> 1) : (wave - 4), svt0 = (STEP == 1) ? 2 * (wave & 1) : 0; constexpr int NST = (STEP == 1) ? 2 : 4;
#pragma unroll
        for (int i = 0; i < 4; ++i)
#pragma unroll
            for (int r = 0; r < 16; ++r) S[i][r] = 0.f;
        if (STEP == 3 && wave >= 4) {
#pragma unroll
            for (int i = 0; i < 4; ++i)
#pragma unroll
                for (int r = 0; r < 16; ++r) S[i][r] = HS[(size_t)unit * 16384 + (32 * skt + crow16(r, hi)) * 128 + 32 * (svt0 + i) + r32];
        }
        for (int slab = 0; slab < 8; ++slab) {
            const int ms = m0 + slab * 32;
            float kin[8], qq[8]; unsigned short vv[8];
#pragma unroll
            for (int e = 0; e < 8; ++e) { const size_t idx = (size_t)(ms + tg * 8 + e) * HGW + h * HGD_ + ch; kin[e] = bf1(KIN[idx]); vv[e] = HI[idx]; qq[e] = (STEP == 3) ? bf1(HQ[idx]) : 0.f; }
            float cs[8]; float run = 0.f;
#pragma unroll
            for (int e = 0; e < 8; ++e) { run += __builtin_amdgcn_logf(fmaxf(1.0f - kin[e], 5.9604645e-8f)); cs[e] = run; }
            gt[tg * 128 + ch] = run;
            __syncthreads();
            const float g0 = gt[ch], g1 = gt[128 + ch], g2 = gt[256 + ch], g3 = gt[384 + ch];
            const float bmid = g0 + g1, bend = bmid + g2 + g3, pre = (tg == 0) ? 0.f : (tg == 1) ? g0 : (tg == 2) ? bmid : bmid + g2;
            { float kh[8];
#pragma unroll
              for (int e = 0; e < 8; ++e) kh[e] = kin[e] * __builtin_amdgcn_exp2f(bend - (pre + cs[e]));
              v4u w; w.x = pg8::cvt_pk_bf16(kh[0], kh[1]); w.y = pg8::cvt_pk_bf16(kh[2], kh[3]); w.z = pg8::cvt_pk_bf16(kh[4], kh[5]); w.w = pg8::cvt_pk_bf16(kh[6], kh[7]);
              *(LAS v4u*)(lds + HL_KT + ch * HL_TP + tg * 16) = w;
              v4u x; x.x = (unsigned)vv[0] | ((unsigned)vv[1] << 16); x.y = (unsigned)vv[2] | ((unsigned)vv[3] << 16); x.z = (unsigned)vv[4] | ((unsigned)vv[5] << 16); x.w = (unsigned)vv[6] | ((unsigned)vv[7] << 16);
              *(LAS v4u*)(lds + HL_VT + ch * HL_TP + tg * 16) = x; }
            if (STEP == 3) {
#pragma unroll
                for (int e = 0; e < 8; ++e) { const float bs = pre + cs[e]; const int tok = tg * 8 + e;
                    const float kt_ = kin[e] * __builtin_amdgcn_exp2f(fminf(bmid - bs, 100.f)), qt_ = qq[e] * __builtin_amdgcn_exp2f(fminf(bs - bmid, 100.f));
                    *(LAS unsigned short*)(lds + HL_KN + tok * HL_QP + ch * 2) = (unsigned short)f2bf(kt_);
                    *(LAS unsigned short*)(lds + HL_QN + tok * HL_QP + ch * 2) = (unsigned short)f2bf(qt_); }
            }
            if (tg == 0) { const float de = __builtin_amdgcn_exp2f(bend); dd[ch] = de; em[ch] = __builtin_amdgcn_exp2f(bmid); Dk *= de; }
            __syncthreads();
            if (STEP == 3) {
                if (wave >= 4) {
#pragma unroll
                    for (int i = 0; i < 4; ++i)
#pragma unroll
                        for (int g4 = 0; g4 < 4; ++g4) { const int k0 = 32 * skt + 8 * g4 + 4 * hi; const f32x4 e4 = *(const LAS f32x4*)(em + k0);
                            v2u w; w.x = pg8::cvt_pk_bf16(S[i][4 * g4] * e4.x, S[i][4 * g4 + 1] * e4.y); w.y = pg8::cvt_pk_bf16(S[i][4 * g4 + 2] * e4.z, S[i][4 * g4 + 3] * e4.w);
                            *(LAS v2u*)(lds + HL_SB + (32 * (svt0 + i) + r32) * HL_QP + k0 * 2) = w; }
                }
                __syncthreads();
            }
            f32x16 O;
            if (STEP == 3 && wave < 4) {
                const int vt = wave;
                bf16x8v qf[8]; f32x16 X;
#pragma unroll
                for (int r = 0; r < 16; ++r) { X[r] = 0.f; O[r] = 0.f; }
#pragma unroll
                for (int ks = 0; ks < 8; ++ks) { qf[ks] = *(const LAS bf16x8v*)(lds + HL_QN + r32 * HL_QP + (16 * ks + 8 * hi) * 2);
                    const bf16x8v kf = *(const LAS bf16x8v*)(lds + HL_KN + r32 * HL_QP + (16 * ks + 8 * hi) * 2);
                    X = __builtin_amdgcn_mfma_f32_32x32x16_bf16(kf, qf[ks], X, 0, 0, 0); }
#pragma unroll
                for (int r = 0; r < 16; ++r) if (crow16(r, hi) > r32) X[r] = 0.f;
#pragma unroll
                for (int k2 = 0; k2 < 2; ++k2) {
                    v4u w; w.x = pg8::cvt_pk_bf16(X[8 * k2 + 0], X[8 * k2 + 1]); w.y = pg8::cvt_pk_bf16(X[8 * k2 + 2], X[8 * k2 + 3]); w.z = pg8::cvt_pk_bf16(X[8 * k2 + 4], X[8 * k2 + 5]); w.w = pg8::cvt_pk_bf16(X[8 * k2 + 6], X[8 * k2 + 7]);
                    const bf16x8v xf = __builtin_bit_cast(bf16x8v, w);
                    const LAS unsigned char* vp = lds + HL_VT + (32 * vt + r32) * HL_TP + (16 * k2 + 4 * hi) * 2;
                    const s16x4v lo = *(const LAS s16x4v*)vp, hi4 = *(const LAS s16x4v*)(vp + 16);
                    const bf16x8v va = {lo[0], lo[1], lo[2], lo[3], hi4[0], hi4[1], hi4[2], hi4[3]};
                    O = __builtin_amdgcn_mfma_f32_32x32x16_bf16(va, xf, O, 0, 0, 0); }
#pragma unroll
                for (int ks = 0; ks < 8; ++ks) { const bf16x8v sa = *(const LAS bf16x8v*)(lds + HL_SB + (32 * vt + r32) * HL_QP + (16 * ks + 8 * hi) * 2);
                    O = __builtin_amdgcn_mfma_f32_32x32x16_bf16(sa, qf[ks], O, 0, 0, 0); }
                float sq = 0.f;
#pragma unroll
                for (int r = 0; r < 16; ++r) sq += O[r] * O[r];
                sq += __shfl_xor(sq, 32);
                if (hi == 0) ssq[vt * 32 + r32] = sq;
            }
            if (STEP == 1 || wave >= 4) {
#pragma unroll
                for (int i = 0; i < NST; ++i) {
#pragma unroll
                    for (int g4 = 0; g4 < 4; ++g4) { const f32x4 d4 = *(const LAS f32x4*)(dd + 32 * skt + 8 * g4 + 4 * hi);
                        S[i][4 * g4] *= d4.x; S[i][4 * g4 + 1] *= d4.y; S[i][4 * g4 + 2] *= d4.z; S[i][4 * g4 + 3] *= d4.w; }
#pragma unroll
                    for (int k2 = 0; k2 < 2; ++k2) { const bf16x8v ka = *(const LAS bf16x8v*)(lds + HL_KT + (32 * skt + r32) * HL_TP + (16 * k2 + 8 * hi) * 2);
                        const bf16x8v vb = *(const LAS bf16x8v*)(lds + HL_VT + (32 * (svt0 + i) + r32) * HL_TP + (16 * k2 + 8 * hi) * 2);
                        S[i] = __builtin_amdgcn_mfma_f32_32x32x16_bf16(ka, vb, S[i], 0, 0, 0); }
                }
            }
            __syncthreads();
            if (STEP == 3 && wave < 4) {
                const int vt = wave; const float tot = ssq[r32] + ssq[32 + r32] + ssq[64 + r32] + ssq[96 + r32];
                const float rstd = 1.f / sqrtf(tot * (1.f / 128.f) + EPS); const size_t mrow = (size_t)(ms + r32) * HGW + h * HGD_;
#pragma unroll
                for (int g4 = 0; g4 < 4; ++g4) { const int v0 = 32 * vt + 8 * g4 + 4 * hi; const f32x4 w4 = *(const f32x4*)(hgw + v0); const v2u gg = *(const v2u*)(HG + mrow + v0);
                    v2u o; o.x = pg8::cvt_pk_bf16(O[4 * g4] * rstd * w4.x * bflo(gg.x), O[4 * g4 + 1] * rstd * w4.y * bfhi(gg.x)); o.y = pg8::cvt_pk_bf16(O[4 * g4 + 2] * rstd * w4.z * bflo(gg.y), O[4 * g4 + 3] * rstd * w4.w * bfhi(gg.y));
                    *(v2u*)(OB + mrow + v0) = o; }
            }
        }
        if (STEP == 1) {
#pragma unroll
            for (int i = 0; i < 2; ++i)
#pragma unroll
                for (int r = 0; r < 16; ++r) HS[(size_t)unit * 16384 + (32 * skt + crow16(r, hi)) * 128 + 32 * (svt0 + i) + r32] = S[i][r];
            if (tid < 128) HGD[unit * 128 + tid] = Dk;
        }
    }
    __syncthreads();
}
__device__ __forceinline__ void hgrn_scan_phase(int gtid, int gthreads, float* HS, const float* HGD) {
    for (int idx = gtid; idx < BATCH * HGH * 16384; idx += gthreads) {
        const int bh = idx >> 14, e = idx & 16383, k = e >> 7; float s = 0.f;
        float tmp[HGNC];
#pragma unroll
        for (int c = 0; c < HGNC; ++c) tmp[c] = HS[(size_t)(bh * HGNC + c) * 16384 + e];
#pragma unroll
        for (int c = 0; c < HGNC; ++c) { HS[(size_t)(bh * HGNC + c) * 16384 + e] = s; s = HGD[(bh * HGNC + c) * 128 + k] * s + tmp[c]; }
    }
}
#ifndef REP_MASK
#define REP_MASK 0u
#endif
struct Args { const float* in[16]; float* out; unsigned char* ws; unsigned mask, rep; };
__global__ void __launch_bounds__(NWAVES * 64, 2) mk_fwd(Args args) {
    extern __shared__ __attribute__((aligned(16))) unsigned char lds_raw[];
    LAS unsigned char* lds = (LAS unsigned char*)lds_raw;
    volatile LAS unsigned* MISC = (volatile LAS unsigned*)(lds + MISC_OFF);
    const int G = gridDim.x, bx = blockIdx.x;
    unsigned char* ws = args.ws;
    gu32* ctl = (gu32*)(ws + WS_CTL);
    for (int u = threadIdx.x; u < (LDS_BYTES - LDSCTL_OFF) / 4; u += NWAVES * 64) ((LAS unsigned*)(lds + LDSCTL_OFF))[u] = 0u;
    __syncthreads();
    XcdBarrier bar = xcd_barrier_post((unsigned*)(ctl + CW_BAR), MISC + 8);
#define GRID_BAR() xcd_barrier(bar)
#define PH(k) for (int rep_ = ((args.mask >> (k)) & 1u) + ((args.rep >> (k)) & 1u); rep_ > 0; --rep_)
#define COORDS() int tid = threadIdx.x; asm volatile("" : "+v"(tid)); const int lane = tid & 63, wave = __builtin_amdgcn_readfirstlane(tid >> 6); \
    const int vcu = (G % 8 == 0) ? (bx % 8) * (G / 8) + bx / 8 : bx; const int gw = vcu * NWAVES + wave, NGW = G * NWAVES; (void)lane; (void)gw; (void)NGW; (void)vcu
#define MKP() Ptrs P; P.x = args.in[0]; P.p = args.in[1]; P.w_gu1 = args.in[2]; P.w_d1 = args.in[3]; P.w_in = args.in[4]; P.w_a = args.in[5]; P.w_b = args.in[6]; P.w_out = args.in[7]; \
    P.w_gu2 = args.in[8]; P.w_d2 = args.in[9]; P.w_ple = args.in[10]; P.w_pg = args.in[11]; P.gains = args.in[12]; P.hgw = args.in[13]; P.lbp = args.in[14]; P.rel = args.in[15]; P.out = args.out; P.ws = args.ws
#define XN ((bf16*)(ws + WS_C))
#define Hb ((bf16*)(ws + WS_A))
#define Fb ((bf16*)(ws + WS_B))
#define Yb ((bf16*)(ws + WS_A))
#define HBS ((bf16*)args.out)
#define Qb ((bf16*)(ws + WS_Q))
#define Kb ((bf16*)(ws + WS_K))
#define VTb ((bf16*)(ws + WS_VT))
#define HQb ((bf16*)(ws + WS_HQ))
#define HIb ((bf16*)(ws + WS_HI))
#define KINb ((bf16*)(ws + WS_KIN))
#define HGb ((bf16*)(ws + WS_HG))
#define SAb ((bf16*)(ws + WS_SA))
#define SBb ((bf16*)(ws + WS_SB))
#define OAb ((bf16*)(ws + WS_OA))
#define OBb ((bf16*)(ws + WS_OB))
#define PBb ((bf16*)(ws + WS_PB))
#define Eb ((bf16*)(ws + WS_A))
#define KMEAN ((float*)(ws + WS_KMEAN))
#define LBt ((float*)(ws + WS_LB))
#define BIAST ((float*)(ws + WS_BIAST))
#define HS ((float*)(ws + WS_HS))
#define HGD ((float*)(ws + WS_HGD))
#define CNTb ((unsigned*)(ws + WS_CNT))
#define LISTb ((unsigned*)(ws + WS_LIST))
#define PO0b ((bf16*)(ws + WS_PO0))
#define PO1b ((bf16*)(ws + WS_PO1))
#define PO2b ((bf16*)(ws + WS_PO2))
#define PO3b ((bf16*)(ws + WS_PO3))
#define PMLb ((float*)(ws + WS_PML))

    PH(0) { COORDS(); MKP(); p0_prologue(P, lds, gw, NGW, wave, lane); }
    GRID_BAR();
    PH(1) { pg8::Gemm g{XN, (const bf16*)(ws + WS_WGU1), M, NGU, D}; pg8::StaticOrder S; S.init(M, NGU, G, bx); pg8::EpiGU E{Hb, FF};
      pg8::gemm_phase<pg8::EpiGU, pg8::StaticOrder, PG8_ALIGN, PG8_SP2>(lds + RING_OFF, g, S, E); }
    GRID_BAR();
    PH(2) { pg8::Gemm g{Hb, (const bf16*)(ws + WS_WD1), M, D, FF}; pg8::StaticOrder S; S.init(M, D, G, bx); pg8::EpiMix<0> E{Fb, nullptr, D};
      pg8::gemm_phase<pg8::EpiMix<0>, pg8::StaticOrder, PG8_ALIGN, PG8_SP2>(lds + RING_OFF, g, S, E); }
    GRID_BAR();
    PH(3) { COORDS(); rowwise_phase<true, 1>(gw, NGW, lane, args.in[0], Fb, args.in[12] + 1 * D, 0.5f, HBS, XN, nullptr); }
    GRID_BAR();
    PH(4) { pg8::Gemm g{XN, (const bf16*)(ws + WS_WIN), M, NIN - 512, D}; pg8::StaticOrder S; S.init(M, NIN - 512, G, bx); pg8::EpiIN E{Qb, Kb, HQb, KINb, HIb, HGb, SAb, SBb, LBt, KMEAN};
      pg8::gemm_phase<pg8::EpiIN, pg8::StaticOrder, PG8_ALIGN, PG8_SP2>(lds + RING_OFF, g, S, E); }
    PH(4) { pg8::Gemm g{(const bf16*)(ws + WS_WIN) + (size_t)(NIN - 512) * D, XN, 512, M, D}; pg8::StaticOrder S; S.init(512, M, G, bx); pg8::EpiMix<0> E{VTb, nullptr, M};
      pg8::gemm_phase<pg8::EpiMix<0>, pg8::StaticOrder, PG8_ALIGN, PG8_SP2>(lds + RING_OFF, g, S, E); }
    GRID_BAR();
    PH(5) { COORDS(); moba_gating_phase(lds, vcu, G, tid, Qb, KMEAN, CNTb, LISTb); }
    PH(18) { COORDS(); hgrn_mfma_phase<1>(lds, vcu, G, tid, wave, lane, KINb, HIb, HQb, HGb, args.in[13], HS, HGD, OBb); }
    GRID_BAR();
    PH(6) { COORDS(); hgrn_scan_phase(vcu * NWAVES * 64 + tid, G * NWAVES * 64, HS, HGD); }
    GRID_BAR();
    PH(7) { COORDS(); hgrn_mfma_phase<3>(lds, vcu, G, tid, wave, lane, KINb, HIb, HQb, HGb, args.in[13], HS, HGD, OBb); }
    GRID_BAR();
    PH(16) { COORDS(); moba_items_phase(lds, vcu, G, tid, wave, lane, Qb, Kb, VTb, CNTb, LISTb, BIAST, PO0b, PO1b, PO2b, PO3b, PMLb); }
    GRID_BAR();
    PH(17) { COORDS(); moba_combine_phase(vcu * NWAVES * 64 + tid, G * NWAVES * 64, PO0b, PO1b, PO2b, PO3b, PMLb, OAb); }
    GRID_BAR();
    PH(8) { pg8::Gemm g{OAb, (const bf16*)(ws + WS_WA), M, D, 512}; pg8::StaticOrder S; S.init(M, D, G, bx); pg8::EpiMix<1> E{SAb, nullptr, D};
      pg8::gemm_phase<pg8::EpiMix<1>, pg8::StaticOrder, PG8_ALIGN, PG8_SP2>(lds + RING_OFF, g, S, E); }
    PH(8) { pg8::Gemm g{OBb, (const bf16*)(ws + WS_WB), M, D, 512}; pg8::StaticOrder S; S.init(M, D, G, bx); pg8::EpiMix<2> E{SAb, SBb, D};
      pg8::gemm_phase<pg8::EpiMix<2>, pg8::StaticOrder, PG8_ALIGN, PG8_SP2>(lds + RING_OFF, g, S, E); }
    GRID_BAR();
    PH(9) { pg8::Gemm g{SAb, (const bf16*)(ws + WS_WOUT), M, D, D}; pg8::StaticOrder S; S.init(M, D, G, bx); pg8::EpiMix<0> E{Yb, nullptr, D};
      pg8::gemm_phase<pg8::EpiMix<0>, pg8::StaticOrder, PG8_ALIGN, PG8_SP2>(lds + RING_OFF, g, S, E); }
    GRID_BAR();
    PH(10) { COORDS(); rowwise_phase<false, 1>(gw, NGW, lane, HBS, Yb, args.in[12] + 3 * D, 1.0f, HBS, XN, nullptr); }
    GRID_BAR();
    PH(11) { pg8::Gemm g{XN, (const bf16*)(ws + WS_WGU2), M, NGU, D}; pg8::StaticOrder S; S.init(M, NGU, G, bx); pg8::EpiGU E{Hb, FF};
      pg8::gemm_phase<pg8::EpiGU, pg8::StaticOrder, PG8_ALIGN, PG8_SP2>(lds + RING_OFF, g, S, E); }
    GRID_BAR();
    PH(12) { pg8::Gemm g{Hb, (const bf16*)(ws + WS_WD2), M, D, FF}; pg8::StaticOrder S; S.init(M, D, G, bx); pg8::EpiMix<0> E{Fb, nullptr, D};
      pg8::gemm_phase<pg8::EpiMix<0>, pg8::StaticOrder, PG8_ALIGN, PG8_SP2>(lds + RING_OFF, g, S, E); }
    GRID_BAR();
    PH(13) { COORDS(); rowwise_phase<false, 2>(gw, NGW, lane, HBS, Fb, args.in[12] + 5 * D, 0.5f, nullptr, XN, nullptr);
        const float* pp = args.in[1];
        for (int i = gw * 64 + lane; i < M * PLE / 8; i += NGW * 64) { const f32x4 a = ((const f32x4*)pp)[2 * i], b = ((const f32x4*)pp)[2 * i + 1];
            v4u o; o.x = pk2(a.x, a.y); o.y = pk2(a.z, a.w); o.z = pk2(b.x, b.y); o.w = pk2(b.z, b.w); ((v4u*)PBb)[i] = o; } }
    GRID_BAR();
    PH(14) { pg8::Gemm g{PBb, (const bf16*)(ws + WS_WPLE), M, D, PLE}; pg8::StaticOrder S; S.init(M, D, G, bx); pg8::EpiMix<0> E{Eb, nullptr, D};
      pg8::gemm_phase<pg8::EpiMix<0>, pg8::StaticOrder, PG8_ALIGN, PG8_SP2>(lds + RING_OFF, g, S, E); }
    PH(14) { pg8::Gemm g{XN, (const bf16*)(ws + WS_WPG), M, D, D}; pg8::StaticOrder S; S.init(M, D, G, bx); pg8::EpiPleB E{Eb, Fb, D};
      pg8::gemm_phase<pg8::EpiPleB, pg8::StaticOrder, PG8_ALIGN, PG8_SP2>(lds + RING_OFF, g, S, E); }
    GRID_BAR();
    PH(15) { COORDS(); rowwise_phase<false, 3>(gw, NGW, lane, XN, Fb, args.in[12] + 6 * D, 1.0f, nullptr, nullptr, args.out); }
}

extern "C" void kernel_launch(void* const* d_in, const int* in_sizes, int n_in, void* d_out, int out_size, void* d_ws, size_t ws_size, hipStream_t stream) {
    static int grid = 0;
    if (grid == 0) {
        if (n_in != 16 || in_sizes[0] != M * D || out_size != M * D || ws_size < WS_END) { fprintf(stderr, "kernel_launch: unexpected shapes: n_in %d in0 %d out %d ws %zu; nothing launched\n", n_in, n_in > 0 ? in_sizes[0] : -1, out_size, ws_size); grid = -1; return; }
        int dev = 0, cus = 0;
        if (hipGetDevice(&dev) != hipSuccess || hipDeviceGetAttribute(&cus, hipDeviceAttributeMultiprocessorCount, dev) != hipSuccess) { fprintf(stderr, "kernel_launch: device query failed\n"); grid = -1; return; }
        if (hipFuncSetAttribute((const void*)mk_fwd, hipFuncAttributeMaxDynamicSharedMemorySize, LDS_BYTES) != hipSuccess) { fprintf(stderr, "kernel_launch: hipFuncSetAttribute failed\n"); grid = -1; return; }
        int per_cu = 0;
        if (hipOccupancyMaxActiveBlocksPerMultiprocessor(&per_cu, (const void*)mk_fwd, NWAVES * 64, LDS_BYTES) != hipSuccess || per_cu < 1) fprintf(stderr, "kernel_launch: note: occupancy query reports %d\n", per_cu);
        (void)hipGetLastError();
        grid = cus;
    }
    if (grid < 0) return;
    if (hipMemsetAsync((char*)d_ws + WS_CTL, 0, CTL_ZERO_BYTES, stream) != hipSuccess) { fprintf(stderr, "kernel_launch: memset failed\n"); return; }
    Args a{};
    for (int i = 0; i < 16; ++i) a.in[i] = (const float*)d_in[i];
    a.out = (float*)d_out; a.ws = (unsigned char*)d_ws; a.mask = 0xffffffffu; a.rep = REP_MASK;
    hipLaunchKernelGGL(mk_fwd, dim3(grid), dim3(NWAVES * 64), LDS_BYTES, stream, a);
    const hipError_t le = hipPeekAtLastError();
    if (le != hipSuccess) fprintf(stderr, "kernel_launch: launch failed: %s\n", hipGetErrorName(le));
}
```

```cpp
#include <hip/hip_runtime.h>
#include <cstdio>
#include <cstdint>
namespace pg8 {
#define PG8_LAS __attribute__((address_space(3)))
typedef unsigned short bf16_t;
typedef short bf16x8 __attribute__((ext_vector_type(8)));
typedef float f32x4 __attribute__((ext_vector_type(4)));
typedef unsigned u32x4 __attribute__((ext_vector_type(4)));
constexpr int BM = 256, BK = 64, HALF = 128, HTB = HALF * BK * 2  , STAGE_BYTES = 8 * HTB, NXCD = 8, WGM = 8;

__host__ __device__ __forceinline__ int lds_byte(int r, int c) { const int st = (r >> 4) * 2 + (c >> 5), rr = r & 15, cc = c & 31, ob = rr * 64 + cc * 2; return st * 1024 + (ob ^ (((ob >> 9) & 1) << 5)); }
__host__ __device__ __forceinline__ void stage_rc(int b, int& R, int& C) { const int st = b / 1024, sb = b % 1024, swz = sb ^ (((sb >> 9) & 1) << 5); R = (st >> 1) * 16 + swz / 64; C = (st & 1) * 32 + (swz % 64) / 2; }
__host__ __device__ __forceinline__ int perm32(int rho) { const int n = rho >> 4, i = rho & 15; return 8 * (i >> 2) + 4 * n + (i & 3); }

struct Unit { int pm, pn; };
struct Gemm { const bf16_t* A; const bf16_t* Bt; int M, N, K; };

struct StaticOrder {
    int nM, nN, nwg, G, c;
    __host__ __device__ void init(int M, int N, int G_, int c_) { nM = M / BM; nN = N / BM; nwg = nM * nN; G = G_; c = c_; }
    __host__ __device__ bool next(int i, Unit& u) const {
        const long L = (long)i * G + c; if (L >= nwg) return false;
        int wgid = (int)L; { const int q = nwg / NXCD, r = nwg % NXCD, xcd = wgid % NXCD, off = wgid / NXCD; wgid = (xcd < r ? xcd * (q + 1) : r * (q + 1) + (xcd - r) * q) + off; }
        const int nig = WGM * nN, gid = wgid / nig, fm = gid * WGM, gsz = (nM - fm) < WGM ? (nM - fm) : WGM;
        u.pm = fm + ((wgid % nig) % gsz); u.pn = (wgid % nig) / gsz; return true;
    }
    __device__ __forceinline__ void a_ready(const Unit&) const {}
    __device__ __forceinline__ void done(const Unit&) const {}
};

typedef float f32x2_t __attribute__((ext_vector_type(2))); typedef __bf16 bf16x2_t __attribute__((ext_vector_type(2)));
__device__ __forceinline__ unsigned cvt_pk_bf16(float lo, float hi) { f32x2_t v = {lo, hi}; bf16x2_t b = __builtin_convertvector(v, bf16x2_t); return __builtin_bit_cast(unsigned, b); }
__device__ __forceinline__ float sigm(float x) { return __builtin_amdgcn_rcpf(1.0f + __builtin_amdgcn_exp2f(-1.4426950408889634f * x)); }
__device__ __forceinline__ float bf_lo(unsigned w) { return __uint_as_float(w << 16); }
__device__ __forceinline__ float bf_hi(unsigned w) { return __uint_as_float(w & 0xffff0000u); }
__device__ __forceinline__ void unpack8(const u32x4 w, float (&o)[8]) { o[0] = bf_lo(w.x); o[1] = bf_hi(w.x); o[2] = bf_lo(w.y); o[3] = bf_hi(w.y); o[4] = bf_lo(w.z); o[5] = bf_hi(w.z); o[6] = bf_lo(w.w); o[7] = bf_hi(w.w); }
__device__ __forceinline__ u32x4 pack8(const float (&o)[8]) { u32x4 w; w.x = cvt_pk_bf16(o[0], o[1]); w.y = cvt_pk_bf16(o[2], o[3]); w.z = cvt_pk_bf16(o[4], o[5]); w.w = cvt_pk_bf16(o[6], o[7]); return w; }

struct EpiGU {
    static constexpr bool PERM = true, AFTER_DRAIN = false;
    bf16_t* H; int ldh;
    __device__ __forceinline__ void operator()(const f32x4 (&acc)[2][2][4][2], const Unit& u, int wr, int wc, int fr, int fq) const {
        const int row0 = u.pm * BM + wr * 64 + fr, col0 = u.pn * HALF + wc * 32 + 8 * fq;
#pragma unroll
        for (int ai = 0; ai < 2; ++ai)
#pragma unroll
            for (int m = 0; m < 4; ++m) { bf16_t* rowp = H + (size_t)(row0 + ai * HALF + m * 16) * ldh + col0;
                const f32x4 g0 = acc[ai][0][m][0], g1 = acc[ai][0][m][1], u0 = acc[ai][1][m][0], u1 = acc[ai][1][m][1]; float o[8];
#pragma unroll
                for (int j = 0; j < 4; ++j) { o[j] = g0[j] * sigm(g0[j]) * u0[j]; o[4 + j] = g1[j] * sigm(g1[j]) * u1[j]; }
                *(u32x4*)rowp = pack8(o); }
    }
};
struct EpiF32 {
    static constexpr bool PERM = false, AFTER_DRAIN = false;
    float* C; int ldc;
    __device__ __forceinline__ void operator()(const f32x4 (&acc)[2][2][4][2], const Unit& u, int wr, int wc, int fr, int fq) const {
        const int row0 = u.pm * BM + wr * 64 + fr, col0 = u.pn * BM + wc * 32 + 4 * fq;
#pragma unroll
        for (int ai = 0; ai < 2; ++ai)
#pragma unroll
            for (int m = 0; m < 4; ++m) { float* rowp = C + (size_t)(row0 + ai * HALF + m * 16) * ldc + col0;
#pragma unroll
                for (int bj = 0; bj < 2; ++bj)
#pragma unroll
                    for (int n = 0; n < 2; ++n) *(f32x4*)(rowp + bj * HALF + n * 16) = acc[ai][bj][m][n]; }
    }
};
struct EpiIN {
    static constexpr bool PERM = true, AFTER_DRAIN = false;
    bf16_t *Q, *K, *HQ, *KIN, *HI, *HG, *SA, *SB; const float* LB; float* KMEAN;
    template <int MODE> __device__ __forceinline__ void body(const f32x4 (&acc)[2][2][4][2], bf16_t* base, int ldc, int row0, int cbase, int pm, int fr) const {
        float lbv[2][8]; float ks[2][8];
#pragma unroll
        for (int bj = 0; bj < 2; ++bj)
#pragma unroll
            for (int j = 0; j < 8; ++j) { lbv[bj][j] = (MODE == 2) ? (1.0f - LB[cbase + bj * HALF + j]) : 0.f; ks[bj][j] = 0.f; }
#pragma unroll
        for (int ai = 0; ai < 2; ++ai)
#pragma unroll
            for (int m = 0; m < 4; ++m) { bf16_t* rowp = base + (size_t)(row0 + ai * HALF + m * 16) * ldc + cbase;
#pragma unroll
                for (int bj = 0; bj < 2; ++bj) { const f32x4 v0 = acc[ai][bj][m][0], v1 = acc[ai][bj][m][1]; float o[8];
#pragma unroll
                    for (int j = 0; j < 4; ++j) { o[j] = v0[j]; o[4 + j] = v1[j]; }
#pragma unroll
                    for (int j = 0; j < 8; ++j) {
                        if (MODE == 1) o[j] = o[j] * sigm(o[j]);
                        if (MODE == 2) o[j] = lbv[bj][j] * sigm(-o[j]);
                        if (MODE == 3) o[j] = sigm(o[j]);
                        if (MODE == 4) ks[bj][j] += o[j]; }
                    *(u32x4*)(rowp + bj * HALF) = pack8(o); } }
        if (MODE == 4) {
#pragma unroll
            for (int bj = 0; bj < 2; ++bj)
#pragma unroll
                for (int j = 0; j < 8; ++j) { float s = ks[bj][j]; s += __shfl_xor(s, 1); s += __shfl_xor(s, 2); s += __shfl_xor(s, 4); s += __shfl_xor(s, 8);
                    if (fr == 0) atomicAdd(KMEAN + (size_t)pm * 512 + cbase + bj * HALF + j, s); }
        }
    }
    __device__ __forceinline__ void operator()(const f32x4 (&acc)[2][2][4][2], const Unit& u, int wr, int wc, int fr, int fq) const {
        const int pn = u.pn, row0 = u.pm * BM + wr * 64 + fr, cw = wc * 32 + 8 * fq;
        if (pn < 2)       body<0>(acc, Q,   512,  row0, (pn)      * BM + cw, u.pm, fr);
        else if (pn < 4)  body<4>(acc, K,   512,  row0, (pn - 2)  * BM + cw, u.pm, fr);
        else if (pn < 6)  body<1>(acc, HQ,  512,  row0, (pn - 4)  * BM + cw, u.pm, fr);
        else if (pn < 8)  body<2>(acc, KIN, 512,  row0, (pn - 6)  * BM + cw, u.pm, fr);
        else if (pn < 10) body<0>(acc, HI,  512,  row0, (pn - 8)  * BM + cw, u.pm, fr);
        else if (pn < 12) body<1>(acc, HG,  512,  row0, (pn - 10) * BM + cw, u.pm, fr);
        else if (pn < 16) body<3>(acc, SA,  1024, row0, (pn - 12) * BM + cw, u.pm, fr);
        else              body<3>(acc, SB,  1024, row0, (pn - 16) * BM + cw, u.pm, fr);
    }
};
template <int MODE> struct EpiMix {
    static constexpr bool PERM = true, AFTER_DRAIN = false;
    bf16_t* T; const bf16_t* S2; int ldc;
    __device__ __forceinline__ void operator()(const f32x4 (&acc)[2][2][4][2], const Unit& u, int wr, int wc, int fr, int fq) const {
        const int row0 = u.pm * BM + wr * 64 + fr, col0 = u.pn * BM + wc * 32 + 8 * fq;
#pragma unroll
        for (int ai = 0; ai < 2; ++ai)
#pragma unroll
            for (int m = 0; m < 4; ++m) { const size_t off = (size_t)(row0 + ai * HALF + m * 16) * ldc + col0;
#pragma unroll
                for (int bj = 0; bj < 2; ++bj) { const f32x4 v0 = acc[ai][bj][m][0], v1 = acc[ai][bj][m][1]; float o[8];
#pragma unroll
                    for (int j = 0; j < 4; ++j) { o[j] = v0[j]; o[4 + j] = v1[j]; }
                    if (MODE == 1) { float t[8]; unpack8(*(const u32x4*)(T + off + bj * HALF), t);
#pragma unroll
                        for (int j = 0; j < 8; ++j) o[j] = t[j] * o[j]; }
                    if (MODE == 2) { float t[8], s[8]; unpack8(*(const u32x4*)(T + off + bj * HALF), t); unpack8(*(const u32x4*)(S2 + off + bj * HALF), s);
#pragma unroll
                        for (int j = 0; j < 8; ++j) o[j] = t[j] + s[j] * o[j]; }
                    *(u32x4*)(T + off + bj * HALF) = pack8(o); } }
    }
};
struct EpiPleB {
    static constexpr bool PERM = true, AFTER_DRAIN = false;
    const bf16_t* E; bf16_t* Y; int ldc;
    __device__ __forceinline__ void operator()(const f32x4 (&acc)[2][2][4][2], const Unit& u, int wr, int wc, int fr, int fq) const {
        const int row0 = u.pm * BM + wr * 64 + fr, col0 = u.pn * BM + wc * 32 + 8 * fq;
#pragma unroll
        for (int ai = 0; ai < 2; ++ai)
#pragma unroll
            for (int m = 0; m < 4; ++m) { const size_t off = (size_t)(row0 + ai * HALF + m * 16) * ldc + col0;
#pragma unroll
                for (int bj = 0; bj < 2; ++bj) { const f32x4 v0 = acc[ai][bj][m][0], v1 = acc[ai][bj][m][1]; float e[8], o[8]; unpack8(*(const u32x4*)(E + off + bj * HALF), e);
#pragma unroll
                    for (int j = 0; j < 4; ++j) { o[j] = sigm(v0[j]) * e[j]; o[4 + j] = sigm(v1[j]) * e[4 + j]; }
                    *(u32x4*)(Y + off + bj * HALF) = pack8(o); } }
    }
};

template <class Epi, class Sched, bool ALIGN_EPI = false, bool SP2 = false>
__device__ __forceinline__ void gemm_phase(PG8_LAS unsigned char* lds, const Gemm g, const Sched& S, const Epi& E) {
    int tid_ = threadIdx.x; asm volatile("" : "+v"(tid_));
    const int tid = tid_, wid = __builtin_amdgcn_readfirstlane(tid >> 6), lane = tid & 63, wr = wid >> 2, wc = wid & 3, fr = lane & 15, fq = lane >> 4;
    int K_ = g.K; asm volatile("" : "+s"(K_));
    const int K = K_, nt = K / BK;
    unsigned voffA[2], voffB[2];
#pragma unroll
    for (int i = 0; i < 2; ++i) { int R, C; stage_rc(tid * 16 + i * 8192, R, C); const int Rb = Epi::PERM ? ((R & ~31) + perm32(R & 31)) : R;
        voffA[i] = (unsigned)(R * K + C) * 2u; voffB[i] = (unsigned)(Rb * K + C) * 2u; }
    const size_t kstep = (size_t)(BK * 2);
    const size_t hstep = (size_t)HALF * K * 2;
    const size_t tstep = 2 * hstep;
    const unsigned ldsw = (unsigned)wid * 1024u;
    const int aoff = lds_byte(wr * 64 + fr, fq * 8), boff = lds_byte(wc * 32 + fr, fq * 8);
#define PG8_SA(b, h) (((b) * 2 + (h)) * HTB)
#define PG8_SB(b, h) ((4 + (b) * 2 + (h)) * HTB)
#define PG8_STAGE(bufoff, gbase, voff) do { _Pragma("unroll") for (int _i = 0; _i < 2; ++_i) \
        __builtin_amdgcn_global_load_lds((const unsigned*)((const char*)(gbase) + (voff)[_i]), (PG8_LAS unsigned*)(lds + (bufoff) + ldsw + _i * 8192), 16, 0, 0); } while (0)
#define PG8_LDA(dst, b, h) do { _Pragma("unroll") for (int m = 0; m < 4; ++m) _Pragma("unroll") for (int k = 0; k < 2; ++k) dst[m][k] = *(const PG8_LAS bf16x8*)(lds + PG8_SA(b, h) + aoff + m * 2048 + k * 1024); } while (0)
#define PG8_LDB(dst, b, h) do { _Pragma("unroll") for (int n = 0; n < 2; ++n) _Pragma("unroll") for (int k = 0; k < 2; ++k) dst[n][k] = *(const PG8_LAS bf16x8*)(lds + PG8_SB(b, h) + boff + n * 2048 + k * 1024); } while (0)
#define PG8_MMA(ai, bj, At, Bt) do { __builtin_amdgcn_s_setprio(1); _Pragma("unroll") for (int m = 0; m < 4; ++m) _Pragma("unroll") for (int n = 0; n < 2; ++n) _Pragma("unroll") for (int k = 0; k < 2; ++k) \
        acc[ai][bj][m][n] = __builtin_amdgcn_mfma_f32_16x16x32_bf16(Bt[n][k], At[m][k], acc[ai][bj][m][n], 0, 0, 0); __builtin_amdgcn_s_setprio(0); } while (0)
#define PG8_WAIT_V(n) asm volatile("s_waitcnt vmcnt(" #n ")" ::: "memory")
#define PG8_WAIT_L(n) asm volatile("s_waitcnt lgkmcnt(" #n ")" ::: "memory")
#define PG8_BAR __builtin_amdgcn_s_barrier()
#define PG8_SCHED __builtin_amdgcn_sched_barrier(0)
    Unit cur, nxt; int ui = 0;
    if (!S.next(0, cur)) return;
    f32x4 acc[2][2][4][2];
#pragma unroll
    for (int a = 0; a < 2; ++a)
#pragma unroll
        for (int b = 0; b < 2; ++b)
#pragma unroll
            for (int m = 0; m < 4; ++m)
#pragma unroll
                for (int n = 0; n < 2; ++n) acc[a][b][m][n] = (f32x4){0.f, 0.f, 0.f, 0.f};
    bf16x8 At[4][2], B0[2][2], B1[2][2];
    const char* cA = (const char*)g.A + (size_t)cur.pm * tstep; const char* cB = (const char*)g.Bt + (size_t)cur.pn * tstep;
    S.a_ready(cur);
    if constexpr (SP2) {
        PG8_STAGE(PG8_SB(0, 0), cB, voffB); PG8_STAGE(PG8_SB(0, 1), cB + hstep, voffB); PG8_STAGE(PG8_SA(0, 0), cA, voffA); PG8_STAGE(PG8_SA(0, 1), cA + hstep, voffA);
        if (wr == 1) PG8_BAR;
        PG8_WAIT_V(2); PG8_BAR;
        PG8_STAGE(PG8_SB(1, 0), cB + kstep, voffB); PG8_STAGE(PG8_SA(1, 0), cA + kstep, voffA); PG8_STAGE(PG8_SB(1, 1), cB + hstep + kstep, voffB);
        PG8_WAIT_V(6); PG8_BAR;
    } else {
        PG8_STAGE(PG8_SB(0, 0), cB, voffB); PG8_STAGE(PG8_SA(0, 0), cA, voffA); PG8_STAGE(PG8_SB(0, 1), cB + hstep, voffB); PG8_STAGE(PG8_SA(0, 1), cA + hstep, voffA);
        if (wr == 1) PG8_BAR;
        PG8_WAIT_V(4); PG8_BAR;
        PG8_STAGE(PG8_SB(1, 0), cB + kstep, voffB); PG8_STAGE(PG8_SA(1, 0), cA + kstep, voffA); PG8_STAGE(PG8_SB(1, 1), cB + hstep + kstep, voffB);
        PG8_WAIT_V(6); PG8_BAR;
    }
    for (;;) {
        const bool has_next = S.next(ui + 1, nxt);
        const char* nA = has_next ? (const char*)g.A + (size_t)nxt.pm * tstep : cA; const char* nB = has_next ? (const char*)g.Bt + (size_t)nxt.pn * tstep : cB;
        for (int t = 0; t < nt; t += 2) {
            const bool last = (t == nt - 2);
            const char* a1 = cA + (size_t)(t + 1) * kstep;
            const char* a2 = last ? nA : cA + (size_t)(t + 2) * kstep; const char* b2 = last ? nB : cB + (size_t)(t + 2) * kstep;
            const char* a3 = a2 + kstep; const char* b3 = b2 + kstep;
            if (last && has_next) S.a_ready(nxt);
            if constexpr (SP2) {
            PG8_LDB(B0, 0, 0); PG8_LDB(B1, 0, 1); PG8_SCHED; PG8_LDA(At, 0, 0); PG8_STAGE(PG8_SA(1, 1), a1 + hstep, voffA);
            PG8_WAIT_V(8); PG8_WAIT_L(0); PG8_BAR; PG8_MMA(0, 0, At, B0); PG8_MMA(0, 1, At, B1); PG8_BAR; PG8_SCHED;
            PG8_LDA(At, 0, 1); PG8_STAGE(PG8_SB(0, 0), b2, voffB); PG8_STAGE(PG8_SB(0, 1), b2 + hstep, voffB); PG8_STAGE(PG8_SA(0, 0), a2, voffA);
            PG8_WAIT_V(8); PG8_WAIT_L(0); PG8_BAR; PG8_MMA(1, 0, At, B0); PG8_MMA(1, 1, At, B1); PG8_BAR; PG8_SCHED;
            PG8_LDB(B0, 1, 0); PG8_LDB(B1, 1, 1); PG8_SCHED; PG8_LDA(At, 1, 0); PG8_STAGE(PG8_SA(0, 1), a2 + hstep, voffA);
            PG8_WAIT_V(8); PG8_WAIT_L(0); PG8_BAR; PG8_MMA(0, 0, At, B0); PG8_MMA(0, 1, At, B1); PG8_BAR; PG8_SCHED;
            PG8_LDA(At, 1, 1); PG8_STAGE(PG8_SB(1, 0), b3, voffB); PG8_STAGE(PG8_SB(1, 1), b3 + hstep, voffB); PG8_STAGE(PG8_SA(1, 0), a3, voffA);
            PG8_WAIT_V(8); PG8_WAIT_L(0); PG8_BAR; PG8_MMA(1, 0, At, B0); PG8_MMA(1, 1, At, B1); PG8_BAR; PG8_SCHED;
            } else {
            PG8_LDB(B0, 0, 0); PG8_SCHED; PG8_LDA(At, 0, 0); PG8_STAGE(PG8_SA(1, 1), a1 + hstep, voffA);
            PG8_WAIT_L(8); PG8_BAR; PG8_WAIT_L(0); PG8_MMA(0, 0, At, B0); PG8_BAR; PG8_SCHED;
            PG8_LDB(B1, 0, 1); PG8_STAGE(PG8_SB(0, 0), b2, voffB);
            PG8_BAR; PG8_WAIT_L(0); PG8_MMA(0, 1, At, B1); PG8_BAR;
            PG8_LDA(At, 0, 1); PG8_STAGE(PG8_SA(0, 0), a2, voffA);
            PG8_BAR; PG8_WAIT_L(0); PG8_MMA(1, 0, At, B0); PG8_BAR; PG8_SCHED;
            PG8_STAGE(PG8_SB(0, 1), b2 + hstep, voffB);
            PG8_WAIT_V(6); PG8_BAR; PG8_MMA(1, 1, At, B1); PG8_BAR;
            PG8_LDB(B0, 1, 0); PG8_SCHED; PG8_LDA(At, 1, 0); PG8_STAGE(PG8_SA(0, 1), a2 + hstep, voffA);
            PG8_WAIT_L(8); PG8_BAR; PG8_WAIT_L(0); PG8_MMA(0, 0, At, B0); PG8_BAR; PG8_SCHED;
            PG8_LDB(B1, 1, 1); PG8_STAGE(PG8_SB(1, 0), b3, voffB);
            PG8_BAR; PG8_WAIT_L(0); PG8_MMA(0, 1, At, B1); PG8_BAR;
            PG8_LDA(At, 1, 1); PG8_STAGE(PG8_SA(1, 0), a3, voffA);
            PG8_BAR; PG8_WAIT_L(0); PG8_MMA(1, 0, At, B0); PG8_BAR; PG8_SCHED;
            PG8_STAGE(PG8_SB(1, 1), b3 + hstep, voffB);
            PG8_WAIT_V(6); PG8_BAR; PG8_MMA(1, 1, At, B1); PG8_BAR;
            }
        }
        if constexpr (ALIGN_EPI) { if (wr == 0) PG8_BAR; }
        if constexpr (!Epi::AFTER_DRAIN) { E(acc, cur, wr, wc, fr, fq); S.done(cur); }
        if (!has_next) break;
#pragma unroll
        for (int a = 0; a < 2; ++a)
#pragma unroll
            for (int b = 0; b < 2; ++b)
#pragma unroll
                for (int m = 0; m < 4; ++m)
#pragma unroll
                    for (int n = 0; n < 2; ++n) acc[a][b][m][n] = (f32x4){0.f, 0.f, 0.f, 0.f};
        cur = nxt; cA = nA; cB = nB; ++ui;
        if constexpr (ALIGN_EPI) { if (wr == 1) PG8_BAR; }
    }
    PG8_WAIT_V(0);
    if constexpr (!ALIGN_EPI) { if (wr == 0) PG8_BAR; }
    PG8_BAR;
    if constexpr (Epi::AFTER_DRAIN) { E.fused(acc, cur, wr, wc, fr, fq, lds, wid, lane); S.done(cur); }
#undef PG8_SA
#undef PG8_SB
#undef PG8_STAGE
#undef PG8_LDA
#undef PG8_LDB
#undef PG8_MMA
#undef PG8_WAIT_V
#undef PG8_WAIT_L
#undef PG8_BAR
#undef PG8_SCHED
}
}
#ifndef PG8_SP2
#define PG8_SP2 true
#endif
#ifndef PG8_ALIGN
#define PG8_ALIGN true
#endif
constexpr int NWAVES = 8;
constexpr int BATCH = 4, SEQ = 8192, D = 1024, FF = 2816, NGU = 2 * FF, NIN = 5632, PLE = 256;
constexpr int M = BATCH * SEQ;
constexpr int MBH = 8, MBD = 64, MBW = 512, MBB = 256, NBLK = SEQ / MBB;
constexpr int HGH = 4, HGD_ = 128, HGW = 512, HGC = 256, HGNC = SEQ / HGC;
constexpr float EPS = 1e-6f;
constexpr size_t MiB = 1u << 20;
constexpr size_t WS_CTL = 0, CTL_ZERO_BYTES = 1 * MiB;
constexpr size_t WS_KMEAN = 512 * 1024;
constexpr size_t WS_LB = 768 * 1024, WS_BIAST = 772 * 1024;
constexpr size_t WS_WGU1 = 1 * MiB, WS_WD1 = 12 * MiB, WS_WIN = WS_WD1 + 5632 * 1024, WS_WA = WS_WIN + 11 * MiB, WS_WB = WS_WA + 1 * MiB, WS_WOUT = WS_WB + 1 * MiB,
                 WS_WGU2 = WS_WOUT + 2 * MiB, WS_WD2 = WS_WGU2 + 11 * MiB, WS_WPLE = WS_WD2 + 5632 * 1024, WS_WPG = WS_WPLE + 512 * 1024, WS_HGD = WS_WPG + 2 * MiB;
constexpr size_t WS_CNT = 256 * 1024;
constexpr size_t WS_A = 52 * MiB;
constexpr size_t WS_Q = WS_A, WS_K = WS_A + 32 * MiB, WS_VT = WS_A + 64 * MiB, WS_HQ = WS_A + 96 * MiB, WS_HI = WS_A + 128 * MiB;
constexpr size_t WS_LIST = 212 * MiB;
constexpr size_t WS_PB = 228 * MiB;
constexpr size_t WS_SB = 228 * MiB;
constexpr size_t WS_PML = 292 * MiB;
constexpr size_t WS_B = 320 * MiB;
constexpr size_t WS_KIN = WS_B, WS_HG = WS_B + 32 * MiB, WS_SA = WS_B + 64 * MiB;
constexpr size_t WS_C = 448 * MiB;
constexpr size_t WS_HS = WS_C, WS_OA = WS_C, WS_OB = WS_C + 32 * MiB;
constexpr size_t WS_PO0 = WS_HQ, WS_PO1 = WS_HI, WS_PO2 = WS_KIN, WS_PO3 = WS_HG;
constexpr size_t WS_END = 512 * MiB;
static_assert(WS_HGD + 256 * 1024 <= WS_A, "weights region");
constexpr int LIST_PER_BH = 126976;
constexpr int CW_TMO = 0, CW_CODE = 1, CW_BAR = 4096;
constexpr int RING_OFF = 0, RING_BYTES = 131072, LDSCTL_OFF = RING_BYTES, MISC_OFF = LDSCTL_OFF + 320, LDS_BYTES = 147456;
#define GAS __attribute__((address_space(1)))
#define LAS __attribute__((address_space(3)))
typedef unsigned short bf16;
typedef unsigned v4u __attribute__((ext_vector_type(4)));
typedef unsigned v2u __attribute__((ext_vector_type(2)));
typedef float f32x4 __attribute__((ext_vector_type(4)));
typedef GAS unsigned gu32;
#define RLX_AGENT __ATOMIC_RELAXED, __HIP_MEMORY_SCOPE_AGENT
#define LDS_WAIT() asm volatile("s_waitcnt lgkmcnt(0)" ::: "memory")
#define VM_WAIT() asm volatile("s_waitcnt vmcnt(0)" ::: "memory")
__device__ __forceinline__ unsigned f2bf(float f) { unsigned u = __builtin_bit_cast(unsigned, f); return (u + 0x7fffu + ((u >> 16) & 1u)) >> 16; }
__device__ __forceinline__ unsigned pk2(float lo, float hi) { return f2bf(lo) | (f2bf(hi) << 16); }
__device__ __forceinline__ float bflo(unsigned w) { return __uint_as_float(w << 16); }
__device__ __forceinline__ float bfhi(unsigned w) { return __uint_as_float(w & 0xffff0000u); }
__device__ __forceinline__ float wave_sum(float v) {
#pragma unroll
    for (int o = 1; o < 64; o <<= 1) v += __shfl_xor(v, o);
    return v;
}
__device__ __forceinline__ float wave_max(float v) {
#pragma unroll
    for (int o = 1; o < 64; o <<= 1) v = fmaxf(v, __shfl_xor(v, o));
    return v;
}
#define XB_TMO      128
#define XB_XCNT(j)  (256  + 64 * (j))
#define XB_XSUB(j)  (1280 + 64 * (j))
#define XB_XGEN(j)  (2304 + 64 * (j))
#define XB_TOP      3328
#define XB_TOPGEN   3392
#define XCD_BAR_WORDS 3456
#define XB_SPIN_CAP (1u << 18)

__device__ __forceinline__ unsigned xb_ld(unsigned* p)              { return __hip_atomic_load(p, __ATOMIC_RELAXED, __HIP_MEMORY_SCOPE_AGENT); }
__device__ __forceinline__ unsigned xb_add(unsigned* p, unsigned v) { return __hip_atomic_fetch_add(p, v, __ATOMIC_RELAXED, __HIP_MEMORY_SCOPE_AGENT); }
__device__ __forceinline__ unsigned xb_xcc_id() { return (unsigned)__builtin_amdgcn_s_getreg((3 << 11) | 20) & 0xFu; }
#define XB_SPIN(cond, bar) do { unsigned _sp = 0; while (cond) { __builtin_amdgcn_s_sleep(1); \
    if ((++_sp & 255u) == 0u) { if (xb_ld(&(bar)[XB_TMO])) break; if (_sp > XB_SPIN_CAP) { atomicAdd(&(bar)[XB_TMO], 1u); break; } } } } while (0)

struct XcdBarrier {
    unsigned* bar; unsigned x;
    volatile LAS unsigned* st;
};

__device__ __forceinline__ XcdBarrier xcd_barrier_post(unsigned* bar, volatile LAS unsigned* st) {
    XcdBarrier b; b.bar = bar; b.x = xb_xcc_id(); b.st = st;
    if (threadIdx.x == 0) (void)xb_add(&bar[XB_XCNT(b.x)], 1u);
    return b;
}
__device__ __forceinline__ void xcd_barrier_complete(unsigned* bar, unsigned x, unsigned& nloc, unsigned& nx) {
    const unsigned G = gridDim.x * gridDim.y * gridDim.z;
    unsigned sum, cnt, mine, sp = 0u;
    for (;;) {
        sum = 0u; cnt = 0u; mine = 0u;
#pragma unroll
        for (unsigned j = 0; j < 16; ++j) { const unsigned c = xb_ld(&bar[XB_XCNT(j)]); sum += c; cnt += (c > 0u) ? 1u : 0u; mine = (j == x) ? c : mine; }
        if (sum == G) break;
        __builtin_amdgcn_s_sleep(1);
        if ((++sp & 255u) == 0u) { if (xb_ld(&bar[XB_TMO])) break; if (sp > XB_SPIN_CAP) { atomicAdd(&bar[XB_TMO], 1u); break; } }
    }
    nloc = mine > 0u ? mine : 1u; nx = cnt > 0u ? cnt : 1u;
}

__device__ __forceinline__ void xcd_barrier(const XcdBarrier& b) {
    asm volatile("s_waitcnt vmcnt(0)" ::: "memory");
    __syncthreads();
    if (threadIdx.x == 0) {
        unsigned* bar = b.bar;
        __builtin_amdgcn_s_waitcnt(0);
        unsigned nloc = b.st[0], nx = b.st[1];
        if (nloc == 0u) { xcd_barrier_complete(bar, b.x, nloc, nx); b.st[0] = nloc; b.st[1] = nx; }
        const unsigned old = xb_add(&bar[XB_XSUB(b.x)], 1u);
        const unsigned gen = old / nloc;
        if (old + 1u == (gen + 1u) * nloc) {
            __builtin_amdgcn_fence(__ATOMIC_RELEASE, "agent");
            asm volatile("s_waitcnt vmcnt(0)" ::: "memory");
            const unsigned og = xb_add(&bar[XB_TOP], 1u);
            const unsigned tg = og / nx;
            if (og + 1u == (tg + 1u) * nx) xb_add(&bar[XB_TOPGEN], 1u);
            else XB_SPIN(xb_ld(&bar[XB_TOPGEN]) == tg, bar);
            __builtin_amdgcn_fence(__ATOMIC_ACQUIRE, "agent");
            xb_add(&bar[XB_XGEN(b.x)], 1u);
            asm volatile("s_waitcnt vmcnt(0)" ::: "memory");
        } else {
            XB_SPIN(xb_ld(&bar[XB_XGEN(b.x)]) == gen, bar);
            __builtin_amdgcn_fence(__ATOMIC_ACQUIRE, "agent");
            asm volatile("s_waitcnt vmcnt(0)" ::: "memory");
        }
    }
    __syncthreads();
}
__device__ __forceinline__ void p0_transpose_item(const float* W, int K, int N, bf16* WT, const float* gain, int mode, LAS float* scr, int item, int lane) {
    const int nblk = N / 32, kb = item / nblk, nb = item % nblk, k0 = 64 * kb, n0 = 32 * nb;
#pragma unroll 8
    for (int i = 0; i < 32; ++i) { const int kk = 2 * i + (lane >> 5); float w = W[(size_t)(k0 + kk) * N + n0 + (lane & 31)]; if (gain) w *= gain[k0 + kk]; scr[kk * 33 + (lane & 31)] = w; }
    LDS_WAIT(); asm volatile("" ::: "memory");
    int rbase = n0;
    if (mode == 1) { if (n0 < FF) rbase = (n0 / 128) * 256 + (n0 % 128); else { const int j = n0 - FF; rbase = (j / 128) * 256 + 128 + (j % 128); } }
    if (mode == 2) { if (n0 >= 1024 && n0 < 1536) rbase = 5120 + (n0 - 1024); else if (n0 >= 1536) rbase = n0 - 512; }
    const int c = lane & 7;
#pragma unroll
    for (int j = 0; j < 4; ++j) { const int n = (lane >> 3) + 8 * j; const LAS float* s = scr + (8 * c) * 33 + n;
        v4u o; o.x = pk2(s[0 * 33], s[1 * 33]); o.y = pk2(s[2 * 33], s[3 * 33]); o.z = pk2(s[4 * 33], s[5 * 33]); o.w = pk2(s[6 * 33], s[7 * 33]);
        *(GAS v4u*)(WT + (size_t)(rbase + n) * K + k0 + 8 * c) = o; }
    LDS_WAIT(); asm volatile("" ::: "memory");
}
__device__ __forceinline__ void rms_row_to_bf16(const float* xrow, bf16* orow, int lane) {
    const GAS f32x4* xr = (const GAS f32x4*)xrow + lane;
    f32x4 v[4]; float s = 0.f;
#pragma unroll
    for (int j = 0; j < 4; ++j) { v[j] = xr[64 * j]; s += (v[j].x * v[j].x + v[j].y * v[j].y) + (v[j].z * v[j].z + v[j].w * v[j].w); }
    const float rstd = 1.f / sqrtf(wave_sum(s) * (1.f / D) + EPS);
    GAS unsigned long long* o8 = (GAS unsigned long long*)orow + lane;
#pragma unroll
    for (int j = 0; j < 4; ++j) o8[64 * j] = (unsigned long long)pk2(v[j].x * rstd, v[j].y * rstd) | ((unsigned long long)pk2(v[j].z * rstd, v[j].w * rstd) << 32);
}
struct Ptrs {
    const float *x, *p, *w_gu1, *w_d1, *w_in, *w_a, *w_b, *w_out, *w_gu2, *w_d2, *w_ple, *w_pg, *gains, *hgw, *lbp, *rel;
    float* out; unsigned char* ws;
};
__device__ __forceinline__ void p0_prologue(const Ptrs P, LAS unsigned char* lds, int gw, int NGW, int wave, int lane) {
    LAS float* scr = (LAS float*)(lds + RING_OFF + wave * 16384);
    unsigned char* ws = P.ws;
    constexpr int I_GU = (D / 64) * (NGU / 32), I_D = (FF / 64) * (D / 32), I_IN = (D / 64) * (NIN / 32), I_AB = (512 / 64) * (D / 32), I_O = (D / 64) * (D / 32), I_PLE = (PLE / 64) * (D / 32);
    constexpr int NITEMS = 2 * I_GU + 2 * I_D + I_IN + 2 * I_AB + 2 * I_O + I_PLE;
    for (int it = gw; it < NITEMS; it += NGW) {
        int r = it;
        if (r < I_GU) { p0_transpose_item(P.w_gu1, D, NGU, (bf16*)(ws + WS_WGU1), P.gains + 0 * D, 1, scr, r, lane); continue; } r -= I_GU;
        if (r < I_GU) { p0_transpose_item(P.w_gu2, D, NGU, (bf16*)(ws + WS_WGU2), P.gains + 4 * D, 1, scr, r, lane); continue; } r -= I_GU;
        if (r < I_IN) { p0_transpose_item(P.w_in, D, NIN, (bf16*)(ws + WS_WIN), P.gains + 2 * D, 2, scr, r, lane); continue; } r -= I_IN;
        if (r < I_D)  { p0_transpose_item(P.w_d1, FF, D, (bf16*)(ws + WS_WD1), nullptr, 0, scr, r, lane); continue; } r -= I_D;
        if (r < I_D)  { p0_transpose_item(P.w_d2, FF, D, (bf16*)(ws + WS_WD2), nullptr, 0, scr, r, lane); continue; } r -= I_D;
        if (r < I_AB) { p0_transpose_item(P.w_a, 512, D, (bf16*)(ws + WS_WA), nullptr, 0, scr, r, lane); continue; } r -= I_AB;
        if (r < I_AB) { p0_transpose_item(P.w_b, 512, D, (bf16*)(ws + WS_WB), nullptr, 0, scr, r, lane); continue; } r -= I_AB;
        if (r < I_O)  { p0_transpose_item(P.w_out, D, D, (bf16*)(ws + WS_WOUT), nullptr, 0, scr, r, lane); continue; } r -= I_O;
        if (r < I_O)  { p0_transpose_item(P.w_pg, D, D, (bf16*)(ws + WS_WPG), nullptr, 0, scr, r, lane); continue; } r -= I_O;
        p0_transpose_item(P.w_ple, PLE, D, (bf16*)(ws + WS_WPLE), nullptr, 0, scr, r, lane);
    }
    for (int m = gw; m < M; m += NGW) rms_row_to_bf16(P.x + (size_t)m * D, (bf16*)(ws + WS_C) + (size_t)m * D, lane);
    const int gt = gw * 64 + lane;
    if (gt < 512) { const float a = P.lbp[gt], b = P.lbp[512 + gt]; const float mx = fmaxf(a, b); const float ea = expf(a - mx), eb = expf(b - mx); ((float*)(ws + WS_LB))[gt] = ea / (ea + eb); }
    if (gt >= 1024 && gt < 2048) { const int h = (gt - 1024) >> 7, d = (gt - 1024) & 127; int bk;
        if (d < 16) bk = d; else { bk = 16 + (int)(logf((float)d / 16.0f) / logf(8.0f) * 16.0f); if (bk > 31) bk = 31; }
        ((float*)(ws + WS_BIAST))[h * 128 + d] = P.rel[bk * 8 + h]; }
}
template <bool HIN_F32, int OMODE> __device__ __forceinline__ void rowwise_phase(int gw, int NGW, int lane, const void* hin, const bf16* Y, const float* gain, float coef, bf16* hb, bf16* xn, float* outf) {
    f32x4 g[4];
#pragma unroll
    for (int j = 0; j < 4; ++j) g[j] = ((const f32x4*)gain)[lane + 64 * j] * coef;
    for (int m = gw; m < M; m += NGW) {
        const GAS v2u* yr = (const GAS v2u*)(Y + (size_t)m * D) + lane;
        f32x4 y[4], h[4]; float s = 0.f;
#pragma unroll
        for (int j = 0; j < 4; ++j) { const v2u w = yr[64 * j]; y[j] = (f32x4){bflo(w.x), bfhi(w.x), bflo(w.y), bfhi(w.y)}; s += (y[j].x * y[j].x + y[j].y * y[j].y) + (y[j].z * y[j].z + y[j].w * y[j].w); }
        if (HIN_F32) { const GAS f32x4* hr = (const GAS f32x4*)((const float*)hin + (size_t)m * D) + lane;
#pragma unroll
            for (int j = 0; j < 4; ++j) h[j] = hr[64 * j]; }
        else { const GAS v2u* hr = (const GAS v2u*)((const bf16*)hin + (size_t)m * D) + lane;
#pragma unroll
            for (int j = 0; j < 4; ++j) { const v2u w = hr[64 * j]; h[j] = (f32x4){bflo(w.x), bfhi(w.x), bflo(w.y), bfhi(w.y)}; } }
        const float rstd = 1.f / sqrtf(wave_sum(s) * (1.f / D) + EPS);
        float s2 = 0.f;
#pragma unroll
        for (int j = 0; j < 4; ++j) { h[j] = h[j] + (g[j] * y[j]) * rstd; s2 += (h[j].x * h[j].x + h[j].y * h[j].y) + (h[j].z * h[j].z + h[j].w * h[j].w); }
        if (OMODE == 3) { GAS f32x4* ho = (GAS f32x4*)(outf + (size_t)m * D) + lane;
#pragma unroll
            for (int j = 0; j < 4; ++j) ho[64 * j] = h[j]; }
        if (OMODE == 1) { GAS v2u* ho = (GAS v2u*)(hb + (size_t)m * D) + lane;
#pragma unroll
            for (int j = 0; j < 4; ++j) ho[64 * j] = (v2u){pk2(h[j].x, h[j].y), pk2(h[j].z, h[j].w)}; }
        if (OMODE == 1 || OMODE == 2) {
            float r2 = 1.f;
            if (OMODE == 1) r2 = 1.f / sqrtf(wave_sum(s2) * (1.f / D) + EPS);
            GAS v2u* o8 = (GAS v2u*)(xn + (size_t)m * D) + lane;
#pragma unroll
            for (int j = 0; j < 4; ++j) o8[64 * j] = (v2u){pk2(h[j].x * r2, h[j].y * r2), pk2(h[j].z * r2, h[j].w * r2)};
        }
    }
}
__device__ __forceinline__ int moba_list_base(int bh, int j) { return bh * LIST_PER_BH + 256 * (31 * j - (j * (j - 1)) / 2); }
__device__ __forceinline__ void moba_gating_phase(LAS unsigned char* lds, int vcu, int G, int tid, const bf16* Q, const float* KMEAN, unsigned* CNT, unsigned* LIST) {
    LAS float* km = (LAS float*)lds;
    const int lane = tid & 63;
    for (int unit = vcu; unit < BATCH * NBLK * 4; unit += G) {
        const int hp = unit & 3, i = (unit >> 2) & 31, b = unit >> 7;
        __syncthreads();
        for (int e = tid; e < i * 128; e += 512) { const int j = e >> 7, c = e & 127; km[e] = KMEAN[(size_t)(b * NBLK + j) * 512 + hp * 128 + c] * (1.0f / 256.0f); }
        __syncthreads();
        const int hh = __builtin_amdgcn_readfirstlane(tid >> 8), ql = tid & 255, m = b * SEQ + i * MBB + ql, h = 2 * hp + hh;
        float q[64];
        { const v4u* qp = (const v4u*)(Q + (size_t)m * MBW + h * MBD);
#pragma unroll
          for (int c = 0; c < 8; ++c) { const v4u w = qp[c]; q[8 * c + 0] = bflo(w.x); q[8 * c + 1] = bfhi(w.x); q[8 * c + 2] = bflo(w.y); q[8 * c + 3] = bfhi(w.y); q[8 * c + 4] = bflo(w.z); q[8 * c + 5] = bfhi(w.z); q[8 * c + 6] = bflo(w.w); q[8 * c + 7] = bfhi(w.w); } }
        float v0 = -INFINITY, v1 = -INFINITY, v2 = -INFINITY; int i0 = -1, i1 = -1, i2 = -1;
        for (int j = 0; j < i; ++j) {
            const LAS f32x4* kp = (const LAS f32x4*)(km + j * 128 + hh * 64); float s = 0.f;
#pragma unroll
            for (int c = 0; c < 16; ++c) { const f32x4 kv = kp[c]; s += q[4 * c] * kv.x; s += q[4 * c + 1] * kv.y; s += q[4 * c + 2] * kv.z; s += q[4 * c + 3] * kv.w; }
            if (s > v0) { v2 = v1; i2 = i1; v1 = v0; i1 = i0; v0 = s; i0 = j; }
            else if (s > v1) { v2 = v1; i2 = i1; v1 = s; i1 = j; }
            else if (s > v2) { v2 = s; i2 = j; }
        }
        const int bh = b * 8 + h; const unsigned tl = (unsigned)(i * MBB + ql); const unsigned long long lt = (1ull << lane) - 1ull;
        for (int j = 0; j < i; ++j) {
            const unsigned long long m0 = __ballot(i0 == j), m1 = __ballot(i1 == j), m2 = __ballot(i2 == j);
            const int c0 = __popcll(m0), c1 = __popcll(m1), c2 = __popcll(m2), tot = c0 + c1 + c2;
            if (tot) {
                unsigned base = 0u; if (lane == 0) base = atomicAdd(CNT + bh * 32 + j, (unsigned)tot);
                base = (unsigned)__builtin_amdgcn_readfirstlane((int)base);
                unsigned* L = LIST + moba_list_base(bh, j) + base;
                if (i0 == j) L[__popcll(m0 & lt)] = tl;
                if (i1 == j) L[c0 + __popcll(m1 & lt)] = tl | (1u << 13);
                if (i2 == j) L[c0 + c1 + __popcll(m2 & lt)] = tl | (2u << 13);
            }
        }
    }
    __syncthreads();
}
typedef float f32x16 __attribute__((ext_vector_type(16)));
typedef short bf16x8v __attribute__((ext_vector_type(8)));
typedef short s16x4v __attribute__((ext_vector_type(4)));
constexpr int IT_KS = 0, IT_VS = 32768, IT_VROW = 520, IT_TB = IT_VS + 64 * IT_VROW  , IT_INFO = IT_TB + 8 * 128 * 4  ;
__device__ __forceinline__ int crow16(int r, int hi) { return (r & 3) + 8 * (r >> 2) + 4 * hi; }
template <bool GENERAL, int NT> __device__ __forceinline__ void moba_item_half(f32x16 (&st)[NT], int half, int ntile, int hi, int dq, float c1, float c0, const LAS float* tb,
                                                                      float& mrun, float& lrun, f32x16 (&o)[2], const LAS unsigned char* vs, int r32) {
    float mloc = -INFINITY;
#pragma unroll
    for (int t4 = 0; t4 < NT; ++t4) { const int kt = half * NT + t4;
        if (kt < ntile) {
#pragma unroll
            for (int r = 0; r < 16; ++r) { float x;
                if (GENERAL) { const int dist = dq - (32 * kt + crow16(r, hi)); const int di = dist > 113 ? 113 : (dist < 0 ? 0 : dist); x = st[t4][r] * c1 + tb[di]; if (dist < 0) x = -INFINITY; }
                else x = st[t4][r] * c1 + c0;
                st[t4][r] = x; mloc = fmaxf(mloc, x); }
        }
    }
    mloc = fmaxf(mloc, __shfl_xor(mloc, 32));
    const float mnew = fmaxf(mrun, mloc);
    const float alpha = __builtin_amdgcn_exp2f(mrun - mnew);
    float ls = 0.f;
#pragma unroll
    for (int t4 = 0; t4 < NT; ++t4) { const int kt = half * NT + t4;
        if (kt < ntile) {
#pragma unroll
            for (int r = 0; r < 16; ++r) { const float pv = __builtin_amdgcn_exp2f(st[t4][r] - mnew); st[t4][r] = pv; ls += pv; }
        }
    }
    ls += __shfl_xor(ls, 32);
    lrun = lrun * alpha + ls; mrun = mnew;
#pragma unroll
    for (int d = 0; d < 2; ++d)
#pragma unroll
        for (int r = 0; r < 16; ++r) o[d][r] *= alpha;
#pragma unroll
    for (int t4 = 0; t4 < NT; ++t4) { const int kt = half * NT + t4;
        if (kt < ntile) {
#pragma unroll
            for (int s = 0; s < 2; ++s) {
                bf16x8v pf; { unsigned w0 = pg8::cvt_pk_bf16(st[t4][8 * s + 0], st[t4][8 * s + 1]), w1 = pg8::cvt_pk_bf16(st[t4][8 * s + 2], st[t4][8 * s + 3]), w2 = pg8::cvt_pk_bf16(st[t4][8 * s + 4], st[t4][8 * s + 5]), w3 = pg8::cvt_pk_bf16(st[t4][8 * s + 6], st[t4][8 * s + 7]);
                    v4u w = {w0, w1, w2, w3}; pf = __builtin_bit_cast(bf16x8v, w); }
#pragma unroll
                for (int d = 0; d < 2; ++d) {
                    const LAS unsigned char* vp = vs + (32 * d + r32) * IT_VROW + (32 * kt + 16 * s + 4 * hi) * 2;
                    const s16x4v lo = *(const LAS s16x4v*)vp, hi4 = *(const LAS s16x4v*)(vp + 16);
                    const bf16x8v va = {lo[0], lo[1], lo[2], lo[3], hi4[0], hi4[1], hi4[2], hi4[3]};
                    o[d] = __builtin_amdgcn_mfma_f32_32x32x16_bf16(va, pf, o[d], 0, 0, 0);
                }
                asm volatile("" ::: "memory");
            }
        }
    }
}
__device__ __forceinline__ void moba_items_phase(LAS unsigned char* lds, int vcu, int G, int tid_in, int wave, int lane, const bf16* Q, const bf16* K, const bf16* VT, const unsigned* CNT, const unsigned* LIST,
                                                 const float* BIAST, bf16* PO0, bf16* PO1, bf16* PO2, bf16* PO3, float* PML) {
    const int r32 = lane & 31, hi = lane >> 5; int tid = tid_in;
    LAS unsigned char* ks = lds + IT_KS; LAS unsigned char* vs = lds + IT_VS; LAS float* tball = (LAS float*)(lds + IT_TB); volatile LAS int* info = (volatile LAS int*)(lds + IT_INFO);
    __syncthreads();
    for (int e = tid; e < 8 * 128; e += 512) tball[e] = BIAST[e] * 1.4426950408889634f;
    if (wave == 0) {
        int loc[16]; int s = 0;
#pragma unroll
        for (int e = 0; e < 16; ++e) { const int n = (int)CNT[16 * lane + e]; loc[e] = 1 + ((n + 255) >> 8); s += loc[e]; }
        int incl = s;
#pragma unroll
        for (int o = 1; o < 64; o <<= 1) { const int t = __shfl_up(incl, o); if (lane >= o) incl += t; }
        const int excl = incl - s, total = __shfl(incl, 63);
        const int c0 = (int)(((long)vcu * total) / G), c1 = (int)(((long)(vcu + 1) * total) / G);
        if (c0 >= excl && c0 < incl) { int acc = excl; bool done = false;
#pragma unroll
            for (int e = 0; e < 16; ++e) { if (!done && c0 < acc + loc[e]) { info[0] = 16 * lane + e; info[1] = c0 - acc; done = true; } acc += loc[e]; } }
        if (lane == 0) info[2] = c1 - c0;
    }
    __syncthreads();
    int li = __builtin_amdgcn_readfirstlane(info[0]), k = __builtin_amdgcn_readfirstlane(info[1]); const int nchunk = __builtin_amdgcn_readfirstlane(info[2]);
    int loaded = -1;
    int n_tl = 0, n_rank = 0; bool n_valid = false, n_active = false; bf16x8v n_qf[4];
#define MOBA_FETCH(LI, KK, NN) do { const int b_ = (LI) >> 8, h_ = ((LI) >> 5) & 7, j_ = (LI) & 31; const bool own_ = ((KK) == 0); const int start_ = (own_ ? wave : ((KK) - 1) * 8 + wave) * 32; \
        n_active = own_ || start_ < (NN); n_valid = own_ || (start_ + r32 < (NN)); \
        if (n_active) { if (own_) { n_tl = j_ * MBB + start_ + r32; n_rank = 3; } \
            else { int idx_ = start_ + r32; if (idx_ >= (NN)) idx_ = (NN) - 1; const unsigned e_ = LIST[moba_list_base(b_ * 8 + h_, j_) + idx_]; n_tl = (int)(e_ & 8191u); n_rank = (int)(e_ >> 13); } \
            const bf16* qp_ = Q + (size_t)(b_ * SEQ + n_tl) * MBW + h_ * MBD + 8 * hi; \
            _Pragma("unroll") for (int s_ = 0; s_ < 4; ++s_) n_qf[s_] = *(const bf16x8v*)(qp_ + 16 * s_); } } while (0)
    int n = (nchunk > 0) ? __builtin_amdgcn_readfirstlane((int)CNT[li]) : 0;
    if (nchunk > 0) MOBA_FETCH(li, k, n);
    for (int c = 0; c < nchunk; ++c) {
        const int b = li >> 8, h = (li >> 5) & 7, j = li & 31;
        if (li != loaded) {
            __syncthreads();
            asm volatile("" : "+v"(tid));
#pragma unroll
            for (int r = 0; r < 4; ++r) { const int idx = tid + 512 * r, key = idx >> 3, ch = idx & 7;
                const v4u w = *(const v4u*)(K + (size_t)(b * SEQ + j * MBB + key) * MBW + h * MBD + ch * 8);
                *(LAS v4u*)(ks + key * 128 + ((ch ^ ((key >> 1) & 7)) * 16)) = w; }
#pragma unroll
            for (int r = 0; r < 4; ++r) { const int idx = tid + 512 * r, d = idx >> 5, ch = idx & 31;
                const v4u w = *(const v4u*)(VT + (size_t)(h * MBD + d) * M + b * SEQ + j * MBB + ch * 8);
                LAS v2u* dst = (LAS v2u*)(vs + d * IT_VROW + ch * 16); dst[0] = (v2u){w.x, w.y}; dst[1] = (v2u){w.z, w.w}; }
            __syncthreads();
            loaded = li;
        }
        const int tl = n_tl, rank = n_rank; const bool valid = n_valid, active = n_active, own = (k == 0);
        bf16x8v qf[4];
#pragma unroll
        for (int s = 0; s < 4; ++s) qf[s] = n_qf[s];
        int li2 = li, k2 = k + 1; if (k2 >= 1 + ((n + 255) >> 8)) { ++li2; k2 = 0; }
        int n2 = n;
        if (c + 1 < nchunk) { if (li2 != li) n2 = __builtin_amdgcn_readfirstlane((int)CNT[li2]); MOBA_FETCH(li2, k2, n2); }
        if (active) {
            const int qin = tl & 255, bd = (tl >> 8) - j, dq = bd * 256 + qin;
            const bool general = own || (__ballot(bd == 1 && qin < 112) != 0ull);
            const int ntile = own ? (wave + 1) : 8;
            const LAS float* tb = tball + h * 128;
            const float c1 = 0.125f * 1.4426950408889634f, c0 = tb[113];
            float mrun = -INFINITY, lrun = 0.f; f32x16 o[2];
#pragma unroll
            for (int d = 0; d < 2; ++d)
#pragma unroll
                for (int r = 0; r < 16; ++r) o[d][r] = 0.f;
#pragma unroll
            for (int half = 0; half < 4; ++half) {
                if (half * 2 < ntile) {
                    f32x16 st[2];
#pragma unroll
                    for (int t4 = 0; t4 < 2; ++t4) { const int kt = half * 2 + t4;
#pragma unroll
                        for (int r = 0; r < 16; ++r) st[t4][r] = 0.f;
                        if (kt < ntile) { const int key = 32 * kt + r32;
#pragma unroll
                            for (int s = 0; s < 4; ++s) { const bf16x8v ka = *(const LAS bf16x8v*)(ks + key * 128 + (((2 * s + hi) ^ ((key >> 1) & 7)) * 16));
                                st[t4] = __builtin_amdgcn_mfma_f32_32x32x16_bf16(ka, qf[s], st[t4], 0, 0, 0); } }
                        asm volatile("" ::: "memory");
                    }
                    if (general) moba_item_half<true, 2>(st, half, ntile, hi, dq, c1, c0, tb, mrun, lrun, o, vs, r32);
                    else         moba_item_half<false, 2>(st, half, ntile, hi, dq, c1, c0, tb, mrun, lrun, o, vs, r32);
                }
            }
            if (valid) {
                const size_t pair = (size_t)(b * SEQ + tl) * 8 + h; const float linv = 1.0f / lrun;
                bf16* po = (rank == 0 ? PO0 : rank == 1 ? PO1 : rank == 2 ? PO2 : PO3) + pair * 64;
#pragma unroll
                for (int d = 0; d < 2; ++d)
#pragma unroll
                    for (int g4 = 0; g4 < 4; ++g4) { v2u w; w.x = pg8::cvt_pk_bf16(o[d][4 * g4] * linv, o[d][4 * g4 + 1] * linv); w.y = pg8::cvt_pk_bf16(o[d][4 * g4 + 2] * linv, o[d][4 * g4 + 3] * linv);
                        *(v2u*)(po + 32 * d + 8 * g4 + 4 * hi) = w; }
                if (hi == 0) { float* pm = PML + ((size_t)rank * (M * 8) + pair) * 2; pm[0] = mrun; pm[1] = lrun; }
            }
        }
        li = li2; k = k2; n = n2;
    }
#undef MOBA_FETCH
    __syncthreads();
}
__device__ __forceinline__ void moba_combine_phase(int gtid, int gthreads, const bf16* PO0, const bf16* PO1, const bf16* PO2, const bf16* PO3, const float* PML, bf16* OA) {
    for (int idx = gtid; idx < M * 8 * 8; idx += gthreads) {
        const int pair = idx >> 3, c8 = idx & 7, m = pair >> 3, own = (m & (SEQ - 1)) >> 8, nv = own < 3 ? own : 3;
        float mm[4], ll[4];
#pragma unroll
        for (int r = 0; r < 4; ++r) { const bool v = (r == 3) || (r < nv); const float* pm = PML + ((size_t)r * (M * 8) + pair) * 2; mm[r] = v ? pm[0] : -INFINITY; ll[r] = v ? pm[1] : 0.f; }
        const float mx = fmaxf(fmaxf(mm[0], mm[1]), fmaxf(mm[2], mm[3]));
        float w[4], ws = 0.f;
#pragma unroll
        for (int r = 0; r < 4; ++r) { w[r] = ll[r] * __builtin_amdgcn_exp2f(mm[r] - mx); ws += w[r]; }
        const float inv = 1.0f / ws; float acc[8];
#pragma unroll
        for (int e = 0; e < 8; ++e) acc[e] = 0.f;
#pragma unroll
        for (int r = 0; r < 4; ++r) { const bool v = (r == 3) || (r < nv);
            if (v) { const bf16* po = (r == 0 ? PO0 : r == 1 ? PO1 : r == 2 ? PO2 : PO3) + (size_t)pair * 64 + c8 * 8; const v4u x = *(const v4u*)po; const float wr = w[r] * inv;
                acc[0] += wr * bflo(x.x); acc[1] += wr * bfhi(x.x); acc[2] += wr * bflo(x.y); acc[3] += wr * bfhi(x.y); acc[4] += wr * bflo(x.z); acc[5] += wr * bfhi(x.z); acc[6] += wr * bflo(x.w); acc[7] += wr * bfhi(x.w); } }
        v4u o; o.x = pk2(acc[0], acc[1]); o.y = pk2(acc[2], acc[3]); o.z = pk2(acc[4], acc[5]); o.w = pk2(acc[6], acc[7]);
        *(v4u*)(OA + (size_t)pair * 64 + c8 * 8) = o;
    }
}
constexpr int HL_QN = 0, HL_KN = 8704, HL_KT = 17408, HL_VT = 27648, HL_SB = 37888, HL_GT = 72704, HL_DD = 74752, HL_EM = 75264, HL_SSQ = 75776, HL_END = 76288;
constexpr int HL_QP = 272, HL_TP = 80;
__device__ __forceinline__ float bf1(bf16 x) { return __uint_as_float((unsigned)x << 16); }
template <int STEP> __device__ __forceinline__ void hgrn_mfma_phase(LAS unsigned char* lds, int vcu, int G, int tid, int wave, int lane, const bf16* KIN, const bf16* HI, const bf16* HQ, const bf16* HG, const float* hgw, float* HS, float* HGD, bf16* OB) {
    const int r32 = lane & 31, hi = lane >> 5, ch = tid & 127, tg = __builtin_amdgcn_readfirstlane(tid >> 7);
    LAS float* gt = (LAS float*)(lds + HL_GT); LAS float* dd = (LAS float*)(lds + HL_DD); LAS float* em = (LAS float*)(lds + HL_EM); LAS float* ssq = (LAS float*)(lds + HL_SSQ);
    for (int unit = vcu; unit < BATCH * HGH * HGNC; unit += G) {
        const int c = unit & 31, bh = unit >> 5, b = bh >> 2, h = bh & 3, m0 = b * SEQ + c * HGC;
        f32x16 S[4]; float Dk = 1.f;
        const int skt = (STEP == 1) ? (wave >> 1) : (wave - 4), svt0 = (STEP == 1) ? 2 * (wave & 1) : 0; constexpr int NST = (STEP == 1) ? 2 : 4;
#pragma unroll
        for (int i = 0; i < 4; ++i)
#pragma unroll
            for (int r = 0; r < 16; ++r) S[i][r] = 0.f;
        if (STEP == 3 && wave >= 4) {
#pragma unroll
            for (int i = 0; i < 4; ++i)
#pragma unroll
                for (int r = 0; r < 16; ++r) S[i][r] = HS[(size_t)unit * 16384 + (32 * skt + crow16(r, hi)) * 128 + 32 * (svt0 + i) + r32];
        }
        unsigned short rk[8], rv[8], rq[8];
#pragma unroll
        for (int e = 0; e < 8; ++e) { const size_t idx = (size_t)(m0 + tg * 8 + e) * HGW + h * HGD_ + ch; rk[e] = KIN[idx]; rv[e] = HI[idx]; rq[e] = (STEP == 3) ? HQ[idx] : (unsigned short)0; }
        for (int slab = 0; slab < 8; ++slab) {
            const int ms = m0 + slab * 32;
            float kin[8], qq[8]; unsigned short vv[8];
#pragma unroll
            for (int e = 0; e < 8; ++e) { kin[e] = bf1(rk[e]); vv[e] = rv[e]; qq[e] = bf1(rq[e]); }
            if (slab < 7) {
#pragma unroll
                for (int e = 0; e < 8; ++e) { const size_t idx = (size_t)(ms + 32 + tg * 8 + e) * HGW + h * HGD_ + ch; rk[e] = KIN[idx]; rv[e] = HI[idx]; rq[e] = (STEP == 3) ? HQ[idx] : (unsigned short)0; }
            }
            float cs[8]; float run = 0.f;
#pragma unroll
            for (int e = 0; e < 8; ++e) { run += __builtin_amdgcn_logf(fmaxf(1.0f - kin[e], 5.9604645e-8f)); cs[e] = run; }
            gt[tg * 128 + ch] = run;
            __syncthreads();
            const float g0 = gt[ch], g1 = gt[128 + ch], g2 = gt[256 + ch], g3 = gt[384 + ch];
            const float bmid = g0 + g1, bend = bmid + g2 + g3, pre = (tg == 0) ? 0.f : (tg == 1) ? g0 : (tg == 2) ? bmid : bmid + g2;
            { float kh[8];
#pragma unroll
              for (int e = 0; e < 8; ++e) kh[e] = kin[e] * __builtin_amdgcn_exp2f(bend - (pre + cs[e]));
              v4u w; w.x = pg8::cvt_pk_bf16(kh[0], kh[1]); w.y = pg8::cvt_pk_bf16(kh[2], kh[3]); w.z = pg8::cvt_pk_bf16(kh[4], kh[5]); w.w = pg8::cvt_pk_bf16(kh[6], kh[7]);
              *(LAS v4u*)(lds + HL_KT + ch * HL_TP + tg * 16) = w;
              v4u x; x.x = (unsigned)vv[0] | ((unsigned)vv[1] << 16); x.y = (unsigned)vv[2] | ((unsigned)vv[3] << 16); x.z = (unsigned)vv[4] | ((unsigned)vv[5] << 16); x.w = (unsigned)vv[6] | ((unsigned)vv[7] << 16);
              *(LAS v4u*)(lds + HL_VT + ch * HL_TP + tg * 16) = x; }
            if (STEP == 3) {
#pragma unroll
                for (int e = 0; e < 8; ++e) { const float bs = pre + cs[e]; const int tok = tg * 8 + e;
                    const float kt_ = kin[e] * __builtin_amdgcn_exp2f(fminf(bmid - bs, 100.f)), qt_ = qq[e] * __builtin_amdgcn_exp2f(fminf(bs - bmid, 100.f));
                    *(LAS unsigned short*)(lds + HL_KN + tok * HL_QP + ch * 2) = (unsigned short)f2bf(kt_);
                    *(LAS unsigned short*)(lds + HL_QN + tok * HL_QP + ch * 2) = (unsigned short)f2bf(qt_); }
            }
            if (tg == 0) { const float de = __builtin_amdgcn_exp2f(bend); dd[ch] = de; em[ch] = __builtin_amdgcn_exp2f(bmid); Dk *= de; }
            __syncthreads();
            if (STEP == 3) {
                if (wave >= 4) {
#pragma unroll
                    for (int i = 0; i < 4; ++i)
#pragma unroll
                        for (int g4 = 0; g4 < 4; ++g4) { const int k0 = 32 * skt + 8 * g4 + 4 * hi; const f32x4 e4 = *(const LAS f32x4*)(em + k0);
                            v2u w; w.x = pg8::cvt_pk_bf16(S[i][4 * g4] * e4.x, S[i][4 * g4 + 1] * e4.y); w.y = pg8::cvt_pk_bf16(S[i][4 * g4 + 2] * e4.z, S[i][4 * g4 + 3] * e4.w);
                            *(LAS v2u*)(lds + HL_SB + (32 * (svt0 + i) + r32) * HL_QP + k0 * 2) = w; }
                }
                __syncthreads();
            }
            f32x16 O;
            if (STEP == 3 && wave < 4) {
                const int vt = wave;
                bf16x8v qf[8]; f32x16 X;
#pragma unroll
                for (int r = 0; r < 16; ++r) { X[r] = 0.f; O[r] = 0.f; }
#pragma unroll
                for (int ks = 0; ks < 8; ++ks) { qf[ks] = *(const LAS bf16x8v*)(lds + HL_QN + r32 * HL_QP + (16 * ks + 8 * hi) * 2);
                    const bf16x8v kf = *(const LAS bf16x8v*)(lds + HL_KN + r32 * HL_QP + (16 * ks + 8 * hi) * 2);
                    X = __builtin_amdgcn_mfma_f32_32x32x16_bf16(kf, qf[ks], X, 0, 0, 0); }
#pragma unroll
                for (int r = 0; r < 16; ++r) if (crow16(r, hi) > r32) X[r] = 0.f;
#pragma unroll
                for (int k2 = 0; k2 < 2; ++k2) {
                    v4u w; w.x = pg8::cvt_pk_bf16(X[8 * k2 + 0], X[8 * k2 + 1]); w.y = pg8::cvt_pk_bf16(X[8 * k2 + 2], X[8 * k2 + 3]); w.z = pg8::cvt_pk_bf16(X[8 * k2 + 4], X[8 * k2 + 5]); w.w = pg8::cvt_pk_bf16(X[8 * k2 + 6], X[8 * k2 + 7]);
                    const bf16x8v xf = __builtin_bit_cast(bf16x8v, w);
                    const LAS unsigned char* vp = lds + HL_VT + (32 * vt + r32) * HL_TP + (16 * k2 + 4 * hi) * 2;
                    const s16x4v lo = *(const LAS s16x4v*)vp, hi4 = *(const LAS s16x4v*)(vp + 16);
                    const bf16x8v va = {lo[0], lo[1], lo[2], lo[3], hi4[0], hi4[1], hi4[2], hi4[3]};
                    O = __builtin_amdgcn_mfma_f32_32x32x16_bf16(va, xf, O, 0, 0, 0); }
#pragma unroll
                for (int ks = 0; ks < 8; ++ks) { const bf16x8v sa = *(const LAS bf16x8v*)(lds + HL_SB + (32 * vt + r32) * HL_QP + (16 * ks + 8 * hi) * 2);
                    O = __builtin_amdgcn_mfma_f32_32x32x16_bf16(sa, qf[ks], O, 0, 0, 0); }
                float sq = 0.f;
#pragma unroll
                for (int r = 0; r < 16; ++r) sq += O[r] * O[r];
                sq += __shfl_xor(sq, 32);
                if (hi == 0) ssq[vt * 32 + r32] = sq;
            }
            if (STEP == 1 || wave >= 4) {
#pragma unroll
                for (int i = 0; i < NST; ++i) {
#pragma unroll
                    for (int g4 = 0; g4 < 4; ++g4) { const f32x4 d4 = *(const LAS f32x4*)(dd + 32 * skt + 8 * g4 + 4 * hi);
                        S[i][4 * g4] *= d4.x; S[i][4 * g4 + 1] *= d4.y; S[i][4 * g4 + 2] *= d4.z; S[i][4 * g4 + 3] *= d4.w; }
#pragma unroll
                    for (int k2 = 0; k2 < 2; ++k2) { const bf16x8v ka = *(const LAS bf16x8v*)(lds + HL_KT + (32 * skt + r32) * HL_TP + (16 * k2 + 8 * hi) * 2);
                        const bf16x8v vb = *(const LAS bf16x8v*)(lds + HL_VT + (32 * (svt0 + i) + r32) * HL_TP + (16 * k2 + 8 * hi) * 2);
                        S[i] = __builtin_amdgcn_mfma_f32_32x32x16_bf16(ka, vb, S[i], 0, 0, 0); }
                }
            }
            __syncthreads();
            if (STEP == 3 && wave < 4) {
                const int vt = wave; const float tot = ssq[r32] + ssq[32 + r32] + ssq[64 + r32] + ssq[96 + r32];
                const float rstd = 1.f / sqrtf(tot * (1.f / 128.f) + EPS); const size_t mrow = (size_t)(ms + r32) * HGW + h * HGD_;
#pragma unroll
                for (int g4 = 0; g4 < 4; ++g4) { const int v0 = 32 * vt + 8 * g4 + 4 * hi; const f32x4 w4 = *(const f32x4*)(hgw + v0); const v2u gg = *(const v2u*)(HG + mrow + v0);
                    v2u o; o.x = pg8::cvt_pk_bf16(O[4 * g4] * rstd * w4.x * bflo(gg.x), O[4 * g4 + 1] * rstd * w4.y * bfhi(gg.x)); o.y = pg8::cvt_pk_bf16(O[4 * g4 + 2] * rstd * w4.z * bflo(gg.y), O[4 * g4 + 3] * rstd * w4.w * bfhi(gg.y));
                    *(v2u*)(OB + mrow + v0) = o; }
            }
        }
        if (STEP == 1) {
#pragma unroll
            for (int i = 0; i < 2; ++i)
#pragma unroll
                for (int r = 0; r < 16; ++r) HS[(size_t)unit * 16384 + (32 * skt + crow16(r, hi)) * 128 + 32 * (svt0 + i) + r32] = S[i][r];
            if (tid < 128) HGD[unit * 128 + tid] = Dk;
        }
    }
    __syncthreads();
}
__device__ __forceinline__ void hgrn_scan_phase(int gtid, int gthreads, float* HS, const float* HGD) {
    for (int idx = gtid; idx < BATCH * HGH * 16384; idx += gthreads) {
        const int bh = idx >> 14, e = idx & 16383, k = e >> 7; float s = 0.f;
        float tmp[HGNC];
#pragma unroll
        for (int c = 0; c < HGNC; ++c) tmp[c] = HS[(size_t)(bh * HGNC + c) * 16384 + e];
#pragma unroll
        for (int c = 0; c < HGNC; ++c) { HS[(size_t)(bh * HGNC + c) * 16384 + e] = s; s = HGD[(bh * HGNC + c) * 128 + k] * s + tmp[c]; }
    }
}
#ifndef REP_MASK
#define REP_MASK 0u
#endif
struct Args { const float* in[16]; float* out; unsigned char* ws; unsigned mask, rep; };
__global__ void __launch_bounds__(NWAVES * 64, 2) mk_fwd(Args args) {
    extern __shared__ __attribute__((aligned(16))) unsigned char lds_raw[];
    LAS unsigned char* lds = (LAS unsigned char*)lds_raw;
    volatile LAS unsigned* MISC = (volatile LAS unsigned*)(lds + MISC_OFF);
    const int G = gridDim.x, bx = blockIdx.x;
    unsigned char* ws = args.ws;
    gu32* ctl = (gu32*)(ws + WS_CTL);
    for (int u = threadIdx.x; u < (LDS_BYTES - LDSCTL_OFF) / 4; u += NWAVES * 64) ((LAS unsigned*)(lds + LDSCTL_OFF))[u] = 0u;
    __syncthreads();
    XcdBarrier bar = xcd_barrier_post((unsigned*)(ctl + CW_BAR), MISC + 8);
#define GRID_BAR() xcd_barrier(bar)
#define PH(k) for (int rep_ = ((args.mask >> (k)) & 1u) + ((args.rep >> (k)) & 1u); rep_ > 0; --rep_)
#define COORDS() int tid = threadIdx.x; asm volatile("" : "+v"(tid)); const int lane = tid & 63, wave = __builtin_amdgcn_readfirstlane(tid >> 6); \
    const int vcu = (G % 8 == 0) ? (bx % 8) * (G / 8) + bx / 8 : bx; const int gw = vcu * NWAVES + wave, NGW = G * NWAVES; (void)lane; (void)gw; (void)NGW; (void)vcu
#define MKP() Ptrs P; P.x = args.in[0]; P.p = args.in[1]; P.w_gu1 = args.in[2]; P.w_d1 = args.in[3]; P.w_in = args.in[4]; P.w_a = args.in[5]; P.w_b = args.in[6]; P.w_out = args.in[7]; \
    P.w_gu2 = args.in[8]; P.w_d2 = args.in[9]; P.w_ple = args.in[10]; P.w_pg = args.in[11]; P.gains = args.in[12]; P.hgw = args.in[13]; P.lbp = args.in[14]; P.rel = args.in[15]; P.out = args.out; P.ws = args.ws
#define XN ((bf16*)(ws + WS_C))
#define Hb ((bf16*)(ws + WS_A))
#define Fb ((bf16*)(ws + WS_B))
#define Yb ((bf16*)(ws + WS_A))
#define HBS ((bf16*)args.out)
#define Qb ((bf16*)(ws + WS_Q))
#define Kb ((bf16*)(ws + WS_K))
#define VTb ((bf16*)(ws + WS_VT))
#define HQb ((bf16*)(ws + WS_HQ))
#define HIb ((bf16*)(ws + WS_HI))
#define KINb ((bf16*)(ws + WS_KIN))
#define HGb ((bf16*)(ws + WS_HG))
#define SAb ((bf16*)(ws + WS_SA))
#define SBb ((bf16*)(ws + WS_SB))
#define OAb ((bf16*)(ws + WS_OA))
#define OBb ((bf16*)(ws + WS_OB))
#define PBb ((bf16*)(ws + WS_PB))
#define Eb ((bf16*)(ws + WS_A))
#define KMEAN ((float*)(ws + WS_KMEAN))
#define LBt ((float*)(ws + WS_LB))
#define BIAST ((float*)(ws + WS_BIAST))
#define HS ((float*)(ws + WS_HS))
#define HGD ((float*)(ws + WS_HGD))
#define CNTb ((unsigned*)(ws + WS_CNT))
#define LISTb ((unsigned*)(ws + WS_LIST))
#define PO0b ((bf16*)(ws + WS_PO0))
#define PO1b ((bf16*)(ws + WS_PO1))
#define PO2b ((bf16*)(ws + WS_PO2))
#define PO3b ((bf16*)(ws + WS_PO3))
#define PMLb ((float*)(ws + WS_PML))

    PH(0) { COORDS(); MKP(); p0_prologue(P, lds, gw, NGW, wave, lane); }
    GRID_BAR();
    PH(1) { pg8::Gemm g{XN, (const bf16*)(ws + WS_WGU1), M, NGU, D}; pg8::StaticOrder S; S.init(M, NGU, G, bx); pg8::EpiGU E{Hb, FF};
      pg8::gemm_phase<pg8::EpiGU, pg8::StaticOrder, PG8_ALIGN, PG8_SP2>(lds + RING_OFF, g, S, E); }
    GRID_BAR();
    PH(2) { pg8::Gemm g{Hb, (const bf16*)(ws + WS_WD1), M, D, FF}; pg8::StaticOrder S; S.init(M, D, G, bx); pg8::EpiMix<0> E{Fb, nullptr, D};
      pg8::gemm_phase<pg8::EpiMix<0>, pg8::StaticOrder, PG8_ALIGN, PG8_SP2>(lds + RING_OFF, g, S, E); }
    GRID_BAR();
    PH(3) { COORDS(); rowwise_phase<true, 1>(gw, NGW, lane, args.in[0], Fb, args.in[12] + 1 * D, 0.5f, HBS, XN, nullptr); }
    GRID_BAR();
    PH(4) { pg8::Gemm g{XN, (const bf16*)(ws + WS_WIN), M, NIN - 512, D}; pg8::StaticOrder S; S.init(M, NIN - 512, G, bx); pg8::EpiIN E{Qb, Kb, HQb, KINb, HIb, HGb, SAb, SBb, LBt, KMEAN};
      pg8::gemm_phase<pg8::EpiIN, pg8::StaticOrder, PG8_ALIGN, PG8_SP2>(lds + RING_OFF, g, S, E); }
    PH(4) { pg8::Gemm g{(const bf16*)(ws + WS_WIN) + (size_t)(NIN - 512) * D, XN, 512, M, D}; pg8::StaticOrder S; S.init(512, M, G, bx); pg8::EpiMix<0> E{VTb, nullptr, M};
      pg8::gemm_phase<pg8::EpiMix<0>, pg8::StaticOrder, PG8_ALIGN, PG8_SP2>(lds + RING_OFF, g, S, E); }
    GRID_BAR();
    PH(5) { COORDS(); moba_gating_phase(lds, vcu, G, tid, Qb, KMEAN, CNTb, LISTb); }
    PH(18) { COORDS(); hgrn_mfma_phase<1>(lds, vcu, G, tid, wave, lane, KINb, HIb, HQb, HGb, args.in[13], HS, HGD, OBb); }
    GRID_BAR();
    PH(6) { COORDS(); hgrn_scan_phase(vcu * NWAVES * 64 + tid, G * NWAVES * 64, HS, HGD); }
    GRID_BAR();
    PH(7) { COORDS(); hgrn_mfma_phase<3>(lds, vcu, G, tid, wave, lane, KINb, HIb, HQb, HGb, args.in[13], HS, HGD, OBb); }
    GRID_BAR();
    PH(16) { COORDS(); moba_items_phase(lds, vcu, G, tid, wave, lane, Qb, Kb, VTb, CNTb, LISTb, BIAST, PO0b, PO1b, PO2b, PO3b, PMLb); }
    GRID_BAR();
    PH(17) { COORDS(); moba_combine_phase(vcu * NWAVES * 64 + tid, G * NWAVES * 64, PO0b, PO1b, PO2b, PO3b, PMLb, OAb); }
    GRID_BAR();
    PH(8) { pg8::Gemm g{OAb, (const bf16*)(ws + WS_WA), M, D, 512}; pg8::StaticOrder S; S.init(M, D, G, bx); pg8::EpiMix<1> E{SAb, nullptr, D};
      pg8::gemm_phase<pg8::EpiMix<1>, pg8::StaticOrder, PG8_ALIGN, PG8_SP2>(lds + RING_OFF, g, S, E); }
    PH(8) { pg8::Gemm g{OBb, (const bf16*)(ws + WS_WB), M, D, 512}; pg8::StaticOrder S; S.init(M, D, G, bx); pg8::EpiMix<2> E{SAb, SBb, D};
      pg8::gemm_phase<pg8::EpiMix<2>, pg8::StaticOrder, PG8_ALIGN, PG8_SP2>(lds + RING_OFF, g, S, E); }
    GRID_BAR();
    PH(9) { pg8::Gemm g{SAb, (const bf16*)(ws + WS_WOUT), M, D, D}; pg8::StaticOrder S; S.init(M, D, G, bx); pg8::EpiMix<0> E{Yb, nullptr, D};
      pg8::gemm_phase<pg8::EpiMix<0>, pg8::StaticOrder, PG8_ALIGN, PG8_SP2>(lds + RING_OFF, g, S, E); }
    GRID_BAR();
    PH(10) { COORDS(); rowwise_phase<false, 1>(gw, NGW, lane, HBS, Yb, args.in[12] + 3 * D, 1.0f, HBS, XN, nullptr); }
    GRID_BAR();
    PH(11) { pg8::Gemm g{XN, (const bf16*)(ws + WS_WGU2), M, NGU, D}; pg8::StaticOrder S; S.init(M, NGU, G, bx); pg8::EpiGU E{Hb, FF};
      pg8::gemm_phase<pg8::EpiGU, pg8::StaticOrder, PG8_ALIGN, PG8_SP2>(lds + RING_OFF, g, S, E); }
    GRID_BAR();
    PH(12) { pg8::Gemm g{Hb, (const bf16*)(ws + WS_WD2), M, D, FF}; pg8::StaticOrder S; S.init(M, D, G, bx); pg8::EpiMix<0> E{Fb, nullptr, D};
      pg8::gemm_phase<pg8::EpiMix<0>, pg8::StaticOrder, PG8_ALIGN, PG8_SP2>(lds + RING_OFF, g, S, E); }
    GRID_BAR();
    PH(13) { COORDS(); rowwise_phase<false, 2>(gw, NGW, lane, HBS, Fb, args.in[12] + 5 * D, 0.5f, nullptr, XN, nullptr);
        const float* pp = args.in[1];
        for (int i = gw * 64 + lane; i < M * PLE / 8; i += NGW * 64) { const f32x4 a = ((const f32x4*)pp)[2 * i], b = ((const f32x4*)pp)[2 * i + 1];
            v4u o; o.x = pk2(a.x, a.y); o.y = pk2(a.z, a.w); o.z = pk2(b.x, b.y); o.w = pk2(b.z, b.w); ((v4u*)PBb)[i] = o; } }
    GRID_BAR();
    PH(14) { pg8::Gemm g{PBb, (const bf16*)(ws + WS_WPLE), M, D, PLE}; pg8::StaticOrder S; S.init(M, D, G, bx); pg8::EpiMix<0> E{Eb, nullptr, D};
      pg8::gemm_phase<pg8::EpiMix<0>, pg8::StaticOrder, PG8_ALIGN, PG8_SP2>(lds + RING_OFF, g, S, E); }
    PH(14) { pg8::Gemm g{XN, (const bf16*)(ws + WS_WPG), M, D, D}; pg8::StaticOrder S; S.init(M, D, G, bx); pg8::EpiPleB E{Eb, Fb, D};
      pg8::gemm_phase<pg8::EpiPleB, pg8::StaticOrder, PG8_ALIGN, PG8_SP2>(lds + RING_OFF, g, S, E); }
    GRID_BAR();
    PH(15) { COORDS(); rowwise_phase<false, 3>(gw, NGW, lane, XN, Fb, args.in[12] + 6 * D, 1.0f, nullptr, nullptr, args.out); }
}

extern "C" void kernel_launch(void* const* d_in, const int* in_sizes, int n_in, void* d_out, int out_size, void* d_ws, size_t ws_size, hipStream_t stream) {
    static int grid = 0;
    if (grid == 0) {
        if (n_in != 16 || in_sizes[0] != M * D || out_size != M * D || ws_size < WS_END) { fprintf(stderr, "kernel_launch: unexpected shapes: n_in %d in0 %d out %d ws %zu; nothing launched\n", n_in, n_in > 0 ? in_sizes[0] : -1, out_size, ws_size); grid = -1; return; }
        int dev = 0, cus = 0;
        if (hipGetDevice(&dev) != hipSuccess || hipDeviceGetAttribute(&cus, hipDeviceAttributeMultiprocessorCount, dev) != hipSuccess) { fprintf(stderr, "kernel_launch: device query failed\n"); grid = -1; return; }
        if (hipFuncSetAttribute((const void*)mk_fwd, hipFuncAttributeMaxDynamicSharedMemorySize, LDS_BYTES) != hipSuccess) { fprintf(stderr, "kernel_launch: hipFuncSetAttribute failed\n"); grid = -1; return; }
        int per_cu = 0;
        if (hipOccupancyMaxActiveBlocksPerMultiprocessor(&per_cu, (const void*)mk_fwd, NWAVES * 64, LDS_BYTES) != hipSuccess || per_cu < 1) fprintf(stderr, "kernel_launch: note: occupancy query reports %d\n", per_cu);
        (void)hipGetLastError();
        grid = cus;
    }
    if (grid < 0) return;
    if (hipMemsetAsync((char*)d_ws + WS_CTL, 0, CTL_ZERO_BYTES, stream) != hipSuccess) { fprintf(stderr, "kernel_launch: memset failed\n"); return; }
    Args a{};
    for (int i = 0; i < 16; ++i) a.in[i] = (const float*)d_in[i];
    a.out = (float*)d_out; a.ws = (unsigned char*)d_ws; a.mask = 0xffffffffu; a.rep = REP_MASK;
    hipLaunchKernelGGL(mk_fwd, dim3(grid), dim3(NWAVES * 64), LDS_BYTES, stream, a);
    const hipError_t le = hipPeekAtLastError();
    if (le != hipSuccess) fprintf(stderr, "kernel_launch: launch failed: %s\n", hipGetErrorName(le));
}
```

```cpp
#include <hip/hip_runtime.h>
#include <cstdio>
#include <cstdint>
namespace pg8 {
#define PG8_LAS __attribute__((address_space(3)))
typedef unsigned short bf16_t;
typedef short bf16x8 __attribute__((ext_vector_type(8)));
typedef float f32x4 __attribute__((ext_vector_type(4)));
typedef unsigned u32x4 __attribute__((ext_vector_type(4)));
typedef int i32x4 __attribute__((ext_vector_type(4)));
constexpr int BM = 256, BK = 64, HALF = 128, HTB = HALF * BK * 2  , STAGE_BYTES = 8 * HTB, NXCD = 8, WGM = 8;

__host__ __device__ __forceinline__ int lds_byte(int r, int c) { const int st = (r >> 4) * 2 + (c >> 5), rr = r & 15, cc = c & 31, ob = rr * 64 + cc * 2; return st * 1024 + (ob ^ (((ob >> 9) & 1) << 5)); }
__host__ __device__ __forceinline__ void stage_rc(int b, int& R, int& C) { const int st = b / 1024, sb = b % 1024, swz = sb ^ (((sb >> 9) & 1) << 5); R = (st >> 1) * 16 + swz / 64; C = (st & 1) * 32 + (swz % 64) / 2; }
__host__ __device__ __forceinline__ int perm32(int rho) { const int n = rho >> 4, i = rho & 15; return 8 * (i >> 2) + 4 * n + (i & 3); }

struct Unit { int pm, pn; };
struct Gemm { const bf16_t* A; const bf16_t* Bt; int M, N, K; };

struct StaticOrder {
    int nM, nN, nwg, G, c;
    __host__ __device__ void init(int M, int N, int G_, int c_) { nM = M / BM; nN = N / BM; nwg = nM * nN; G = G_; c = c_; }
    __host__ __device__ bool next(int i, Unit& u) const {
        const long L = (long)i * G + c; if (L >= nwg) return false;
        int wgid = (int)L; { const int q = nwg / NXCD, r = nwg % NXCD, xcd = wgid % NXCD, off = wgid / NXCD; wgid = (xcd < r ? xcd * (q + 1) : r * (q + 1) + (xcd - r) * q) + off; }
        const int nig = WGM * nN, gid = wgid / nig, fm = gid * WGM, gsz = (nM - fm) < WGM ? (nM - fm) : WGM;
        u.pm = fm + ((wgid % nig) % gsz); u.pn = (wgid % nig) / gsz; return true;
    }
    __device__ __forceinline__ void a_ready(const Unit&) const {}
    __device__ __forceinline__ void done(const Unit&) const {}
};

typedef float f32x2_t __attribute__((ext_vector_type(2))); typedef __bf16 bf16x2_t __attribute__((ext_vector_type(2)));
__device__ __forceinline__ unsigned cvt_pk_bf16(float lo, float hi) { f32x2_t v = {lo, hi}; bf16x2_t b = __builtin_convertvector(v, bf16x2_t); return __builtin_bit_cast(unsigned, b); }
__device__ __forceinline__ float sigm(float x) { return __builtin_amdgcn_rcpf(1.0f + __builtin_amdgcn_exp2f(-1.4426950408889634f * x)); }
__device__ __forceinline__ float bf_lo(unsigned w) { return __uint_as_float(w << 16); }
__device__ __forceinline__ float bf_hi(unsigned w) { return __uint_as_float(w & 0xffff0000u); }
__device__ __forceinline__ void unpack8(const u32x4 w, float (&o)[8]) { o[0] = bf_lo(w.x); o[1] = bf_hi(w.x); o[2] = bf_lo(w.y); o[3] = bf_hi(w.y); o[4] = bf_lo(w.z); o[5] = bf_hi(w.z); o[6] = bf_lo(w.w); o[7] = bf_hi(w.w); }
__device__ __forceinline__ u32x4 pack8(const float (&o)[8]) { u32x4 w; w.x = cvt_pk_bf16(o[0], o[1]); w.y = cvt_pk_bf16(o[2], o[3]); w.z = cvt_pk_bf16(o[4], o[5]); w.w = cvt_pk_bf16(o[6], o[7]); return w; }

struct EpiGU {
    static constexpr bool PERM = true, AFTER_DRAIN = false;
    bf16_t* H; int ldh;
    __device__ __forceinline__ void operator()(const f32x4 (&acc)[2][2][4][2], const Unit& u, int wr, int wc, int fr, int fq) const {
        const int row0 = u.pm * BM + wr * 64 + fr, col0 = u.pn * HALF + wc * 32 + 8 * fq;
#pragma unroll
        for (int ai = 0; ai < 2; ++ai)
#pragma unroll
            for (int m = 0; m < 4; ++m) { bf16_t* rowp = H + (size_t)(row0 + ai * HALF + m * 16) * ldh + col0;
                const f32x4 g0 = acc[ai][0][m][0], g1 = acc[ai][0][m][1], u0 = acc[ai][1][m][0], u1 = acc[ai][1][m][1]; float o[8];
#pragma unroll
                for (int j = 0; j < 4; ++j) { o[j] = g0[j] * sigm(g0[j]) * u0[j]; o[4 + j] = g1[j] * sigm(g1[j]) * u1[j]; }
                *(u32x4*)rowp = pack8(o); }
    }
};
struct EpiF32 {
    static constexpr bool PERM = false, AFTER_DRAIN = false;
    float* C; int ldc;
    __device__ __forceinline__ void operator()(const f32x4 (&acc)[2][2][4][2], const Unit& u, int wr, int wc, int fr, int fq) const {
        const int row0 = u.pm * BM + wr * 64 + fr, col0 = u.pn * BM + wc * 32 + 4 * fq;
#pragma unroll
        for (int ai = 0; ai < 2; ++ai)
#pragma unroll
            for (int m = 0; m < 4; ++m) { float* rowp = C + (size_t)(row0 + ai * HALF + m * 16) * ldc + col0;
#pragma unroll
                for (int bj = 0; bj < 2; ++bj)
#pragma unroll
                    for (int n = 0; n < 2; ++n) *(f32x4*)(rowp + bj * HALF + n * 16) = acc[ai][bj][m][n]; }
    }
};
struct EpiIN {
    static constexpr bool PERM = true, AFTER_DRAIN = false;
    bf16_t *Q, *K, *HQ, *KIN, *HI, *HG, *SA, *SB; const float* LB; float* KMEAN;
    template <int MODE> __device__ __forceinline__ void body(const f32x4 (&acc)[2][2][4][2], bf16_t* base, int ldc, int row0, int cbase, int pm, int fr) const {
        float lbv[2][8]; float ks[2][8];
#pragma unroll
        for (int bj = 0; bj < 2; ++bj)
#pragma unroll
            for (int j = 0; j < 8; ++j) { lbv[bj][j] = (MODE == 2) ? (1.0f - LB[cbase + bj * HALF + j]) : 0.f; ks[bj][j] = 0.f; }
#pragma unroll
        for (int ai = 0; ai < 2; ++ai)
#pragma unroll
            for (int m = 0; m < 4; ++m) { bf16_t* rowp = base + (size_t)(row0 + ai * HALF + m * 16) * ldc + cbase;
#pragma unroll
                for (int bj = 0; bj < 2; ++bj) { const f32x4 v0 = acc[ai][bj][m][0], v1 = acc[ai][bj][m][1]; float o[8];
#pragma unroll
                    for (int j = 0; j < 4; ++j) { o[j] = v0[j]; o[4 + j] = v1[j]; }
#pragma unroll
                    for (int j = 0; j < 8; ++j) {
                        if (MODE == 1) o[j] = o[j] * sigm(o[j]);
                        if (MODE == 2) o[j] = lbv[bj][j] * sigm(-o[j]);
                        if (MODE == 3) o[j] = sigm(o[j]);
                        if (MODE == 4) ks[bj][j] += o[j]; }
                    *(u32x4*)(rowp + bj * HALF) = pack8(o); } }
        if (MODE == 4) {
#pragma unroll
            for (int bj = 0; bj < 2; ++bj)
#pragma unroll
                for (int j = 0; j < 8; ++j) { float s = ks[bj][j]; s += __shfl_xor(s, 1); s += __shfl_xor(s, 2); s += __shfl_xor(s, 4); s += __shfl_xor(s, 8);
                    if (fr == 0) atomicAdd(KMEAN + (size_t)pm * 512 + cbase + bj * HALF + j, s); }
        }
    }
    __device__ __forceinline__ void operator()(const f32x4 (&acc)[2][2][4][2], const Unit& u, int wr, int wc, int fr, int fq) const {
        const int pn = u.pn, row0 = u.pm * BM + wr * 64 + fr, cw = wc * 32 + 8 * fq;
        if (pn < 2)       body<0>(acc, Q,   512,  row0, (pn)      * BM + cw, u.pm, fr);
        else if (pn < 4)  body<4>(acc, K,   512,  row0, (pn - 2)  * BM + cw, u.pm, fr);
        else if (pn < 6)  body<1>(acc, HQ,  512,  row0, (pn - 4)  * BM + cw, u.pm, fr);
        else if (pn < 8)  body<2>(acc, KIN, 512,  row0, (pn - 6)  * BM + cw, u.pm, fr);
        else if (pn < 10) body<0>(acc, HI,  512,  row0, (pn - 8)  * BM + cw, u.pm, fr);
        else if (pn < 12) body<1>(acc, HG,  512,  row0, (pn - 10) * BM + cw, u.pm, fr);
        else if (pn < 16) body<3>(acc, SA,  1024, row0, (pn - 12) * BM + cw, u.pm, fr);
        else              body<3>(acc, SB,  1024, row0, (pn - 16) * BM + cw, u.pm, fr);
    }
};
template <int MODE> struct EpiMix {
    static constexpr bool PERM = true, AFTER_DRAIN = false;
    bf16_t* T; const bf16_t* S2; int ldc;
    __device__ __forceinline__ void operator()(const f32x4 (&acc)[2][2][4][2], const Unit& u, int wr, int wc, int fr, int fq) const {
        const int row0 = u.pm * BM + wr * 64 + fr, col0 = u.pn * BM + wc * 32 + 8 * fq;
#pragma unroll
        for (int ai = 0; ai < 2; ++ai)
#pragma unroll
            for (int m = 0; m < 4; ++m) { const size_t off = (size_t)(row0 + ai * HALF + m * 16) * ldc + col0;
#pragma unroll
                for (int bj = 0; bj < 2; ++bj) { const f32x4 v0 = acc[ai][bj][m][0], v1 = acc[ai][bj][m][1]; float o[8];
#pragma unroll
                    for (int j = 0; j < 4; ++j) { o[j] = v0[j]; o[4 + j] = v1[j]; }
                    if (MODE == 1) { float t[8]; unpack8(*(const u32x4*)(T + off + bj * HALF), t);
#pragma unroll
                        for (int j = 0; j < 8; ++j) o[j] = t[j] * o[j]; }
                    if (MODE == 2) { float t[8], s[8]; unpack8(*(const u32x4*)(T + off + bj * HALF), t); unpack8(*(const u32x4*)(S2 + off + bj * HALF), s);
#pragma unroll
                        for (int j = 0; j < 8; ++j) o[j] = t[j] + s[j] * o[j]; }
                    *(u32x4*)(T + off + bj * HALF) = pack8(o); } }
    }
};
struct EpiPleB {
    static constexpr bool PERM = true, AFTER_DRAIN = false;
    const bf16_t* E; bf16_t* Y; int ldc;
    __device__ __forceinline__ void operator()(const f32x4 (&acc)[2][2][4][2], const Unit& u, int wr, int wc, int fr, int fq) const {
        const int row0 = u.pm * BM + wr * 64 + fr, col0 = u.pn * BM + wc * 32 + 8 * fq;
#pragma unroll
        for (int ai = 0; ai < 2; ++ai)
#pragma unroll
            for (int m = 0; m < 4; ++m) { const size_t off = (size_t)(row0 + ai * HALF + m * 16) * ldc + col0;
#pragma unroll
                for (int bj = 0; bj < 2; ++bj) { const f32x4 v0 = acc[ai][bj][m][0], v1 = acc[ai][bj][m][1]; float e[8], o[8]; unpack8(*(const u32x4*)(E + off + bj * HALF), e);
#pragma unroll
                    for (int j = 0; j < 4; ++j) { o[j] = sigm(v0[j]) * e[j]; o[4 + j] = sigm(v1[j]) * e[4 + j]; }
                    *(u32x4*)(Y + off + bj * HALF) = pack8(o); } }
    }
};

struct EpiGU8 {
    static constexpr bool PERM = true, AFTER_DRAIN = false;
    bf16_t* H; int ldh; const float* RS; const float* CMAX;
    __device__ __forceinline__ void operator()(const i32x4 (&acc)[2][2][4][2], const Unit& u, int wr, int wc, int fr, int fq) const {
        const int row0 = u.pm * BM + wr * 64 + fr, cw = wc * 32 + 8 * fq, col0 = u.pn * HALF + cw;
        float cg[8], cu[8];
#pragma unroll
        for (int j = 0; j < 8; ++j) { cg[j] = CMAX[u.pn * BM + cw + j] * (1.0f / 127.0f); cu[j] = CMAX[u.pn * BM + HALF + cw + j] * (1.0f / 127.0f); }
#pragma unroll
        for (int ai = 0; ai < 2; ++ai)
#pragma unroll
            for (int m = 0; m < 4; ++m) { const int row = row0 + ai * HALF + m * 16; const float rs = RS[row]; bf16_t* rowp = H + (size_t)row * ldh + col0;
                const i32x4 g0 = acc[ai][0][m][0], g1 = acc[ai][0][m][1], u0 = acc[ai][1][m][0], u1 = acc[ai][1][m][1]; float o[8];
#pragma unroll
                for (int j = 0; j < 4; ++j) { const float ga = (float)g0[j] * (rs * cg[j]), gb = (float)g1[j] * (rs * cg[4 + j]), ua = (float)u0[j] * (rs * cu[j]), ub = (float)u1[j] * (rs * cu[4 + j]);
                    o[j] = ga * sigm(ga) * ua; o[4 + j] = gb * sigm(gb) * ub; }
                *(u32x4*)rowp = pack8(o); }
    }
};

struct EpiNull {
    static constexpr bool PERM = true, AFTER_DRAIN = false;
    template <class AT> __device__ __forceinline__ void operator()(const AT (&acc)[2][2][4][2], const Unit& u, int wr, int wc, int fr, int fq) const {
#pragma unroll
        for (int ai = 0; ai < 2; ++ai)
#pragma unroll
            for (int bj = 0; bj < 2; ++bj)
#pragma unroll
                for (int m = 0; m < 4; ++m)
#pragma unroll
                    for (int n = 0; n < 2; ++n) asm volatile("" :: "v"(acc[ai][bj][m][n]));
    }
};

template <bool I8> struct AccT { typedef f32x4 T; }; template <> struct AccT<true> { typedef i32x4 T; };
template <class Epi, class Sched, bool ALIGN_EPI = false, bool SP2 = false, bool I8 = false>
__device__ __forceinline__ void gemm_phase(PG8_LAS unsigned char* lds, const Gemm g, const Sched& S, const Epi& E) {
    int tid_ = threadIdx.x; asm volatile("" : "+v"(tid_));
    const int tid = tid_, wid = __builtin_amdgcn_readfirstlane(tid >> 6), lane = tid & 63, wr = wid >> 2, wc = wid & 3, fr = lane & 15, fq = lane >> 4;
    int K_ = g.K; asm volatile("" : "+s"(K_));
    const int K = K_, nt = K / BK;
    unsigned voffA[2], voffB[2];
#pragma unroll
    for (int i = 0; i < 2; ++i) { int R, C; stage_rc(tid * 16 + i * 8192, R, C); const int Rb = Epi::PERM ? ((R & ~31) + perm32(R & 31)) : R;
        voffA[i] = (unsigned)(R * K + C) * 2u; voffB[i] = (unsigned)(Rb * K + C) * 2u; }
    const size_t kstep = (size_t)(BK * 2);
    const size_t hstep = (size_t)HALF * K * 2;
    const size_t tstep = 2 * hstep;
    const unsigned ldsw = (unsigned)wid * 1024u;
    const int aoff = lds_byte(wr * 64 + fr, fq * 8), boff = lds_byte(wc * 32 + fr, fq * 8);
#define PG8_SA(b, h) (((b) * 2 + (h)) * HTB)
#define PG8_SB(b, h) ((4 + (b) * 2 + (h)) * HTB)
#define PG8_STAGE(bufoff, gbase, voff) do { _Pragma("unroll") for (int _i = 0; _i < 2; ++_i) \
        __builtin_amdgcn_global_load_lds((const unsigned*)((const char*)(gbase) + (voff)[_i]), (PG8_LAS unsigned*)(lds + (bufoff) + ldsw + _i * 8192), 16, 0, 0); } while (0)
#define PG8_LDA(dst, b, h) do { _Pragma("unroll") for (int m = 0; m < 4; ++m) _Pragma("unroll") for (int k = 0; k < 2; ++k) dst[m][k] = *(const PG8_LAS bf16x8*)(lds + PG8_SA(b, h) + aoff + m * 2048 + k * 1024); } while (0)
#define PG8_LDB(dst, b, h) do { _Pragma("unroll") for (int n = 0; n < 2; ++n) _Pragma("unroll") for (int k = 0; k < 2; ++k) dst[n][k] = *(const PG8_LAS bf16x8*)(lds + PG8_SB(b, h) + boff + n * 2048 + k * 1024); } while (0)
#define PG8_MMA(ai, bj, At, Bt) do { __builtin_amdgcn_s_setprio(1); _Pragma("unroll") for (int m = 0; m < 4; ++m) _Pragma("unroll") for (int n = 0; n < 2; ++n) _Pragma("unroll") for (int k = 0; k < 2; ++k) \
        { if constexpr (I8) acc[ai][bj][m][n] = __builtin_amdgcn_mfma_i32_16x16x64_i8(__builtin_bit_cast(i32x4, Bt[n][k]), __builtin_bit_cast(i32x4, At[m][k]), acc[ai][bj][m][n], 0, 0, 0); \
          else acc[ai][bj][m][n] = __builtin_amdgcn_mfma_f32_16x16x32_bf16(Bt[n][k], At[m][k], acc[ai][bj][m][n], 0, 0, 0); } __builtin_amdgcn_s_setprio(0); } while (0)
#define PG8_WAIT_V(n) asm volatile("s_waitcnt vmcnt(" #n ")" ::: "memory")
#define PG8_WAIT_L(n) asm volatile("s_waitcnt lgkmcnt(" #n ")" ::: "memory")
#define PG8_BAR __builtin_amdgcn_s_barrier()
#define PG8_SCHED __builtin_amdgcn_sched_barrier(0)
    Unit cur, nxt; int ui = 0;
    if (!S.next(0, cur)) return;
    typedef typename AccT<I8>::T acc_t; acc_t acc[2][2][4][2];
#pragma unroll
    for (int a = 0; a < 2; ++a)
#pragma unroll
        for (int b = 0; b < 2; ++b)
#pragma unroll
            for (int m = 0; m < 4; ++m)
#pragma unroll
                for (int n = 0; n < 2; ++n) acc[a][b][m][n] = (acc_t){0, 0, 0, 0};
    bf16x8 At[4][2], B0[2][2], B1[2][2];
    const char* cA = (const char*)g.A + (size_t)cur.pm * tstep; const char* cB = (const char*)g.Bt + (size_t)cur.pn * tstep;
    S.a_ready(cur);
    if constexpr (SP2) {
        PG8_STAGE(PG8_SB(0, 0), cB, voffB); PG8_STAGE(PG8_SB(0, 1), cB + hstep, voffB); PG8_STAGE(PG8_SA(0, 0), cA, voffA); PG8_STAGE(PG8_SA(0, 1), cA + hstep, voffA);
        if (wr == 1) PG8_BAR;
        PG8_WAIT_V(2); PG8_BAR;
        PG8_STAGE(PG8_SB(1, 0), cB + kstep, voffB); PG8_STAGE(PG8_SA(1, 0), cA + kstep, voffA); PG8_STAGE(PG8_SB(1, 1), cB + hstep + kstep, voffB);
        PG8_WAIT_V(6); PG8_BAR;
    } else {
        PG8_STAGE(PG8_SB(0, 0), cB, voffB); PG8_STAGE(PG8_SA(0, 0), cA, voffA); PG8_STAGE(PG8_SB(0, 1), cB + hstep, voffB); PG8_STAGE(PG8_SA(0, 1), cA + hstep, voffA);
        if (wr == 1) PG8_BAR;
        PG8_WAIT_V(4); PG8_BAR;
        PG8_STAGE(PG8_SB(1, 0), cB + kstep, voffB); PG8_STAGE(PG8_SA(1, 0), cA + kstep, voffA); PG8_STAGE(PG8_SB(1, 1), cB + hstep + kstep, voffB);
        PG8_WAIT_V(6); PG8_BAR;
    }
    for (;;) {
        const bool has_next = S.next(ui + 1, nxt);
        const char* nA = has_next ? (const char*)g.A + (size_t)nxt.pm * tstep : cA; const char* nB = has_next ? (const char*)g.Bt + (size_t)nxt.pn * tstep : cB;
        for (int t = 0; t < nt; t += 2) {
            const bool last = (t == nt - 2);
            const char* a1 = cA + (size_t)(t + 1) * kstep;
            const char* a2 = last ? nA : cA + (size_t)(t + 2) * kstep; const char* b2 = last ? nB : cB + (size_t)(t + 2) * kstep;
            const char* a3 = a2 + kstep; const char* b3 = b2 + kstep;
            if (last && has_next) S.a_ready(nxt);
            if constexpr (SP2) {
            PG8_LDB(B0, 0, 0); PG8_LDB(B1, 0, 1); PG8_SCHED; PG8_LDA(At, 0, 0); PG8_STAGE(PG8_SA(1, 1), a1 + hstep, voffA);
            PG8_WAIT_V(8); PG8_WAIT_L(0); PG8_BAR; PG8_MMA(0, 0, At, B0); PG8_MMA(0, 1, At, B1); PG8_BAR; PG8_SCHED;
            PG8_LDA(At, 0, 1); PG8_STAGE(PG8_SB(0, 0), b2, voffB); PG8_STAGE(PG8_SB(0, 1), b2 + hstep, voffB); PG8_STAGE(PG8_SA(0, 0), a2, voffA);
            PG8_WAIT_V(8); PG8_WAIT_L(0); PG8_BAR; PG8_MMA(1, 0, At, B0); PG8_MMA(1, 1, At, B1); PG8_BAR; PG8_SCHED;
            PG8_LDB(B0, 1, 0); PG8_LDB(B1, 1, 1); PG8_SCHED; PG8_LDA(At, 1, 0); PG8_STAGE(PG8_SA(0, 1), a2 + hstep, voffA);
            PG8_WAIT_V(8); PG8_WAIT_L(0); PG8_BAR; PG8_MMA(0, 0, At, B0); PG8_MMA(0, 1, At, B1); PG8_BAR; PG8_SCHED;
            PG8_LDA(At, 1, 1); PG8_STAGE(PG8_SB(1, 0), b3, voffB); PG8_STAGE(PG8_SB(1, 1), b3 + hstep, voffB); PG8_STAGE(PG8_SA(1, 0), a3, voffA);
            PG8_WAIT_V(8); PG8_WAIT_L(0); PG8_BAR; PG8_MMA(1, 0, At, B0); PG8_MMA(1, 1, At, B1); PG8_BAR; PG8_SCHED;
            } else {
            PG8_LDB(B0, 0, 0); PG8_SCHED; PG8_LDA(At, 0, 0); PG8_STAGE(PG8_SA(1, 1), a1 + hstep, voffA);
            PG8_WAIT_L(8); PG8_BAR; PG8_WAIT_L(0); PG8_MMA(0, 0, At, B0); PG8_BAR; PG8_SCHED;
            PG8_LDB(B1, 0, 1); PG8_STAGE(PG8_SB(0, 0), b2, voffB);
            PG8_BAR; PG8_WAIT_L(0); PG8_MMA(0, 1, At, B1); PG8_BAR;
            PG8_LDA(At, 0, 1); PG8_STAGE(PG8_SA(0, 0), a2, voffA);
            PG8_BAR; PG8_WAIT_L(0); PG8_MMA(1, 0, At, B0); PG8_BAR; PG8_SCHED;
            PG8_STAGE(PG8_SB(0, 1), b2 + hstep, voffB);
            PG8_WAIT_V(6); PG8_BAR; PG8_MMA(1, 1, At, B1); PG8_BAR;
            PG8_LDB(B0, 1, 0); PG8_SCHED; PG8_LDA(At, 1, 0); PG8_STAGE(PG8_SA(0, 1), a2 + hstep, voffA);
            PG8_WAIT_L(8); PG8_BAR; PG8_WAIT_L(0); PG8_MMA(0, 0, At, B0); PG8_BAR; PG8_SCHED;
            PG8_LDB(B1, 1, 1); PG8_STAGE(PG8_SB(1, 0), b3, voffB);
            PG8_BAR; PG8_WAIT_L(0); PG8_MMA(0, 1, At, B1); PG8_BAR;
            PG8_LDA(At, 1, 1); PG8_STAGE(PG8_SA(1, 0), a3, voffA);
            PG8_BAR; PG8_WAIT_L(0); PG8_MMA(1, 0, At, B0); PG8_BAR; PG8_SCHED;
            PG8_STAGE(PG8_SB(1, 1), b3 + hstep, voffB);
            PG8_WAIT_V(6); PG8_BAR; PG8_MMA(1, 1, At, B1); PG8_BAR;
            }
        }
        if constexpr (ALIGN_EPI) { if (wr == 0) PG8_BAR; }
        if constexpr (!Epi::AFTER_DRAIN) { E(acc, cur, wr, wc, fr, fq); S.done(cur); }
        if (!has_next) break;
#pragma unroll
        for (int a = 0; a < 2; ++a)
#pragma unroll
            for (int b = 0; b < 2; ++b)
#pragma unroll
                for (int m = 0; m < 4; ++m)
#pragma unroll
                    for (int n = 0; n < 2; ++n) acc[a][b][m][n] = (acc_t){0, 0, 0, 0};
        cur = nxt; cA = nA; cB = nB; ++ui;
        if constexpr (ALIGN_EPI) { if (wr == 1) PG8_BAR; }
    }
    PG8_WAIT_V(0);
    if constexpr (!ALIGN_EPI) { if (wr == 0) PG8_BAR; }
    PG8_BAR;
    if constexpr (Epi::AFTER_DRAIN) { E.fused(acc, cur, wr, wc, fr, fq, lds, wid, lane); S.done(cur); }
#undef PG8_SA
#undef PG8_SB
#undef PG8_STAGE
#undef PG8_LDA
#undef PG8_LDB
#undef PG8_MMA
#undef PG8_WAIT_V
#undef PG8_WAIT_L
#undef PG8_BAR
#undef PG8_SCHED
}
}
#ifndef PG8_SP2
#define PG8_SP2 true
#endif
#ifndef PG8_ALIGN
#define PG8_ALIGN true
#endif
constexpr int NWAVES = 8;
constexpr int BATCH = 4, SEQ = 8192, D = 1024, FF = 2816, NGU = 2 * FF, NIN = 5632, PLE = 256;
constexpr int M = BATCH * SEQ;
constexpr int MBH = 8, MBD = 64, MBW = 512, MBB = 256, NBLK = SEQ / MBB;
constexpr int HGH = 4, HGD_ = 128, HGW = 512, HGC = 256, HGNC = SEQ / HGC;
constexpr float EPS = 1e-6f;
constexpr size_t MiB = 1u << 20;
constexpr size_t WS_CTL = 0, CTL_ZERO_BYTES = 1 * MiB;
constexpr size_t WS_KMEAN = 512 * 1024;
constexpr size_t WS_LB = 768 * 1024, WS_BIAST = 772 * 1024;
constexpr size_t WS_WGU1 = 1 * MiB, WS_WD1 = 12 * MiB, WS_WIN = WS_WD1 + 5632 * 1024, WS_WA = WS_WIN + 11 * MiB, WS_WB = WS_WA + 1 * MiB, WS_WOUT = WS_WB + 1 * MiB,
                 WS_WGU2 = WS_WOUT + 2 * MiB, WS_WD2 = WS_WGU2 + 11 * MiB, WS_WPLE = WS_WD2 + 5632 * 1024, WS_WPG = WS_WPLE + 512 * 1024, WS_HGD = WS_WPG + 2 * MiB;
constexpr size_t WS_CMAX = 128 * 1024;
constexpr size_t WS_CNT = 256 * 1024;
constexpr size_t WS_A = 52 * MiB;
constexpr size_t WS_Q = WS_A, WS_K = WS_A + 32 * MiB, WS_VT = WS_A + 64 * MiB, WS_HQ = WS_A + 96 * MiB, WS_HI = WS_A + 128 * MiB;
constexpr size_t WS_LIST = 212 * MiB;
constexpr size_t WS_PB = 228 * MiB;
constexpr size_t WS_SB = 228 * MiB;
constexpr size_t WS_RS = 300 * MiB;
constexpr size_t WS_PML = 292 * MiB;
constexpr size_t WS_B = 320 * MiB;
constexpr size_t WS_KIN = WS_B, WS_HG = WS_B + 32 * MiB, WS_SA = WS_B + 64 * MiB;
constexpr size_t WS_C = 448 * MiB;
constexpr size_t WS_HS = WS_C, WS_OA = WS_C, WS_OB = WS_C + 32 * MiB;
constexpr size_t WS_PO0 = WS_HQ, WS_PO1 = WS_HI, WS_PO2 = WS_KIN, WS_PO3 = WS_HG;
constexpr size_t WS_END = 512 * MiB;
static_assert(WS_HGD + 256 * 1024 <= WS_A, "weights region");
constexpr int LIST_PER_BH = 126976;
constexpr int CW_TMO = 0, CW_CODE = 1, CW_BAR = 4096;
constexpr int RING_OFF = 0, RING_BYTES = 131072, LDSCTL_OFF = RING_BYTES, MISC_OFF = LDSCTL_OFF + 320, LDS_BYTES = 147456;
#define GAS __attribute__((address_space(1)))
#define LAS __attribute__((address_space(3)))
typedef unsigned short bf16;
typedef unsigned v4u __attribute__((ext_vector_type(4)));
typedef unsigned v2u __attribute__((ext_vector_type(2)));
typedef float f32x4 __attribute__((ext_vector_type(4)));
typedef GAS unsigned gu32;
#define RLX_AGENT __ATOMIC_RELAXED, __HIP_MEMORY_SCOPE_AGENT
#define LDS_WAIT() asm volatile("s_waitcnt lgkmcnt(0)" ::: "memory")
#define VM_WAIT() asm volatile("s_waitcnt vmcnt(0)" ::: "memory")
__device__ __forceinline__ unsigned f2bf(float f) { unsigned u = __builtin_bit_cast(unsigned, f); return (u + 0x7fffu + ((u >> 16) & 1u)) >> 16; }
__device__ __forceinline__ unsigned pk2(float lo, float hi) { return f2bf(lo) | (f2bf(hi) << 16); }
__device__ __forceinline__ float bflo(unsigned w) { return __uint_as_float(w << 16); }
__device__ __forceinline__ float bfhi(unsigned w) { return __uint_as_float(w & 0xffff0000u); }
__device__ __forceinline__ float wave_sum(float v) {
#pragma unroll
    for (int o = 1; o < 64; o <<= 1) v += __shfl_xor(v, o);
    return v;
}
__device__ __forceinline__ float wave_max(float v) {
#pragma unroll
    for (int o = 1; o < 64; o <<= 1) v = fmaxf(v, __shfl_xor(v, o));
    return v;
}
#define XB_TMO      128
#define XB_XCNT(j)  (256  + 64 * (j))
#define XB_XSUB(j)  (1280 + 64 * (j))
#define XB_XGEN(j)  (2304 + 64 * (j))
#define XB_TOP      3328
#define XB_TOPGEN   3392
#define XCD_BAR_WORDS 3456
#define XB_SPIN_CAP (1u << 18)

__device__ __forceinline__ unsigned xb_ld(unsigned* p)              { return __hip_atomic_load(p, __ATOMIC_RELAXED, __HIP_MEMORY_SCOPE_AGENT); }
__device__ __forceinline__ unsigned xb_add(unsigned* p, unsigned v) { return __hip_atomic_fetch_add(p, v, __ATOMIC_RELAXED, __HIP_MEMORY_SCOPE_AGENT); }
__device__ __forceinline__ unsigned xb_xcc_id() { return (unsigned)__builtin_amdgcn_s_getreg((3 << 11) | 20) & 0xFu; }
#define XB_SPIN(cond, bar) do { unsigned _sp = 0; while (cond) { __builtin_amdgcn_s_sleep(1); \
    if ((++_sp & 255u) == 0u) { if (xb_ld(&(bar)[XB_TMO])) break; if (_sp > XB_SPIN_CAP) { atomicAdd(&(bar)[XB_TMO], 1u); break; } } } } while (0)

struct XcdBarrier {
    unsigned* bar; unsigned x;
    volatile LAS unsigned* st;
};

__device__ __forceinline__ XcdBarrier xcd_barrier_post(unsigned* bar, volatile LAS unsigned* st) {
    XcdBarrier b; b.bar = bar; b.x = xb_xcc_id(); b.st = st;
    if (threadIdx.x == 0) (void)xb_add(&bar[XB_XCNT(b.x)], 1u);
    return b;
}
__device__ __forceinline__ void xcd_barrier_complete(unsigned* bar, unsigned x, unsigned& nloc, unsigned& nx) {
    const unsigned G = gridDim.x * gridDim.y * gridDim.z;
    unsigned sum, cnt, mine, sp = 0u;
    for (;;) {
        sum = 0u; cnt = 0u; mine = 0u;
#pragma unroll
        for (unsigned j = 0; j < 16; ++j) { const unsigned c = xb_ld(&bar[XB_XCNT(j)]); sum += c; cnt += (c > 0u) ? 1u : 0u; mine = (j == x) ? c : mine; }
        if (sum == G) break;
        __builtin_amdgcn_s_sleep(1);
        if ((++sp & 255u) == 0u) { if (xb_ld(&bar[XB_TMO])) break; if (sp > XB_SPIN_CAP) { atomicAdd(&bar[XB_TMO], 1u); break; } }
    }
    nloc = mine > 0u ? mine : 1u; nx = cnt > 0u ? cnt : 1u;
}

__device__ __forceinline__ void xcd_barrier(const XcdBarrier& b) {
    asm volatile("s_waitcnt vmcnt(0)" ::: "memory");
    __syncthreads();
    if (threadIdx.x == 0) {
        unsigned* bar = b.bar;
        __builtin_amdgcn_s_waitcnt(0);
        unsigned nloc = b.st[0], nx = b.st[1];
        if (nloc == 0u) { xcd_barrier_complete(bar, b.x, nloc, nx); b.st[0] = nloc; b.st[1] = nx; }
        const unsigned old = xb_add(&bar[XB_XSUB(b.x)], 1u);
        const unsigned gen = old / nloc;
        if (old + 1u == (gen + 1u) * nloc) {
            __builtin_amdgcn_fence(__ATOMIC_RELEASE, "agent");
            asm volatile("s_waitcnt vmcnt(0)" ::: "memory");
            const unsigned og = xb_add(&bar[XB_TOP], 1u);
            const unsigned tg = og / nx;
            if (og + 1u == (tg + 1u) * nx) xb_add(&bar[XB_TOPGEN], 1u);
            else XB_SPIN(xb_ld(&bar[XB_TOPGEN]) == tg, bar);
            __builtin_amdgcn_fence(__ATOMIC_ACQUIRE, "agent");
            xb_add(&bar[XB_XGEN(b.x)], 1u);
            asm volatile("s_waitcnt vmcnt(0)" ::: "memory");
        } else {
            XB_SPIN(xb_ld(&bar[XB_XGEN(b.x)]) == gen, bar);
            __builtin_amdgcn_fence(__ATOMIC_ACQUIRE, "agent");
            asm volatile("s_waitcnt vmcnt(0)" ::: "memory");
        }
    }
    __syncthreads();
}
__device__ __forceinline__ void p0_transpose_item(const float* W, int K, int N, bf16* WT, const float* gain, int mode, LAS float* scr, int item, int lane) {
    const int nblk = N / 32, kb = item / nblk, nb = item % nblk, k0 = 64 * kb, n0 = 32 * nb;
#pragma unroll 8
    for (int i = 0; i < 32; ++i) { const int kk = 2 * i + (lane >> 5); float w = W[(size_t)(k0 + kk) * N + n0 + (lane & 31)]; if (gain) w *= gain[k0 + kk]; scr[kk * 33 + (lane & 31)] = w; }
    LDS_WAIT(); asm volatile("" ::: "memory");
    int rbase = n0;
    if (mode == 1) { if (n0 < FF) rbase = (n0 / 128) * 256 + (n0 % 128); else { const int j = n0 - FF; rbase = (j / 128) * 256 + 128 + (j % 128); } }
    if (mode == 2) { if (n0 >= 1024 && n0 < 1536) rbase = 5120 + (n0 - 1024); else if (n0 >= 1536) rbase = n0 - 512; }
    const int c = lane & 7;
#pragma unroll
    for (int j = 0; j < 4; ++j) { const int n = (lane >> 3) + 8 * j; const LAS float* s = scr + (8 * c) * 33 + n;
        v4u o; o.x = pk2(s[0 * 33], s[1 * 33]); o.y = pk2(s[2 * 33], s[3 * 33]); o.z = pk2(s[4 * 33], s[5 * 33]); o.w = pk2(s[6 * 33], s[7 * 33]);
        *(GAS v4u*)(WT + (size_t)(rbase + n) * K + k0 + 8 * c) = o; }
    LDS_WAIT(); asm volatile("" ::: "memory");
}
__device__ __forceinline__ int gu_row(int n0) { if (n0 < FF) return (n0 / 128) * 256 + (n0 % 128); const int j = n0 - FF; return (j / 128) * 256 + 128 + (j % 128); }
__device__ __forceinline__ void p0_colmax_item(const float* W, int N, const float* gain, unsigned* CMAXB, int item, int lane) {
    const int nblk = N / 32, kb = item / nblk, nb = item % nblk, k0 = 64 * kb, n0 = 32 * nb; float mx = 0.f;
#pragma unroll 8
    for (int i = 0; i < 32; ++i) { const int kk = 2 * i + (lane >> 5); mx = fmaxf(mx, fabsf(W[(size_t)(k0 + kk) * N + n0 + (lane & 31)] * gain[k0 + kk])); }
    mx = fmaxf(mx, __shfl_xor(mx, 32));
    if (lane < 32) atomicMax(CMAXB + gu_row(n0) + lane, __float_as_uint(mx));
}
__device__ __forceinline__ void p0_quant_item(const float* W, int N, const float* gain, const float* CMAX, signed char* W8, int K, LAS float* scr, int item, int lane) {
    const int nblk = N / 32, kb = item / nblk, nb = item % nblk, k0 = 64 * kb, n0 = 32 * nb, rbase = gu_row(n0);
    const float inv = 127.0f / fmaxf(CMAX[rbase + (lane & 31)], 1e-30f);
#pragma unroll 8
    for (int i = 0; i < 32; ++i) { const int kk = 2 * i + (lane >> 5); scr[kk * 33 + (lane & 31)] = rintf(W[(size_t)(k0 + kk) * N + n0 + (lane & 31)] * gain[k0 + kk] * inv); }
    LDS_WAIT(); asm volatile("" ::: "memory");
    const int c = lane & 3;
#pragma unroll
    for (int j = 0; j < 2; ++j) { const int n = (lane >> 2) + 16 * j; const LAS float* sp = scr + (16 * c) * 33 + n; unsigned w[4];
#pragma unroll
        for (int q = 0; q < 4; ++q) { const int b0 = (int)sp[(4 * q) * 33], b1 = (int)sp[(4 * q + 1) * 33], b2 = (int)sp[(4 * q + 2) * 33], b3 = (int)sp[(4 * q + 3) * 33];
            w[q] = (unsigned)(b0 & 255) | ((unsigned)(b1 & 255) << 8) | ((unsigned)(b2 & 255) << 16) | ((unsigned)(b3 & 255) << 24); }
        *(GAS v4u*)(W8 + (size_t)(rbase + n) * K + k0 + 16 * c) = (v4u){w[0], w[1], w[2], w[3]}; }
    LDS_WAIT(); asm volatile("" ::: "memory");
}
__device__ __forceinline__ void row_to_i8(const f32x4 (&v)[4], float rstd, signed char* orow, float* rs, int lane) {
    float mx = 0.f;
#pragma unroll
    for (int j = 0; j < 4; ++j) mx = fmaxf(fmaxf(mx, fmaxf(fabsf(v[j].x), fabsf(v[j].y))), fmaxf(fabsf(v[j].z), fabsf(v[j].w)));
    mx = fmaxf(wave_max(mx), 1e-30f); const float inv = 127.0f / mx;
    GAS unsigned* o4 = (GAS unsigned*)orow + lane;
#pragma unroll
    for (int j = 0; j < 4; ++j) { const int b0 = (int)rintf(v[j].x * inv), b1 = (int)rintf(v[j].y * inv), b2 = (int)rintf(v[j].z * inv), b3 = (int)rintf(v[j].w * inv);
        o4[64 * j] = (unsigned)(b0 & 255) | ((unsigned)(b1 & 255) << 8) | ((unsigned)(b2 & 255) << 16) | ((unsigned)(b3 & 255) << 24); }
    if (lane == 0) *rs = mx * rstd * (1.0f / 127.0f);
}
__device__ __forceinline__ void rms_row_to_i8(const float* xrow, signed char* orow, float* rs, int lane) {
    const GAS f32x4* xr = (const GAS f32x4*)xrow + lane;
    f32x4 v[4]; float s = 0.f;
#pragma unroll
    for (int j = 0; j < 4; ++j) { v[j] = xr[64 * j]; s += (v[j].x * v[j].x + v[j].y * v[j].y) + (v[j].z * v[j].z + v[j].w * v[j].w); }
    const float rstd = 1.f / sqrtf(wave_sum(s) * (1.f / D) + EPS);
    row_to_i8(v, rstd, orow, rs, lane);
}
__device__ __forceinline__ void rms_row_to_bf16(const float* xrow, bf16* orow, int lane) {
    const GAS f32x4* xr = (const GAS f32x4*)xrow + lane;
    f32x4 v[4]; float s = 0.f;
#pragma unroll
    for (int j = 0; j < 4; ++j) { v[j] = xr[64 * j]; s += (v[j].x * v[j].x + v[j].y * v[j].y) + (v[j].z * v[j].z + v[j].w * v[j].w); }
    const float rstd = 1.f / sqrtf(wave_sum(s) * (1.f / D) + EPS);
    GAS unsigned long long* o8 = (GAS unsigned long long*)orow + lane;
#pragma unroll
    for (int j = 0; j < 4; ++j) o8[64 * j] = (unsigned long long)pk2(v[j].x * rstd, v[j].y * rstd) | ((unsigned long long)pk2(v[j].z * rstd, v[j].w * rstd) << 32);
}
struct Ptrs {
    const float *x, *p, *w_gu1, *w_d1, *w_in, *w_a, *w_b, *w_out, *w_gu2, *w_d2, *w_ple, *w_pg, *gains, *hgw, *lbp, *rel;
    float* out; unsigned char* ws;
};
__device__ __forceinline__ void p0_prologue(const Ptrs P, LAS unsigned char* lds, int gw, int NGW, int wave, int lane) {
    LAS float* scr = (LAS float*)(lds + RING_OFF + wave * 16384);
    unsigned char* ws = P.ws;
    constexpr int I_GU = (D / 64) * (NGU / 32), I_D = (FF / 64) * (D / 32), I_IN = (D / 64) * (NIN / 32), I_AB = (512 / 64) * (D / 32), I_O = (D / 64) * (D / 32), I_PLE = (PLE / 64) * (D / 32);
    constexpr int NITEMS = 2 * I_GU + 2 * I_D + I_IN + 2 * I_AB + 2 * I_O + I_PLE;
    for (int it = gw; it < NITEMS; it += NGW) {
        int r = it;
        if (r < I_GU) { p0_colmax_item(P.w_gu1, NGU, P.gains + 0 * D, (unsigned*)(ws + WS_CMAX), r, lane); continue; } r -= I_GU;
        if (r < I_GU) { p0_colmax_item(P.w_gu2, NGU, P.gains + 4 * D, (unsigned*)(ws + WS_CMAX) + NGU, r, lane); continue; } r -= I_GU;
        if (r < I_IN) { p0_transpose_item(P.w_in, D, NIN, (bf16*)(ws + WS_WIN), P.gains + 2 * D, 2, scr, r, lane); continue; } r -= I_IN;
        if (r < I_D)  { p0_transpose_item(P.w_d1, FF, D, (bf16*)(ws + WS_WD1), nullptr, 0, scr, r, lane); continue; } r -= I_D;
        if (r < I_D)  { p0_transpose_item(P.w_d2, FF, D, (bf16*)(ws + WS_WD2), nullptr, 0, scr, r, lane); continue; } r -= I_D;
        if (r < I_AB) { p0_transpose_item(P.w_a, 512, D, (bf16*)(ws + WS_WA), nullptr, 0, scr, r, lane); continue; } r -= I_AB;
        if (r < I_AB) { p0_transpose_item(P.w_b, 512, D, (bf16*)(ws + WS_WB), nullptr, 0, scr, r, lane); continue; } r -= I_AB;
        if (r < I_O)  { p0_transpose_item(P.w_out, D, D, (bf16*)(ws + WS_WOUT), nullptr, 0, scr, r, lane); continue; } r -= I_O;
        if (r < I_O)  { p0_transpose_item(P.w_pg, D, D, (bf16*)(ws + WS_WPG), nullptr, 0, scr, r, lane); continue; } r -= I_O;
        p0_transpose_item(P.w_ple, PLE, D, (bf16*)(ws + WS_WPLE), nullptr, 0, scr, r, lane);
    }
    for (int m = gw; m < M; m += NGW) rms_row_to_i8(P.x + (size_t)m * D, (signed char*)(ws + WS_C) + (size_t)m * D, (float*)(ws + WS_RS) + m, lane);
    const int gt = gw * 64 + lane;
    if (gt < 512) { const float a = P.lbp[gt], b = P.lbp[512 + gt]; const float mx = fmaxf(a, b); const float ea = expf(a - mx), eb = expf(b - mx); ((float*)(ws + WS_LB))[gt] = ea / (ea + eb); }
    if (gt >= 1024 && gt < 2048) { const int h = (gt - 1024) >> 7, d = (gt - 1024) & 127; int bk;
        if (d < 16) bk = d; else { bk = 16 + (int)(logf((float)d / 16.0f) / logf(8.0f) * 16.0f); if (bk > 31) bk = 31; }
        ((float*)(ws + WS_BIAST))[h * 128 + d] = P.rel[bk * 8 + h]; }
}
__device__ __forceinline__ void p0b_quant_phase(const Ptrs P, LAS unsigned char* lds, int gw, int NGW, int wave, int lane) {
    LAS float* scr = (LAS float*)(lds + RING_OFF + wave * 16384); unsigned char* ws = P.ws;
    constexpr int I_GU = (D / 64) * (NGU / 32);
    for (int it = gw; it < 2 * I_GU; it += NGW) {
        if (it < I_GU) p0_quant_item(P.w_gu1, NGU, P.gains + 0 * D, (const float*)(ws + WS_CMAX), (signed char*)(ws + WS_WGU1), D, scr, it, lane);
        else p0_quant_item(P.w_gu2, NGU, P.gains + 4 * D, (const float*)(ws + WS_CMAX) + NGU, (signed char*)(ws + WS_WGU2), D, scr, it - I_GU, lane);
    }
}
template <bool HIN_F32, int OMODE> __device__ __forceinline__ void rowwise_phase(int gw, int NGW, int lane, const void* hin, const bf16* Y, const float* gain, float coef, bf16* hb, bf16* xn, float* outf) {
    f32x4 g[4];
#pragma unroll
    for (int j = 0; j < 4; ++j) g[j] = ((const f32x4*)gain)[lane + 64 * j] * coef;
    for (int m = gw; m < M; m += NGW) {
        const GAS v2u* yr = (const GAS v2u*)(Y + (size_t)m * D) + lane;
        f32x4 y[4], h[4]; float s = 0.f;
#pragma unroll
        for (int j = 0; j < 4; ++j) { const v2u w = yr[64 * j]; y[j] = (f32x4){bflo(w.x), bfhi(w.x), bflo(w.y), bfhi(w.y)}; s += (y[j].x * y[j].x + y[j].y * y[j].y) + (y[j].z * y[j].z + y[j].w * y[j].w); }
        if (HIN_F32) { const GAS f32x4* hr = (const GAS f32x4*)((const float*)hin + (size_t)m * D) + lane;
#pragma unroll
            for (int j = 0; j < 4; ++j) h[j] = hr[64 * j]; }
        else { const GAS v2u* hr = (const GAS v2u*)((const bf16*)hin + (size_t)m * D) + lane;
#pragma unroll
            for (int j = 0; j < 4; ++j) { const v2u w = hr[64 * j]; h[j] = (f32x4){bflo(w.x), bfhi(w.x), bflo(w.y), bfhi(w.y)}; } }
        const float rstd = 1.f / sqrtf(wave_sum(s) * (1.f / D) + EPS);
        float s2 = 0.f;
#pragma unroll
        for (int j = 0; j < 4; ++j) { h[j] = h[j] + (g[j] * y[j]) * rstd; s2 += (h[j].x * h[j].x + h[j].y * h[j].y) + (h[j].z * h[j].z + h[j].w * h[j].w); }
        if (OMODE == 3) { GAS f32x4* ho = (GAS f32x4*)(outf + (size_t)m * D) + lane;
#pragma unroll
            for (int j = 0; j < 4; ++j) ho[64 * j] = h[j]; }
        if (OMODE == 1 || OMODE == 4) { GAS v2u* ho = (GAS v2u*)(hb + (size_t)m * D) + lane;
#pragma unroll
            for (int j = 0; j < 4; ++j) ho[64 * j] = (v2u){pk2(h[j].x, h[j].y), pk2(h[j].z, h[j].w)}; }
        if (OMODE == 4) { const float r2 = 1.f / sqrtf(wave_sum(s2) * (1.f / D) + EPS); row_to_i8(h, r2, (signed char*)xn + (size_t)m * D, outf + m, lane); }
        if (OMODE == 1 || OMODE == 2) {
            float r2 = 1.f;
            if (OMODE == 1) r2 = 1.f / sqrtf(wave_sum(s2) * (1.f / D) + EPS);
            GAS v2u* o8 = (GAS v2u*)(xn + (size_t)m * D) + lane;
#pragma unroll
            for (int j = 0; j < 4; ++j) o8[64 * j] = (v2u){pk2(h[j].x * r2, h[j].y * r2), pk2(h[j].z * r2, h[j].w * r2)};
        }
    }
}
__device__ __forceinline__ int moba_list_base(int bh, int j) { return bh * LIST_PER_BH + 256 * (31 * j - (j * (j - 1)) / 2); }
__device__ __forceinline__ void moba_gating_phase(LAS unsigned char* lds, int vcu, int G, int tid, const bf16* Q, const float* KMEAN, unsigned* CNT, unsigned* LIST) {
    LAS float* km = (LAS float*)lds;
    const int lane = tid & 63;
    for (int unit = vcu; unit < BATCH * NBLK * 4; unit += G) {
        const int hp = unit & 3, i = (unit >> 2) & 31, b = unit >> 7;
        __syncthreads();
        for (int e = tid; e < i * 128; e += 512) { const int j = e >> 7, c = e & 127; km[e] = KMEAN[(size_t)(b * NBLK + j) * 512 + hp * 128 + c] * (1.0f / 256.0f); }
        __syncthreads();
        const int hh = __builtin_amdgcn_readfirstlane(tid >> 8), ql = tid & 255, m = b * SEQ + i * MBB + ql, h = 2 * hp + hh;
        float q[64];
        { const v4u* qp = (const v4u*)(Q + (size_t)m * MBW + h * MBD);
#pragma unroll
          for (int c = 0; c < 8; ++c) { const v4u w = qp[c]; q[8 * c + 0] = bflo(w.x); q[8 * c + 1] = bfhi(w.x); q[8 * c + 2] = bflo(w.y); q[8 * c + 3] = bfhi(w.y); q[8 * c + 4] = bflo(w.z); q[8 * c + 5] = bfhi(w.z); q[8 * c + 6] = bflo(w.w); q[8 * c + 7] = bfhi(w.w); } }
        float v0 = -INFINITY, v1 = -INFINITY, v2 = -INFINITY; int i0 = -1, i1 = -1, i2 = -1;
        for (int j = 0; j < i; ++j) {
            const LAS f32x4* kp = (const LAS f32x4*)(km + j * 128 + hh * 64); float s = 0.f;
#pragma unroll
            for (int c = 0; c < 16; ++c) { const f32x4 kv = kp[c]; s += q[4 * c] * kv.x; s += q[4 * c + 1] * kv.y; s += q[4 * c + 2] * kv.z; s += q[4 * c + 3] * kv.w; }
            if (s > v0) { v2 = v1; i2 = i1; v1 = v0; i1 = i0; v0 = s; i0 = j; }
            else if (s > v1) { v2 = v1; i2 = i1; v1 = s; i1 = j; }
            else if (s > v2) { v2 = s; i2 = j; }
        }
        const int bh = b * 8 + h; const unsigned tl = (unsigned)(i * MBB + ql); const unsigned long long lt = (1ull << lane) - 1ull;
        for (int j = 0; j < i; ++j) {
            const unsigned long long m0 = __ballot(i0 == j), m1 = __ballot(i1 == j), m2 = __ballot(i2 == j);
            const int c0 = __popcll(m0), c1 = __popcll(m1), c2 = __popcll(m2), tot = c0 + c1 + c2;
            if (tot) {
                unsigned base = 0u; if (lane == 0) base = atomicAdd(CNT + bh * 32 + j, (unsigned)tot);
                base = (unsigned)__builtin_amdgcn_readfirstlane((int)base);
                unsigned* L = LIST + moba_list_base(bh, j) + base;
                if (i0 == j) L[__popcll(m0 & lt)] = tl;
                if (i1 == j) L[c0 + __popcll(m1 & lt)] = tl | (1u << 13);
                if (i2 == j) L[c0 + c1 + __popcll(m2 & lt)] = tl | (2u << 13);
            }
        }
    }
    __syncthreads();
}
typedef float f32x16 __attribute__((ext_vector_type(16)));
typedef short bf16x8v __attribute__((ext_vector_type(8)));
typedef short s16x4v __attribute__((ext_vector_type(4)));
constexpr int IT_KS = 0, IT_VS = 32768, IT_VROW = 520, IT_TB = IT_VS + 64 * IT_VROW  , IT_INFO = IT_TB + 8 * 128 * 4  ;
__device__ __forceinline__ int crow16(int r, int hi) { return (r & 3) + 8 * (r >> 2) + 4 * hi; }
template <bool GENERAL, int NT> __device__ __forceinline__ void moba_item_half(f32x16 (&st)[NT], int half, int ntile, int hi, int dq, float c1, float c0, const LAS float* tb,
                                                                      float& mrun, float& lrun, f32x16 (&o)[2], const LAS unsigned char* vs, int r32) {
    float mloc = -INFINITY;
#pragma unroll
    for (int t4 = 0; t4 < NT; ++t4) { const int kt = half * NT + t4;
        if (kt < ntile) {
#pragma unroll
            for (int r = 0; r < 16; ++r) { float x;
                if (GENERAL) { const int dist = dq - (32 * kt + crow16(r, hi)); const int di = dist > 113 ? 113 : (dist < 0 ? 0 : dist); x = st[t4][r] * c1 + tb[di]; if (dist < 0) x = -INFINITY; }
                else x = st[t4][r] * c1 + c0;
                st[t4][r] = x; mloc = fmaxf(mloc, x); }
        }
    }
    mloc = fmaxf(mloc, __shfl_xor(mloc, 32));
    const float mnew = fmaxf(mrun, mloc);
    const float alpha = __builtin_amdgcn_exp2f(mrun - mnew);
    float ls = 0.f;
#pragma unroll
    for (int t4 = 0; t4 < NT; ++t4) { const int kt = half * NT + t4;
        if (kt < ntile) {
#pragma unroll
            for (int r = 0; r < 16; ++r) { const float pv = __builtin_amdgcn_exp2f(st[t4][r] - mnew); st[t4][r] = pv; ls += pv; }
        }
    }
    ls += __shfl_xor(ls, 32);
    lrun = lrun * alpha + ls; mrun = mnew;
#pragma unroll
    for (int d = 0; d < 2; ++d)
#pragma unroll
        for (int r = 0; r < 16; ++r) o[d][r] *= alpha;
#pragma unroll
    for (int t4 = 0; t4 < NT; ++t4) { const int kt = half * NT + t4;
        if (kt < ntile) {
#pragma unroll
            for (int s = 0; s < 2; ++s) {
                bf16x8v pf; { unsigned w0 = pg8::cvt_pk_bf16(st[t4][8 * s + 0], st[t4][8 * s + 1]), w1 = pg8::cvt_pk_bf16(st[t4][8 * s + 2], st[t4][8 * s + 3]), w2 = pg8::cvt_pk_bf16(st[t4][8 * s + 4], st[t4][8 * s + 5]), w3 = pg8::cvt_pk_bf16(st[t4][8 * s + 6], st[t4][8 * s + 7]);
                    v4u w = {w0, w1, w2, w3}; pf = __builtin_bit_cast(bf16x8v, w); }
#pragma unroll
                for (int d = 0; d < 2; ++d) {
                    const LAS unsigned char* vp = vs + (32 * d + r32) * IT_VROW + (32 * kt + 16 * s + 4 * hi) * 2;
                    const s16x4v lo = *(const LAS s16x4v*)vp, hi4 = *(const LAS s16x4v*)(vp + 16);
                    const bf16x8v va = {lo[0], lo[1], lo[2], lo[3], hi4[0], hi4[1], hi4[2], hi4[3]};
                    o[d] = __builtin_amdgcn_mfma_f32_32x32x16_bf16(va, pf, o[d], 0, 0, 0);
                }
                asm volatile("" ::: "memory");
            }
        }
    }
}
__device__ __forceinline__ void moba_items_phase(LAS unsigned char* lds, int vcu, int G, int tid_in, int wave, int lane, const bf16* Q, const bf16* K, const bf16* VT, const unsigned* CNT, const unsigned* LIST,
                                                 const float* BIAST, bf16* PO0, bf16* PO1, bf16* PO2, bf16* PO3, float* PML) {
    const int r32 = lane & 31, hi = lane >> 5; int tid = tid_in;
    LAS unsigned char* ks = lds + IT_KS; LAS unsigned char* vs = lds + IT_VS; LAS float* tball = (LAS float*)(lds + IT_TB); volatile LAS int* info = (volatile LAS int*)(lds + IT_INFO);
    __syncthreads();
    for (int e = tid; e < 8 * 128; e += 512) tball[e] = BIAST[e] * 1.4426950408889634f;
    if (wave == 0) {
        int loc[16]; int s = 0;
#pragma unroll
        for (int e = 0; e < 16; ++e) { const int n = (int)CNT[16 * lane + e]; loc[e] = 1 + ((n + 255) >> 8); s += loc[e]; }
        int incl = s;
#pragma unroll
        for (int o = 1; o < 64; o <<= 1) { const int t = __shfl_up(incl, o); if (lane >= o) incl += t; }
        const int excl = incl - s, total = __shfl(incl, 63);
        const int c0 = (int)(((long)vcu * total) / G), c1 = (int)(((long)(vcu + 1) * total) / G);
        if (c0 >= excl && c0 < incl) { int acc = excl; bool done = false;
#pragma unroll
            for (int e = 0; e < 16; ++e) { if (!done && c0 < acc + loc[e]) { info[0] = 16 * lane + e; info[1] = c0 - acc; done = true; } acc += loc[e]; } }
        if (lane == 0) info[2] = c1 - c0;
    }
    __syncthreads();
    int li = __builtin_amdgcn_readfirstlane(info[0]), k = __builtin_amdgcn_readfirstlane(info[1]); const int nchunk = __builtin_amdgcn_readfirstlane(info[2]);
    int loaded = -1;
    int n_tl = 0, n_rank = 0; bool n_valid = false, n_active = false; bf16x8v n_qf[4];
#define MOBA_FETCH(LI, KK, NN) do { const int b_ = (LI) >> 8, h_ = ((LI) >> 5) & 7, j_ = (LI) & 31; const bool own_ = ((KK) == 0); const int start_ = (own_ ? wave : ((KK) - 1) * 8 + wave) * 32; \
        n_active = own_ || start_ < (NN); n_valid = own_ || (start_ + r32 < (NN)); \
        if (n_active) { if (own_) { n_tl = j_ * MBB + start_ + r32; n_rank = 3; } \
            else { int idx_ = start_ + r32; if (idx_ >= (NN)) idx_ = (NN) - 1; const unsigned e_ = LIST[moba_list_base(b_ * 8 + h_, j_) + idx_]; n_tl = (int)(e_ & 8191u); n_rank = (int)(e_ >> 13); } \
            const bf16* qp_ = Q + (size_t)(b_ * SEQ + n_tl) * MBW + h_ * MBD + 8 * hi; \
            _Pragma("unroll") for (int s_ = 0; s_ < 4; ++s_) n_qf[s_] = *(const bf16x8v*)(qp_ + 16 * s_); } } while (0)
    int n = (nchunk > 0) ? __builtin_amdgcn_readfirstlane((int)CNT[li]) : 0;
    if (nchunk > 0) MOBA_FETCH(li, k, n);
    for (int c = 0; c < nchunk; ++c) {
        const int b = li >> 8, h = (li >> 5) & 7, j = li & 31;
        if (li != loaded) {
            __syncthreads();
            asm volatile("" : "+v"(tid));
#pragma unroll
            for (int r = 0; r < 4; ++r) { const int idx = tid + 512 * r, key = idx >> 3, ch = idx & 7;
                const v4u w = *(const v4u*)(K + (size_t)(b * SEQ + j * MBB + key) * MBW + h * MBD + ch * 8);
                *(LAS v4u*)(ks + key * 128 + ((ch ^ ((key >> 1) & 7)) * 16)) = w; }
#pragma unroll
            for (int r = 0; r < 4; ++r) { const int idx = tid + 512 * r, d = idx >> 5, ch = idx & 31;
                const v4u w = *(const v4u*)(VT + (size_t)(h * MBD + d) * M + b * SEQ + j * MBB + ch * 8);
                LAS v2u* dst = (LAS v2u*)(vs + d * IT_VROW + ch * 16); dst[0] = (v2u){w.x, w.y}; dst[1] = (v2u){w.z, w.w}; }
            __syncthreads();
            loaded = li;
        }
        const int tl = n_tl, rank = n_rank; const bool valid = n_valid, active = n_active, own = (k == 0);
        bf16x8v qf[4];
#pragma unroll
        for (int s = 0; s < 4; ++s) qf[s] = n_qf[s];
        int li2 = li, k2 = k + 1; if (k2 >= 1 + ((n + 255) >> 8)) { ++li2; k2 = 0; }
        int n2 = n;
        if (c + 1 < nchunk) { if (li2 != li) n2 = __builtin_amdgcn_readfirstlane((int)CNT[li2]); MOBA_FETCH(li2, k2, n2); }
        if (active) {
            const int qin = tl & 255, bd = (tl >> 8) - j, dq = bd * 256 + qin;
            const bool general = own || (__ballot(bd == 1 && qin < 112) != 0ull);
            const int ntile = own ? (wave + 1) : 8;
            const LAS float* tb = tball + h * 128;
            const float c1 = 0.125f * 1.4426950408889634f, c0 = tb[113];
            float mrun = -INFINITY, lrun = 0.f; f32x16 o[2];
#pragma unroll
            for (int d = 0; d < 2; ++d)
#pragma unroll
                for (int r = 0; r < 16; ++r) o[d][r] = 0.f;
#pragma unroll
            for (int half = 0; half < 4; ++half) {
                if (half * 2 < ntile) {
                    f32x16 st[2];
#pragma unroll
                    for (int t4 = 0; t4 < 2; ++t4) { const int kt = half * 2 + t4;
#pragma unroll
                        for (int r = 0; r < 16; ++r) st[t4][r] = 0.f;
                        if (kt < ntile) { const int key = 32 * kt + r32;
#pragma unroll
                            for (int s = 0; s < 4; ++s) { const bf16x8v ka = *(const LAS bf16x8v*)(ks + key * 128 + (((2 * s + hi) ^ ((key >> 1) & 7)) * 16));
                                st[t4] = __builtin_amdgcn_mfma_f32_32x32x16_bf16(ka, qf[s], st[t4], 0, 0, 0); } }
                        asm volatile("" ::: "memory");
                    }
                    if (general) moba_item_half<true, 2>(st, half, ntile, hi, dq, c1, c0, tb, mrun, lrun, o, vs, r32);
                    else         moba_item_half<false, 2>(st, half, ntile, hi, dq, c1, c0, tb, mrun, lrun, o, vs, r32);
                }
            }
            if (valid) {
                const size_t pair = (size_t)(b * SEQ + tl) * 8 + h; const float linv = 1.0f / lrun;
                bf16* po = (rank == 0 ? PO0 : rank == 1 ? PO1 : rank == 2 ? PO2 : PO3) + pair * 64;
#pragma unroll
                for (int d = 0; d < 2; ++d)
#pragma unroll
                    for (int g4 = 0; g4 < 4; ++g4) { v2u w; w.x = pg8::cvt_pk_bf16(o[d][4 * g4] * linv, o[d][4 * g4 + 1] * linv); w.y = pg8::cvt_pk_bf16(o[d][4 * g4 + 2] * linv, o[d][4 * g4 + 3] * linv);
                        *(v2u*)(po + 32 * d + 8 * g4 + 4 * hi) = w; }
                if (hi == 0) { float* pm = PML + ((size_t)rank * (M * 8) + pair) * 2; pm[0] = mrun; pm[1] = lrun; }
            }
        }
        li = li2; k = k2; n = n2;
    }
#undef MOBA_FETCH
    __syncthreads();
}
__device__ __forceinline__ void moba_combine_phase(int gtid, int gthreads, const bf16* PO0, const bf16* PO1, const bf16* PO2, const bf16* PO3, const float* PML, bf16* OA) {
    for (int idx = gtid; idx < M * 8 * 8; idx += gthreads) {
        const int pair = idx >> 3, c8 = idx & 7, m = pair >> 3, own = (m & (SEQ - 1)) >> 8, nv = own < 3 ? own : 3;
        float mm[4], ll[4];
#pragma unroll
        for (int r = 0; r < 4; ++r) { const bool v = (r == 3) || (r < nv); const float* pm = PML + ((size_t)r * (M * 8) + pair) * 2; mm[r] = v ? pm[0] : -INFINITY; ll[r] = v ? pm[1] : 0.f; }
        const float mx = fmaxf(fmaxf(mm[0], mm[1]), fmaxf(mm[2], mm[3]));
        float w[4], ws = 0.f;
#pragma unroll
        for (int r = 0; r < 4; ++r) { w[r] = ll[r] * __builtin_amdgcn_exp2f(mm[r] - mx); ws += w[r]; }
        const float inv = 1.0f / ws; float acc[8];
#pragma unroll
        for (int e = 0; e < 8; ++e) acc[e] = 0.f;
#pragma unroll
        for (int r = 0; r < 4; ++r) { const bool v = (r == 3) || (r < nv);
            if (v) { const bf16* po = (r == 0 ? PO0 : r == 1 ? PO1 : r == 2 ? PO2 : PO3) + (size_t)pair * 64 + c8 * 8; const v4u x = *(const v4u*)po; const float wr = w[r] * inv;
                acc[0] += wr * bflo(x.x); acc[1] += wr * bfhi(x.x); acc[2] += wr * bflo(x.y); acc[3] += wr * bfhi(x.y); acc[4] += wr * bflo(x.z); acc[5] += wr * bfhi(x.z); acc[6] += wr * bflo(x.w); acc[7] += wr * bfhi(x.w); } }
        v4u o; o.x = pk2(acc[0], acc[1]); o.y = pk2(acc[2], acc[3]); o.z = pk2(acc[4], acc[5]); o.w = pk2(acc[6], acc[7]);
        *(v4u*)(OA + (size_t)pair * 64 + c8 * 8) = o;
    }
}
constexpr int HL_QN = 0, HL_KN = 8704, HL_KT = 17408, HL_VT = 27648, HL_SB = 37888, HL_GT = 72704, HL_DD = 74752, HL_EM = 75264, HL_SSQ = 75776, HL_END = 76288;
constexpr int HL_QP = 272, HL_TP = 80;
__device__ __forceinline__ float bf1(bf16 x) { return __uint_as_float((unsigned)x << 16); }
template <int STEP> __device__ __forceinline__ void hgrn_mfma_phase(LAS unsigned char* lds, int vcu, int G, int tid, int wave, int lane, const bf16* KIN, const bf16* HI, const bf16* HQ, const bf16* HG, const float* hgw, float* HS, float* HGD, bf16* OB) {
    const int r32 = lane & 31, hi = lane >> 5, ch = tid & 127, tg = __builtin_amdgcn_readfirstlane(tid >> 7);
    LAS float* gt = (LAS float*)(lds + HL_GT); LAS float* dd = (LAS float*)(lds + HL_DD); LAS float* em = (LAS float*)(lds + HL_EM); LAS float* ssq = (LAS float*)(lds + HL_SSQ);
    for (int unit = vcu; unit < BATCH * HGH * HGNC; unit += G) {
        const int c = unit & 31, bh = unit >> 5, b = bh >> 2, h = bh & 3, m0 = b * SEQ + c * HGC;
        f32x16 S[4]; float Dk = 1.f;
        const int skt = (STEP == 1) ? (wave >> 1) : (wave - 4), svt0 = (STEP == 1) ? 2 * (wave & 1) : 0; constexpr int NST = (STEP == 1) ? 2 : 4;
#pragma unroll
        for (int i = 0; i < 4; ++i)
#pragma unroll
            for (int r = 0; r < 16; ++r) S[i][r] = 0.f;
        if (STEP == 3 && wave >= 4) {
#pragma unroll
            for (int i = 0; i < 4; ++i)
#pragma unroll
                for (int r = 0; r < 16; ++r) S[i][r] = HS[(size_t)unit * 16384 + (32 * skt + crow16(r, hi)) * 128 + 32 * (svt0 + i) + r32];
        }
        unsigned short rk[8], rv[8], rq[8];
#pragma unroll
        for (int e = 0; e < 8; ++e) { const size_t idx = (size_t)(m0 + tg * 8 + e) * HGW + h * HGD_ + ch; rk[e] = KIN[idx]; rv[e] = HI[idx]; rq[e] = (STEP == 3) ? HQ[idx] : (unsigned short)0; }
        for (int slab = 0; slab < 8; ++slab) {
            const int ms = m0 + slab * 32;
            float kin[8], qq[8]; unsigned short vv[8];
#pragma unroll
            for (int e = 0; e < 8; ++e) { kin[e] = bf1(rk[e]); vv[e] = rv[e]; qq[e] = bf1(rq[e]); }
            if (slab < 7) {
#pragma unroll
                for (int e = 0; e < 8; ++e) { const size_t idx = (size_t)(ms + 32 + tg * 8 + e) * HGW + h * HGD_ + ch; rk[e] = KIN[idx]; rv[e] = HI[idx]; rq[e] = (STEP == 3) ? HQ[idx] : (unsigned short)0; }
            }
            float cs[8]; float run = 0.f;
#pragma unroll
            for (int e = 0; e < 8; ++e) { run += __builtin_amdgcn_logf(fmaxf(1.0f - kin[e], 5.9604645e-8f)); cs[e] = run; }
            gt[tg * 128 + ch] = run;
            __syncthreads();
            const float g0 = gt[ch], g1 = gt[128 + ch], g2 = gt[256 + ch], g3 = gt[384 + ch];
            const float bmid = g0 + g1, bend = bmid + g2 + g3, pre = (tg == 0) ? 0.f : (tg == 1) ? g0 : (tg == 2) ? bmid : bmid + g2;
            { float kh[8];
#pragma unroll
              for (int e = 0; e < 8; ++e) kh[e] = kin[e] * __builtin_amdgcn_exp2f(bend - (pre + cs[e]));
              v4u w; w.x = pg8::cvt_pk_bf16(kh[0], kh[1]); w.y = pg8::cvt_pk_bf16(kh[2], kh[3]); w.z = pg8::cvt_pk_bf16(kh[4], kh[5]); w.w = pg8::cvt_pk_bf16(kh[6], kh[7]);
              *(LAS v4u*)(lds + HL_KT + ch * HL_TP + tg * 16) = w;
              v4u x; x.x = (unsigned)vv[0] | ((unsigned)vv[1] << 16); x.y = (unsigned)vv[2] | ((unsigned)vv[3] << 16); x.z = (unsigned)vv[4] | ((unsigned)vv[5] << 16); x.w = (unsigned)vv[6] | ((unsigned)vv[7] << 16);
              *(LAS v4u*)(lds + HL_VT + ch * HL_TP + tg * 16) = x; }
            if (STEP == 3) {
#pragma unroll
                for (int e = 0; e < 8; ++e) { const float bs = pre + cs[e]; const int tok = tg * 8 + e;
                    const float kt_ = kin[e] * __builtin_amdgcn_exp2f(fminf(bmid - bs, 100.f)), qt_ = qq[e] * __builtin_amdgcn_exp2f(fminf(bs - bmid, 100.f));
                    *(LAS unsigned short*)(lds + HL_KN + tok * HL_QP + ch * 2) = (unsigned short)f2bf(kt_);
                    *(LAS unsigned short*)(lds + HL_QN + tok * HL_QP + ch * 2) = (unsigned short)f2bf(qt_); }
            }
            if (tg == 0) { const float de = __builtin_amdgcn_exp2f(bend); dd[ch] = de; em[ch] = __builtin_amdgcn_exp2f(bmid); Dk *= de; }
            __syncthreads();
            if (STEP == 3) {
                if (wave >= 4) {
#pragma unroll
                    for (int i = 0; i < 4; ++i)
#pragma unroll
                        for (int g4 = 0; g4 < 4; ++g4) { const int k0 = 32 * skt + 8 * g4 + 4 * hi; const f32x4 e4 = *(const LAS f32x4*)(em + k0);
                            v2u w; w.x = pg8::cvt_pk_bf16(S[i][4 * g4] * e4.x, S[i][4 * g4 + 1] * e4.y); w.y = pg8::cvt_pk_bf16(S[i][4 * g4 + 2] * e4.z, S[i][4 * g4 + 3] * e4.w);
                            *(LAS v2u*)(lds + HL_SB + (32 * (svt0 + i) + r32) * HL_QP + k0 * 2) = w; }
                }
                __syncthreads();
            }
            f32x16 O;
            if (STEP == 3 && wave < 4) {
                const int vt = wave;
                bf16x8v qf[8]; f32x16 X;
#pragma unroll
                for (int r = 0; r < 16; ++r) { X[r] = 0.f; O[r] = 0.f; }
#pragma unroll
                for (int ks = 0; ks < 8; ++ks) { qf[ks] = *(const LAS bf16x8v*)(lds + HL_QN + r32 * HL_QP + (16 * ks + 8 * hi) * 2);
                    const bf16x8v kf = *(const LAS bf16x8v*)(lds + HL_KN + r32 * HL_QP + (16 * ks + 8 * hi) * 2);
                    X = __builtin_amdgcn_mfma_f32_32x32x16_bf16(kf, qf[ks], X, 0, 0, 0); }
#pragma unroll
                for (int r = 0; r < 16; ++r) if (crow16(r, hi) > r32) X[r] = 0.f;
#pragma unroll
                for (int k2 = 0; k2 < 2; ++k2) {
                    v4u w; w.x = pg8::cvt_pk_bf16(X[8 * k2 + 0], X[8 * k2 + 1]); w.y = pg8::cvt_pk_bf16(X[8 * k2 + 2], X[8 * k2 + 3]); w.z = pg8::cvt_pk_bf16(X[8 * k2 + 4], X[8 * k2 + 5]); w.w = pg8::cvt_pk_bf16(X[8 * k2 + 6], X[8 * k2 + 7]);
                    const bf16x8v xf = __builtin_bit_cast(bf16x8v, w);
                    const LAS unsigned char* vp = lds + HL_VT + (32 * vt + r32) * HL_TP + (16 * k2 + 4 * hi) * 2;
                    const s16x4v lo = *(const LAS s16x4v*)vp, hi4 = *(const LAS s16x4v*)(vp + 16);
                    const bf16x8v va = {lo[0], lo[1], lo[2], lo[3], hi4[0], hi4[1], hi4[2], hi4[3]};
                    O = __builtin_amdgcn_mfma_f32_32x32x16_bf16(va, xf, O, 0, 0, 0); }
#pragma unroll
                for (int ks = 0; ks < 8; ++ks) { const bf16x8v sa = *(const LAS bf16x8v*)(lds + HL_SB + (32 * vt + r32) * HL_QP + (16 * ks + 8 * hi) * 2);
                    O = __builtin_amdgcn_mfma_f32_32x32x16_bf16(sa, qf[ks], O, 0, 0, 0); }
                float sq = 0.f;
#pragma unroll
                for (int r = 0; r < 16; ++r) sq += O[r] * O[r];
                sq += __shfl_xor(sq, 32);
                if (hi == 0) ssq[vt * 32 + r32] = sq;
            }
            if (STEP == 1 || wave >= 4) {
#pragma unroll
                for (int i = 0; i < NST; ++i) {
#pragma unroll
                    for (int g4 = 0; g4 < 4; ++g4) { const f32x4 d4 = *(const LAS f32x4*)(dd + 32 * skt + 8 * g4 + 4 * hi);
                        S[i][4 * g4] *= d4.x; S[i][4 * g4 + 1] *= d4.y; S[i][4 * g4 + 2] *= d4.z; S[i][4 * g4 + 3] *= d4.w; }
#pragma unroll
                    for (int k2 = 0; k2 < 2; ++k2) { const bf16x8v ka = *(const LAS bf16x8v*)(lds + HL_KT + (32 * skt + r32) * HL_TP + (16 * k2 + 8 * hi) * 2);
                        const bf16x8v vb = *(const LAS bf16x8v*)(lds + HL_VT + (32 * (svt0 + i) + r32) * HL_TP + (16 * k2 + 8 * hi) * 2);
                        S[i] = __builtin_amdgcn_mfma_f32_32x32x16_bf16(ka, vb, S[i], 0, 0, 0); }
                }
            }
            __syncthreads();
            if (STEP == 3 && wave < 4) {
                const int vt = wave; const float tot = ssq[r32] + ssq[32 + r32] + ssq[64 + r32] + ssq[96 + r32];
                const float rstd = 1.f / sqrtf(tot * (1.f / 128.f) + EPS); const size_t mrow = (size_t)(ms + r32) * HGW + h * HGD_;
#pragma unroll
                for (int g4 = 0; g4 < 4; ++g4) { const int v0 = 32 * vt + 8 * g4 + 4 * hi; const f32x4 w4 = *(const f32x4*)(hgw + v0); const v2u gg = *(const v2u*)(HG + mrow + v0);
                    v2u o; o.x = pg8::cvt_pk_bf16(O[4 * g4] * rstd * w4.x * bflo(gg.x), O[4 * g4 + 1] * rstd * w4.y * bfhi(gg.x)); o.y = pg8::cvt_pk_bf16(O[4 * g4 + 2] * rstd * w4.z * bflo(gg.y), O[4 * g4 + 3] * rstd * w4.w * bfhi(gg.y));
                    *(v2u*)(OB + mrow + v0) = o; }
            }
        }
        if (STEP == 1) {
#pragma unroll
            for (int i = 0; i < 2; ++i)
#pragma unroll
                for (int r = 0; r < 16; ++r) HS[(size_t)unit * 16384 + (32 * skt + crow16(r, hi)) * 128 + 32 * (svt0 + i) + r32] = S[i][r];
            if (tid < 128) HGD[unit * 128 + tid] = Dk;
        }
    }
    __syncthreads();
}
__device__ __forceinline__ void hgrn_scan_phase(int gtid, int gthreads, float* HS, const float* HGD) {
    for (int idx = gtid; idx < BATCH * HGH * 16384; idx += gthreads) {
        const int bh = idx >> 14, e = idx & 16383, k = e >> 7; float s = 0.f;
        float tmp[HGNC];
#pragma unroll
        for (int c = 0; c < HGNC; ++c) tmp[c] = HS[(size_t)(bh * HGNC + c) * 16384 + e];
#pragma unroll
        for (int c = 0; c < HGNC; ++c) { HS[(size_t)(bh * HGNC + c) * 16384 + e] = s; s = HGD[(bh * HGNC + c) * 128 + k] * s + tmp[c]; }
    }
}
#ifndef MASK_BITS
#define MASK_BITS 0x00ffffffu
#endif
#ifndef REP_MASK
#define REP_MASK 0u
#endif
struct Args { const float* in[16]; float* out; unsigned char* ws; unsigned mask, rep; };
__global__ void __launch_bounds__(NWAVES * 64, 2) mk_fwd(Args args) {
    extern __shared__ __attribute__((aligned(16))) unsigned char lds_raw[];
    LAS unsigned char* lds = (LAS unsigned char*)lds_raw;
    volatile LAS unsigned* MISC = (volatile LAS unsigned*)(lds + MISC_OFF);
    const int G = gridDim.x, bx = blockIdx.x;
    unsigned char* ws = args.ws;
    gu32* ctl = (gu32*)(ws + WS_CTL);
    for (int u = threadIdx.x; u < (LDS_BYTES - LDSCTL_OFF) / 4; u += NWAVES * 64) ((LAS unsigned*)(lds + LDSCTL_OFF))[u] = 0u;
    __syncthreads();
    XcdBarrier bar = xcd_barrier_post((unsigned*)(ctl + CW_BAR), MISC + 8);
#define GRID_BAR() xcd_barrier(bar)
#define PH(k) for (int rep_ = ((args.mask >> (k)) & 1u) + ((args.rep >> (k)) & 1u); rep_ > 0; --rep_)
#define COORDS() int tid = threadIdx.x; asm volatile("" : "+v"(tid)); const int lane = tid & 63, wave = __builtin_amdgcn_readfirstlane(tid >> 6); \
    const int vcu = (G % 8 == 0) ? (bx % 8) * (G / 8) + bx / 8 : bx; const int gw = vcu * NWAVES + wave, NGW = G * NWAVES; (void)lane; (void)gw; (void)NGW; (void)vcu
#define MKP() Ptrs P; P.x = args.in[0]; P.p = args.in[1]; P.w_gu1 = args.in[2]; P.w_d1 = args.in[3]; P.w_in = args.in[4]; P.w_a = args.in[5]; P.w_b = args.in[6]; P.w_out = args.in[7]; \
    P.w_gu2 = args.in[8]; P.w_d2 = args.in[9]; P.w_ple = args.in[10]; P.w_pg = args.in[11]; P.gains = args.in[12]; P.hgw = args.in[13]; P.lbp = args.in[14]; P.rel = args.in[15]; P.out = args.out; P.ws = args.ws
#define XN ((bf16*)(ws + WS_C))
#define Hb ((bf16*)(ws + WS_A))
#define Fb ((bf16*)(ws + WS_B))
#define Yb ((bf16*)(ws + WS_A))
#define HBS ((bf16*)args.out)
#define Qb ((bf16*)(ws + WS_Q))
#define Kb ((bf16*)(ws + WS_K))
#define VTb ((bf16*)(ws + WS_VT))
#define HQb ((bf16*)(ws + WS_HQ))
#define HIb ((bf16*)(ws + WS_HI))
#define KINb ((bf16*)(ws + WS_KIN))
#define HGb ((bf16*)(ws + WS_HG))
#define SAb ((bf16*)(ws + WS_SA))
#define SBb ((bf16*)(ws + WS_SB))
#define OAb ((bf16*)(ws + WS_OA))
#define OBb ((bf16*)(ws + WS_OB))
#define PBb ((bf16*)(ws + WS_PB))
#define Eb ((bf16*)(ws + WS_A))
#define KMEAN ((float*)(ws + WS_KMEAN))
#define LBt ((float*)(ws + WS_LB))
#define BIAST ((float*)(ws + WS_BIAST))
#define HS ((float*)(ws + WS_HS))
#define HGD ((float*)(ws + WS_HGD))
#define CNTb ((unsigned*)(ws + WS_CNT))
#define LISTb ((unsigned*)(ws + WS_LIST))
#define PO0b ((bf16*)(ws + WS_PO0))
#define PO1b ((bf16*)(ws + WS_PO1))
#define PO2b ((bf16*)(ws + WS_PO2))
#define PO3b ((bf16*)(ws + WS_PO3))
#define PMLb ((float*)(ws + WS_PML))

    PH(0) { COORDS(); MKP(); p0_prologue(P, lds, gw, NGW, wave, lane); }
    GRID_BAR();
    PH(0) { COORDS(); MKP(); p0b_quant_phase(P, lds, gw, NGW, wave, lane); }
    GRID_BAR();
    PH(1) { pg8::Gemm g{XN, (const bf16*)(ws + WS_WGU1), M, NGU, D / 2}; pg8::StaticOrder S; S.init(M, NGU, G, bx); pg8::EpiGU8 E{Hb, FF, (const float*)(ws + WS_RS), (const float*)(ws + WS_CMAX)};
      pg8::gemm_phase<pg8::EpiGU8, pg8::StaticOrder, PG8_ALIGN, PG8_SP2, true>(lds + RING_OFF, g, S, E); }
    GRID_BAR();
    PH(2) { pg8::Gemm g{Hb, (const bf16*)(ws + WS_WD1), M, D, FF}; pg8::StaticOrder S; S.init(M, D, G, bx); pg8::EpiMix<0> E{Fb, nullptr, D};
      pg8::gemm_phase<pg8::EpiMix<0>, pg8::StaticOrder, PG8_ALIGN, PG8_SP2>(lds + RING_OFF, g, S, E); }
    GRID_BAR();
    PH(3) { COORDS(); rowwise_phase<true, 1>(gw, NGW, lane, args.in[0], Fb, args.in[12] + 1 * D, 0.5f, HBS, XN, nullptr); }
    GRID_BAR();
    PH(4) { pg8::Gemm g{XN, (const bf16*)(ws + WS_WIN), M, NIN - 512, D}; pg8::StaticOrder S; S.init(M, NIN - 512, G, bx); pg8::EpiIN E{Qb, Kb, HQb, KINb, HIb, HGb, SAb, SBb, LBt, KMEAN};
      pg8::gemm_phase<pg8::EpiIN, pg8::StaticOrder, PG8_ALIGN, PG8_SP2>(lds + RING_OFF, g, S, E); }
    PH(4) { pg8::Gemm g{(const bf16*)(ws + WS_WIN) + (size_t)(NIN - 512) * D, XN, 512, M, D}; pg8::StaticOrder S; S.init(512, M, G, bx); pg8::EpiMix<0> E{VTb, nullptr, M};
      pg8::gemm_phase<pg8::EpiMix<0>, pg8::StaticOrder, PG8_ALIGN, PG8_SP2>(lds + RING_OFF, g, S, E); }
    GRID_BAR();
    PH(5) { COORDS(); moba_gating_phase(lds, vcu, G, tid, Qb, KMEAN, CNTb, LISTb); }
    PH(18) { COORDS(); hgrn_mfma_phase<1>(lds, vcu, G, tid, wave, lane, KINb, HIb, HQb, HGb, args.in[13], HS, HGD, OBb); }
    GRID_BAR();
    PH(6) { COORDS(); hgrn_scan_phase(vcu * NWAVES * 64 + tid, G * NWAVES * 64, HS, HGD); }
    GRID_BAR();
    PH(7) { COORDS(); hgrn_mfma_phase<3>(lds, vcu, G, tid, wave, lane, KINb, HIb, HQb, HGb, args.in[13], HS, HGD, OBb); }
    GRID_BAR();
    PH(16) { COORDS(); moba_items_phase(lds, vcu, G, tid, wave, lane, Qb, Kb, VTb, CNTb, LISTb, BIAST, PO0b, PO1b, PO2b, PO3b, PMLb); }
    GRID_BAR();
    PH(17) { COORDS(); moba_combine_phase(vcu * NWAVES * 64 + tid, G * NWAVES * 64, PO0b, PO1b, PO2b, PO3b, PMLb, OAb); }
    GRID_BAR();
    PH(8) { pg8::Gemm g{OAb, (const bf16*)(ws + WS_WA), M, D, 512}; pg8::StaticOrder S; S.init(M, D, G, bx); pg8::EpiMix<1> E{SAb, nullptr, D};
      pg8::gemm_phase<pg8::EpiMix<1>, pg8::StaticOrder, PG8_ALIGN, PG8_SP2>(lds + RING_OFF, g, S, E); }
    PH(8) { pg8::Gemm g{OBb, (const bf16*)(ws + WS_WB), M, D, 512}; pg8::StaticOrder S; S.init(M, D, G, bx); pg8::EpiMix<2> E{SAb, SBb, D};
      pg8::gemm_phase<pg8::EpiMix<2>, pg8::StaticOrder, PG8_ALIGN, PG8_SP2>(lds + RING_OFF, g, S, E); }
    GRID_BAR();
    PH(9) { pg8::Gemm g{SAb, (const bf16*)(ws + WS_WOUT), M, D, D}; pg8::StaticOrder S; S.init(M, D, G, bx); pg8::EpiMix<0> E{Yb, nullptr, D};
      pg8::gemm_phase<pg8::EpiMix<0>, pg8::StaticOrder, PG8_ALIGN, PG8_SP2>(lds + RING_OFF, g, S, E); }
    GRID_BAR();
    PH(10) { COORDS(); rowwise_phase<false, 4>(gw, NGW, lane, HBS, Yb, args.in[12] + 3 * D, 1.0f, HBS, XN, (float*)(ws + WS_RS)); }
    GRID_BAR();
    PH(11) { pg8::Gemm g{XN, (const bf16*)(ws + WS_WGU2), M, NGU, D / 2}; pg8::StaticOrder S; S.init(M, NGU, G, bx); pg8::EpiGU8 E{Hb, FF, (const float*)(ws + WS_RS), (const float*)(ws + WS_CMAX) + NGU};
      pg8::gemm_phase<pg8::EpiGU8, pg8::StaticOrder, PG8_ALIGN, PG8_SP2, true>(lds + RING_OFF, g, S, E); }
    GRID_BAR();
    PH(12) { pg8::Gemm g{Hb, (const bf16*)(ws + WS_WD2), M, D, FF}; pg8::StaticOrder S; S.init(M, D, G, bx); pg8::EpiMix<0> E{Fb, nullptr, D};
      pg8::gemm_phase<pg8::EpiMix<0>, pg8::StaticOrder, PG8_ALIGN, PG8_SP2>(lds + RING_OFF, g, S, E); }
    GRID_BAR();
    PH(13) { COORDS(); rowwise_phase<false, 2>(gw, NGW, lane, HBS, Fb, args.in[12] + 5 * D, 0.5f, nullptr, XN, nullptr);
        const float* pp = args.in[1];
        for (int i = gw * 64 + lane; i < M * PLE / 8; i += NGW * 64) { const f32x4 a = ((const f32x4*)pp)[2 * i], b = ((const f32x4*)pp)[2 * i + 1];
            v4u o; o.x = pk2(a.x, a.y); o.y = pk2(a.z, a.w); o.z = pk2(b.x, b.y); o.w = pk2(b.z, b.w); ((v4u*)PBb)[i] = o; } }
    GRID_BAR();
    PH(14) { pg8::Gemm g{PBb, (const bf16*)(ws + WS_WPLE), M, D, PLE}; pg8::StaticOrder S; S.init(M, D, G, bx); pg8::EpiMix<0> E{Eb, nullptr, D};
      pg8::gemm_phase<pg8::EpiMix<0>, pg8::StaticOrder, PG8_ALIGN, PG8_SP2>(lds + RING_OFF, g, S, E); }
    PH(14) { pg8::Gemm g{XN, (const bf16*)(ws + WS_WPG), M, D, D}; pg8::StaticOrder S; S.init(M, D, G, bx); pg8::EpiPleB E{Eb, Fb, D};
      pg8::gemm_phase<pg8::EpiPleB, pg8::StaticOrder, PG8_ALIGN, PG8_SP2>(lds + RING_OFF, g, S, E); }
    GRID_BAR();
    PH(15) { COORDS(); rowwise_phase<false, 3>(gw, NGW, lane, XN, Fb, args.in[12] + 6 * D, 1.0f, nullptr, nullptr, args.out); }
#if defined(PROBE_GEMM)
    GRID_BAR();
    PH(24) { pg8::Gemm g{XN, (const bf16*)(ws + WS_WGU1), M, NGU, D}; pg8::StaticOrder S; S.init(M, NGU, G, bx); pg8::EpiNull E{};
      pg8::gemm_phase<pg8::EpiNull, pg8::StaticOrder, PG8_ALIGN, PG8_SP2, true>(lds + RING_OFF, g, S, E); }
    PH(25) { pg8::Gemm g{XN, (const bf16*)(ws + WS_WGU1), M, NGU, D}; pg8::StaticOrder S; S.init(M, NGU, G, bx); pg8::EpiGU E{Hb, FF};
      pg8::gemm_phase<pg8::EpiGU, pg8::StaticOrder, PG8_ALIGN, PG8_SP2>(lds + RING_OFF, g, S, E); }
    PH(26) { pg8::Gemm g{Hb, (const bf16*)(ws + WS_WD1), M, D, FF}; pg8::StaticOrder S; S.init(M, D, G, bx); pg8::EpiNull E{};
      pg8::gemm_phase<pg8::EpiNull, pg8::StaticOrder, PG8_ALIGN, PG8_SP2>(lds + RING_OFF, g, S, E); }
#endif
}

extern "C" void kernel_launch(void* const* d_in, const int* in_sizes, int n_in, void* d_out, int out_size, void* d_ws, size_t ws_size, hipStream_t stream) {
    static int grid = 0;
    if (grid == 0) {
        if (n_in != 16 || in_sizes[0] != M * D || out_size != M * D || ws_size < WS_END) { fprintf(stderr, "kernel_launch: unexpected shapes: n_in %d in0 %d out %d ws %zu; nothing launched\n", n_in, n_in > 0 ? in_sizes[0] : -1, out_size, ws_size); grid = -1; return; }
        int dev = 0, cus = 0;
        if (hipGetDevice(&dev) != hipSuccess || hipDeviceGetAttribute(&cus, hipDeviceAttributeMultiprocessorCount, dev) != hipSuccess) { fprintf(stderr, "kernel_launch: device query failed\n"); grid = -1; return; }
        if (hipFuncSetAttribute((const void*)mk_fwd, hipFuncAttributeMaxDynamicSharedMemorySize, LDS_BYTES) != hipSuccess) { fprintf(stderr, "kernel_launch: hipFuncSetAttribute failed\n"); grid = -1; return; }
        int per_cu = 0;
        if (hipOccupancyMaxActiveBlocksPerMultiprocessor(&per_cu, (const void*)mk_fwd, NWAVES * 64, LDS_BYTES) != hipSuccess || per_cu < 1) fprintf(stderr, "kernel_launch: note: occupancy query reports %d\n", per_cu);
        (void)hipGetLastError();
        grid = cus;
    }
    if (grid < 0) return;
    if (hipMemsetAsync((char*)d_ws + WS_CTL, 0, CTL_ZERO_BYTES, stream) != hipSuccess) { fprintf(stderr, "kernel_launch: memset failed\n"); return; }
    Args a{};
    for (int i = 0; i < 16; ++i) a.in[i] = (const float*)d_in[i];
    a.out = (float*)d_out; a.ws = (unsigned char*)d_ws; a.mask = MASK_BITS; a.rep = REP_MASK;
    hipLaunchKernelGGL(mk_fwd, dim3(grid), dim3(NWAVES * 64), LDS_BYTES, stream, a);
    const hipError_t le = hipPeekAtLastError();
    if (le != hipSuccess) fprintf(stderr, "kernel_launch: launch failed: %s\n", hipGetErrorName(le));
}
```

```cpp
#include <hip/hip_runtime.h>
#include <cstdio>
#include <cstdint>
namespace pg8 {
#define PG8_LAS __attribute__((address_space(3)))
typedef unsigned short bf16_t;
typedef short bf16x8 __attribute__((ext_vector_type(8)));
typedef float f32x4 __attribute__((ext_vector_type(4)));
typedef unsigned u32x4 __attribute__((ext_vector_type(4)));
typedef int i32x4 __attribute__((ext_vector_type(4)));
constexpr int BM = 256, BK = 64, HALF = 128, HTB = HALF * BK * 2  , STAGE_BYTES = 8 * HTB, NXCD = 8, WGM = 8;

__host__ __device__ __forceinline__ int lds_byte(int r, int c) { const int st = (r >> 4) * 2 + (c >> 5), rr = r & 15, cc = c & 31, ob = rr * 64 + cc * 2; return st * 1024 + (ob ^ (((ob >> 9) & 1) << 5)); }
__host__ __device__ __forceinline__ void stage_rc(int b, int& R, int& C) { const int st = b / 1024, sb = b % 1024, swz = sb ^ (((sb >> 9) & 1) << 5); R = (st >> 1) * 16 + swz / 64; C = (st & 1) * 32 + (swz % 64) / 2; }
__host__ __device__ __forceinline__ int perm32(int rho) { const int n = rho >> 4, i = rho & 15; return 8 * (i >> 2) + 4 * n + (i & 3); }

struct Unit { int pm, pn, half; };
struct Gemm { const bf16_t* A; const bf16_t* Bt; int M, N, K, Klen; };

struct StaticOrder {
    int nM, nN, nwg, G, c;
    __host__ __device__ void init(int M, int N, int G_, int c_) { nM = M / BM; nN = N / BM; nwg = nM * nN; G = G_; c = c_; }
    __host__ __device__ bool next(int i, Unit& u) const {
        const long L = (long)i * G + c; if (L >= nwg) return false;
        int wgid = (int)L; { const int q = nwg / NXCD, r = nwg % NXCD, xcd = wgid % NXCD, off = wgid / NXCD; wgid = (xcd < r ? xcd * (q + 1) : r * (q + 1) + (xcd - r) * q) + off; }
        const int nig = WGM * nN, gid = wgid / nig, fm = gid * WGM, gsz = (nM - fm) < WGM ? (nM - fm) : WGM;
        u.pm = fm + ((wgid % nig) % gsz); u.pn = (wgid % nig) / gsz; u.half = 0; return true;
    }
    __device__ __forceinline__ void a_ready(const Unit&) const {}
    __device__ __forceinline__ void done(const Unit&) const {}
};

struct HalfOrder : StaticOrder {
    __host__ __device__ bool next(int i, Unit& u) const { if (!StaticOrder::next(i >> 1, u)) return false; u.half = i & 1; return true; }
};

struct SameOrder { int n; __host__ __device__ bool next(int i, Unit& u) const { if (i >= n) return false; u.pm = 0; u.pn = 0; u.half = 0; return true; }
    __device__ __forceinline__ void a_ready(const Unit&) const {} __device__ __forceinline__ void done(const Unit&) const {} };

typedef float f32x2_t __attribute__((ext_vector_type(2))); typedef __bf16 bf16x2_t __attribute__((ext_vector_type(2)));
__device__ __forceinline__ unsigned cvt_pk_bf16(float lo, float hi) { f32x2_t v = {lo, hi}; bf16x2_t b = __builtin_convertvector(v, bf16x2_t); return __builtin_bit_cast(unsigned, b); }
#ifndef ST16_WT
#define ST16_WT 0
#endif
__device__ __forceinline__ void st16(void* p, u32x4 v) {
#if ST16_WT == 1
    asm volatile("global_store_dwordx4 %0, %1, off sc1\n\ts_nop 1" :: "v"(p), "v"(v) : "memory");
#elif ST16_WT == 2
    __builtin_nontemporal_store(v, (u32x4*)p);
#else
    *(u32x4*)p = v;
#endif
}
__device__ __forceinline__ void st16nt(void* p, u32x4 v) { __builtin_nontemporal_store(v, (u32x4*)p); }
__device__ __forceinline__ float sigm(float x) { return __builtin_amdgcn_rcpf(1.0f + __builtin_amdgcn_exp2f(-1.4426950408889634f * x)); }
__device__ __forceinline__ float bf_lo(unsigned w) { return __uint_as_float(w << 16); }
__device__ __forceinline__ float bf_hi(unsigned w) { return __uint_as_float(w & 0xffff0000u); }
__device__ __forceinline__ void unpack8(const u32x4 w, float (&o)[8]) { o[0] = bf_lo(w.x); o[1] = bf_hi(w.x); o[2] = bf_lo(w.y); o[3] = bf_hi(w.y); o[4] = bf_lo(w.z); o[5] = bf_hi(w.z); o[6] = bf_lo(w.w); o[7] = bf_hi(w.w); }
__device__ __forceinline__ u32x4 pack8(const float (&o)[8]) { u32x4 w; w.x = cvt_pk_bf16(o[0], o[1]); w.y = cvt_pk_bf16(o[2], o[3]); w.z = cvt_pk_bf16(o[4], o[5]); w.w = cvt_pk_bf16(o[6], o[7]); return w; }

struct EpiGU {
    static constexpr bool PERM = true, AFTER_DRAIN = false, HAS_MID = false;
    bf16_t* H; int ldh;
    __device__ __forceinline__ void operator()(const f32x4 (&acc)[2][2][4][2], const Unit& u, int wr, int wc, int fr, int fq) const {
        const int row0 = u.pm * BM + wr * 64 + fr, col0 = u.pn * HALF + wc * 32 + 8 * fq;
#pragma unroll
        for (int ai = 0; ai < 2; ++ai)
#pragma unroll
            for (int m = 0; m < 4; ++m) { bf16_t* rowp = H + (size_t)(row0 + ai * HALF + m * 16) * ldh + col0;
                const f32x4 g0 = acc[ai][0][m][0], g1 = acc[ai][0][m][1], u0 = acc[ai][1][m][0], u1 = acc[ai][1][m][1]; float o[8];
#pragma unroll
                for (int j = 0; j < 4; ++j) { o[j] = g0[j] * sigm(g0[j]) * u0[j]; o[4 + j] = g1[j] * sigm(g1[j]) * u1[j]; }
                st16(rowp, pack8(o)); }
    }
};
struct EpiF32 {
    static constexpr bool PERM = false, AFTER_DRAIN = false, HAS_MID = false;
    float* C; int ldc;
    __device__ __forceinline__ void operator()(const f32x4 (&acc)[2][2][4][2], const Unit& u, int wr, int wc, int fr, int fq) const {
        const int row0 = u.pm * BM + wr * 64 + fr, col0 = u.pn * BM + wc * 32 + 4 * fq;
#pragma unroll
        for (int ai = 0; ai < 2; ++ai)
#pragma unroll
            for (int m = 0; m < 4; ++m) { float* rowp = C + (size_t)(row0 + ai * HALF + m * 16) * ldc + col0;
#pragma unroll
                for (int bj = 0; bj < 2; ++bj)
#pragma unroll
                    for (int n = 0; n < 2; ++n) *(f32x4*)(rowp + bj * HALF + n * 16) = acc[ai][bj][m][n]; }
    }
};
struct EpiIN {
    static constexpr bool PERM = true, AFTER_DRAIN = false, HAS_MID = false;
    bf16_t *Q; const float* LB; float* KMEAN; const float* R2;
    template <int MODE> __device__ __forceinline__ void body(const f32x4 (&acc)[2][2][4][2], bf16_t* base, int ldc, int row0, int cbase, int pm, int fr) const {
        float rsv[2][4];
#pragma unroll
        for (int ai = 0; ai < 2; ++ai)
#pragma unroll
            for (int m = 0; m < 4; ++m) rsv[ai][m] = R2[row0 + ai * HALF + m * 16];
        float lbv[2][8]; float ks[2][8];
#pragma unroll
        for (int bj = 0; bj < 2; ++bj)
#pragma unroll
            for (int j = 0; j < 8; ++j) { lbv[bj][j] = (MODE == 2) ? (1.0f - LB[cbase + bj * HALF + j]) : 0.f; ks[bj][j] = 0.f; }
#pragma unroll
        for (int ai = 0; ai < 2; ++ai)
#pragma unroll
            for (int m = 0; m < 4; ++m) { const int row = row0 + ai * HALF + m * 16; const float r2 = rsv[ai][m]; bf16_t* rowp = base + (size_t)row * ldc + cbase;
#pragma unroll
                for (int bj = 0; bj < 2; ++bj) { const f32x4 v0 = acc[ai][bj][m][0], v1 = acc[ai][bj][m][1]; float o[8];
#pragma unroll
                    for (int j = 0; j < 4; ++j) { o[j] = v0[j] * r2; o[4 + j] = v1[j] * r2; }
#pragma unroll
                    for (int j = 0; j < 8; ++j) {
                        if (MODE == 1) o[j] = o[j] * sigm(o[j]);
                        if (MODE == 2) o[j] = lbv[bj][j] * sigm(-o[j]);
                        if (MODE == 4) { ks[bj][j] += o[j]; asm volatile("" : "+v"(ks[bj][j])); }
                        if (MODE == 5) o[j] *= 0.18033688011112042f; }
                    st16(rowp + bj * HALF, pack8(o)); } }
        if (MODE == 4) {
#pragma unroll
            for (int bj = 0; bj < 2; ++bj)
#pragma unroll
                for (int j = 0; j < 8; ++j) { float s = ks[bj][j]; s += __shfl_xor(s, 1); s += __shfl_xor(s, 2); s += __shfl_xor(s, 4); s += __shfl_xor(s, 8);
                    if (fr == 0) atomicAdd(KMEAN + (size_t)pm * 512 + cbase + bj * HALF + j, s); }
        }
    }
    __device__ __forceinline__ void operator()(const f32x4 (&acc)[2][2][4][2], const Unit& u, int wr, int wc, int fr, int fq) const {
        const int pn = u.pn, row0 = u.pm * BM + wr * 64 + fr, cw = wc * 32 + 8 * fq;
        body<5>(acc, Q, 512, row0, pn * BM + cw, u.pm, fr);
    }
};
struct EpiIN8 {
    static constexpr bool PERM = true, AFTER_DRAIN = false, HAS_MID = false;
    bf16_t *SA, *SB, *HQ, *KIN, *HI, *HG, *K; const float* LB; const float* RS; const float* CMX; float* KMEAN;
    template <int MODE> __device__ __forceinline__ void body(const i32x4 (&acc)[2][2][4][2], bf16_t* base, int ldc, int row0, int cbase, int gcol, int pm = 0, int fr = 0) const {
        float rsv[2][4];
#pragma unroll
        for (int ai = 0; ai < 2; ++ai)
#pragma unroll
            for (int m = 0; m < 4; ++m) rsv[ai][m] = RS[row0 + ai * HALF + m * 16];
        float cf[2][8], lbv[2][8], ks[2][8];
#pragma unroll
        for (int bj = 0; bj < 2; ++bj)
#pragma unroll
            for (int j = 0; j < 8; ++j) { cf[bj][j] = CMX[gcol + bj * HALF + j] * (1.0f / 127.0f); lbv[bj][j] = (MODE == 2) ? (1.0f - LB[cbase + bj * HALF + j]) : 0.f; ks[bj][j] = 0.f; }
#pragma unroll
        for (int ai = 0; ai < 2; ++ai)
#pragma unroll
            for (int m = 0; m < 4; ++m) { const int row = row0 + ai * HALF + m * 16; const float rf = rsv[ai][m]; bf16_t* rowp = base + (size_t)row * ldc + cbase;
#pragma unroll
                for (int bj = 0; bj < 2; ++bj) { const i32x4 v0 = acc[ai][bj][m][0], v1 = acc[ai][bj][m][1]; float o[8];
#pragma unroll
                    for (int j = 0; j < 4; ++j) { o[j] = (float)v0[j] * (rf * cf[bj][j]); o[4 + j] = (float)v1[j] * (rf * cf[bj][4 + j]); }
#pragma unroll
                    for (int j = 0; j < 8; ++j) {
                        if (MODE == 1) o[j] = o[j] * sigm(o[j]);
                        if (MODE == 2) o[j] = lbv[bj][j] * sigm(-o[j]);
                        if (MODE == 3) o[j] = sigm(o[j]);
                        if (MODE == 4) { ks[bj][j] += o[j]; asm volatile("" : "+v"(ks[bj][j])); } }
                    st16nt(rowp + bj * HALF, pack8(o)); } }
        if (MODE == 4) {
#pragma unroll
            for (int bj = 0; bj < 2; ++bj)
#pragma unroll
                for (int j = 0; j < 8; ++j) { float s = ks[bj][j]; s += __shfl_xor(s, 1); s += __shfl_xor(s, 2); s += __shfl_xor(s, 4); s += __shfl_xor(s, 8);
                    if (fr == 0) atomicAdd(KMEAN + (size_t)pm * 512 + cbase + bj * HALF + j, s); }
        }
    }
    __device__ __forceinline__ void operator()(const i32x4 (&acc)[2][2][4][2], const Unit& u, int wr, int wc, int fr, int fq) const {
        const int pn = u.pn, row0 = u.pm * BM + wr * 64 + fr, cw = wc * 32 + 8 * fq, gcol = pn * BM + cw;
        if (pn >= 16) { body<4>(acc, K, 512, row0, (pn - 16) * BM + cw, gcol, u.pm, fr); return; }
        if (pn < 4)       body<3>(acc, SA,  1024, row0, (pn)      * BM + cw, gcol);
        else if (pn < 8)  body<3>(acc, SB,  1024, row0, (pn - 4)  * BM + cw, gcol);
        else if (pn < 10) body<1>(acc, HQ,  512,  row0, (pn - 8)  * BM + cw, gcol);
        else if (pn < 12) body<2>(acc, KIN, 512,  row0, (pn - 10) * BM + cw, gcol);
        else if (pn < 14) body<0>(acc, HI,  512,  row0, (pn - 12) * BM + cw, gcol);
        else              body<1>(acc, HG,  512,  row0, (pn - 14) * BM + cw, gcol);
    }
};
template <int MODE> struct EpiI8 {
    static constexpr bool PERM = true, AFTER_DRAIN = false, HAS_MID = false;
    bf16_t* O; bf16_t* O2; const bf16_t* E; int ldc; int split; const float* RF; const float* CF; float cmul;
    __device__ __forceinline__ void operator()(const i32x4 (&acc)[2][2][4][2], const Unit& u, int wr, int wc, int fr, int fq) const {
        const int row0 = u.pm * BM + wr * 64 + fr; int colt = u.pn * BM; bf16_t* base = O;
        if (MODE == 3 && colt >= split) { base = O2; colt -= split; }
        const int col0 = colt + wc * 32 + 8 * fq, gcol0 = u.pn * BM + wc * 32 + 8 * fq;
        float rsv[2][4];
#pragma unroll
        for (int ai = 0; ai < 2; ++ai)
#pragma unroll
            for (int m = 0; m < 4; ++m) rsv[ai][m] = RF[row0 + ai * HALF + m * 16];
        float cf[2][8];
#pragma unroll
        for (int bj = 0; bj < 2; ++bj)
#pragma unroll
            for (int j = 0; j < 8; ++j) cf[bj][j] = CF[gcol0 + bj * HALF + j] * cmul;
#pragma unroll
        for (int ai = 0; ai < 2; ++ai) {
            u32x4 ew[4][2];
            if (MODE == 6) {
#pragma unroll
                for (int m = 0; m < 4; ++m)
#pragma unroll
                    for (int bj = 0; bj < 2; ++bj) ew[m][bj] = *(const u32x4*)(E + (size_t)(row0 + ai * HALF + m * 16) * ldc + col0 + bj * HALF); }
#pragma unroll
            for (int m = 0; m < 4; ++m) { const int row = row0 + ai * HALF + m * 16; const float rf = rsv[ai][m]; const size_t off = (size_t)row * ldc + col0;
#pragma unroll
                for (int bj = 0; bj < 2; ++bj) { const i32x4 v0 = acc[ai][bj][m][0], v1 = acc[ai][bj][m][1]; float o[8];
#pragma unroll
                    for (int j = 0; j < 4; ++j) { o[j] = (float)v0[j] * (rf * cf[bj][j]); o[4 + j] = (float)v1[j] * (rf * cf[bj][4 + j]); }
                    if (MODE == 3) {
#pragma unroll
                        for (int j = 0; j < 8; ++j) o[j] = sigm(o[j]); }
                    if (MODE == 6) { float ev[8]; unpack8(ew[m][bj], ev);
#pragma unroll
                        for (int j = 0; j < 8; ++j) o[j] = sigm(o[j]) * ev[j]; }
                    if (MODE == 0) st16nt(base + off + bj * HALF, pack8(o)); else st16(base + off + bj * HALF, pack8(o)); } } }
    }
};
template <int MODE> struct EpiMix {
    static constexpr bool PERM = true, AFTER_DRAIN = false, HAS_MID = false;
    bf16_t* T; const bf16_t* S2; int ldc;
    __device__ __forceinline__ void operator()(const f32x4 (&acc)[2][2][4][2], const Unit& u, int wr, int wc, int fr, int fq) const {
        const int row0 = u.pm * BM + wr * 64 + fr, col0 = u.pn * BM + wc * 32 + 8 * fq;
#pragma unroll
        for (int ai = 0; ai < 2; ++ai)
#pragma unroll
            for (int m = 0; m < 4; ++m) { const size_t off = (size_t)(row0 + ai * HALF + m * 16) * ldc + col0;
#pragma unroll
                for (int bj = 0; bj < 2; ++bj) { const f32x4 v0 = acc[ai][bj][m][0], v1 = acc[ai][bj][m][1]; float o[8];
#pragma unroll
                    for (int j = 0; j < 4; ++j) { o[j] = v0[j]; o[4 + j] = v1[j]; }
                    if (MODE == 1) { float t[8]; unpack8(*(const u32x4*)(T + off + bj * HALF), t);
#pragma unroll
                        for (int j = 0; j < 8; ++j) o[j] = t[j] * o[j]; }
                    if (MODE == 2) { float t[8], s[8]; unpack8(*(const u32x4*)(T + off + bj * HALF), t); unpack8(*(const u32x4*)(S2 + off + bj * HALF), s);
#pragma unroll
                        for (int j = 0; j < 8; ++j) o[j] = t[j] + s[j] * o[j]; }
                    st16(T + off + bj * HALF, pack8(o)); } }
    }
};
struct EpiPleB {
    static constexpr bool PERM = true, AFTER_DRAIN = false, HAS_MID = false;
    const bf16_t* E; bf16_t* Y; int ldc;
    __device__ __forceinline__ void operator()(const f32x4 (&acc)[2][2][4][2], const Unit& u, int wr, int wc, int fr, int fq) const {
        const int row0 = u.pm * BM + wr * 64 + fr, col0 = u.pn * BM + wc * 32 + 8 * fq;
#pragma unroll
        for (int ai = 0; ai < 2; ++ai)
#pragma unroll
            for (int m = 0; m < 4; ++m) { const size_t off = (size_t)(row0 + ai * HALF + m * 16) * ldc + col0;
#pragma unroll
                for (int bj = 0; bj < 2; ++bj) { const f32x4 v0 = acc[ai][bj][m][0], v1 = acc[ai][bj][m][1]; float e[8], o[8]; unpack8(*(const u32x4*)(E + off + bj * HALF), e);
#pragma unroll
                    for (int j = 0; j < 4; ++j) { o[j] = sigm(v0[j]) * e[j]; o[4 + j] = sigm(v1[j]) * e[4 + j]; }
                    st16(Y + off + bj * HALF, pack8(o)); } }
    }
};

struct EpiGU8 {
    static constexpr bool PERM = true, AFTER_DRAIN = false, HAS_MID = false;
    bf16_t* H; int ldh; const float* RS; const float* CMAX;
    __device__ __forceinline__ void operator()(const i32x4 (&acc)[2][2][4][2], const Unit& u, int wr, int wc, int fr, int fq) const {
        const int row0 = u.pm * BM + wr * 64 + fr, cw = wc * 32 + 8 * fq, col0 = u.pn * HALF + cw;
        float rsv[2][4];
#pragma unroll
        for (int ai = 0; ai < 2; ++ai)
#pragma unroll
            for (int m = 0; m < 4; ++m) rsv[ai][m] = RS[row0 + ai * HALF + m * 16];
        float cg[8], cu[8];
#pragma unroll
        for (int j = 0; j < 8; ++j) { cg[j] = CMAX[u.pn * BM + cw + j] * (1.0f / 127.0f); cu[j] = CMAX[u.pn * BM + HALF + cw + j] * (1.0f / 127.0f); }
#pragma unroll
        for (int ai = 0; ai < 2; ++ai)
#pragma unroll
            for (int m = 0; m < 4; ++m) { const int row = row0 + ai * HALF + m * 16; const float rs = rsv[ai][m]; bf16_t* rowp = H + (size_t)row * ldh + col0;
                const i32x4 g0 = acc[ai][0][m][0], g1 = acc[ai][0][m][1], u0 = acc[ai][1][m][0], u1 = acc[ai][1][m][1]; float o[8];
#pragma unroll
                for (int j = 0; j < 4; ++j) { const float ga = (float)g0[j] * (rs * cg[j]), gb = (float)g1[j] * (rs * cg[4 + j]), ua = (float)u0[j] * (rs * cu[j]), ub = (float)u1[j] * (rs * cu[4 + j]);
                    o[j] = ga * sigm(ga) * ua; o[4 + j] = gb * sigm(gb) * ub; }
                st16nt(rowp, pack8(o)); }
    }
};

struct EpiMerge {
    static constexpr bool PERM = true, AFTER_DRAIN = false, HAS_MID = true;
    bf16_t* T; const bf16_t* S2; int ldc;
    __device__ __forceinline__ void mid(f32x4 (&acc)[2][2][4][2], const Unit& u, int wr, int wc, int fr, int fq) const {
        const int row0 = u.pm * BM + wr * 64 + fr, col0 = u.pn * BM + wc * 32 + 8 * fq;
#pragma unroll
        for (int ai = 0; ai < 2; ++ai)
#pragma unroll
            for (int m = 0; m < 4; ++m)
#pragma unroll
                for (int bj = 0; bj < 2; ++bj) { const size_t off = (size_t)(row0 + ai * HALF + m * 16) * ldc + col0 + bj * HALF;
                    const u32x4 tw = *(const u32x4*)(T + off), sw = *(const u32x4*)(S2 + off);
                    acc[ai][bj][m][0][0] *= bf_lo(tw.x) * __builtin_amdgcn_rcpf(bf_lo(sw.x)); acc[ai][bj][m][0][1] *= bf_hi(tw.x) * __builtin_amdgcn_rcpf(bf_hi(sw.x));
                    acc[ai][bj][m][0][2] *= bf_lo(tw.y) * __builtin_amdgcn_rcpf(bf_lo(sw.y)); acc[ai][bj][m][0][3] *= bf_hi(tw.y) * __builtin_amdgcn_rcpf(bf_hi(sw.y));
                    acc[ai][bj][m][1][0] *= bf_lo(tw.z) * __builtin_amdgcn_rcpf(bf_lo(sw.z)); acc[ai][bj][m][1][1] *= bf_hi(tw.z) * __builtin_amdgcn_rcpf(bf_hi(sw.z));
                    acc[ai][bj][m][1][2] *= bf_lo(tw.w) * __builtin_amdgcn_rcpf(bf_lo(sw.w)); acc[ai][bj][m][1][3] *= bf_hi(tw.w) * __builtin_amdgcn_rcpf(bf_hi(sw.w));
                    asm volatile("" ::: "memory"); }
    }
    __device__ __forceinline__ void operator()(const f32x4 (&acc)[2][2][4][2], const Unit& u, int wr, int wc, int fr, int fq) const {
        const int row0 = u.pm * BM + wr * 64 + fr, col0 = u.pn * BM + wc * 32 + 8 * fq;
#pragma unroll
        for (int ai = 0; ai < 2; ++ai) {
            u32x4 sw[4][2];
#pragma unroll
            for (int m = 0; m < 4; ++m)
#pragma unroll
                for (int bj = 0; bj < 2; ++bj) sw[m][bj] = *(const u32x4*)(S2 + (size_t)(row0 + ai * HALF + m * 16) * ldc + col0 + bj * HALF);
#pragma unroll
            for (int m = 0; m < 4; ++m) { const size_t off = (size_t)(row0 + ai * HALF + m * 16) * ldc + col0;
#pragma unroll
                for (int bj = 0; bj < 2; ++bj) { const f32x4 v0 = acc[ai][bj][m][0], v1 = acc[ai][bj][m][1]; float s[8], o[8]; unpack8(sw[m][bj], s);
#pragma unroll
                    for (int j = 0; j < 4; ++j) { o[j] = v0[j] * s[j]; o[4 + j] = v1[j] * s[4 + j]; }
                    st16(T + off + bj * HALF, pack8(o)); } } }
    }
};

struct EpiNull {
    static constexpr bool PERM = true, AFTER_DRAIN = false, HAS_MID = false;
    template <class AT> __device__ __forceinline__ void operator()(const AT (&acc)[2][2][4][2], const Unit& u, int wr, int wc, int fr, int fq) const {
#pragma unroll
        for (int ai = 0; ai < 2; ++ai)
#pragma unroll
            for (int bj = 0; bj < 2; ++bj)
#pragma unroll
                for (int m = 0; m < 4; ++m)
#pragma unroll
                    for (int n = 0; n < 2; ++n) asm volatile("" :: "v"(acc[ai][bj][m][n]));
    }
};

template <bool I8> struct AccT { typedef f32x4 T; }; template <> struct AccT<true> { typedef i32x4 T; };
template <class Epi, class Sched, bool ALIGN_EPI = false, bool SP2 = false, bool I8 = false>
__device__ __forceinline__ void gemm_phase(PG8_LAS unsigned char* lds, const Gemm g, const Sched& S, const Epi& E) {
    int tid_ = threadIdx.x; asm volatile("" : "+v"(tid_));
    const int tid = tid_, wid = __builtin_amdgcn_readfirstlane(tid >> 6), lane = tid & 63, wr = wid >> 2, wc = wid & 3, fr = lane & 15, fq = lane >> 4;
    int K_ = g.K; asm volatile("" : "+s"(K_));
    const int K = K_, nt = (g.Klen ? g.Klen : K) / BK;
    const size_t koff = (size_t)(g.Klen ? g.Klen : K) * 2;
    unsigned voffA[2], voffB[2];
#pragma unroll
    for (int i = 0; i < 2; ++i) { int R, C; stage_rc(tid * 16 + i * 8192, R, C); const int Rb = Epi::PERM ? ((R & ~31) + perm32(R & 31)) : R;
        voffA[i] = (unsigned)(R * K + C) * 2u; voffB[i] = (unsigned)(Rb * K + C) * 2u; }
    const size_t kstep = (size_t)(BK * 2);
    const size_t hstep = (size_t)HALF * K * 2;
    const size_t tstep = 2 * hstep;
    const unsigned ldsw = (unsigned)wid * 1024u;
    const int aoff = lds_byte(wr * 64 + fr, fq * 8), boff = lds_byte(wc * 32 + fr, fq * 8);
#define PG8_SA(b, h) (((b) * 2 + (h)) * HTB)
#define PG8_SB(b, h) ((4 + (b) * 2 + (h)) * HTB)
#define PG8_STAGE(bufoff, gbase, voff) do { _Pragma("unroll") for (int _i = 0; _i < 2; ++_i) \
        __builtin_amdgcn_global_load_lds((const unsigned*)((const char*)(gbase) + (voff)[_i]), (PG8_LAS unsigned*)(lds + (bufoff) + ldsw + _i * 8192), 16, 0, 0); } while (0)
#define PG8_LDA(dst, b, h) do { _Pragma("unroll") for (int m = 0; m < 4; ++m) _Pragma("unroll") for (int k = 0; k < 2; ++k) dst[m][k] = *(const PG8_LAS bf16x8*)(lds + PG8_SA(b, h) + aoff + m * 2048 + k * 1024); } while (0)
#define PG8_LDB(dst, b, h) do { _Pragma("unroll") for (int n = 0; n < 2; ++n) _Pragma("unroll") for (int k = 0; k < 2; ++k) dst[n][k] = *(const PG8_LAS bf16x8*)(lds + PG8_SB(b, h) + boff + n * 2048 + k * 1024); } while (0)
#define PG8_MMA(ai, bj, At, Bt) do { __builtin_amdgcn_s_setprio(1); _Pragma("unroll") for (int m = 0; m < 4; ++m) _Pragma("unroll") for (int n = 0; n < 2; ++n) _Pragma("unroll") for (int k = 0; k < 2; ++k) \
        { if constexpr (I8) acc[ai][bj][m][n] = __builtin_amdgcn_mfma_i32_16x16x64_i8(__builtin_bit_cast(i32x4, Bt[n][k]), __builtin_bit_cast(i32x4, At[m][k]), acc[ai][bj][m][n], 0, 0, 0); \
          else acc[ai][bj][m][n] = __builtin_amdgcn_mfma_f32_16x16x32_bf16(Bt[n][k], At[m][k], acc[ai][bj][m][n], 0, 0, 0); } __builtin_amdgcn_s_setprio(0); } while (0)
#define PG8_WAIT_V(n) asm volatile("s_waitcnt vmcnt(" #n ")" ::: "memory")
#define PG8_WAIT_L(n) asm volatile("s_waitcnt lgkmcnt(" #n ")" ::: "memory")
#define PG8_BAR __builtin_amdgcn_s_barrier()
#define PG8_SCHED __builtin_amdgcn_sched_barrier(0)
    Unit cur, nxt; int ui = 0;
    if (!S.next(0, cur)) return;
    typedef typename AccT<I8>::T acc_t; acc_t acc[2][2][4][2];
#pragma unroll
    for (int a = 0; a < 2; ++a)
#pragma unroll
        for (int b = 0; b < 2; ++b)
#pragma unroll
            for (int m = 0; m < 4; ++m)
#pragma unroll
                for (int n = 0; n < 2; ++n) acc[a][b][m][n] = (acc_t){0, 0, 0, 0};
    bf16x8 At[4][2], B0[2][2], B1[2][2];
    const char* cA = (const char*)g.A + (size_t)cur.pm * tstep + cur.half * koff; const char* cB = (const char*)g.Bt + (size_t)cur.pn * tstep + cur.half * koff;
    S.a_ready(cur);
    if constexpr (SP2) {
        PG8_STAGE(PG8_SB(0, 0), cB, voffB); PG8_STAGE(PG8_SB(0, 1), cB + hstep, voffB); PG8_STAGE(PG8_SA(0, 0), cA, voffA); PG8_STAGE(PG8_SA(0, 1), cA + hstep, voffA);
        if (wr == 1) PG8_BAR;
        PG8_WAIT_V(2); PG8_BAR;
        PG8_STAGE(PG8_SB(1, 0), cB + kstep, voffB); PG8_STAGE(PG8_SA(1, 0), cA + kstep, voffA); PG8_STAGE(PG8_SB(1, 1), cB + hstep + kstep, voffB);
        PG8_WAIT_V(6); PG8_BAR;
    } else {
        PG8_STAGE(PG8_SB(0, 0), cB, voffB); PG8_STAGE(PG8_SA(0, 0), cA, voffA); PG8_STAGE(PG8_SB(0, 1), cB + hstep, voffB); PG8_STAGE(PG8_SA(0, 1), cA + hstep, voffA);
        if (wr == 1) PG8_BAR;
        PG8_WAIT_V(4); PG8_BAR;
        PG8_STAGE(PG8_SB(1, 0), cB + kstep, voffB); PG8_STAGE(PG8_SA(1, 0), cA + kstep, voffA); PG8_STAGE(PG8_SB(1, 1), cB + hstep + kstep, voffB);
        PG8_WAIT_V(6); PG8_BAR;
    }
    for (;;) {
        const bool has_next = S.next(ui + 1, nxt);
        const char* nA = has_next ? (const char*)g.A + (size_t)nxt.pm * tstep + nxt.half * koff : cA; const char* nB = has_next ? (const char*)g.Bt + (size_t)nxt.pn * tstep + nxt.half * koff : cB;
        for (int t = 0; t < nt; t += 2) {
            const bool last = (t == nt - 2);
            const char* a1 = cA + (size_t)(t + 1) * kstep;
            const char* a2 = last ? nA : cA + (size_t)(t + 2) * kstep; const char* b2 = last ? nB : cB + (size_t)(t + 2) * kstep;
            const char* a3 = a2 + kstep; const char* b3 = b2 + kstep;
            if (last && has_next) S.a_ready(nxt);
            if constexpr (SP2) {
            PG8_LDB(B0, 0, 0); PG8_LDB(B1, 0, 1); PG8_SCHED; PG8_LDA(At, 0, 0); PG8_STAGE(PG8_SA(1, 1), a1 + hstep, voffA);
            PG8_WAIT_V(8); PG8_WAIT_L(0); PG8_BAR; PG8_MMA(0, 0, At, B0); PG8_MMA(0, 1, At, B1); PG8_BAR; PG8_SCHED;
            PG8_LDA(At, 0, 1); PG8_STAGE(PG8_SB(0, 0), b2, voffB); PG8_STAGE(PG8_SB(0, 1), b2 + hstep, voffB); PG8_STAGE(PG8_SA(0, 0), a2, voffA);
            PG8_WAIT_V(8); PG8_WAIT_L(0); PG8_BAR; PG8_MMA(1, 0, At, B0); PG8_MMA(1, 1, At, B1); PG8_BAR; PG8_SCHED;
            PG8_LDB(B0, 1, 0); PG8_LDB(B1, 1, 1); PG8_SCHED; PG8_LDA(At, 1, 0); PG8_STAGE(PG8_SA(0, 1), a2 + hstep, voffA);
            PG8_WAIT_V(8); PG8_WAIT_L(0); PG8_BAR; PG8_MMA(0, 0, At, B0); PG8_MMA(0, 1, At, B1); PG8_BAR; PG8_SCHED;
            PG8_LDA(At, 1, 1); PG8_STAGE(PG8_SB(1, 0), b3, voffB); PG8_STAGE(PG8_SB(1, 1), b3 + hstep, voffB); PG8_STAGE(PG8_SA(1, 0), a3, voffA);
            PG8_WAIT_V(8); PG8_WAIT_L(0); PG8_BAR; PG8_MMA(1, 0, At, B0); PG8_MMA(1, 1, At, B1); PG8_BAR; PG8_SCHED;
            } else {
            PG8_LDB(B0, 0, 0); PG8_SCHED; PG8_LDA(At, 0, 0); PG8_STAGE(PG8_SA(1, 1), a1 + hstep, voffA);
            PG8_WAIT_L(8); PG8_BAR; PG8_WAIT_L(0); PG8_MMA(0, 0, At, B0); PG8_BAR; PG8_SCHED;
            PG8_LDB(B1, 0, 1); PG8_STAGE(PG8_SB(0, 0), b2, voffB);
            PG8_BAR; PG8_WAIT_L(0); PG8_MMA(0, 1, At, B1); PG8_BAR;
            PG8_LDA(At, 0, 1); PG8_STAGE(PG8_SA(0, 0), a2, voffA);
            PG8_BAR; PG8_WAIT_L(0); PG8_MMA(1, 0, At, B0); PG8_BAR; PG8_SCHED;
            PG8_STAGE(PG8_SB(0, 1), b2 + hstep, voffB);
            PG8_WAIT_V(6); PG8_BAR; PG8_MMA(1, 1, At, B1); PG8_BAR;
            PG8_LDB(B0, 1, 0); PG8_SCHED; PG8_LDA(At, 1, 0); PG8_STAGE(PG8_SA(0, 1), a2 + hstep, voffA);
            PG8_WAIT_L(8); PG8_BAR; PG8_WAIT_L(0); PG8_MMA(0, 0, At, B0); PG8_BAR; PG8_SCHED;
            PG8_LDB(B1, 1, 1); PG8_STAGE(PG8_SB(1, 0), b3, voffB);
            PG8_BAR; PG8_WAIT_L(0); PG8_MMA(0, 1, At, B1); PG8_BAR;
            PG8_LDA(At, 1, 1); PG8_STAGE(PG8_SA(1, 0), a3, voffA);
            PG8_BAR; PG8_WAIT_L(0); PG8_MMA(1, 0, At, B0); PG8_BAR; PG8_SCHED;
            PG8_STAGE(PG8_SB(1, 1), b3 + hstep, voffB);
            PG8_WAIT_V(6); PG8_BAR; PG8_MMA(1, 1, At, B1); PG8_BAR;
            }
        }
        if constexpr (ALIGN_EPI) { if (wr == 0) PG8_BAR; }
        if constexpr (Epi::HAS_MID) { if (cur.half == 0) E.mid(acc, cur, wr, wc, fr, fq); else E(acc, cur, wr, wc, fr, fq); }
        else if constexpr (!Epi::AFTER_DRAIN) { E(acc, cur, wr, wc, fr, fq); S.done(cur); }
        if (!has_next) break;
        if (!(Epi::HAS_MID && nxt.half == 1))
#pragma unroll
        for (int a = 0; a < 2; ++a)
#pragma unroll
            for (int b = 0; b < 2; ++b)
#pragma unroll
                for (int m = 0; m < 4; ++m)
#pragma unroll
                    for (int n = 0; n < 2; ++n) acc[a][b][m][n] = (acc_t){0, 0, 0, 0};
        cur = nxt; cA = nA; cB = nB; ++ui;
        if constexpr (ALIGN_EPI) { if (wr == 1) PG8_BAR; }
    }
    PG8_WAIT_V(0);
    if constexpr (!ALIGN_EPI) { if (wr == 0) PG8_BAR; }
    PG8_BAR;
    if constexpr (Epi::AFTER_DRAIN) { E.fused(acc, cur, wr, wc, fr, fq, lds, wid, lane); S.done(cur); }
#undef PG8_SA
#undef PG8_SB
#undef PG8_STAGE
#undef PG8_LDA
#undef PG8_LDB
#undef PG8_MMA
#undef PG8_WAIT_V
#undef PG8_WAIT_L
#undef PG8_BAR
#undef PG8_SCHED
}
}
#ifndef PG8_SP2
#define PG8_SP2 true
#endif
#ifndef PG8_ALIGN
#define PG8_ALIGN true
#endif
constexpr int NWAVES = 8;
constexpr int BATCH = 4, SEQ = 8192, D = 1024, FF = 2816, NGU = 2 * FF, NIN = 5632, PLE = 256;
constexpr int M = BATCH * SEQ;
constexpr int MBH = 8, MBD = 64, MBW = 512, MBB = 256, NBLK = SEQ / MBB;
constexpr int HGH = 4, HGD_ = 128, HGW = 512, HGC = 256, HGNC = SEQ / HGC;
constexpr float EPS = 1e-6f;
constexpr size_t MiB = 1u << 20;
constexpr size_t WS_CTL = 0, CTL_ZERO_BYTES = 1 * MiB;
constexpr size_t WS_KMEAN = 512 * 1024;
constexpr size_t WS_LB = 768 * 1024, WS_BIAST = 772 * 1024;
constexpr size_t WS_WGU1 = 1 * MiB, WS_WD1 = 12 * MiB, WS_WIN = WS_WD1 + 5632 * 1024, WS_WA = WS_WIN + 11 * MiB, WS_WB = WS_WA + 1 * MiB, WS_WOUT = WS_WB + 1 * MiB,
                 WS_WGU2 = WS_WOUT + 2 * MiB, WS_WD2 = WS_WGU2 + 11 * MiB, WS_WPLE = WS_WD2 + 5632 * 1024, WS_WPG = WS_WPLE + 512 * 1024, WS_HGD = WS_WPG + 2 * MiB;
constexpr size_t WS_CMAX = 128 * 1024;
constexpr int CM_GU1 = 0, CM_GU2 = 5632, CM_IN = 11264, CM_PG = 11264 + 5120;
constexpr size_t WS_DYN = 64 * 1024;
constexpr size_t WS_CNT = 256 * 1024;
constexpr size_t WS_A = 52 * MiB;
constexpr size_t WS_Q = WS_A, WS_K = WS_A + 32 * MiB, WS_VT = WS_A + 64 * MiB, WS_HQ = WS_A + 96 * MiB, WS_HI = WS_A + 128 * MiB;
constexpr size_t WS_LIST = 212 * MiB;
constexpr size_t WS_PB = 228 * MiB;
constexpr size_t WS_SB = 228 * MiB;
constexpr size_t WS_RS = 300 * MiB;
constexpr size_t WS_R2 = WS_RS + 128 * 1024;
constexpr size_t WS_W8IN = WS_WIN + 1 * MiB;
constexpr size_t WS_X8B = WS_A + 64 * MiB;
constexpr size_t WS_PML = 292 * MiB;
constexpr size_t WS_B = 320 * MiB;
constexpr size_t WS_KIN = WS_B, WS_HG = WS_B + 32 * MiB, WS_SA = WS_B + 64 * MiB;
constexpr size_t WS_C = 448 * MiB;
constexpr size_t WS_OAB = WS_C;
constexpr size_t WS_PO0 = WS_HQ, WS_PO1 = WS_HI, WS_PO2 = WS_KIN, WS_PO3 = WS_HG;
constexpr size_t WS_END = 512 * MiB;
static_assert(WS_HGD + 256 * 1024 <= WS_A, "weights region");
constexpr int LIST_PER_BH = 126976;
constexpr int CW_TMO = 0, CW_CODE = 1, CW_BAR = 4096;
constexpr int RING_OFF = 0, RING_BYTES = 131072, LDSCTL_OFF = RING_BYTES, MISC_OFF = LDSCTL_OFF + 320, LDS_BYTES = 147456;
#define GAS __attribute__((address_space(1)))
#define LAS __attribute__((address_space(3)))
typedef unsigned short bf16;
typedef unsigned v4u __attribute__((ext_vector_type(4)));
typedef unsigned v2u __attribute__((ext_vector_type(2)));
typedef float f32x4 __attribute__((ext_vector_type(4)));
typedef GAS unsigned gu32;
#define RLX_AGENT __ATOMIC_RELAXED, __HIP_MEMORY_SCOPE_AGENT
#define LDS_WAIT() asm volatile("s_waitcnt lgkmcnt(0)" ::: "memory")
#define VM_WAIT() asm volatile("s_waitcnt vmcnt(0)" ::: "memory")
__device__ __forceinline__ unsigned f2bf(float f) { unsigned u = __builtin_bit_cast(unsigned, f); return (u + 0x7fffu + ((u >> 16) & 1u)) >> 16; }
__device__ __forceinline__ unsigned pk2(float lo, float hi) { return f2bf(lo) | (f2bf(hi) << 16); }
__device__ __forceinline__ float bflo(unsigned w) { return __uint_as_float(w << 16); }
__device__ __forceinline__ float bfhi(unsigned w) { return __uint_as_float(w & 0xffff0000u); }
__device__ __forceinline__ float wave_sum(float v) {
#pragma unroll
    for (int o = 1; o < 64; o <<= 1) v += __shfl_xor(v, o);
    return v;
}
__device__ __forceinline__ float wave_max(float v) {
#pragma unroll
    for (int o = 1; o < 64; o <<= 1) v = fmaxf(v, __shfl_xor(v, o));
    return v;
}
#define XB_TMO      128
#define XB_XCNT(j)  (256  + 64 * (j))
#define XB_XSUB(j)  (1280 + 64 * (j))
#define XB_XGEN(j)  (2304 + 64 * (j))
#define XB_TOP      3328
#define XB_TOPGEN   3392
#define XCD_BAR_WORDS 3456
#define XB_SPIN_CAP (1u << 18)

__device__ __forceinline__ unsigned xb_ld(unsigned* p)              { return __hip_atomic_load(p, __ATOMIC_RELAXED, __HIP_MEMORY_SCOPE_AGENT); }
__device__ __forceinline__ unsigned xb_add(unsigned* p, unsigned v) { return __hip_atomic_fetch_add(p, v, __ATOMIC_RELAXED, __HIP_MEMORY_SCOPE_AGENT); }
__device__ __forceinline__ unsigned xb_xcc_id() { return (unsigned)__builtin_amdgcn_s_getreg((3 << 11) | 20) & 0xFu; }
#define XB_SPIN(cond, bar) do { unsigned _sp = 0; while (cond) { __builtin_amdgcn_s_sleep(1); \
    if ((++_sp & 255u) == 0u) { if (xb_ld(&(bar)[XB_TMO])) break; if (_sp > XB_SPIN_CAP) { atomicAdd(&(bar)[XB_TMO], 1u); break; } } } } while (0)

struct XcdBarrier {
    unsigned* bar; unsigned x;
    volatile LAS unsigned* st;
};

__device__ __forceinline__ XcdBarrier xcd_barrier_post(unsigned* bar, volatile LAS unsigned* st) {
    XcdBarrier b; b.bar = bar; b.x = xb_xcc_id(); b.st = st;
    if (threadIdx.x == 0) (void)xb_add(&bar[XB_XCNT(b.x)], 1u);
    return b;
}
__device__ __forceinline__ void xcd_barrier_complete(unsigned* bar, unsigned x, unsigned& nloc, unsigned& nx) {
    const unsigned G = gridDim.x * gridDim.y * gridDim.z;
    unsigned sum, cnt, mine, sp = 0u;
    for (;;) {
        sum = 0u; cnt = 0u; mine = 0u;
#pragma unroll
        for (unsigned j = 0; j < 16; ++j) { const unsigned c = xb_ld(&bar[XB_XCNT(j)]); sum += c; cnt += (c > 0u) ? 1u : 0u; mine = (j == x) ? c : mine; }
        if (sum == G) break;
        __builtin_amdgcn_s_sleep(1);
        if ((++sp & 255u) == 0u) { if (xb_ld(&bar[XB_TMO])) break; if (sp > XB_SPIN_CAP) { atomicAdd(&bar[XB_TMO], 1u); break; } }
    }
    nloc = mine > 0u ? mine : 1u; nx = cnt > 0u ? cnt : 1u;
}

__device__ __forceinline__ void xcd_barrier(const XcdBarrier& b) {
    asm volatile("s_waitcnt vmcnt(0)" ::: "memory");
    __syncthreads();
    if (threadIdx.x == 0) {
        unsigned* bar = b.bar;
        __builtin_amdgcn_s_waitcnt(0);
        unsigned nloc = b.st[0], nx = b.st[1];
        if (nloc == 0u) { xcd_barrier_complete(bar, b.x, nloc, nx); b.st[0] = nloc; b.st[1] = nx; }
        const unsigned old = xb_add(&bar[XB_XSUB(b.x)], 1u);
        const unsigned gen = old / nloc;
        if (old + 1u == (gen + 1u) * nloc) {
            __builtin_amdgcn_fence(__ATOMIC_RELEASE, "agent");
            asm volatile("s_waitcnt vmcnt(0)" ::: "memory");
            const unsigned og = xb_add(&bar[XB_TOP], 1u);
            const unsigned tg = og / nx;
            if (og + 1u == (tg + 1u) * nx) xb_add(&bar[XB_TOPGEN], 1u);
            else XB_SPIN(xb_ld(&bar[XB_TOPGEN]) == tg, bar);
            __builtin_amdgcn_fence(__ATOMIC_ACQUIRE, "agent");
            xb_add(&bar[XB_XGEN(b.x)], 1u);
            asm volatile("s_waitcnt vmcnt(0)" ::: "memory");
        } else {
            XB_SPIN(xb_ld(&bar[XB_XGEN(b.x)]) == gen, bar);
            __builtin_amdgcn_fence(__ATOMIC_ACQUIRE, "agent");
            asm volatile("s_waitcnt vmcnt(0)" ::: "memory");
        }
    }
    __syncthreads();
}
__device__ __forceinline__ int inb_row(int n0) { if (n0 < 512) return n0; return -1; }
__device__ __forceinline__ int in8_row(int n0) { if (n0 >= 3584) return n0 - 3584; if (n0 >= 1536) return 2048 + (n0 - 1536); if (n0 >= 1024) return 4608 + (n0 - 1024); if (n0 >= 512) return 4096 + (n0 - 512); return -1; }
__device__ __forceinline__ int map_row(int mode, int n0);
__device__ __forceinline__ void p0_transpose_item(const float* W, int K, int N, bf16* WT, const float* gain, int mode, LAS float* scr, int item, int lane, int ldo = 0) {
    if (ldo == 0) ldo = K;
    const int nblk = N / 32, kb = item / nblk, nb = item % nblk, k0 = 64 * kb, n0 = 32 * nb;
#pragma unroll 8
    for (int i = 0; i < 32; ++i) { const int kk = 2 * i + (lane >> 5); float w = W[(size_t)(k0 + kk) * N + n0 + (lane & 31)]; if (gain) w *= gain[k0 + kk]; scr[kk * 33 + (lane & 31)] = w; }
    LDS_WAIT(); asm volatile("" ::: "memory");
    int rbase = n0;
    if (mode == 1) { if (n0 < FF) rbase = (n0 / 128) * 256 + (n0 % 128); else { const int j = n0 - FF; rbase = (j / 128) * 256 + 128 + (j % 128); } }
    if (mode == 3) rbase = inb_row(n0);
    const int c = lane & 7;
#pragma unroll
    for (int j = 0; j < 4; ++j) { const int n = (lane >> 3) + 8 * j; const LAS float* s = scr + (8 * c) * 33 + n;
        v4u o; o.x = pk2(s[0 * 33], s[1 * 33]); o.y = pk2(s[2 * 33], s[3 * 33]); o.z = pk2(s[4 * 33], s[5 * 33]); o.w = pk2(s[6 * 33], s[7 * 33]);
        *(GAS v4u*)(WT + (size_t)(rbase + n) * ldo + k0 + 8 * c) = o; }
    LDS_WAIT(); asm volatile("" ::: "memory");
}
__device__ __forceinline__ int gu_row(int n0) { if (n0 < FF) return (n0 / 128) * 256 + (n0 % 128); const int j = n0 - FF; return (j / 128) * 256 + 128 + (j % 128); }
__device__ __forceinline__ int map_row(int mode, int n0) { return mode == 1 ? gu_row(n0) : mode == 3 ? in8_row(n0) : n0; }
__device__ __forceinline__ void p0_colmax_item(const float* W, int N, const float* gain, unsigned* CMAXB, int mode, int item, int lane) {
    const int nblk = N / 32, kb = item / nblk, nb = item % nblk, k0 = 64 * kb, n0 = 32 * nb; float mx = 0.f;
#pragma unroll 8
    for (int i = 0; i < 32; ++i) { const int kk = 2 * i + (lane >> 5); mx = fmaxf(mx, fabsf(W[(size_t)(k0 + kk) * N + n0 + (lane & 31)] * (gain ? gain[k0 + kk] : 1.0f))); }
    mx = fmaxf(mx, __shfl_xor(mx, 32));
    if (lane < 32) atomicMax(CMAXB + map_row(mode, n0) + lane, __float_as_uint(mx));
}
__device__ __forceinline__ void p0_quant_item(const float* W, int N, const float* gain, const float* CMAX, signed char* W8, int K, int mode, LAS float* scr, int item, int lane) {
    const int nblk = N / 32, kb = item / nblk, nb = item % nblk, k0 = 64 * kb, n0 = 32 * nb, rbase = map_row(mode, n0);
    if (rbase < 0) return;
    const float inv = 127.0f / fmaxf(CMAX[rbase + (lane & 31)], 1e-30f);
#pragma unroll 8
    for (int i = 0; i < 32; ++i) { const int kk = 2 * i + (lane >> 5); scr[kk * 33 + (lane & 31)] = rintf(W[(size_t)(k0 + kk) * N + n0 + (lane & 31)] * (gain ? gain[k0 + kk] : 1.0f) * inv); }
    LDS_WAIT(); asm volatile("" ::: "memory");
    const int c = lane & 3;
#pragma unroll
    for (int j = 0; j < 2; ++j) { const int n = (lane >> 2) + 16 * j; const LAS float* sp = scr + (16 * c) * 33 + n; unsigned w[4];
#pragma unroll
        for (int q = 0; q < 4; ++q) { const int b0 = (int)sp[(4 * q) * 33], b1 = (int)sp[(4 * q + 1) * 33], b2 = (int)sp[(4 * q + 2) * 33], b3 = (int)sp[(4 * q + 3) * 33];
            w[q] = (unsigned)(b0 & 255) | ((unsigned)(b1 & 255) << 8) | ((unsigned)(b2 & 255) << 16) | ((unsigned)(b3 & 255) << 24); }
        *(GAS v4u*)(W8 + (size_t)(rbase + n) * K + k0 + 16 * c) = (v4u){w[0], w[1], w[2], w[3]}; }
    LDS_WAIT(); asm volatile("" ::: "memory");
}
__device__ __forceinline__ void p0_quant_block(const float* W, int N, const float* gain, float* CMAX, signed char* W8, int mode, int n0, LAS float* scr, LAS float* cm, int wave, int lane) {
    const int rbase = map_row(mode, n0); float mx = 0.f;
    LAS float* gl = scr + 64 * 33;
    gl[lane] = gain ? gain[128 * wave + lane] : 1.0f; gl[64 + lane] = gain ? gain[128 * wave + 64 + lane] : 1.0f;
    const unsigned voff = (unsigned)((lane >> 5) * N + n0 + (lane & 31));
    float wv[2][32];
#pragma unroll
    for (int sl = 0; sl < 2; ++sl)
#pragma unroll
        for (int i = 0; i < 32; ++i) { const float* rp = W + (size_t)(64 * (2 * wave + sl) + 2 * i) * N; wv[sl][i] = rp[voff]; }
    LDS_WAIT(); asm volatile("" ::: "memory");
#pragma unroll
    for (int sl = 0; sl < 2; ++sl)
#pragma unroll
        for (int i = 0; i < 32; ++i) { wv[sl][i] *= gl[sl * 64 + 2 * i + (lane >> 5)]; mx = fmaxf(mx, fabsf(wv[sl][i])); }
    mx = fmaxf(mx, __shfl_xor(mx, 32));
    __syncthreads();
    if (lane < 32) cm[wave * 32 + lane] = mx;
    __syncthreads();
    float cmx = 0.f;
#pragma unroll
    for (int w = 0; w < 8; ++w) cmx = fmaxf(cmx, cm[w * 32 + (lane & 31)]);
    if (wave == 0 && lane < 32) CMAX[rbase + lane] = cmx;
    const float inv = 127.0f / fmaxf(cmx, 1e-30f);
#pragma unroll
    for (int sl = 0; sl < 2; ++sl) { const int k0 = 64 * (2 * wave + sl);
#pragma unroll
        for (int i = 0; i < 32; ++i) { const int kk = 2 * i + (lane >> 5); scr[kk * 33 + (lane & 31)] = rintf(wv[sl][i] * inv); }
        LDS_WAIT(); asm volatile("" ::: "memory");
        const int c = lane & 3;
#pragma unroll
        for (int j = 0; j < 2; ++j) { const int n = (lane >> 2) + 16 * j; const LAS float* sp = scr + (16 * c) * 33 + n; unsigned w[4];
#pragma unroll
            for (int q = 0; q < 4; ++q) { const int b0 = (int)sp[(4 * q) * 33], b1 = (int)sp[(4 * q + 1) * 33], b2 = (int)sp[(4 * q + 2) * 33], b3 = (int)sp[(4 * q + 3) * 33];
                w[q] = (unsigned)(b0 & 255) | ((unsigned)(b1 & 255) << 8) | ((unsigned)(b2 & 255) << 16) | ((unsigned)(b3 & 255) << 24); }
            *(GAS v4u*)(W8 + (size_t)(rbase + n) * 1024 + k0 + 16 * c) = (v4u){w[0], w[1], w[2], w[3]}; }
        LDS_WAIT(); asm volatile("" ::: "memory"); }
}
__device__ __forceinline__ void row_to_i8(const f32x4 (&v)[4], float rstd, signed char* orow, float* rs, int lane) {
    float mx = 0.f;
#pragma unroll
    for (int j = 0; j < 4; ++j) mx = fmaxf(fmaxf(mx, fmaxf(fabsf(v[j].x), fabsf(v[j].y))), fmaxf(fabsf(v[j].z), fabsf(v[j].w)));
    mx = fmaxf(wave_max(mx), 1e-30f); const float inv = 127.0f / mx;
    GAS unsigned* o4 = (GAS unsigned*)orow + lane;
#pragma unroll
    for (int j = 0; j < 4; ++j) { const int b0 = (int)rintf(v[j].x * inv), b1 = (int)rintf(v[j].y * inv), b2 = (int)rintf(v[j].z * inv), b3 = (int)rintf(v[j].w * inv);
        o4[64 * j] = (unsigned)(b0 & 255) | ((unsigned)(b1 & 255) << 8) | ((unsigned)(b2 & 255) << 16) | ((unsigned)(b3 & 255) << 24); }
    if (lane == 0) *rs = mx * rstd * (1.0f / 127.0f);
}
__device__ __forceinline__ void rms_row_to_i8(const float* xrow, signed char* orow, float* rs, int lane) {
    const GAS f32x4* xr = (const GAS f32x4*)xrow + lane;
    f32x4 v[4]; float s = 0.f;
#pragma unroll
    for (int j = 0; j < 4; ++j) { v[j] = xr[64 * j]; s += (v[j].x * v[j].x + v[j].y * v[j].y) + (v[j].z * v[j].z + v[j].w * v[j].w); }
    const float rstd = 1.f / sqrtf(wave_sum(s) * (1.f / D) + EPS);
    row_to_i8(v, rstd, orow, rs, lane);
}
__device__ __forceinline__ void rms_row_to_bf16(const float* xrow, bf16* orow, int lane) {
    const GAS f32x4* xr = (const GAS f32x4*)xrow + lane;
    f32x4 v[4]; float s = 0.f;
#pragma unroll
    for (int j = 0; j < 4; ++j) { v[j] = xr[64 * j]; s += (v[j].x * v[j].x + v[j].y * v[j].y) + (v[j].z * v[j].z + v[j].w * v[j].w); }
    const float rstd = 1.f / sqrtf(wave_sum(s) * (1.f / D) + EPS);
    GAS unsigned long long* o8 = (GAS unsigned long long*)orow + lane;
#pragma unroll
    for (int j = 0; j < 4; ++j) o8[64 * j] = (unsigned long long)pk2(v[j].x * rstd, v[j].y * rstd) | ((unsigned long long)pk2(v[j].z * rstd, v[j].w * rstd) << 32);
}
struct Ptrs {
    const float *x, *p, *w_gu1, *w_d1, *w_in, *w_a, *w_b, *w_out, *w_gu2, *w_d2, *w_ple, *w_pg, *gains, *hgw, *lbp, *rel;
    float* out; unsigned char* ws;
};
template <int STAGE> __device__ __forceinline__ void p0_prologue(const Ptrs P, LAS unsigned char* lds, int gw, int NGW, int wave, int lane, int vcu, int G) {
    LAS float* scr = (LAS float*)(lds + RING_OFF + wave * 16384); LAS float* cm = (LAS float*)(lds + RING_OFF + 130048);
    unsigned char* ws = P.ws; float* CM = (float*)(ws + WS_CMAX);
    constexpr int I_D = (FF / 64) * (D / 32), I_IN = (D / 64) * (NIN / 32), I_AB = (512 / 64) * (D / 32), I_O = (D / 64) * (D / 32), I_PLE = (PLE / 64) * (D / 32);
    if (STAGE == 0) {
        for (int id = vcu; id < 176 + 160; id += G) {
            if (id < 176) p0_quant_block(P.w_gu1, NGU, P.gains + 0 * D, CM + CM_GU1, (signed char*)(ws + WS_WGU1), 1, 32 * id, scr, cm, wave, lane);
            else { const int n0 = 512 + 32 * (id - 176);   p0_quant_block(P.w_in, NIN, P.gains + 2 * D, CM + CM_IN, (signed char*)(ws + WS_W8IN), 3, n0, scr, cm, wave, lane); }
        }
        for (int it = gw; it < I_IN + I_D; it += NGW) {
            int r = it;
            if (r < I_IN) { const int n0 = 32 * (r % (NIN / 32)); if (inb_row(n0) >= 0) p0_transpose_item(P.w_in, D, NIN, (bf16*)(ws + WS_WIN), P.gains + 2 * D, 3, scr, r, lane); continue; } r -= I_IN;
            p0_transpose_item(P.w_d1, FF, D, (bf16*)(ws + WS_WD1), nullptr, 0, scr, r, lane);
        }
    } else {
        for (int id = vcu; id < 176 + 32; id += G) {
            if (id < 176) p0_quant_block(P.w_gu2, NGU, P.gains + 4 * D, CM + CM_GU2, (signed char*)(ws + WS_WGU2), 1, 32 * id, scr, cm, wave, lane);
            else p0_quant_block(P.w_pg, D, nullptr, CM + CM_PG, (signed char*)(ws + WS_WPG), 0, 32 * (id - 176), scr, cm, wave, lane);
        }
        for (int it = gw; it < I_D + 2 * I_AB + I_O + I_PLE; it += NGW) {
            int r = it;
            if (r < I_D)  { p0_transpose_item(P.w_d2, FF, D, (bf16*)(ws + WS_WD2), nullptr, 0, scr, r, lane); continue; } r -= I_D;
            if (r < I_AB) { p0_transpose_item(P.w_a, 512, D, (bf16*)(ws + WS_WA), nullptr, 0, scr, r, lane, 1024); continue; } r -= I_AB;
            if (r < I_AB) { p0_transpose_item(P.w_b, 512, D, (bf16*)(ws + WS_WA) + 512, nullptr, 0, scr, r, lane, 1024); continue; } r -= I_AB;
            if (r < I_O)  { p0_transpose_item(P.w_out, D, D, (bf16*)(ws + WS_WOUT), nullptr, 0, scr, r, lane); continue; } r -= I_O;
            p0_transpose_item(P.w_ple, PLE, D, (bf16*)(ws + WS_WPLE), nullptr, 0, scr, r, lane);
        }
        return;
    }
    { unsigned* dyn = (unsigned*)(ws + WS_DYN); LAS unsigned* nxs = (LAS unsigned*)(lds + RING_OFF + 12288);     const bool t0 = (wave == 0 && lane == 0);
      if (t0) nxs[0] = atomicAdd(dyn, 1u);
      __syncthreads();
      unsigned c = __builtin_amdgcn_readfirstlane(nxs[0]); int par = 1;
      while (c < (unsigned)(M / 16)) {
        unsigned nxt = 0; if (t0) nxt = atomicAdd(dyn, 1u);
        f32x4 v[2][4]; float s[2] = {0.f, 0.f}; const int m0 = (int)c * 16 + wave * 2;
#pragma unroll
        for (int u = 0; u < 2; ++u) { const GAS f32x4* xr = (const GAS f32x4*)(P.x + (size_t)(m0 + u) * D) + lane;
#pragma unroll
            for (int j = 0; j < 4; ++j) v[u][j] = xr[64 * j]; }
#pragma unroll
        for (int u = 0; u < 2; ++u) {
#pragma unroll
            for (int j = 0; j < 4; ++j) s[u] += (v[u][j].x * v[u][j].x + v[u][j].y * v[u][j].y) + (v[u][j].z * v[u][j].z + v[u][j].w * v[u][j].w);
            const int m = m0 + u; const float rstd = 1.f / sqrtf(wave_sum(s[u]) * (1.f / D) + EPS);
            row_to_i8(v[u], rstd, (signed char*)(ws + WS_C) + (size_t)m * D, (float*)(ws + WS_RS) + m, lane); }
        if (t0) nxs[par] = nxt;
        __syncthreads();
        c = __builtin_amdgcn_readfirstlane(nxs[par]); par ^= 1;
      }
    }
    const int gt = gw * 64 + lane;
    if (gt < 512) { const float a = P.lbp[gt], b = P.lbp[512 + gt]; const float mx = fmaxf(a, b); const float ea = expf(a - mx), eb = expf(b - mx); ((float*)(ws + WS_LB))[gt] = ea / (ea + eb); }
    if (gt >= 1024 && gt < 2048) { const int h = (gt - 1024) >> 7, d = (gt - 1024) & 127; int bk;
        if (d < 16) bk = d; else { bk = 16 + (int)(logf((float)d / 16.0f) / logf(8.0f) * 16.0f); if (bk > 31) bk = 31; }
        ((float*)(ws + WS_BIAST))[h * 128 + d] = P.rel[bk * 8 + h]; }
}
template <int STAGE> __device__ __forceinline__ void p0b_quant_phase(const Ptrs P, LAS unsigned char* lds, int gw, int NGW, int wave, int lane) {
    LAS float* scr = (LAS float*)(lds + RING_OFF + wave * 16384); unsigned char* ws = P.ws; const float* CM = (const float*)(ws + WS_CMAX);
    constexpr int I_GU = (D / 64) * (NGU / 32), I_IN = (D / 64) * (NIN / 32), I_O = (D / 64) * (D / 32);
    if (STAGE == 0) {
        for (int it = gw; it < I_GU + I_IN; it += NGW) {
            if (it < I_GU) p0_quant_item(P.w_gu1, NGU, P.gains + 0 * D, CM + CM_GU1, (signed char*)(ws + WS_WGU1), D, 1, scr, it, lane);
            else p0_quant_item(P.w_in, NIN, P.gains + 2 * D, CM + CM_IN, (signed char*)(ws + WS_W8IN), D, 3, scr, it - I_GU, lane);
        }
    } else {
        for (int it = gw; it < I_GU + I_O; it += NGW) {
            if (it < I_GU) p0_quant_item(P.w_gu2, NGU, P.gains + 4 * D, CM + CM_GU2, (signed char*)(ws + WS_WGU2), D, 1, scr, it, lane);
            else p0_quant_item(P.w_pg, D, nullptr, CM + CM_PG, (signed char*)(ws + WS_WPG), D, 0, scr, it - I_GU, lane);
        }
    }
}
template <bool HIN_F32, int OMODE> __device__ __forceinline__ void rowwise_phase(int gw, int NGW, int lane, const void* hin, const bf16* Y, const float* gain, float coef, bf16* hb, bf16* xn, float* outf) {
    f32x4 g[4];
#pragma unroll
    for (int j = 0; j < 4; ++j) g[j] = ((const f32x4*)gain)[lane + 64 * j] * coef;
    for (int m0 = gw; m0 < M; m0 += 2 * NGW) {
        f32x4 y[2][4], h[2][4]; float s[2] = {0.f, 0.f};
#pragma unroll
        for (int u = 0; u < 2; ++u) { const int m = m0 + u * NGW;
            const GAS v2u* yr = (const GAS v2u*)(Y + (size_t)m * D) + lane;
#pragma unroll
            for (int j = 0; j < 4; ++j) { const v2u w = yr[64 * j]; y[u][j] = (f32x4){bflo(w.x), bfhi(w.x), bflo(w.y), bfhi(w.y)}; }
            if (HIN_F32) { const GAS f32x4* hr = (const GAS f32x4*)((const float*)hin + (size_t)m * D) + lane;
#pragma unroll
                for (int j = 0; j < 4; ++j) h[u][j] = hr[64 * j]; }
            else { const GAS v2u* hr = (const GAS v2u*)((const bf16*)hin + (size_t)m * D) + lane;
#pragma unroll
                for (int j = 0; j < 4; ++j) { const v2u w = hr[64 * j]; h[u][j] = (f32x4){bflo(w.x), bfhi(w.x), bflo(w.y), bfhi(w.y)}; } }
        }
#pragma unroll
        for (int u = 0; u < 2; ++u)
#pragma unroll
            for (int j = 0; j < 4; ++j) s[u] += (y[u][j].x * y[u][j].x + y[u][j].y * y[u][j].y) + (y[u][j].z * y[u][j].z + y[u][j].w * y[u][j].w);
#pragma unroll
        for (int u = 0; u < 2; ++u) { const int m = m0 + u * NGW;
            const float rstd = 1.f / sqrtf(wave_sum(s[u]) * (1.f / D) + EPS);
            float s2 = 0.f;
#pragma unroll
            for (int j = 0; j < 4; ++j) { h[u][j] = h[u][j] + (g[j] * y[u][j]) * rstd; s2 += (h[u][j].x * h[u][j].x + h[u][j].y * h[u][j].y) + (h[u][j].z * h[u][j].z + h[u][j].w * h[u][j].w); }
            if (OMODE == 3) { GAS f32x4* ho = (GAS f32x4*)(outf + (size_t)m * D) + lane;
#pragma unroll
                for (int j = 0; j < 4; ++j) ho[64 * j] = h[u][j]; }
            if (OMODE == 1 || OMODE == 4 || OMODE == 5 || OMODE == 6) { GAS v2u* ho = (GAS v2u*)(hb + (size_t)m * D) + lane;
#pragma unroll
                for (int j = 0; j < 4; ++j) ho[64 * j] = (v2u){pk2(h[u][j].x, h[u][j].y), pk2(h[u][j].z, h[u][j].w)}; }
            if (OMODE == 4 || OMODE == 5) { const float r2 = 1.f / sqrtf(wave_sum(s2) * (1.f / D) + EPS); row_to_i8(h[u], r2, (signed char*)xn + (size_t)m * D, outf + m, lane); if (OMODE == 5 && lane == 0) outf[32768 + m] = r2; }
            if (OMODE == 6) row_to_i8(h[u], 1.0f, (signed char*)xn + (size_t)m * D, outf + m, lane);
            if (OMODE == 1 || OMODE == 2) {
                float r2 = 1.f;
                if (OMODE == 1) r2 = 1.f / sqrtf(wave_sum(s2) * (1.f / D) + EPS);
                GAS v2u* o8 = (GAS v2u*)(xn + (size_t)m * D) + lane;
#pragma unroll
                for (int j = 0; j < 4; ++j) o8[64 * j] = (v2u){pk2(h[u][j].x * r2, h[u][j].y * r2), pk2(h[u][j].z * r2, h[u][j].w * r2)};
            }
        }
    }
}
__device__ __forceinline__ int moba_list_base(int bh, int j) { return bh * LIST_PER_BH + 256 * (31 * j - (j * (j - 1)) / 2); }
__device__ __forceinline__ void moba_gating_phase(LAS unsigned char* lds, int vcu, int G, int tid, const bf16* Q, const float* KMEAN, unsigned* CNT, unsigned* LIST) {
    LAS float* km = (LAS float*)lds;
    const int lane = tid & 63;
    for (int unit = vcu; unit < BATCH * NBLK * 4; unit += G) {
        const int hp = unit & 3, b = unit >> 7; int i = (unit >> 2) & 31; if (b & 2) i = 31 - i;
        __syncthreads();
        { float kv[8];
#pragma unroll
          for (int r = 0; r < 8; ++r) { const int e = tid + 512 * r, j = e >> 7, c = e & 127; kv[r] = (e < i * 128) ? KMEAN[(size_t)(b * NBLK + j) * 512 + hp * 128 + c] : 0.f; }
#pragma unroll
          for (int r = 0; r < 8; ++r) { const int e = tid + 512 * r; if (e < i * 128) km[e] = kv[r] * (1.0f / 256.0f); } }
        __syncthreads();
        const int hh = __builtin_amdgcn_readfirstlane(tid >> 8), ql = tid & 255, m = b * SEQ + i * MBB + ql, h = 2 * hp + hh;
        float q[64];
        { const v4u* qp = (const v4u*)(Q + (size_t)m * MBW + h * MBD);
#pragma unroll
          for (int c = 0; c < 8; ++c) { const v4u w = qp[c]; q[8 * c + 0] = bflo(w.x); q[8 * c + 1] = bfhi(w.x); q[8 * c + 2] = bflo(w.y); q[8 * c + 3] = bfhi(w.y); q[8 * c + 4] = bflo(w.z); q[8 * c + 5] = bfhi(w.z); q[8 * c + 6] = bflo(w.w); q[8 * c + 7] = bfhi(w.w); } }
        float v0 = -INFINITY, v1 = -INFINITY, v2 = -INFINITY; int i0 = -1, i1 = -1, i2 = -1;
        for (int j = 0; j < i; ++j) {
            const LAS f32x4* kp = (const LAS f32x4*)(km + j * 128 + hh * 64); float s = 0.f;
#pragma unroll
            for (int c = 0; c < 16; ++c) { const f32x4 kv = kp[c]; s += q[4 * c] * kv.x; s += q[4 * c + 1] * kv.y; s += q[4 * c + 2] * kv.z; s += q[4 * c + 3] * kv.w; }
            if (s > v0) { v2 = v1; i2 = i1; v1 = v0; i1 = i0; v0 = s; i0 = j; }
            else if (s > v1) { v2 = v1; i2 = i1; v1 = s; i1 = j; }
            else if (s > v2) { v2 = s; i2 = j; }
        }
        const int bh = b * 8 + h; const unsigned tl = (unsigned)(i * MBB + ql); const unsigned long long lt = (1ull << lane) - 1ull;
        const bool nearq = (ql < 112);
        int totf = 0, totn = 0;
        for (int j = 0; j < i; ++j) {
            const bool nl = (j == i - 1) && nearq;
            const unsigned long long mf = __ballot((i0 == j || i1 == j || i2 == j) && !nl), mn = __ballot((i0 == j || i1 == j || i2 == j) && nl);
            if (lane == j) { totf = (int)__popcll(mf); totn = (int)__popcll(mn); }
        }
        unsigned basef = 0u, basen = 0u;
        if (lane < i && totf > 0) basef = atomicAdd(CNT + bh * 32 + lane, (unsigned)totf);
        if (lane < i && totn > 0) basen = atomicAdd(CNT + 1024 + bh * 32 + lane, (unsigned)totn);
        for (int j = 0; j < i; ++j) {
            const bool nl = (j == i - 1) && nearq;
            const unsigned bf_ = (unsigned)__shfl((int)basef, j), bn_ = (unsigned)__shfl((int)basen, j);
            const unsigned long long m0 = __ballot(i0 == j && !nl), m1 = __ballot(i1 == j && !nl), m2 = __ballot(i2 == j && !nl);
            const int c0 = (int)__popcll(m0), c1 = (int)__popcll(m1);
            unsigned* L = LIST + moba_list_base(bh, j) + bf_;
            if (i0 == j && !nl) L[(int)__popcll(m0 & lt)] = tl;
            if (i1 == j && !nl) L[c0 + (int)__popcll(m1 & lt)] = tl | (1u << 13);
            if (i2 == j && !nl) L[c0 + c1 + (int)__popcll(m2 & lt)] = tl | (2u << 13);
            if (j == i - 1) {
                const unsigned long long n0 = __ballot(i0 == j && nl), n1 = __ballot(i1 == j && nl), n2 = __ballot(i2 == j && nl);
                const int d0 = (int)__popcll(n0), d1 = (int)__popcll(n1);
                unsigned* LN = LIST + moba_list_base(bh, j) + (31 - j) * 256 - 1 - bn_;
                if (i0 == j && nl) LN[-(int)__popcll(n0 & lt)] = tl;
                if (i1 == j && nl) LN[-(d0 + (int)__popcll(n1 & lt))] = tl | (1u << 13);
                if (i2 == j && nl) LN[-(d0 + d1 + (int)__popcll(n2 & lt))] = tl | (2u << 13);
            }
        }
    }
    __syncthreads();
}
typedef float f32x16 __attribute__((ext_vector_type(16)));
typedef short bf16x8v __attribute__((ext_vector_type(8)));
typedef short s16x4v __attribute__((ext_vector_type(4)));
constexpr int IT_KS = 0, IT_VS = 32768, IT_VROW = 520, IT_TB = IT_VS + 64 * IT_VROW  , IT_TBN = 768, IT_INFO = IT_TB + 8 * IT_TBN * 4  , IT_STG = 91136  ;
__device__ __forceinline__ int crow16(int r, int hi) { return (r & 3) + 8 * (r >> 2) + 4 * hi; }
__device__ __forceinline__ void moba_pv_tile(const f32x16& st, int kt, int hi, int r32, const LAS unsigned char* vs, f32x16 (&o)[2]) {
#pragma unroll
    for (int s = 0; s < 2; ++s) {
        const unsigned w0 = pg8::cvt_pk_bf16(st[8 * s + 0], st[8 * s + 1]), w1 = pg8::cvt_pk_bf16(st[8 * s + 2], st[8 * s + 3]), w2 = pg8::cvt_pk_bf16(st[8 * s + 4], st[8 * s + 5]), w3 = pg8::cvt_pk_bf16(st[8 * s + 6], st[8 * s + 7]);
        const v4u w = {w0, w1, w2, w3}; const bf16x8v pf = __builtin_bit_cast(bf16x8v, w);
#pragma unroll
        for (int d = 0; d < 2; ++d) {
            const LAS unsigned char* vp = vs + (32 * d + r32) * IT_VROW + (32 * kt + 16 * s + 4 * hi) * 2;
            const s16x4v lo = *(const LAS s16x4v*)vp, hi4 = *(const LAS s16x4v*)(vp + 16);
            const bf16x8v va = {lo[0], lo[1], lo[2], lo[3], hi4[0], hi4[1], hi4[2], hi4[3]};
            o[d] = __builtin_amdgcn_mfma_f32_32x32x16_bf16(va, pf, o[d], 0, 0, 0);
        }
    }
}
__device__ __forceinline__ float moba_rowmax(const f32x16& st) {
    float ra = fmaxf(fmaxf(st[0], st[1]), st[2]), rb = fmaxf(fmaxf(st[3], st[4]), st[5]);
    ra = fmaxf(fmaxf(ra, st[6]), st[7]); rb = fmaxf(fmaxf(rb, st[8]), st[9]); ra = fmaxf(fmaxf(ra, st[10]), st[11]); rb = fmaxf(fmaxf(rb, st[12]), st[13]); ra = fmaxf(fmaxf(ra, st[14]), st[15]);
    const float rm = fmaxf(ra, rb); return fmaxf(rm, __shfl_xor(rm, 32));
}
__device__ __forceinline__ void moba_exp_sum(f32x16& st, float& lrun) {
    float ls = 0.f, ls2 = 0.f;
#pragma unroll
    for (int r = 0; r < 16; r += 2) { const float p0 = __builtin_amdgcn_exp2f(st[r]), p1 = __builtin_amdgcn_exp2f(st[r + 1]); st[r] = p0; st[r + 1] = p1; ls += p0; ls2 += p1; }
    lrun += ls + ls2;
}
__device__ __forceinline__ void moba_items_phase(LAS unsigned char* lds, int vcu, int G, int tid_in, int wave, int lane, const bf16* Q, const bf16* K, const bf16* VT, const unsigned* CNT, const unsigned* LIST,
                                                 const float* BIAST, bf16* PO0, bf16* PO1, bf16* PO2, bf16* PO3, float* PML) {
    const int r32 = lane & 31, hi = lane >> 5; int tid = tid_in;
    LAS unsigned char* ks = lds + IT_KS; LAS unsigned char* vs = lds + IT_VS; LAS float* tball = (LAS float*)(lds + IT_TB); volatile LAS int* info = (volatile LAS int*)(lds + IT_INFO);
    __syncthreads();
    for (int e = tid; e < 8 * IT_TBN; e += 512) { const int h_ = e / IT_TBN, d_ = 512 - (e % IT_TBN); tball[e] = d_ < 0 ? -INFINITY : BIAST[h_ * 128 + (d_ > 113 ? 113 : d_)] * 1.4426950408889634f; }
    if (wave == 0) {
        int loc[16]; int s = 0;
#pragma unroll
        for (int e = 0; e < 16; ++e) { const int nf = (int)CNT[16 * lane + e], nn = (int)CNT[1024 + 16 * lane + e]; loc[e] = 1 + ((((nf + 31) >> 5) + ((nn + 31) >> 5) + 7) >> 3); s += loc[e]; }
        int incl = s;
#pragma unroll
        for (int o = 1; o < 64; o <<= 1) { const int t = __shfl_up(incl, o); if (lane >= o) incl += t; }
        const int excl = incl - s, total = __shfl(incl, 63);
        const int c0 = (int)(((long)vcu * total) / G), c1 = (int)(((long)(vcu + 1) * total) / G);
        if (c0 >= excl && c0 < incl) { int acc = excl; bool done = false;
#pragma unroll
            for (int e = 0; e < 16; ++e) { if (!done && c0 < acc + loc[e]) { info[0] = 16 * lane + e; info[1] = c0 - acc; done = true; } acc += loc[e]; } }
        if (lane == 0) info[2] = c1 - c0;
    }
    __syncthreads();
    int li = __builtin_amdgcn_readfirstlane(info[0]), k = __builtin_amdgcn_readfirstlane(info[1]); const int nchunk = __builtin_amdgcn_readfirstlane(info[2]);
    int loaded = -1; bool pre = false; v4u pk[4], pv[4];
    int n_tl = 0, n_rank = 0; bool n_valid = false, n_active = false;
    bool n_near = false;
#define MOBA_FETCH(LI, KK, NN) do { const int b_ = (LI) >> 8, h_ = ((LI) >> 5) & 7, j_ = (LI) & 31; const bool own_ = ((KK) == 0); const int nf_ = (NN) & 0xffff, nn_ = (NN) >> 16, itf_ = (nf_ + 31) >> 5, itn_ = (nn_ + 31) >> 5; \
        const int it_ = own_ ? wave : ((KK) - 1) * 8 + wave; n_near = !own_ && it_ >= itf_; const int start_ = (n_near ? it_ - itf_ : it_) * 32; const int cnt_ = n_near ? nn_ : nf_; \
        n_active = own_ || it_ < itf_ + itn_; n_valid = own_ || (n_active && start_ + r32 < cnt_); \
        if (n_active) { if (own_) { n_tl = j_ * MBB + start_ + r32; n_rank = 3; } \
            else { int idx_ = start_ + r32; if (idx_ >= cnt_) idx_ = cnt_ - 1; const int pos_ = n_near ? ((31 - j_) * 256 - 1 - idx_) : idx_; const unsigned e_ = LIST[moba_list_base(b_ * 8 + h_, j_) + pos_]; n_tl = (int)(e_ & 8191u); n_rank = (int)(e_ >> 13); } } } while (0)
#define MOBA_CNT(LI) (__builtin_amdgcn_readfirstlane((int)CNT[(LI)]) | (__builtin_amdgcn_readfirstlane((int)CNT[1024 + (LI)]) << 16))
#define MOBA_NCH(NN) (1 + ((((((NN) & 0xffff) + 31) >> 5) + ((((NN) >> 16) + 31) >> 5) + 7) >> 3))
    int n = (nchunk > 0) ? MOBA_CNT(li) : 0;
    if (nchunk > 0) MOBA_FETCH(li, k, n);
    for (int c = 0; c < nchunk; ++c) {
        const int b = li >> 8, h = (li >> 5) & 7, j = li & 31;
        if (li != loaded) {
            __syncthreads();
            asm volatile("" : "+v"(tid));
            if (!pre) {
#pragma unroll
                for (int r = 0; r < 4; ++r) { const int idx = tid + 512 * r, key = idx >> 3, ch = idx & 7; pk[r] = *(const v4u*)(K + (size_t)(b * SEQ + j * MBB + key) * MBW + h * MBD + ch * 8); }
#pragma unroll
                for (int r = 0; r < 4; ++r) { const int idx = tid + 512 * r, d = idx >> 5, ch = idx & 31; pv[r] = *(const v4u*)(VT + (size_t)(h * MBD + d) * M + b * SEQ + j * MBB + ch * 8); }
            }
#pragma unroll
            for (int r = 0; r < 4; ++r) { const int idx = tid + 512 * r, key = idx >> 3, ch = idx & 7;
                *(LAS v4u*)(ks + key * 128 + ((ch ^ ((key >> 1) & 7)) * 16)) = pk[r]; }
#pragma unroll
            for (int r = 0; r < 4; ++r) { const int idx = tid + 512 * r, d = idx >> 5, ch = idx & 31;
                LAS v2u* dst = (LAS v2u*)(vs + d * IT_VROW + ch * 16); dst[0] = (v2u){pv[r].x, pv[r].y}; dst[1] = (v2u){pv[r].z, pv[r].w}; }
            __syncthreads();
            loaded = li; pre = false;
        }
        const int tl = n_tl, rank = n_rank; const bool valid = n_valid, active = n_active, own = (k == 0), nearit = n_near;
        bf16x8v qf[4];
        if (active) { const bf16* qp = Q + (size_t)(b * SEQ + tl) * MBW + h * MBD + 8 * hi;
#pragma unroll
            for (int s = 0; s < 4; ++s) qf[s] = *(const bf16x8v*)(qp + 16 * s); }
        int li2 = li, k2 = k + 1; if (k2 >= MOBA_NCH(n)) { ++li2; k2 = 0; }
        int n2 = n;
        if (c + 1 < nchunk) { if (li2 != li) n2 = MOBA_CNT(li2); MOBA_FETCH(li2, k2, n2); }
        if (c + 1 < nchunk && li2 != li) {
            const int b2 = li2 >> 8, h2 = (li2 >> 5) & 7, j2 = li2 & 31; pre = true;
#pragma unroll
            for (int r = 0; r < 4; ++r) { const int idx = tid + 512 * r, key = idx >> 3, ch = idx & 7; pk[r] = *(const v4u*)(K + (size_t)(b2 * SEQ + j2 * MBB + key) * MBW + h2 * MBD + ch * 8); }
#pragma unroll
            for (int r = 0; r < 4; ++r) { const int idx = tid + 512 * r, d = idx >> 5, ch = idx & 31; pv[r] = *(const v4u*)(VT + (size_t)(h2 * MBD + d) * M + b2 * SEQ + j2 * MBB + ch * 8); }
        }
        if (active) {
            const int qin = tl & 255, bd = (tl >> 8) - j, dq = bd * 256 + qin;
            const bool general = own || nearit;
            const int ntile = own ? (wave + 1) : 8;
            const LAS float* tb = tball + h * IT_TBN;
            const size_t pair = (size_t)(b * SEQ + tl) * 8 + h;
            bf16* po = (rank == 0 ? PO0 : rank == 1 ? PO1 : rank == 2 ? PO2 : PO3) + pair * 64; float* pm = PML + ((size_t)rank * (M * 8) + pair) * 2;
#define MOBA_STORE(MR, LR) do { const float linv_ = 1.0f / (LR); LAS unsigned char* stg_ = lds + IT_STG + wave * 4864; \
                _Pragma("unroll") for (int d = 0; d < 2; ++d) _Pragma("unroll") for (int g4 = 0; g4 < 4; ++g4) { v2u w; w.x = pg8::cvt_pk_bf16(o[d][4 * g4] * linv_, o[d][4 * g4 + 1] * linv_); w.y = pg8::cvt_pk_bf16(o[d][4 * g4 + 2] * linv_, o[d][4 * g4 + 3] * linv_); \
                    *(LAS v2u*)(stg_ + r32 * 144 + (32 * d + 8 * g4 + 4 * hi) * 2) = w; } \
                if (hi == 0) { *(LAS unsigned long long*)(stg_ + 4608 + r32 * 8) = valid ? (unsigned long long)(uintptr_t)po : 0ull; if (valid) { pm[0] = (MR); pm[1] = (LR); } } \
                asm volatile("s_waitcnt lgkmcnt(0)" ::: "memory"); \
                _Pragma("unroll") for (int i_ = 0; i_ < 4; ++i_) { const int row_ = i_ * 8 + (lane >> 3), ch_ = lane & 7; const unsigned long long p_ = *(const LAS unsigned long long*)(stg_ + 4608 + row_ * 8); \
                    const v4u v_ = *(const LAS v4u*)(stg_ + row_ * 144 + ch_ * 16); if (p_) *(v4u*)((unsigned char*)(uintptr_t)p_ + ch_ * 16) = v_; } \
                asm volatile("s_waitcnt lgkmcnt(0)" ::: "memory"); } while (0)
            bool done = false;
            {
                float mhat = 0.f, lrun = 0.f; f32x16 o[2], negm;
#pragma unroll
                for (int r = 0; r < 16; ++r) { o[0][r] = 0.f; o[1][r] = 0.f; negm[r] = 0.f; }
                const LAS float* rp0 = tb + (512 - dq + 4 * hi);
#define MOBA_QK(ST, KT) do { const int key_ = 32 * (KT) + r32; \
                    _Pragma("unroll") for (int s_ = 0; s_ < 4; ++s_) { const bf16x8v ka_ = *(const LAS bf16x8v*)(ks + key_ * 128 + (((2 * s_ + hi) ^ ((key_ >> 1) & 7)) * 16)); \
                        ST = __builtin_amdgcn_mfma_f32_32x32x16_bf16(ka_, qf[s_], ST, 0, 0, 0); } } while (0)
#define MOBA_BIAS(ST, KT) do { if (general) { const LAS float* rp_ = rp0 + 32 * (KT); _Pragma("unroll") for (int r_ = 0; r_ < 16; ++r_) ST[r_] += rp_[8 * (r_ >> 2) + (r_ & 3)]; } } while (0)
                f32x16 sa = negm, sb;
                MOBA_QK(sa, 0); MOBA_BIAS(sa, 0);
                mhat = moba_rowmax(sa);
#pragma unroll
                for (int r = 0; r < 16; ++r) { sa[r] -= mhat; negm[r] = -mhat; }
#pragma unroll
                for (int kt = 0; kt < 8; kt += 2) {
                    if (kt < ntile) {
                        if (kt + 1 < ntile) { sb = negm; MOBA_QK(sb, kt + 1); }
                        moba_exp_sum(sa, lrun); moba_pv_tile(sa, kt, hi, r32, vs, o);
                        if (kt + 1 < ntile) {
                            MOBA_BIAS(sb, kt + 1);
                            if (kt + 2 < ntile) { sa = negm; MOBA_QK(sa, kt + 2); }
                            moba_exp_sum(sb, lrun); moba_pv_tile(sb, kt + 1, hi, r32, vs, o);
                            if (kt + 2 < ntile) MOBA_BIAS(sa, kt + 2);
                        }
                    }
                }
#undef MOBA_QK
#undef MOBA_BIAS
                lrun += __shfl_xor(lrun, 32);
                if (__builtin_expect(!__any(!(lrun < 1.0e30f)), 1)) { MOBA_STORE(mhat + (general ? 0.f : tb[0]), lrun); done = true; }
            }
            if (!done) {
                const int dq2 = general ? dq : 511;
                float mrun = -INFINITY, lrun = 0.f; f32x16 o[2];
#pragma unroll
                for (int r = 0; r < 16; ++r) { o[0][r] = 0.f; o[1][r] = 0.f; }
#pragma unroll
                for (int kt = 0; kt < 8; ++kt) {
                    if (kt < ntile) {
                        f32x16 st; const int key = 32 * kt + r32;
#pragma unroll
                        for (int r = 0; r < 16; ++r) st[r] = 0.f;
#pragma unroll
                        for (int s = 0; s < 4; ++s) { const bf16x8v ka = *(const LAS bf16x8v*)(ks + key * 128 + (((2 * s + hi) ^ ((key >> 1) & 7)) * 16));
                            st = __builtin_amdgcn_mfma_f32_32x32x16_bf16(ka, qf[s], st, 0, 0, 0); }
                        { const LAS float* rp = tb + (512 - dq2 + 32 * kt + 4 * hi);
#pragma unroll
                          for (int r = 0; r < 16; ++r) st[r] += rp[8 * (r >> 2) + (r & 3)]; }
                        const float mnew = fmaxf(mrun, moba_rowmax(st)), alpha = __builtin_amdgcn_exp2f(mrun - mnew);
#pragma unroll
                        for (int r = 0; r < 16; ++r) st[r] -= mnew;
                        lrun *= alpha; mrun = mnew;
#pragma unroll
                        for (int d = 0; d < 2; ++d)
#pragma unroll
                            for (int r = 0; r < 16; ++r) o[d][r] *= alpha;
                        moba_exp_sum(st, lrun);
                        moba_pv_tile(st, kt, hi, r32, vs, o);
                        asm volatile("" ::: "memory");
                    }
                }
                lrun += __shfl_xor(lrun, 32);
                MOBA_STORE(mrun, lrun);
            }
#undef MOBA_STORE
        }
        li = li2; k = k2; n = n2;
    }
#undef MOBA_FETCH
#undef MOBA_CNT
#undef MOBA_NCH
    __syncthreads();
}
__device__ __forceinline__ void moba_combine_phase(int gtid, int gthreads, const bf16* PO0, const bf16* PO1, const bf16* PO2, const bf16* PO3, const float* PML, bf16* OA) {
    for (int idx0 = gtid; idx0 < M * 8 * 8; idx0 += 4 * gthreads) {
        typedef float f32x2l __attribute__((ext_vector_type(2)));
        f32x2l ml[4][4]; v4u x[4][4];
#pragma unroll
        for (int u = 0; u < 4; ++u) { const int idx = idx0 + u * gthreads, pair = idx >> 3, c8 = idx & 7, m = pair >> 3, own = (m & (SEQ - 1)) >> 8, nv = own < 3 ? own : 3;
#pragma unroll
            for (int r = 0; r < 4; ++r) { const bool v = (r == 3) || (r < nv);
                ml[u][r] = v ? *(const f32x2l*)(PML + ((size_t)r * (M * 8) + pair) * 2) : (f32x2l){-INFINITY, 0.f};
                x[u][r] = v ? *(const v4u*)((r == 0 ? PO0 : r == 1 ? PO1 : r == 2 ? PO2 : PO3) + (size_t)pair * 64 + c8 * 8) : (v4u){0u, 0u, 0u, 0u}; }
        }
#pragma unroll
        for (int u = 0; u < 4; ++u) { const int idx = idx0 + u * gthreads, pair = idx >> 3, c8 = idx & 7, m = pair >> 3;
            const float mx = fmaxf(fmaxf(ml[u][0].x, ml[u][1].x), fmaxf(ml[u][2].x, ml[u][3].x));
            float w[4], ws = 0.f;
#pragma unroll
            for (int r = 0; r < 4; ++r) { w[r] = ml[u][r].y * __builtin_amdgcn_exp2f(ml[u][r].x - mx); ws += w[r]; }
            const float inv = 1.0f / ws; float acc[8];
#pragma unroll
            for (int e = 0; e < 8; ++e) acc[e] = 0.f;
#pragma unroll
            for (int r = 0; r < 4; ++r) { const float wr = w[r] * inv; const v4u xx = x[u][r];
                acc[0] += wr * bflo(xx.x); acc[1] += wr * bfhi(xx.x); acc[2] += wr * bflo(xx.y); acc[3] += wr * bfhi(xx.y); acc[4] += wr * bflo(xx.z); acc[5] += wr * bfhi(xx.z); acc[6] += wr * bflo(xx.w); acc[7] += wr * bfhi(xx.w); }
            v4u o; o.x = pk2(acc[0], acc[1]); o.y = pk2(acc[2], acc[3]); o.z = pk2(acc[4], acc[5]); o.w = pk2(acc[6], acc[7]);
            *(v4u*)(OA + (size_t)m * 1024 + (pair & 7) * 64 + c8 * 8) = o;
        }
    }
}
constexpr int HL_IMG = 37888, HL_QN = 0, HL_KN = 8704, HL_KT = 17408, HL_VT = 27648, HL_SB = 2 * HL_IMG  , HL_DD = HL_SB + 34816  , HL_EM = HL_DD + 1024, HL_SSQ = HL_EM + 1024, HL_END = HL_SSQ + 512;
constexpr int HL_QP = 272, HL_TP = 80;
__device__ __forceinline__ float bf1(bf16 x) { return __uint_as_float((unsigned)x << 16); }
template <int STEP> __device__ __forceinline__ void hgrn_mfma_phase(LAS unsigned char* lds, int vcu, int G, int tid, int wave, int lane, const bf16* KIN, const bf16* HI, const bf16* HQ, const bf16* HG, const float* hgw, float* HS, float* HGD, bf16* OB) {
    const int r32 = lane & 31, hi = lane >> 5, cl = lane & 15, tg = lane >> 4, ch = 16 * wave + cl;
    LAS float* ssq = (LAS float*)(lds + HL_SSQ); LAS float* hgwl = (LAS float*)(lds + HL_END);
    __syncthreads();
    if (STEP == 3 && tid < 128) hgwl[tid] = hgw[tid];
    for (int unit = vcu; unit < BATCH * HGH * HGNC; unit += G) {
        const int c = unit & 31, bh = unit >> 5, b = bh >> 2, h = bh & 3, m0 = b * SEQ + c * HGC;
        f32x16 S[4]; float Dk = 1.f;
        const int skt = (STEP == 1) ? (wave >> 1) : (wave - 4), svt0 = (STEP == 1) ? 2 * (wave & 1) : 0; constexpr int NST = (STEP == 1) ? 2 : 4;
#pragma unroll
        for (int i = 0; i < 4; ++i)
#pragma unroll
            for (int r = 0; r < 16; ++r) S[i][r] = 0.f;
        if (STEP == 3 && wave >= 4) {
#pragma unroll
            for (int i = 0; i < 4; ++i)
#pragma unroll
                for (int r = 0; r < 16; ++r) S[i][r] = HS[(size_t)unit * 16384 + (32 * skt + crow16(r, hi)) * 128 + 32 * (svt0 + i) + r32];
        }
        unsigned short rk[8], rv[8], rq[8];
#define HG_LOAD(SLAB) do { _Pragma("unroll") for (int e = 0; e < 8; ++e) { const size_t idx = (size_t)(m0 + (SLAB) * 32 + tg * 8 + e) * HGW + h * HGD_ + ch; rk[e] = KIN[idx]; rv[e] = HI[idx]; rq[e] = (STEP == 3) ? HQ[idx] : (unsigned short)0; } } while (0)
#define HG_STAGE(BUF) do { LAS unsigned char* img_ = lds + (BUF) * HL_IMG; \
            float kin_[8], cs_[8]; float run_ = 0.f; \
            _Pragma("unroll") for (int e = 0; e < 8; ++e) { kin_[e] = bf1(rk[e]); run_ += __builtin_amdgcn_logf(fmaxf(1.0f - kin_[e], 5.9604645e-8f)); cs_[e] = run_; } \
            const float g0_ = __shfl(run_, cl), g1_ = __shfl(run_, cl + 16), g2_ = __shfl(run_, cl + 32), g3_ = __shfl(run_, cl + 48); \
            const float bmid_ = g0_ + g1_, bend_ = bmid_ + g2_ + g3_, pre_ = (tg == 0) ? 0.f : (tg == 1) ? g0_ : (tg == 2) ? bmid_ : bmid_ + g2_; \
            { float kh_[8]; _Pragma("unroll") for (int e = 0; e < 8; ++e) kh_[e] = kin_[e] * __builtin_amdgcn_exp2f(bend_ - (pre_ + cs_[e])); \
              v4u w_; w_.x = pg8::cvt_pk_bf16(kh_[0], kh_[1]); w_.y = pg8::cvt_pk_bf16(kh_[2], kh_[3]); w_.z = pg8::cvt_pk_bf16(kh_[4], kh_[5]); w_.w = pg8::cvt_pk_bf16(kh_[6], kh_[7]); \
              *(LAS v4u*)(img_ + HL_KT + ch * HL_TP + tg * 16) = w_; \
              v4u x_; x_.x = (unsigned)rv[0] | ((unsigned)rv[1] << 16); x_.y = (unsigned)rv[2] | ((unsigned)rv[3] << 16); x_.z = (unsigned)rv[4] | ((unsigned)rv[5] << 16); x_.w = (unsigned)rv[6] | ((unsigned)rv[7] << 16); \
              *(LAS v4u*)(img_ + HL_VT + ch * HL_TP + tg * 16) = x_; } \
            if (STEP == 3) { _Pragma("unroll") for (int e = 0; e < 8; ++e) { const float bs_ = pre_ + cs_[e]; const int tok_ = tg * 8 + e; \
                    const float kt_ = kin_[e] * __builtin_amdgcn_exp2f(fminf(bmid_ - bs_, 100.f)), qt_ = bf1(rq[e]) * __builtin_amdgcn_exp2f(fminf(bs_ - bmid_, 100.f)); \
                    *(LAS unsigned short*)(img_ + HL_KN + tok_ * HL_QP + ch * 2) = (unsigned short)f2bf(kt_); \
                    *(LAS unsigned short*)(img_ + HL_QN + tok_ * HL_QP + ch * 2) = (unsigned short)f2bf(qt_); } } \
            if (tg == 0) { const float de_ = __builtin_amdgcn_exp2f(bend_); ((LAS float*)(lds + HL_DD))[(BUF) * 128 + ch] = de_; ((LAS float*)(lds + HL_EM))[(BUF) * 128 + ch] = __builtin_amdgcn_exp2f(bmid_); Dk *= de_; } } while (0)
        HG_LOAD(0);
        __syncthreads();
        HG_STAGE(0);
        HG_LOAD(1);
        __syncthreads();
        for (int slab = 0; slab < 8; ++slab) {
            const int buf = slab & 1, ms = m0 + slab * 32;
            const LAS unsigned char* img = lds + buf * HL_IMG; const LAS float* dd = (const LAS float*)(lds + HL_DD) + buf * 128; const LAS float* em = (const LAS float*)(lds + HL_EM) + buf * 128;
            f32x16 O; v2u gg[4];
            if (STEP == 3 && wave < 4) {
#pragma unroll
                for (int g4 = 0; g4 < 4; ++g4) gg[g4] = *(const v2u*)(HG + (size_t)(ms + r32) * HGW + h * HGD_ + 32 * wave + 8 * g4 + 4 * hi);
            }
            if (STEP == 3) {
                if (wave >= 4) {
#pragma unroll
                    for (int i = 0; i < 4; ++i)
#pragma unroll
                        for (int g4 = 0; g4 < 4; ++g4) { const int k0 = 32 * skt + 8 * g4 + 4 * hi; const f32x4 e4 = *(const LAS f32x4*)(em + k0);
                            v2u w; w.x = pg8::cvt_pk_bf16(S[i][4 * g4] * e4.x, S[i][4 * g4 + 1] * e4.y); w.y = pg8::cvt_pk_bf16(S[i][4 * g4 + 2] * e4.z, S[i][4 * g4 + 3] * e4.w);
                            *(LAS v2u*)(lds + HL_SB + (32 * (svt0 + i) + r32) * HL_QP + k0 * 2) = w; }
                } else {
                    const int vt = wave; f32x16 X;
#pragma unroll
                    for (int r = 0; r < 16; ++r) { X[r] = 0.f; O[r] = 0.f; }
#pragma unroll
                    for (int ks = 0; ks < 8; ++ks) { const bf16x8v qf = *(const LAS bf16x8v*)(img + HL_QN + r32 * HL_QP + (16 * ks + 8 * hi) * 2);
                        const bf16x8v kf = *(const LAS bf16x8v*)(img + HL_KN + r32 * HL_QP + (16 * ks + 8 * hi) * 2);
                        X = __builtin_amdgcn_mfma_f32_32x32x16_bf16(kf, qf, X, 0, 0, 0); }
#pragma unroll
                    for (int r = 0; r < 16; ++r) if (crow16(r, hi) > r32) X[r] = 0.f;
#pragma unroll
                    for (int k2 = 0; k2 < 2; ++k2) {
                        v4u w; w.x = pg8::cvt_pk_bf16(X[8 * k2 + 0], X[8 * k2 + 1]); w.y = pg8::cvt_pk_bf16(X[8 * k2 + 2], X[8 * k2 + 3]); w.z = pg8::cvt_pk_bf16(X[8 * k2 + 4], X[8 * k2 + 5]); w.w = pg8::cvt_pk_bf16(X[8 * k2 + 6], X[8 * k2 + 7]);
                        const bf16x8v xf = __builtin_bit_cast(bf16x8v, w);
                        const LAS unsigned char* vp = img + HL_VT + (32 * vt + r32) * HL_TP + (16 * k2 + 4 * hi) * 2;
                        const s16x4v lo = *(const LAS s16x4v*)vp, hi4 = *(const LAS s16x4v*)(vp + 16);
                        const bf16x8v va = {lo[0], lo[1], lo[2], lo[3], hi4[0], hi4[1], hi4[2], hi4[3]};
                        O = __builtin_amdgcn_mfma_f32_32x32x16_bf16(va, xf, O, 0, 0, 0); }
                }
                __syncthreads();
                if (wave < 4) {
                    const int vt = wave;
#pragma unroll
                    for (int ks = 0; ks < 8; ++ks) { const bf16x8v sa = *(const LAS bf16x8v*)(lds + HL_SB + (32 * vt + r32) * HL_QP + (16 * ks + 8 * hi) * 2);
                        const bf16x8v qf = *(const LAS bf16x8v*)(img + HL_QN + r32 * HL_QP + (16 * ks + 8 * hi) * 2);
                        O = __builtin_amdgcn_mfma_f32_32x32x16_bf16(sa, qf, O, 0, 0, 0); }
                    float sq = 0.f;
#pragma unroll
                    for (int r = 0; r < 16; ++r) sq += O[r] * O[r];
                    sq += __shfl_xor(sq, 32);
                    if (hi == 0) ssq[vt * 32 + r32] = sq;
                }
            }
            if (STEP == 1 || wave >= 4) {
#pragma unroll
                for (int i = 0; i < NST; ++i) {
#pragma unroll
                    for (int g4 = 0; g4 < 4; ++g4) { const f32x4 d4 = *(const LAS f32x4*)(dd + 32 * skt + 8 * g4 + 4 * hi);
                        S[i][4 * g4] *= d4.x; S[i][4 * g4 + 1] *= d4.y; S[i][4 * g4 + 2] *= d4.z; S[i][4 * g4 + 3] *= d4.w; }
#pragma unroll
                    for (int k2 = 0; k2 < 2; ++k2) { const bf16x8v ka = *(const LAS bf16x8v*)(img + HL_KT + (32 * skt + r32) * HL_TP + (16 * k2 + 8 * hi) * 2);
                        const bf16x8v vb = *(const LAS bf16x8v*)(img + HL_VT + (32 * (svt0 + i) + r32) * HL_TP + (16 * k2 + 8 * hi) * 2);
                        S[i] = __builtin_amdgcn_mfma_f32_32x32x16_bf16(ka, vb, S[i], 0, 0, 0); }
                }
            }
            if (slab < 7) { HG_STAGE(buf ^ 1); if (slab < 6) HG_LOAD(slab + 2); }
            __syncthreads();
            if (STEP == 3 && wave < 4) {
                const int vt = wave; const float tot = ssq[r32] + ssq[32 + r32] + ssq[64 + r32] + ssq[96 + r32];
                const float rstd = 1.f / sqrtf(tot * (1.f / 128.f) + EPS); const size_t orow = (size_t)(ms + r32) * 1024 + 512 + h * HGD_;
#pragma unroll
                for (int g4 = 0; g4 < 4; ++g4) { const int v0 = 32 * vt + 8 * g4 + 4 * hi; const f32x4 w4 = *(const LAS f32x4*)(hgwl + v0);
                    v2u o; o.x = pg8::cvt_pk_bf16(O[4 * g4] * rstd * w4.x * bflo(gg[g4].x), O[4 * g4 + 1] * rstd * w4.y * bfhi(gg[g4].x)); o.y = pg8::cvt_pk_bf16(O[4 * g4 + 2] * rstd * w4.z * bflo(gg[g4].y), O[4 * g4 + 3] * rstd * w4.w * bfhi(gg[g4].y));
                    *(v2u*)(OB + orow + v0) = o; }
            }
        }
#undef HG_LOAD
#undef HG_STAGE
        if (STEP == 1) {
#pragma unroll
            for (int i = 0; i < 2; ++i)
#pragma unroll
                for (int r = 0; r < 16; ++r) HS[(size_t)unit * 16384 + (32 * skt + crow16(r, hi)) * 128 + 32 * (svt0 + i) + r32] = S[i][r];
            if (tg == 0) HGD[unit * 128 + ch] = Dk;
        }
    }
    __syncthreads();
}
__device__ __forceinline__ void hgrn_scan_phase(int gtid, int gthreads, float* HS, const float* HGD) {
    for (int idx = gtid; idx < BATCH * HGH * 16384; idx += gthreads) {
        const int bh = idx >> 14, e = idx & 16383, k = e >> 7; float s = 0.f;
        float tmp[HGNC];
#pragma unroll
        for (int c = 0; c < HGNC; ++c) tmp[c] = HS[(size_t)(bh * HGNC + c) * 16384 + e];
#pragma unroll
        for (int c = 0; c < HGNC; ++c) { HS[(size_t)(bh * HGNC + c) * 16384 + e] = s; s = HGD[(bh * HGNC + c) * 128 + k] * s + tmp[c]; }
    }
}
#ifndef MASK_BITS
#define MASK_BITS 0x00ffffffu
#endif
#ifndef REP_MASK
#define REP_MASK 0u
#endif
struct Args { const float* in[16]; float* out; unsigned char* ws; unsigned mask, rep; };
typedef const __attribute__((address_space(4))) Args* KArgs;
__device__ __forceinline__ KArgs hide_args() {
#if defined(__HIP_DEVICE_COMPILE__)
    KArgs p = (KArgs)__builtin_amdgcn_kernarg_segment_ptr(); asm volatile("" : "+s"(p)); return p;
#else
    return nullptr;
#endif
}
__global__ void __launch_bounds__(NWAVES * 64, 2) mk_fwd(Args args) {
    extern __shared__ __attribute__((aligned(16))) unsigned char lds_raw[];
    LAS unsigned char* lds = (LAS unsigned char*)lds_raw;
    volatile LAS unsigned* MISC = (volatile LAS unsigned*)(lds + MISC_OFF);
    const int G = gridDim.x, bx = blockIdx.x;
    unsigned char* ws = args.ws;
    gu32* ctl = (gu32*)(ws + WS_CTL);
    for (int u = threadIdx.x; u < (LDS_BYTES - LDSCTL_OFF) / 4; u += NWAVES * 64) ((LAS unsigned*)(lds + LDSCTL_OFF))[u] = 0u;
    __syncthreads();
    XcdBarrier bar = xcd_barrier_post((unsigned*)(ctl + CW_BAR), MISC + 8);
#define GRID_BAR() xcd_barrier(bar)
#define PH(k) for (int rep_ = ((args.mask >> (k)) & 1u) + ((args.rep >> (k)) & 1u); rep_ > 0; --rep_) if (KArgs A_ = hide_args()) if (unsigned char* ws = A_->ws)
#define COORDS() int tid = threadIdx.x; asm volatile("" : "+v"(tid)); const int lane = tid & 63, wave = __builtin_amdgcn_readfirstlane(tid >> 6); \
    const int vcu = (G % 8 == 0) ? (bx % 8) * (G / 8) + bx / 8 : bx; const int gw = vcu * NWAVES + wave, NGW = G * NWAVES; (void)lane; (void)gw; (void)NGW; (void)vcu
#define MKP() Ptrs P; P.x = A_->in[0]; P.p = A_->in[1]; P.w_gu1 = A_->in[2]; P.w_d1 = A_->in[3]; P.w_in = A_->in[4]; P.w_a = A_->in[5]; P.w_b = A_->in[6]; P.w_out = A_->in[7]; \
    P.w_gu2 = A_->in[8]; P.w_d2 = A_->in[9]; P.w_ple = A_->in[10]; P.w_pg = A_->in[11]; P.gains = A_->in[12]; P.hgw = A_->in[13]; P.lbp = A_->in[14]; P.rel = A_->in[15]; P.out = A_->out; P.ws = A_->ws
#define XN ((bf16*)(ws + WS_C))
#define Hb ((bf16*)(ws + WS_A))
#define Fb ((bf16*)(ws + WS_B))
#define Yb ((bf16*)(ws + WS_A))
#define HBS ((bf16*)A_->out)
#define Qb ((bf16*)(ws + WS_Q))
#define Kb ((bf16*)(ws + WS_K))
#define VTb ((bf16*)(ws + WS_VT))
#define HQb ((bf16*)(ws + WS_HQ))
#define HIb ((bf16*)(ws + WS_HI))
#define KINb ((bf16*)(ws + WS_KIN))
#define HGb ((bf16*)(ws + WS_HG))
#define SAb ((bf16*)(ws + WS_SA))
#define SBb ((bf16*)(ws + WS_SB))
#define OAb ((bf16*)(ws + WS_OAB))
#define OBb ((bf16*)(ws + WS_OAB))
#define PBb ((bf16*)(ws + WS_PB))
#define Eb ((bf16*)(ws + WS_A))
#define KMEAN ((float*)(ws + WS_KMEAN))
#define LBt ((float*)(ws + WS_LB))
#define BIAST ((float*)(ws + WS_BIAST))
#define HS ((float*)A_->out + 16 * 1024 * 1024)
#define HGD ((float*)(ws + WS_HGD))
#define CNTb ((unsigned*)(ws + WS_CNT))
#define LISTb ((unsigned*)(ws + WS_LIST))
#define PO0b ((bf16*)(ws + WS_PO0))
#define PO1b ((bf16*)(ws + WS_PO1))
#define PO2b ((bf16*)(ws + WS_PO2))
#define PO3b ((bf16*)(ws + WS_PO3))
#define PMLb ((float*)(ws + WS_PML))

    PH(0) { COORDS(); MKP(); p0_prologue<0>(P, lds, gw, NGW, wave, lane, vcu, G); }
    GRID_BAR();
    PH(1) { pg8::Gemm g{XN, (const bf16*)(ws + WS_WGU1), M, NGU, D / 2}; pg8::StaticOrder S; S.init(M, NGU, G, bx); pg8::EpiGU8 E{Hb, FF, (const float*)(ws + WS_RS), (const float*)(ws + WS_CMAX) + CM_GU1};
      pg8::gemm_phase<pg8::EpiGU8, pg8::StaticOrder, PG8_ALIGN, PG8_SP2, true>(lds + RING_OFF, g, S, E); }
    GRID_BAR();
    PH(2) { pg8::Gemm g{Hb, (const bf16*)(ws + WS_WD1), M, D, FF}; pg8::StaticOrder S; S.init(M, D, G, bx); pg8::EpiMix<0> E{Fb, nullptr, D};
      pg8::gemm_phase<pg8::EpiMix<0>, pg8::StaticOrder, PG8_ALIGN, PG8_SP2>(lds + RING_OFF, g, S, E); }
    GRID_BAR();
    PH(3) { COORDS(); rowwise_phase<true, 5>(gw, NGW, lane, A_->in[0], Fb, A_->in[12] + 1 * D, 0.5f, HBS, XN, (float*)(ws + WS_RS)); }
    GRID_BAR();
    PH(4) { pg8::Gemm g{HBS, (const bf16*)(ws + WS_WIN), M, 512, D}; pg8::StaticOrder S; S.init(M, 512, G, bx); pg8::EpiIN E{Qb, LBt, KMEAN, (const float*)(ws + WS_R2)};
      pg8::gemm_phase<pg8::EpiIN, pg8::StaticOrder, PG8_ALIGN, PG8_SP2>(lds + RING_OFF, g, S, E); }
    PH(4) { pg8::Gemm g{XN, (const bf16*)(ws + WS_W8IN), M, 4608, D / 2}; pg8::StaticOrder S; S.init(M, 4608, G, bx);
      pg8::EpiIN8 E{SAb, SBb, HQb, KINb, HIb, HGb, Kb, LBt, (const float*)(ws + WS_RS), (const float*)(ws + WS_CMAX) + CM_IN, KMEAN};
      pg8::gemm_phase<pg8::EpiIN8, pg8::StaticOrder, PG8_ALIGN, PG8_SP2, true>(lds + RING_OFF, g, S, E); }
    PH(4) { pg8::Gemm g{(const bf16*)(ws + WS_W8IN + (size_t)4608 * D), XN, 512, M, D / 2}; pg8::StaticOrder S; S.init(512, M, G, bx);
      pg8::EpiI8<0> E{VTb, nullptr, nullptr, M, 0, (const float*)(ws + WS_CMAX) + CM_IN + 4608, (const float*)(ws + WS_RS), 1.0f / 127.0f};
      pg8::gemm_phase<pg8::EpiI8<0>, pg8::StaticOrder, PG8_ALIGN, PG8_SP2, true>(lds + RING_OFF, g, S, E); }
    GRID_BAR();
    PH(19) { COORDS(); MKP(); p0_prologue<1>(P, lds, gw, NGW, wave, lane, vcu, G); }
    PH(5) { COORDS(); moba_gating_phase(lds, vcu, G, tid, Qb, KMEAN, CNTb, LISTb); }
    PH(18) { COORDS(); hgrn_mfma_phase<1>(lds, vcu, G, tid, wave, lane, KINb, HIb, HQb, HGb, A_->in[13], HS, HGD, OBb); }
    GRID_BAR();
    PH(6) { COORDS(); hgrn_scan_phase(vcu * NWAVES * 64 + tid, G * NWAVES * 64, HS, HGD); }
    GRID_BAR();
    PH(7) { COORDS(); hgrn_mfma_phase<3>(lds, vcu, G, tid, wave, lane, KINb, HIb, HQb, HGb, A_->in[13], HS, HGD, OBb); }
    GRID_BAR();
    PH(16) { COORDS(); moba_items_phase(lds, vcu, G, tid, wave, lane, Qb, Kb, VTb, CNTb, LISTb, BIAST, PO0b, PO1b, PO2b, PO3b, PMLb); }
    GRID_BAR();
    PH(17) { COORDS(); moba_combine_phase(vcu * NWAVES * 64 + tid, G * NWAVES * 64, PO0b, PO1b, PO2b, PO3b, PMLb, OAb); }
    GRID_BAR();
    PH(8) { pg8::Gemm g{OAb, (const bf16*)(ws + WS_WA), M, D, D, 512}; pg8::HalfOrder S; S.init(M, D, G, bx); pg8::EpiMerge E{SAb, SBb, D};
      pg8::gemm_phase<pg8::EpiMerge, pg8::HalfOrder, PG8_ALIGN, PG8_SP2>(lds + RING_OFF, g, S, E); }
    GRID_BAR();
    PH(9) { pg8::Gemm g{SAb, (const bf16*)(ws + WS_WOUT), M, D, D}; pg8::StaticOrder S; S.init(M, D, G, bx); pg8::EpiMix<0> E{Yb, nullptr, D};
      pg8::gemm_phase<pg8::EpiMix<0>, pg8::StaticOrder, PG8_ALIGN, PG8_SP2>(lds + RING_OFF, g, S, E); }
    GRID_BAR();
    PH(10) { COORDS(); rowwise_phase<false, 4>(gw, NGW, lane, HBS, Yb, A_->in[12] + 3 * D, 1.0f, HBS, XN, (float*)(ws + WS_RS)); }
    GRID_BAR();
    PH(11) { pg8::Gemm g{XN, (const bf16*)(ws + WS_WGU2), M, NGU, D / 2}; pg8::StaticOrder S; S.init(M, NGU, G, bx); pg8::EpiGU8 E{Hb, FF, (const float*)(ws + WS_RS), (const float*)(ws + WS_CMAX) + CM_GU2};
      pg8::gemm_phase<pg8::EpiGU8, pg8::StaticOrder, PG8_ALIGN, PG8_SP2, true>(lds + RING_OFF, g, S, E); }
    GRID_BAR();
    PH(12) { pg8::Gemm g{Hb, (const bf16*)(ws + WS_WD2), M, D, FF}; pg8::StaticOrder S; S.init(M, D, G, bx); pg8::EpiMix<0> E{Fb, nullptr, D};
      pg8::gemm_phase<pg8::EpiMix<0>, pg8::StaticOrder, PG8_ALIGN, PG8_SP2>(lds + RING_OFF, g, S, E); }
    GRID_BAR();
    PH(13) { COORDS(); rowwise_phase<false, 6>(gw, NGW, lane, HBS, Fb, A_->in[12] + 5 * D, 0.5f, XN, (bf16*)(ws + WS_X8B), (float*)(ws + WS_RS));
        const float* pp = A_->in[1];
        for (int i0 = gw * 64 + lane; i0 < M * PLE / 8; i0 += 4 * NGW * 64) {
            f32x4 a[4], b[4];
#pragma unroll
            for (int u = 0; u < 4; ++u) { int i = i0 + u * NGW * 64; if (i >= M * PLE / 8) i = i0; a[u] = ((const f32x4*)pp)[2 * i]; b[u] = ((const f32x4*)pp)[2 * i + 1]; }
#pragma unroll
            for (int u = 0; u < 4; ++u) { int i = i0 + u * NGW * 64; if (i >= M * PLE / 8) i = i0;
                v4u o; o.x = pk2(a[u].x, a[u].y); o.y = pk2(a[u].z, a[u].w); o.z = pk2(b[u].x, b[u].y); o.w = pk2(b[u].z, b[u].w); ((v4u*)PBb)[i] = o; } } }
    GRID_BAR();
    PH(14) { pg8::Gemm g{PBb, (const bf16*)(ws + WS_WPLE), M, D, PLE}; pg8::StaticOrder S; S.init(M, D, G, bx); pg8::EpiMix<0> E{Eb, nullptr, D};
      pg8::gemm_phase<pg8::EpiMix<0>, pg8::StaticOrder, PG8_ALIGN, PG8_SP2>(lds + RING_OFF, g, S, E); }
    PH(14) { pg8::Gemm g{(const bf16*)(ws + WS_X8B), (const bf16*)(ws + WS_WPG), M, D, D / 2}; pg8::StaticOrder S; S.init(M, D, G, bx);
      pg8::EpiI8<6> E{Fb, nullptr, Eb, D, 0, (const float*)(ws + WS_RS), (const float*)(ws + WS_CMAX) + CM_PG, 1.0f / 127.0f};
      pg8::gemm_phase<pg8::EpiI8<6>, pg8::StaticOrder, PG8_ALIGN, PG8_SP2, true>(lds + RING_OFF, g, S, E); }
    GRID_BAR();
    PH(15) { COORDS(); rowwise_phase<false, 3>(gw, NGW, lane, XN, Fb, A_->in[12] + 6 * D, 1.0f, nullptr, nullptr, A_->out); }
#if defined(PROBE_GEMM)
    GRID_BAR();
    PH(24) { pg8::Gemm g{(const bf16*)(ws + WS_A), (const bf16*)(ws + WS_WD1), M, D, D}; pg8::SameOrder S{11}; pg8::EpiNull E{};
      pg8::gemm_phase<pg8::EpiNull, pg8::SameOrder, PG8_ALIGN, PG8_SP2>(lds + RING_OFF, g, S, E); }
    PH(25) { pg8::Gemm g{(const bf16*)(ws + WS_A), (const bf16*)(ws + WS_WD1), M, NGU, D}; pg8::StaticOrder S; S.init(M, NGU, G, bx); pg8::EpiNull E{};
      pg8::gemm_phase<pg8::EpiNull, pg8::StaticOrder, PG8_ALIGN, PG8_SP2>(lds + RING_OFF, g, S, E); }
#endif
}

extern "C" void kernel_launch(void* const* d_in, const int* in_sizes, int n_in, void* d_out, int out_size, void* d_ws, size_t ws_size, hipStream_t stream) {
    static int grid = 0;
    if (grid == 0) {
        if (n_in != 16 || in_sizes[0] != M * D || out_size != M * D || ws_size < WS_END) { fprintf(stderr, "kernel_launch: unexpected shapes: n_in %d in0 %d out %d ws %zu; nothing launched\n", n_in, n_in > 0 ? in_sizes[0] : -1, out_size, ws_size); grid = -1; return; }
        int dev = 0, cus = 0;
        if (hipGetDevice(&dev) != hipSuccess || hipDeviceGetAttribute(&cus, hipDeviceAttributeMultiprocessorCount, dev) != hipSuccess) { fprintf(stderr, "kernel_launch: device query failed\n"); grid = -1; return; }
        if (hipFuncSetAttribute((const void*)mk_fwd, hipFuncAttributeMaxDynamicSharedMemorySize, LDS_BYTES) != hipSuccess) { fprintf(stderr, "kernel_launch: hipFuncSetAttribute failed\n"); grid = -1; return; }
        int per_cu = 0;
        if (hipOccupancyMaxActiveBlocksPerMultiprocessor(&per_cu, (const void*)mk_fwd, NWAVES * 64, LDS_BYTES) != hipSuccess || per_cu < 1) fprintf(stderr, "kernel_launch: note: occupancy query reports %d\n", per_cu);
        (void)hipGetLastError();
        grid = cus;
    }
    if (grid < 0) return;
    if (hipMemsetAsync((char*)d_ws + WS_CTL, 0, CTL_ZERO_BYTES, stream) != hipSuccess) { fprintf(stderr, "kernel_launch: memset failed\n"); return; }
    Args a{};
    for (int i = 0; i < 16; ++i) a.in[i] = (const float*)d_in[i];
    a.out = (float*)d_out; a.ws = (unsigned char*)d_ws; a.mask = MASK_BITS; a.rep = REP_MASK;
    hipLaunchKernelGGL(mk_fwd, dim3(grid), dim3(NWAVES * 64), LDS_BYTES, stream, a);
    const hipError_t le = hipPeekAtLastError();
    if (le != hipSuccess) fprintf(stderr, "kernel_launch: launch failed: %s\n", hipGetErrorName(le));
}
```

```cpp
#include <hip/hip_runtime.h>
#include <cstdio>
#include <cstdint>
namespace pg8 {
#define PG8_LAS __attribute__((address_space(3)))
typedef unsigned short bf16_t;
typedef short bf16x8 __attribute__((ext_vector_type(8)));
typedef float f32x4 __attribute__((ext_vector_type(4)));
typedef unsigned u32x4 __attribute__((ext_vector_type(4)));
typedef int i32x4 __attribute__((ext_vector_type(4)));
constexpr int BM = 256, BK = 64, HALF = 128, HTB = HALF * BK * 2  , STAGE_BYTES = 8 * HTB, NXCD = 8, WGM = 8;

__host__ __device__ __forceinline__ int lds_byte(int r, int c) { const int st = (r >> 4) * 2 + (c >> 5), rr = r & 15, cc = c & 31, ob = rr * 64 + cc * 2; return st * 1024 + (ob ^ (((ob >> 9) & 1) << 5)); }
__host__ __device__ __forceinline__ void stage_rc(int b, int& R, int& C) { const int st = b / 1024, sb = b % 1024, swz = sb ^ (((sb >> 9) & 1) << 5); R = (st >> 1) * 16 + swz / 64; C = (st & 1) * 32 + (swz % 64) / 2; }
__host__ __device__ __forceinline__ int perm32(int rho) { const int n = rho >> 4, i = rho & 15; return 8 * (i >> 2) + 4 * n + (i & 3); }

struct Unit { int pm, pn, half; };
struct Gemm { const bf16_t* A; const bf16_t* Bt; int M, N, K, Klen; };

struct StaticOrder {
    int nM, nN, nwg, G, c;
    __host__ __device__ void init(int M, int N, int G_, int c_) { nM = M / BM; nN = N / BM; nwg = nM * nN; G = G_; c = c_; }
    __host__ __device__ bool next(int i, Unit& u) const {
        const long L = (long)i * G + c; if (L >= nwg) return false;
        int wgid = (int)L; { const int q = nwg / NXCD, r = nwg % NXCD, xcd = wgid % NXCD, off = wgid / NXCD; wgid = (xcd < r ? xcd * (q + 1) : r * (q + 1) + (xcd - r) * q) + off; }
        const int nig = WGM * nN, gid = wgid / nig, fm = gid * WGM, gsz = (nM - fm) < WGM ? (nM - fm) : WGM;
        u.pm = fm + ((wgid % nig) % gsz); u.pn = (wgid % nig) / gsz; u.half = 0; return true;
    }
    __device__ __forceinline__ void a_ready(const Unit&) const {}
    __device__ __forceinline__ void done(const Unit&) const {}
};

struct HalfOrder : StaticOrder {
    __host__ __device__ bool next(int i, Unit& u) const { if (!StaticOrder::next(i >> 1, u)) return false; u.half = i & 1; return true; }
};

struct SameOrder { int n; __host__ __device__ bool next(int i, Unit& u) const { if (i >= n) return false; u.pm = 0; u.pn = 0; u.half = 0; return true; }
    __device__ __forceinline__ void a_ready(const Unit&) const {} __device__ __forceinline__ void done(const Unit&) const {} };

typedef float f32x2_t __attribute__((ext_vector_type(2))); typedef __bf16 bf16x2_t __attribute__((ext_vector_type(2)));
__device__ __forceinline__ unsigned cvt_pk_bf16(float lo, float hi) { f32x2_t v = {lo, hi}; bf16x2_t b = __builtin_convertvector(v, bf16x2_t); return __builtin_bit_cast(unsigned, b); }
#ifndef ST16_WT
#define ST16_WT 0
#endif
__device__ __forceinline__ void st16(void* p, u32x4 v) {
#if ST16_WT == 1
    asm volatile("global_store_dwordx4 %0, %1, off sc1\n\ts_nop 1" :: "v"(p), "v"(v) : "memory");
#elif ST16_WT == 2
    __builtin_nontemporal_store(v, (u32x4*)p);
#else
    *(u32x4*)p = v;
#endif
}
__device__ __forceinline__ void st16nt(void* p, u32x4 v) { __builtin_nontemporal_store(v, (u32x4*)p); }
__device__ __forceinline__ float sigm(float x) { return __builtin_amdgcn_rcpf(1.0f + __builtin_amdgcn_exp2f(-1.4426950408889634f * x)); }
__device__ __forceinline__ float bf_lo(unsigned w) { return __uint_as_float(w << 16); }
__device__ __forceinline__ float bf_hi(unsigned w) { return __uint_as_float(w & 0xffff0000u); }
__device__ __forceinline__ void unpack8(const u32x4 w, float (&o)[8]) { o[0] = bf_lo(w.x); o[1] = bf_hi(w.x); o[2] = bf_lo(w.y); o[3] = bf_hi(w.y); o[4] = bf_lo(w.z); o[5] = bf_hi(w.z); o[6] = bf_lo(w.w); o[7] = bf_hi(w.w); }
__device__ __forceinline__ u32x4 pack8(const float (&o)[8]) { u32x4 w; w.x = cvt_pk_bf16(o[0], o[1]); w.y = cvt_pk_bf16(o[2], o[3]); w.z = cvt_pk_bf16(o[4], o[5]); w.w = cvt_pk_bf16(o[6], o[7]); return w; }

struct EpiGU {
    static constexpr bool PERM = true, AFTER_DRAIN = false, HAS_MID = false;
    bf16_t* H; int ldh;
    __device__ __forceinline__ void operator()(const f32x4 (&acc)[2][2][4][2], const Unit& u, int wr, int wc, int fr, int fq) const {
        const int row0 = u.pm * BM + wr * 64 + fr, col0 = u.pn * HALF + wc * 32 + 8 * fq;
#pragma unroll
        for (int ai = 0; ai < 2; ++ai)
#pragma unroll
            for (int m = 0; m < 4; ++m) { bf16_t* rowp = H + (size_t)(row0 + ai * HALF + m * 16) * ldh + col0;
                const f32x4 g0 = acc[ai][0][m][0], g1 = acc[ai][0][m][1], u0 = acc[ai][1][m][0], u1 = acc[ai][1][m][1]; float o[8];
#pragma unroll
                for (int j = 0; j < 4; ++j) { o[j] = g0[j] * sigm(g0[j]) * u0[j]; o[4 + j] = g1[j] * sigm(g1[j]) * u1[j]; }
                st16(rowp, pack8(o)); }
    }
};
struct EpiF32 {
    static constexpr bool PERM = false, AFTER_DRAIN = false, HAS_MID = false;
    float* C; int ldc;
    __device__ __forceinline__ void operator()(const f32x4 (&acc)[2][2][4][2], const Unit& u, int wr, int wc, int fr, int fq) const {
        const int row0 = u.pm * BM + wr * 64 + fr, col0 = u.pn * BM + wc * 32 + 4 * fq;
#pragma unroll
        for (int ai = 0; ai < 2; ++ai)
#pragma unroll
            for (int m = 0; m < 4; ++m) { float* rowp = C + (size_t)(row0 + ai * HALF + m * 16) * ldc + col0;
#pragma unroll
                for (int bj = 0; bj < 2; ++bj)
#pragma unroll
                    for (int n = 0; n < 2; ++n) *(f32x4*)(rowp + bj * HALF + n * 16) = acc[ai][bj][m][n]; }
    }
};
struct EpiIN {
    static constexpr bool PERM = true, AFTER_DRAIN = false, HAS_MID = false;
    bf16_t *Q; const float* LB; float* KMEAN; const float* R2;
    template <int MODE> __device__ __forceinline__ void body(const f32x4 (&acc)[2][2][4][2], bf16_t* base, int ldc, int row0, int cbase, int pm, int fr) const {
        float rsv[2][4];
#pragma unroll
        for (int ai = 0; ai < 2; ++ai)
#pragma unroll
            for (int m = 0; m < 4; ++m) rsv[ai][m] = R2[row0 + ai * HALF + m * 16];
        float lbv[2][8]; float ks[2][8];
#pragma unroll
        for (int bj = 0; bj < 2; ++bj)
#pragma unroll
            for (int j = 0; j < 8; ++j) { lbv[bj][j] = (MODE == 2) ? (1.0f - LB[cbase + bj * HALF + j]) : 0.f; ks[bj][j] = 0.f; }
#pragma unroll
        for (int ai = 0; ai < 2; ++ai)
#pragma unroll
            for (int m = 0; m < 4; ++m) { const int row = row0 + ai * HALF + m * 16; const float r2 = rsv[ai][m]; bf16_t* rowp = base + (size_t)row * ldc + cbase;
#pragma unroll
                for (int bj = 0; bj < 2; ++bj) { const f32x4 v0 = acc[ai][bj][m][0], v1 = acc[ai][bj][m][1]; float o[8];
#pragma unroll
                    for (int j = 0; j < 4; ++j) { o[j] = v0[j] * r2; o[4 + j] = v1[j] * r2; }
#pragma unroll
                    for (int j = 0; j < 8; ++j) {
                        if (MODE == 1) o[j] = o[j] * sigm(o[j]);
                        if (MODE == 2) o[j] = lbv[bj][j] * sigm(-o[j]);
                        if (MODE == 4) { ks[bj][j] += o[j]; asm volatile("" : "+v"(ks[bj][j])); }
                        if (MODE == 5) o[j] *= 0.18033688011112042f; }
                    st16(rowp + bj * HALF, pack8(o)); } }
        if (MODE == 4) {
#pragma unroll
            for (int bj = 0; bj < 2; ++bj)
#pragma unroll
                for (int j = 0; j < 8; ++j) { float s = ks[bj][j]; s += __shfl_xor(s, 1); s += __shfl_xor(s, 2); s += __shfl_xor(s, 4); s += __shfl_xor(s, 8);
                    if (fr == 0) atomicAdd(KMEAN + (size_t)pm * 512 + cbase + bj * HALF + j, s); }
        }
    }
    __device__ __forceinline__ void operator()(const f32x4 (&acc)[2][2][4][2], const Unit& u, int wr, int wc, int fr, int fq) const {
        const int pn = u.pn, row0 = u.pm * BM + wr * 64 + fr, cw = wc * 32 + 8 * fq;
        body<5>(acc, Q, 512, row0, pn * BM + cw, u.pm, fr);
    }
};
struct EpiIN8 {
    static constexpr bool PERM = true, AFTER_DRAIN = false, HAS_MID = false;
    bf16_t *SA, *SB, *HQ, *KIN, *HI, *HG, *K; const float* LB; const float* RS; const float* CMX; float* KMEAN;
    template <int MODE> __device__ __forceinline__ void body(const i32x4 (&acc)[2][2][4][2], bf16_t* base, int ldc, int row0, int cbase, int gcol, int pm = 0, int fr = 0) const {
        float rsv[2][4];
#pragma unroll
        for (int ai = 0; ai < 2; ++ai)
#pragma unroll
            for (int m = 0; m < 4; ++m) rsv[ai][m] = RS[row0 + ai * HALF + m * 16];
        float cf[2][8], lbv[2][8], ks[2][8];
#pragma unroll
        for (int bj = 0; bj < 2; ++bj)
#pragma unroll
            for (int j = 0; j < 8; ++j) { cf[bj][j] = CMX[gcol + bj * HALF + j] * (1.0f / 127.0f); lbv[bj][j] = (MODE == 2) ? (1.0f - LB[cbase + bj * HALF + j]) : 0.f; ks[bj][j] = 0.f; }
#pragma unroll
        for (int ai = 0; ai < 2; ++ai)
#pragma unroll
            for (int m = 0; m < 4; ++m) { const int row = row0 + ai * HALF + m * 16; const float rf = rsv[ai][m]; bf16_t* rowp = base + (size_t)row * ldc + cbase;
#pragma unroll
                for (int bj = 0; bj < 2; ++bj) { const i32x4 v0 = acc[ai][bj][m][0], v1 = acc[ai][bj][m][1]; float o[8];
#pragma unroll
                    for (int j = 0; j < 4; ++j) { o[j] = (float)v0[j] * (rf * cf[bj][j]); o[4 + j] = (float)v1[j] * (rf * cf[bj][4 + j]); }
#pragma unroll
                    for (int j = 0; j < 8; ++j) {
                        if (MODE == 1) o[j] = o[j] * sigm(o[j]);
                        if (MODE == 2) o[j] = lbv[bj][j] * sigm(-o[j]);
                        if (MODE == 3) o[j] = sigm(o[j]);
                        if (MODE == 4) { ks[bj][j] += o[j]; asm volatile("" : "+v"(ks[bj][j])); } }
                    st16nt(rowp + bj * HALF, pack8(o)); } }
        if (MODE == 4) {
#pragma unroll
            for (int bj = 0; bj < 2; ++bj)
#pragma unroll
                for (int j = 0; j < 8; ++j) { float s = ks[bj][j]; s += __shfl_xor(s, 1); s += __shfl_xor(s, 2); s += __shfl_xor(s, 4); s += __shfl_xor(s, 8);
                    if (fr == 0) atomicAdd(KMEAN + (size_t)pm * 512 + cbase + bj * HALF + j, s); }
        }
    }
    __device__ __forceinline__ void operator()(const i32x4 (&acc)[2][2][4][2], const Unit& u, int wr, int wc, int fr, int fq) const {
        const int pn = u.pn, row0 = u.pm * BM + wr * 64 + fr, cw = wc * 32 + 8 * fq, gcol = pn * BM + cw;
        if (pn >= 16) { body<4>(acc, K, 512, row0, (pn - 16) * BM + cw, gcol, u.pm, fr); return; }
        if (pn < 4)       body<3>(acc, SA,  1024, row0, (pn)      * BM + cw, gcol);
        else if (pn < 8)  body<3>(acc, SB,  1024, row0, (pn - 4)  * BM + cw, gcol);
        else if (pn < 10) body<1>(acc, HQ,  512,  row0, (pn - 8)  * BM + cw, gcol);
        else if (pn < 12) body<2>(acc, KIN, 512,  row0, (pn - 10) * BM + cw, gcol);
        else if (pn < 14) body<0>(acc, HI,  512,  row0, (pn - 12) * BM + cw, gcol);
        else              body<1>(acc, HG,  512,  row0, (pn - 14) * BM + cw, gcol);
    }
};
template <int MODE> struct EpiI8 {
    static constexpr bool PERM = true, AFTER_DRAIN = false, HAS_MID = false;
    bf16_t* O; bf16_t* O2; const bf16_t* E; int ldc; int split; const float* RF; const float* CF; float cmul;
    __device__ __forceinline__ void operator()(const i32x4 (&acc)[2][2][4][2], const Unit& u, int wr, int wc, int fr, int fq) const {
        const int row0 = u.pm * BM + wr * 64 + fr; int colt = u.pn * BM; bf16_t* base = O;
        if (MODE == 3 && colt >= split) { base = O2; colt -= split; }
        const int col0 = colt + wc * 32 + 8 * fq, gcol0 = u.pn * BM + wc * 32 + 8 * fq;
        float rsv[2][4];
#pragma unroll
        for (int ai = 0; ai < 2; ++ai)
#pragma unroll
            for (int m = 0; m < 4; ++m) rsv[ai][m] = RF[row0 + ai * HALF + m * 16];
        float cf[2][8];
#pragma unroll
        for (int bj = 0; bj < 2; ++bj)
#pragma unroll
            for (int j = 0; j < 8; ++j) cf[bj][j] = CF[gcol0 + bj * HALF + j] * cmul;
#pragma unroll
        for (int ai = 0; ai < 2; ++ai) {
            u32x4 ew[4][2];
            if (MODE == 6) {
#pragma unroll
                for (int m = 0; m < 4; ++m)
#pragma unroll
                    for (int bj = 0; bj < 2; ++bj) ew[m][bj] = *(const u32x4*)(E + (size_t)(row0 + ai * HALF + m * 16) * ldc + col0 + bj * HALF); }
#pragma unroll
            for (int m = 0; m < 4; ++m) { const int row = row0 + ai * HALF + m * 16; const float rf = rsv[ai][m]; const size_t off = (size_t)row * ldc + col0;
#pragma unroll
                for (int bj = 0; bj < 2; ++bj) { const i32x4 v0 = acc[ai][bj][m][0], v1 = acc[ai][bj][m][1]; float o[8];
#pragma unroll
                    for (int j = 0; j < 4; ++j) { o[j] = (float)v0[j] * (rf * cf[bj][j]); o[4 + j] = (float)v1[j] * (rf * cf[bj][4 + j]); }
                    if (MODE == 3) {
#pragma unroll
                        for (int j = 0; j < 8; ++j) o[j] = sigm(o[j]); }
                    if (MODE == 6) { float ev[8]; unpack8(ew[m][bj], ev);
#pragma unroll
                        for (int j = 0; j < 8; ++j) o[j] = sigm(o[j]) * ev[j]; }
                    if (MODE == 0) st16nt(base + off + bj * HALF, pack8(o)); else st16(base + off + bj * HALF, pack8(o)); } } }
    }
};
template <int MODE> struct EpiMix {
    static constexpr bool PERM = true, AFTER_DRAIN = false, HAS_MID = false;
    bf16_t* T; const bf16_t* S2; int ldc;
    __device__ __forceinline__ void operator()(const f32x4 (&acc)[2][2][4][2], const Unit& u, int wr, int wc, int fr, int fq) const {
        const int row0 = u.pm * BM + wr * 64 + fr, col0 = u.pn * BM + wc * 32 + 8 * fq;
#pragma unroll
        for (int ai = 0; ai < 2; ++ai)
#pragma unroll
            for (int m = 0; m < 4; ++m) { const size_t off = (size_t)(row0 + ai * HALF + m * 16) * ldc + col0;
#pragma unroll
                for (int bj = 0; bj < 2; ++bj) { const f32x4 v0 = acc[ai][bj][m][0], v1 = acc[ai][bj][m][1]; float o[8];
#pragma unroll
                    for (int j = 0; j < 4; ++j) { o[j] = v0[j]; o[4 + j] = v1[j]; }
                    if (MODE == 1) { float t[8]; unpack8(*(const u32x4*)(T + off + bj * HALF), t);
#pragma unroll
                        for (int j = 0; j < 8; ++j) o[j] = t[j] * o[j]; }
                    if (MODE == 2) { float t[8], s[8]; unpack8(*(const u32x4*)(T + off + bj * HALF), t); unpack8(*(const u32x4*)(S2 + off + bj * HALF), s);
#pragma unroll
                        for (int j = 0; j < 8; ++j) o[j] = t[j] + s[j] * o[j]; }
                    st16(T + off + bj * HALF, pack8(o)); } }
    }
};
struct EpiPleB {
    static constexpr bool PERM = true, AFTER_DRAIN = false, HAS_MID = false;
    const bf16_t* E; bf16_t* Y; int ldc;
    __device__ __forceinline__ void operator()(const f32x4 (&acc)[2][2][4][2], const Unit& u, int wr, int wc, int fr, int fq) const {
        const int row0 = u.pm * BM + wr * 64 + fr, col0 = u.pn * BM + wc * 32 + 8 * fq;
#pragma unroll
        for (int ai = 0; ai < 2; ++ai)
#pragma unroll
            for (int m = 0; m < 4; ++m) { const size_t off = (size_t)(row0 + ai * HALF + m * 16) * ldc + col0;
#pragma unroll
                for (int bj = 0; bj < 2; ++bj) { const f32x4 v0 = acc[ai][bj][m][0], v1 = acc[ai][bj][m][1]; float e[8], o[8]; unpack8(*(const u32x4*)(E + off + bj * HALF), e);
#pragma unroll
                    for (int j = 0; j < 4; ++j) { o[j] = sigm(v0[j]) * e[j]; o[4 + j] = sigm(v1[j]) * e[4 + j]; }
                    st16(Y + off + bj * HALF, pack8(o)); } }
    }
};

struct EpiGU8 {
    static constexpr bool PERM = true, AFTER_DRAIN = false, HAS_MID = false;
    bf16_t* H; int ldh; const float* RS; const float* CMAX;
    __device__ __forceinline__ void operator()(const i32x4 (&acc)[2][2][4][2], const Unit& u, int wr, int wc, int fr, int fq) const {
        const int row0 = u.pm * BM + wr * 64 + fr, cw = wc * 32 + 8 * fq, col0 = u.pn * HALF + cw;
        float rsv[2][4];
#pragma unroll
        for (int ai = 0; ai < 2; ++ai)
#pragma unroll
            for (int m = 0; m < 4; ++m) rsv[ai][m] = RS[row0 + ai * HALF + m * 16];
        float cg[8], cu[8];
#pragma unroll
        for (int j = 0; j < 8; ++j) { cg[j] = CMAX[u.pn * BM + cw + j] * (1.0f / 127.0f); cu[j] = CMAX[u.pn * BM + HALF + cw + j] * (1.0f / 127.0f); }
#pragma unroll
        for (int ai = 0; ai < 2; ++ai)
#pragma unroll
            for (int m = 0; m < 4; ++m) { const int row = row0 + ai * HALF + m * 16; const float rs = rsv[ai][m]; bf16_t* rowp = H + (size_t)row * ldh + col0;
                const i32x4 g0 = acc[ai][0][m][0], g1 = acc[ai][0][m][1], u0 = acc[ai][1][m][0], u1 = acc[ai][1][m][1]; float o[8];
#pragma unroll
                for (int j = 0; j < 4; ++j) { const float ga = (float)g0[j] * (rs * cg[j]), gb = (float)g1[j] * (rs * cg[4 + j]), ua = (float)u0[j] * (rs * cu[j]), ub = (float)u1[j] * (rs * cu[4 + j]);
                    o[j] = ga * sigm(ga) * ua; o[4 + j] = gb * sigm(gb) * ub; }
                st16nt(rowp, pack8(o)); }
    }
};

struct EpiMerge {
    static constexpr bool PERM = true, AFTER_DRAIN = false, HAS_MID = true;
    bf16_t* T; const bf16_t* S2; int ldc;
    __device__ __forceinline__ void mid(f32x4 (&acc)[2][2][4][2], const Unit& u, int wr, int wc, int fr, int fq) const {
        const int row0 = u.pm * BM + wr * 64 + fr, col0 = u.pn * BM + wc * 32 + 8 * fq;
#pragma unroll
        for (int ai = 0; ai < 2; ++ai)
#pragma unroll
            for (int m = 0; m < 4; ++m)
#pragma unroll
                for (int bj = 0; bj < 2; ++bj) { const size_t off = (size_t)(row0 + ai * HALF + m * 16) * ldc + col0 + bj * HALF;
                    const u32x4 tw = *(const u32x4*)(T + off), sw = *(const u32x4*)(S2 + off);
                    acc[ai][bj][m][0][0] *= bf_lo(tw.x) * __builtin_amdgcn_rcpf(bf_lo(sw.x)); acc[ai][bj][m][0][1] *= bf_hi(tw.x) * __builtin_amdgcn_rcpf(bf_hi(sw.x));
                    acc[ai][bj][m][0][2] *= bf_lo(tw.y) * __builtin_amdgcn_rcpf(bf_lo(sw.y)); acc[ai][bj][m][0][3] *= bf_hi(tw.y) * __builtin_amdgcn_rcpf(bf_hi(sw.y));
                    acc[ai][bj][m][1][0] *= bf_lo(tw.z) * __builtin_amdgcn_rcpf(bf_lo(sw.z)); acc[ai][bj][m][1][1] *= bf_hi(tw.z) * __builtin_amdgcn_rcpf(bf_hi(sw.z));
                    acc[ai][bj][m][1][2] *= bf_lo(tw.w) * __builtin_amdgcn_rcpf(bf_lo(sw.w)); acc[ai][bj][m][1][3] *= bf_hi(tw.w) * __builtin_amdgcn_rcpf(bf_hi(sw.w));
                    asm volatile("" ::: "memory"); }
    }
    __device__ __forceinline__ void operator()(const f32x4 (&acc)[2][2][4][2], const Unit& u, int wr, int wc, int fr, int fq) const {
        const int row0 = u.pm * BM + wr * 64 + fr, col0 = u.pn * BM + wc * 32 + 8 * fq;
#pragma unroll
        for (int ai = 0; ai < 2; ++ai) {
            u32x4 sw[4][2];
#pragma unroll
            for (int m = 0; m < 4; ++m)
#pragma unroll
                for (int bj = 0; bj < 2; ++bj) sw[m][bj] = *(const u32x4*)(S2 + (size_t)(row0 + ai * HALF + m * 16) * ldc + col0 + bj * HALF);
#pragma unroll
            for (int m = 0; m < 4; ++m) { const size_t off = (size_t)(row0 + ai * HALF + m * 16) * ldc + col0;
#pragma unroll
                for (int bj = 0; bj < 2; ++bj) { const f32x4 v0 = acc[ai][bj][m][0], v1 = acc[ai][bj][m][1]; float s[8], o[8]; unpack8(sw[m][bj], s);
#pragma unroll
                    for (int j = 0; j < 4; ++j) { o[j] = v0[j] * s[j]; o[4 + j] = v1[j] * s[4 + j]; }
                    st16(T + off + bj * HALF, pack8(o)); } } }
    }
};

struct EpiNull {
    static constexpr bool PERM = true, AFTER_DRAIN = false, HAS_MID = false;
    template <class AT> __device__ __forceinline__ void operator()(const AT (&acc)[2][2][4][2], const Unit& u, int wr, int wc, int fr, int fq) const {
#pragma unroll
        for (int ai = 0; ai < 2; ++ai)
#pragma unroll
            for (int bj = 0; bj < 2; ++bj)
#pragma unroll
                for (int m = 0; m < 4; ++m)
#pragma unroll
                    for (int n = 0; n < 2; ++n) asm volatile("" :: "v"(acc[ai][bj][m][n]));
    }
};

template <bool I8> struct AccT { typedef f32x4 T; }; template <> struct AccT<true> { typedef i32x4 T; };
template <class Epi, class Sched, bool ALIGN_EPI = false, bool SP2 = false, bool I8 = false>
__device__ __forceinline__ void gemm_phase(PG8_LAS unsigned char* lds, const Gemm g, const Sched& S, const Epi& E) {
    int tid_ = threadIdx.x; asm volatile("" : "+v"(tid_));
    const int tid = tid_, wid = __builtin_amdgcn_readfirstlane(tid >> 6), lane = tid & 63, wr = wid >> 2, wc = wid & 3, fr = lane & 15, fq = lane >> 4;
    int K_ = g.K; asm volatile("" : "+s"(K_));
    const int K = K_, nt = (g.Klen ? g.Klen : K) / BK;
    const size_t koff = (size_t)(g.Klen ? g.Klen : K) * 2;
    unsigned voffA[2], voffB[2];
#pragma unroll
    for (int i = 0; i < 2; ++i) { int R, C; stage_rc(tid * 16 + i * 8192, R, C); const int Rb = Epi::PERM ? ((R & ~31) + perm32(R & 31)) : R;
        voffA[i] = (unsigned)(R * K + C) * 2u; voffB[i] = (unsigned)(Rb * K + C) * 2u; }
    const size_t kstep = (size_t)(BK * 2);
    const size_t hstep = (size_t)HALF * K * 2;
    const size_t tstep = 2 * hstep;
    const unsigned ldsw = (unsigned)wid * 1024u;
    const int aoff = lds_byte(wr * 64 + fr, fq * 8), boff = lds_byte(wc * 32 + fr, fq * 8);
#define PG8_SA(b, h) (((b) * 2 + (h)) * HTB)
#define PG8_SB(b, h) ((4 + (b) * 2 + (h)) * HTB)
#define PG8_STAGE(bufoff, gbase, voff) do { _Pragma("unroll") for (int _i = 0; _i < 2; ++_i) \
        __builtin_amdgcn_global_load_lds((const unsigned*)((const char*)(gbase) + (voff)[_i]), (PG8_LAS unsigned*)(lds + (bufoff) + ldsw + _i * 8192), 16, 0, 0); } while (0)
#define PG8_LDA(dst, b, h) do { _Pragma("unroll") for (int m = 0; m < 4; ++m) _Pragma("unroll") for (int k = 0; k < 2; ++k) dst[m][k] = *(const PG8_LAS bf16x8*)(lds + PG8_SA(b, h) + aoff + m * 2048 + k * 1024); } while (0)
#define PG8_LDB(dst, b, h) do { _Pragma("unroll") for (int n = 0; n < 2; ++n) _Pragma("unroll") for (int k = 0; k < 2; ++k) dst[n][k] = *(const PG8_LAS bf16x8*)(lds + PG8_SB(b, h) + boff + n * 2048 + k * 1024); } while (0)
#define PG8_MMA(ai, bj, At, Bt) do { __builtin_amdgcn_s_setprio(1); _Pragma("unroll") for (int m = 0; m < 4; ++m) _Pragma("unroll") for (int n = 0; n < 2; ++n) _Pragma("unroll") for (int k = 0; k < 2; ++k) \
        { if constexpr (I8) acc[ai][bj][m][n] = __builtin_amdgcn_mfma_i32_16x16x64_i8(__builtin_bit_cast(i32x4, Bt[n][k]), __builtin_bit_cast(i32x4, At[m][k]), acc[ai][bj][m][n], 0, 0, 0); \
          else acc[ai][bj][m][n] = __builtin_amdgcn_mfma_f32_16x16x32_bf16(Bt[n][k], At[m][k], acc[ai][bj][m][n], 0, 0, 0); } __builtin_amdgcn_s_setprio(0); } while (0)
#define PG8_WAIT_V(n) asm volatile("s_waitcnt vmcnt(" #n ")" ::: "memory")
#define PG8_WAIT_L(n) asm volatile("s_waitcnt lgkmcnt(" #n ")" ::: "memory")
#define PG8_BAR __builtin_amdgcn_s_barrier()
#define PG8_SCHED __builtin_amdgcn_sched_barrier(0)
    Unit cur, nxt; int ui = 0;
    if (!S.next(0, cur)) return;
    typedef typename AccT<I8>::T acc_t; acc_t acc[2][2][4][2];
#pragma unroll
    for (int a = 0; a < 2; ++a)
#pragma unroll
        for (int b = 0; b < 2; ++b)
#pragma unroll
            for (int m = 0; m < 4; ++m)
#pragma unroll
                for (int n = 0; n < 2; ++n) acc[a][b][m][n] = (acc_t){0, 0, 0, 0};
    bf16x8 At[4][2], B0[2][2], B1[2][2];
    const char* cA = (const char*)g.A + (size_t)cur.pm * tstep + cur.half * koff; const char* cB = (const char*)g.Bt + (size_t)cur.pn * tstep + cur.half * koff;
    S.a_ready(cur);
    if constexpr (SP2) {
        PG8_STAGE(PG8_SB(0, 0), cB, voffB); PG8_STAGE(PG8_SB(0, 1), cB + hstep, voffB); PG8_STAGE(PG8_SA(0, 0), cA, voffA); PG8_STAGE(PG8_SA(0, 1), cA + hstep, voffA);
        if (wr == 1) PG8_BAR;
        PG8_WAIT_V(2); PG8_BAR;
        PG8_STAGE(PG8_SB(1, 0), cB + kstep, voffB); PG8_STAGE(PG8_SA(1, 0), cA + kstep, voffA); PG8_STAGE(PG8_SB(1, 1), cB + hstep + kstep, voffB);
        PG8_WAIT_V(6); PG8_BAR;
    } else {
        PG8_STAGE(PG8_SB(0, 0), cB, voffB); PG8_STAGE(PG8_SA(0, 0), cA, voffA); PG8_STAGE(PG8_SB(0, 1), cB + hstep, voffB); PG8_STAGE(PG8_SA(0, 1), cA + hstep, voffA);
        if (wr == 1) PG8_BAR;
        PG8_WAIT_V(4); PG8_BAR;
        PG8_STAGE(PG8_SB(1, 0), cB + kstep, voffB); PG8_STAGE(PG8_SA(1, 0), cA + kstep, voffA); PG8_STAGE(PG8_SB(1, 1), cB + hstep + kstep, voffB);
        PG8_WAIT_V(6); PG8_BAR;
    }
    for (;;) {
        const bool has_next = S.next(ui + 1, nxt);
        const char* nA = has_next ? (const char*)g.A + (size_t)nxt.pm * tstep + nxt.half * koff : cA; const char* nB = has_next ? (const char*)g.Bt + (size_t)nxt.pn * tstep + nxt.half * koff : cB;
        for (int t = 0; t < nt; t += 2) {
            const bool last = (t == nt - 2);
            const char* a1 = cA + (size_t)(t + 1) * kstep;
            const char* a2 = last ? nA : cA + (size_t)(t + 2) * kstep; const char* b2 = last ? nB : cB + (size_t)(t + 2) * kstep;
            const char* a3 = a2 + kstep; const char* b3 = b2 + kstep;
            if (last && has_next) S.a_ready(nxt);
            if constexpr (SP2) {
            PG8_LDB(B0, 0, 0); PG8_LDB(B1, 0, 1); PG8_SCHED; PG8_LDA(At, 0, 0); PG8_STAGE(PG8_SA(1, 1), a1 + hstep, voffA);
            PG8_WAIT_V(8); PG8_WAIT_L(0); PG8_BAR; PG8_MMA(0, 0, At, B0); PG8_MMA(0, 1, At, B1); PG8_BAR; PG8_SCHED;
            PG8_LDA(At, 0, 1); PG8_STAGE(PG8_SB(0, 0), b2, voffB); PG8_STAGE(PG8_SB(0, 1), b2 + hstep, voffB); PG8_STAGE(PG8_SA(0, 0), a2, voffA);
            PG8_WAIT_V(8); PG8_WAIT_L(0); PG8_BAR; PG8_MMA(1, 0, At, B0); PG8_MMA(1, 1, At, B1); PG8_BAR; PG8_SCHED;
            PG8_LDB(B0, 1, 0); PG8_LDB(B1, 1, 1); PG8_SCHED; PG8_LDA(At, 1, 0); PG8_STAGE(PG8_SA(0, 1), a2 + hstep, voffA);
            PG8_WAIT_V(8); PG8_WAIT_L(0); PG8_BAR; PG8_MMA(0, 0, At, B0); PG8_MMA(0, 1, At, B1); PG8_BAR; PG8_SCHED;
            PG8_LDA(At, 1, 1); PG8_STAGE(PG8_SB(1, 0), b3, voffB); PG8_STAGE(PG8_SB(1, 1), b3 + hstep, voffB); PG8_STAGE(PG8_SA(1, 0), a3, voffA);
            PG8_WAIT_V(8); PG8_WAIT_L(0); PG8_BAR; PG8_MMA(1, 0, At, B0); PG8_MMA(1, 1, At, B1); PG8_BAR; PG8_SCHED;
            } else {
            PG8_LDB(B0, 0, 0); PG8_SCHED; PG8_LDA(At, 0, 0); PG8_STAGE(PG8_SA(1, 1), a1 + hstep, voffA);
            PG8_WAIT_L(8); PG8_BAR; PG8_WAIT_L(0); PG8_MMA(0, 0, At, B0); PG8_BAR; PG8_SCHED;
            PG8_LDB(B1, 0, 1); PG8_STAGE(PG8_SB(0, 0), b2, voffB);
            PG8_BAR; PG8_WAIT_L(0); PG8_MMA(0, 1, At, B1); PG8_BAR;
            PG8_LDA(At, 0, 1); PG8_STAGE(PG8_SA(0, 0), a2, voffA);
            PG8_BAR; PG8_WAIT_L(0); PG8_MMA(1, 0, At, B0); PG8_BAR; PG8_SCHED;
            PG8_STAGE(PG8_SB(0, 1), b2 + hstep, voffB);
            PG8_WAIT_V(6); PG8_BAR; PG8_MMA(1, 1, At, B1); PG8_BAR;
            PG8_LDB(B0, 1, 0); PG8_SCHED; PG8_LDA(At, 1, 0); PG8_STAGE(PG8_SA(0, 1), a2 + hstep, voffA);
            PG8_WAIT_L(8); PG8_BAR; PG8_WAIT_L(0); PG8_MMA(0, 0, At, B0); PG8_BAR; PG8_SCHED;
            PG8_LDB(B1, 1, 1); PG8_STAGE(PG8_SB(1, 0), b3, voffB);
            PG8_BAR; PG8_WAIT_L(0); PG8_MMA(0, 1, At, B1); PG8_BAR;
            PG8_LDA(At, 1, 1); PG8_STAGE(PG8_SA(1, 0), a3, voffA);
            PG8_BAR; PG8_WAIT_L(0); PG8_MMA(1, 0, At, B0); PG8_BAR; PG8_SCHED;
            PG8_STAGE(PG8_SB(1, 1), b3 + hstep, voffB);
            PG8_WAIT_V(6); PG8_BAR; PG8_MMA(1, 1, At, B1); PG8_BAR;
            }
        }
        if constexpr (ALIGN_EPI) { if (wr == 0) PG8_BAR; }
        if constexpr (Epi::HAS_MID) { if (cur.half == 0) E.mid(acc, cur, wr, wc, fr, fq); else E(acc, cur, wr, wc, fr, fq); }
        else if constexpr (!Epi::AFTER_DRAIN) { E(acc, cur, wr, wc, fr, fq); S.done(cur); }
        if (!has_next) break;
        if (!(Epi::HAS_MID && nxt.half == 1))
#pragma unroll
        for (int a = 0; a < 2; ++a)
#pragma unroll
            for (int b = 0; b < 2; ++b)
#pragma unroll
                for (int m = 0; m < 4; ++m)
#pragma unroll
                    for (int n = 0; n < 2; ++n) acc[a][b][m][n] = (acc_t){0, 0, 0, 0};
        cur = nxt; cA = nA; cB = nB; ++ui;
        if constexpr (ALIGN_EPI) { if (wr == 1) PG8_BAR; }
    }
    PG8_WAIT_V(0);
    if constexpr (!ALIGN_EPI) { if (wr == 0) PG8_BAR; }
    PG8_BAR;
    if constexpr (Epi::AFTER_DRAIN) { E.fused(acc, cur, wr, wc, fr, fq, lds, wid, lane); S.done(cur); }
#undef PG8_SA
#undef PG8_SB
#undef PG8_STAGE
#undef PG8_LDA
#undef PG8_LDB
#undef PG8_MMA
#undef PG8_WAIT_V
#undef PG8_WAIT_L
#undef PG8_BAR
#undef PG8_SCHED
}
}
#ifndef PG8_SP2
#define PG8_SP2 true
#endif
#ifndef PG8_ALIGN
#define PG8_ALIGN true
#endif
constexpr int NWAVES = 8;
constexpr int BATCH = 4, SEQ = 8192, D = 1024, FF = 2816, NGU = 2 * FF, NIN = 5632, PLE = 256;
constexpr int M = BATCH * SEQ;
constexpr int MBH = 8, MBD = 64, MBW = 512, MBB = 256, NBLK = SEQ / MBB;
constexpr int HGH = 4, HGD_ = 128, HGW = 512, HGC = 256, HGNC = SEQ / HGC;
constexpr float EPS = 1e-6f;
constexpr size_t MiB = 1u << 20;
constexpr size_t WS_CTL = 0, CTL_ZERO_BYTES = 1 * MiB;
constexpr size_t WS_KMEAN = 512 * 1024;
constexpr size_t WS_LB = 768 * 1024, WS_BIAST = 772 * 1024;
constexpr size_t WS_WGU1 = 1 * MiB, WS_WD1 = 12 * MiB, WS_WIN = WS_WD1 + 5632 * 1024, WS_WA = WS_WIN + 11 * MiB, WS_WB = WS_WA + 1 * MiB, WS_WOUT = WS_WB + 1 * MiB,
                 WS_WGU2 = WS_WOUT + 2 * MiB, WS_WD2 = WS_WGU2 + 11 * MiB, WS_WPLE = WS_WD2 + 5632 * 1024, WS_WPG = WS_WPLE + 512 * 1024, WS_HGD = WS_WPG + 2 * MiB;
constexpr size_t WS_CMAX = 128 * 1024;
constexpr int CM_GU1 = 0, CM_GU2 = 5632, CM_IN = 11264, CM_PG = 11264 + 5120;
constexpr size_t WS_DYN = 64 * 1024;
constexpr size_t WS_CNT = 256 * 1024;
constexpr size_t WS_A = 52 * MiB;
constexpr size_t WS_Q = WS_A, WS_K = WS_A + 32 * MiB, WS_VT = WS_A + 64 * MiB, WS_HQ = WS_A + 96 * MiB, WS_HI = WS_A + 128 * MiB;
constexpr size_t WS_LIST = 212 * MiB;
constexpr size_t WS_PB = 228 * MiB;
constexpr size_t WS_SB = 228 * MiB;
constexpr size_t WS_RS = 300 * MiB;
constexpr size_t WS_R2 = WS_RS + 128 * 1024;
constexpr size_t WS_W8IN = WS_WIN + 1 * MiB;
constexpr size_t WS_X8B = WS_A + 64 * MiB;
constexpr size_t WS_PML = 292 * MiB;
constexpr size_t WS_B = 320 * MiB;
constexpr size_t WS_KIN = WS_B, WS_HG = WS_B + 32 * MiB, WS_SA = WS_B + 64 * MiB;
constexpr size_t WS_C = 448 * MiB;
constexpr size_t WS_OAB = WS_C;
constexpr size_t WS_PO0 = WS_HQ, WS_PO1 = WS_HI, WS_PO2 = WS_KIN, WS_PO3 = WS_HG;
constexpr size_t WS_END = 512 * MiB;
static_assert(WS_HGD + 256 * 1024 <= WS_A, "weights region");
constexpr int LIST_PER_BH = 126976;
constexpr int CW_TMO = 0, CW_CODE = 1, CW_BAR = 4096;
constexpr int RING_OFF = 0, RING_BYTES = 131072, LDSCTL_OFF = RING_BYTES, MISC_OFF = LDSCTL_OFF + 320, LDS_BYTES = 147456;
#define GAS __attribute__((address_space(1)))
#define LAS __attribute__((address_space(3)))
typedef unsigned short bf16;
typedef unsigned v4u __attribute__((ext_vector_type(4)));
typedef unsigned v2u __attribute__((ext_vector_type(2)));
typedef float f32x4 __attribute__((ext_vector_type(4)));
typedef GAS unsigned gu32;
#define RLX_AGENT __ATOMIC_RELAXED, __HIP_MEMORY_SCOPE_AGENT
#define LDS_WAIT() asm volatile("s_waitcnt lgkmcnt(0)" ::: "memory")
#define VM_WAIT() asm volatile("s_waitcnt vmcnt(0)" ::: "memory")
__device__ __forceinline__ unsigned f2bf(float f) { unsigned u = __builtin_bit_cast(unsigned, f); return (u + 0x7fffu + ((u >> 16) & 1u)) >> 16; }
__device__ __forceinline__ unsigned pk2(float lo, float hi) { return f2bf(lo) | (f2bf(hi) << 16); }
__device__ __forceinline__ float bflo(unsigned w) { return __uint_as_float(w << 16); }
__device__ __forceinline__ float bfhi(unsigned w) { return __uint_as_float(w & 0xffff0000u); }
__device__ __forceinline__ float wave_sum(float v) {
#pragma unroll
    for (int o = 1; o < 64; o <<= 1) v += __shfl_xor(v, o);
    return v;
}
__device__ __forceinline__ float wave_max(float v) {
#pragma unroll
    for (int o = 1; o < 64; o <<= 1) v = fmaxf(v, __shfl_xor(v, o));
    return v;
}
#define XB_TMO      128
#define XB_XCNT(j)  (256  + 64 * (j))
#define XB_XSUB(j)  (1280 + 64 * (j))
#define XB_XGEN(j)  (2304 + 64 * (j))
#define XB_TOP      3328
#define XB_TOPGEN   3392
#define XCD_BAR_WORDS 3456
#define XB_SPIN_CAP (1u << 18)

__device__ __forceinline__ unsigned xb_ld(unsigned* p)              { return __hip_atomic_load(p, __ATOMIC_RELAXED, __HIP_MEMORY_SCOPE_AGENT); }
__device__ __forceinline__ unsigned xb_add(unsigned* p, unsigned v) { return __hip_atomic_fetch_add(p, v, __ATOMIC_RELAXED, __HIP_MEMORY_SCOPE_AGENT); }
__device__ __forceinline__ unsigned xb_xcc_id() { return (unsigned)__builtin_amdgcn_s_getreg((3 << 11) | 20) & 0xFu; }
#define XB_SPIN(cond, bar) do { unsigned _sp = 0; while (cond) { __builtin_amdgcn_s_sleep(1); \
    if ((++_sp & 255u) == 0u) { if (xb_ld(&(bar)[XB_TMO])) break; if (_sp > XB_SPIN_CAP) { atomicAdd(&(bar)[XB_TMO], 1u); break; } } } } while (0)

struct XcdBarrier {
    unsigned* bar; unsigned x;
    volatile LAS unsigned* st;
};

__device__ __forceinline__ XcdBarrier xcd_barrier_post(unsigned* bar, volatile LAS unsigned* st) {
    XcdBarrier b; b.bar = bar; b.x = xb_xcc_id(); b.st = st;
    if (threadIdx.x == 0) (void)xb_add(&bar[XB_XCNT(b.x)], 1u);
    return b;
}
__device__ __forceinline__ void xcd_barrier_complete(unsigned* bar, unsigned x, unsigned& nloc, unsigned& nx) {
    const unsigned G = gridDim.x * gridDim.y * gridDim.z;
    unsigned sum, cnt, mine, sp = 0u;
    for (;;) {
        sum = 0u; cnt = 0u; mine = 0u;
#pragma unroll
        for (unsigned j = 0; j < 16; ++j) { const unsigned c = xb_ld(&bar[XB_XCNT(j)]); sum += c; cnt += (c > 0u) ? 1u : 0u; mine = (j == x) ? c : mine; }
        if (sum == G) break;
        __builtin_amdgcn_s_sleep(1);
        if ((++sp & 255u) == 0u) { if (xb_ld(&bar[XB_TMO])) break; if (sp > XB_SPIN_CAP) { atomicAdd(&bar[XB_TMO], 1u); break; } }
    }
    nloc = mine > 0u ? mine : 1u; nx = cnt > 0u ? cnt : 1u;
}

__device__ __forceinline__ void xcd_barrier(const XcdBarrier& b) {
    asm volatile("s_waitcnt vmcnt(0)" ::: "memory");
    __syncthreads();
    if (threadIdx.x == 0) {
        unsigned* bar = b.bar;
        __builtin_amdgcn_s_waitcnt(0);
        unsigned nloc = b.st[0], nx = b.st[1];
        if (nloc == 0u) { xcd_barrier_complete(bar, b.x, nloc, nx); b.st[0] = nloc; b.st[1] = nx; }
        const unsigned old = xb_add(&bar[XB_XSUB(b.x)], 1u);
        const unsigned gen = old / nloc;
        if (old + 1u == (gen + 1u) * nloc) {
            __builtin_amdgcn_fence(__ATOMIC_RELEASE, "agent");
            asm volatile("s_waitcnt vmcnt(0)" ::: "memory");
            const unsigned og = xb_add(&bar[XB_TOP], 1u);
            const unsigned tg = og / nx;
            if (og + 1u == (tg + 1u) * nx) xb_add(&bar[XB_TOPGEN], 1u);
            else XB_SPIN(xb_ld(&bar[XB_TOPGEN]) == tg, bar);
            __builtin_amdgcn_fence(__ATOMIC_ACQUIRE, "agent");
            xb_add(&bar[XB_XGEN(b.x)], 1u);
            asm volatile("s_waitcnt vmcnt(0)" ::: "memory");
        } else {
            XB_SPIN(xb_ld(&bar[XB_XGEN(b.x)]) == gen, bar);
            __builtin_amdgcn_fence(__ATOMIC_ACQUIRE, "agent");
            asm volatile("s_waitcnt vmcnt(0)" ::: "memory");
        }
    }
    __syncthreads();
}
__device__ __forceinline__ int inb_row(int n0) { if (n0 < 512) return n0; return -1; }
__device__ __forceinline__ int in8_row(int n0) { if (n0 >= 3584) return n0 - 3584; if (n0 >= 1536) return 2048 + (n0 - 1536); if (n0 >= 1024) return 4608 + (n0 - 1024); if (n0 >= 512) return 4096 + (n0 - 512); return -1; }
__device__ __forceinline__ int map_row(int mode, int n0);
__device__ __forceinline__ void p0_transpose_item(const float* W, int K, int N, bf16* WT, const float* gain, int mode, LAS float* scr, int item, int lane, int ldo = 0) {
    if (ldo == 0) ldo = K;
    const int nblk = N / 32, kb = item / nblk, nb = item % nblk, k0 = 64 * kb, n0 = 32 * nb;
#pragma unroll 8
    for (int i = 0; i < 32; ++i) { const int kk = 2 * i + (lane >> 5); float w = W[(size_t)(k0 + kk) * N + n0 + (lane & 31)]; if (gain) w *= gain[k0 + kk]; scr[kk * 33 + (lane & 31)] = w; }
    LDS_WAIT(); asm volatile("" ::: "memory");
    int rbase = n0;
    if (mode == 1) { if (n0 < FF) rbase = (n0 / 128) * 256 + (n0 % 128); else { const int j = n0 - FF; rbase = (j / 128) * 256 + 128 + (j % 128); } }
    if (mode == 3) rbase = inb_row(n0);
    const int c = lane & 7;
#pragma unroll
    for (int j = 0; j < 4; ++j) { const int n = (lane >> 3) + 8 * j; const LAS float* s = scr + (8 * c) * 33 + n;
        v4u o; o.x = pk2(s[0 * 33], s[1 * 33]); o.y = pk2(s[2 * 33], s[3 * 33]); o.z = pk2(s[4 * 33], s[5 * 33]); o.w = pk2(s[6 * 33], s[7 * 33]);
        *(GAS v4u*)(WT + (size_t)(rbase + n) * ldo + k0 + 8 * c) = o; }
    LDS_WAIT(); asm volatile("" ::: "memory");
}
__device__ __forceinline__ int gu_row(int n0) { if (n0 < FF) return (n0 / 128) * 256 + (n0 % 128); const int j = n0 - FF; return (j / 128) * 256 + 128 + (j % 128); }
__device__ __forceinline__ int map_row(int mode, int n0) { return mode == 1 ? gu_row(n0) : mode == 3 ? in8_row(n0) : n0; }
__device__ __forceinline__ void p0_colmax_item(const float* W, int N, const float* gain, unsigned* CMAXB, int mode, int item, int lane) {
    const int nblk = N / 32, kb = item / nblk, nb = item % nblk, k0 = 64 * kb, n0 = 32 * nb; float mx = 0.f;
#pragma unroll 8
    for (int i = 0; i < 32; ++i) { const int kk = 2 * i + (lane >> 5); mx = fmaxf(mx, fabsf(W[(size_t)(k0 + kk) * N + n0 + (lane & 31)] * (gain ? gain[k0 + kk] : 1.0f))); }
    mx = fmaxf(mx, __shfl_xor(mx, 32));
    if (lane < 32) atomicMax(CMAXB + map_row(mode, n0) + lane, __float_as_uint(mx));
}
__device__ __forceinline__ void p0_quant_item(const float* W, int N, const float* gain, const float* CMAX, signed char* W8, int K, int mode, LAS float* scr, int item, int lane) {
    const int nblk = N / 32, kb = item / nblk, nb = item % nblk, k0 = 64 * kb, n0 = 32 * nb, rbase = map_row(mode, n0);
    if (rbase < 0) return;
    const float inv = 127.0f / fmaxf(CMAX[rbase + (lane & 31)], 1e-30f);
#pragma unroll 8
    for (int i = 0; i < 32; ++i) { const int kk = 2 * i + (lane >> 5); scr[kk * 33 + (lane & 31)] = rintf(W[(size_t)(k0 + kk) * N + n0 + (lane & 31)] * (gain ? gain[k0 + kk] : 1.0f) * inv); }
    LDS_WAIT(); asm volatile("" ::: "memory");
    const int c = lane & 3;
#pragma unroll
    for (int j = 0; j < 2; ++j) { const int n = (lane >> 2) + 16 * j; const LAS float* sp = scr + (16 * c) * 33 + n; unsigned w[4];
#pragma unroll
        for (int q = 0; q < 4; ++q) { const int b0 = (int)sp[(4 * q) * 33], b1 = (int)sp[(4 * q + 1) * 33], b2 = (int)sp[(4 * q + 2) * 33], b3 = (int)sp[(4 * q + 3) * 33];
            w[q] = (unsigned)(b0 & 255) | ((unsigned)(b1 & 255) << 8) | ((unsigned)(b2 & 255) << 16) | ((unsigned)(b3 & 255) << 24); }
        *(GAS v4u*)(W8 + (size_t)(rbase + n) * K + k0 + 16 * c) = (v4u){w[0], w[1], w[2], w[3]}; }
    LDS_WAIT(); asm volatile("" ::: "memory");
}
__device__ __forceinline__ void p0_quant_block(const float* W, int N, const float* gain, float* CMAX, signed char* W8, int mode, int n0, LAS float* scr, LAS float* cm, int wave, int lane) {
    const int rbase = map_row(mode, n0); float mx = 0.f;
    LAS float* gl = scr + 64 * 33;
    gl[lane] = gain ? gain[128 * wave + lane] : 1.0f; gl[64 + lane] = gain ? gain[128 * wave + 64 + lane] : 1.0f;
    const unsigned voff = (unsigned)((lane >> 5) * N + n0 + (lane & 31));
    float wv[2][32];
#pragma unroll
    for (int sl = 0; sl < 2; ++sl)
#pragma unroll
        for (int i = 0; i < 32; ++i) { const float* rp = W + (size_t)(64 * (2 * wave + sl) + 2 * i) * N; wv[sl][i] = rp[voff]; }
    LDS_WAIT(); asm volatile("" ::: "memory");
#pragma unroll
    for (int sl = 0; sl < 2; ++sl)
#pragma unroll
        for (int i = 0; i < 32; ++i) { wv[sl][i] *= gl[sl * 64 + 2 * i + (lane >> 5)]; mx = fmaxf(mx, fabsf(wv[sl][i])); }
    mx = fmaxf(mx, __shfl_xor(mx, 32));
    __syncthreads();
    if (lane < 32) cm[wave * 32 + lane] = mx;
    __syncthreads();
    float cmx = 0.f;
#pragma unroll
    for (int w = 0; w < 8; ++w) cmx = fmaxf(cmx, cm[w * 32 + (lane & 31)]);
    if (wave == 0 && lane < 32) CMAX[rbase + lane] = cmx;
    const float inv = 127.0f / fmaxf(cmx, 1e-30f);
#pragma unroll
    for (int sl = 0; sl < 2; ++sl) { const int k0 = 64 * (2 * wave + sl);
#pragma unroll
        for (int i = 0; i < 32; ++i) { const int kk = 2 * i + (lane >> 5); scr[kk * 33 + (lane & 31)] = rintf(wv[sl][i] * inv); }
        LDS_WAIT(); asm volatile("" ::: "memory");
        const int c = lane & 3;
#pragma unroll
        for (int j = 0; j < 2; ++j) { const int n = (lane >> 2) + 16 * j; const LAS float* sp = scr + (16 * c) * 33 + n; unsigned w[4];
#pragma unroll
            for (int q = 0; q < 4; ++q) { const int b0 = (int)sp[(4 * q) * 33], b1 = (int)sp[(4 * q + 1) * 33], b2 = (int)sp[(4 * q + 2) * 33], b3 = (int)sp[(4 * q + 3) * 33];
                w[q] = (unsigned)(b0 & 255) | ((unsigned)(b1 & 255) << 8) | ((unsigned)(b2 & 255) << 16) | ((unsigned)(b3 & 255) << 24); }
            *(GAS v4u*)(W8 + (size_t)(rbase + n) * 1024 + k0 + 16 * c) = (v4u){w[0], w[1], w[2], w[3]}; }
        LDS_WAIT(); asm volatile("" ::: "memory"); }
}
__device__ __forceinline__ void row_to_i8(const f32x4 (&v)[4], float rstd, signed char* orow, float* rs, int lane) {
    float mx = 0.f;
#pragma unroll
    for (int j = 0; j < 4; ++j) mx = fmaxf(fmaxf(mx, fmaxf(fabsf(v[j].x), fabsf(v[j].y))), fmaxf(fabsf(v[j].z), fabsf(v[j].w)));
    mx = fmaxf(wave_max(mx), 1e-30f); const float inv = 127.0f / mx;
    GAS unsigned* o4 = (GAS unsigned*)orow + lane;
#pragma unroll
    for (int j = 0; j < 4; ++j) { const int b0 = (int)rintf(v[j].x * inv), b1 = (int)rintf(v[j].y * inv), b2 = (int)rintf(v[j].z * inv), b3 = (int)rintf(v[j].w * inv);
        o4[64 * j] = (unsigned)(b0 & 255) | ((unsigned)(b1 & 255) << 8) | ((unsigned)(b2 & 255) << 16) | ((unsigned)(b3 & 255) << 24); }
    if (lane == 0) *rs = mx * rstd * (1.0f / 127.0f);
}
__device__ __forceinline__ void rms_row_to_i8(const float* xrow, signed char* orow, float* rs, int lane) {
    const GAS f32x4* xr = (const GAS f32x4*)xrow + lane;
    f32x4 v[4]; float s = 0.f;
#pragma unroll
    for (int j = 0; j < 4; ++j) { v[j] = xr[64 * j]; s += (v[j].x * v[j].x + v[j].y * v[j].y) + (v[j].z * v[j].z + v[j].w * v[j].w); }
    const float rstd = 1.f / sqrtf(wave_sum(s) * (1.f / D) + EPS);
    row_to_i8(v, rstd, orow, rs, lane);
}
__device__ __forceinline__ void rms_row_to_bf16(const float* xrow, bf16* orow, int lane) {
    const GAS f32x4* xr = (const GAS f32x4*)xrow + lane;
    f32x4 v[4]; float s = 0.f;
#pragma unroll
    for (int j = 0; j < 4; ++j) { v[j] = xr[64 * j]; s += (v[j].x * v[j].x + v[j].y * v[j].y) + (v[j].z * v[j].z + v[j].w * v[j].w); }
    const float rstd = 1.f / sqrtf(wave_sum(s) * (1.f / D) + EPS);
    GAS unsigned long long* o8 = (GAS unsigned long long*)orow + lane;
#pragma unroll
    for (int j = 0; j < 4; ++j) o8[64 * j] = (unsigned long long)pk2(v[j].x * rstd, v[j].y * rstd) | ((unsigned long long)pk2(v[j].z * rstd, v[j].w * rstd) << 32);
}
struct Ptrs {
    const float *x, *p, *w_gu1, *w_d1, *w_in, *w_a, *w_b, *w_out, *w_gu2, *w_d2, *w_ple, *w_pg, *gains, *hgw, *lbp, *rel;
    float* out; unsigned char* ws;
};
template <int STAGE> __device__ __forceinline__ void p0_prologue(const Ptrs P, LAS unsigned char* lds, int gw, int NGW, int wave, int lane, int vcu, int G) {
    LAS float* scr = (LAS float*)(lds + RING_OFF + wave * 16384); LAS float* cm = (LAS float*)(lds + RING_OFF + 130048);
    unsigned char* ws = P.ws; float* CM = (float*)(ws + WS_CMAX);
    constexpr int I_D = (FF / 64) * (D / 32), I_IN = (D / 64) * (NIN / 32), I_AB = (512 / 64) * (D / 32), I_O = (D / 64) * (D / 32), I_PLE = (PLE / 64) * (D / 32);
    if (STAGE == 0) {
        for (int id = vcu; id < 176 + 160; id += G) {
            if (id < 176) p0_quant_block(P.w_gu1, NGU, P.gains + 0 * D, CM + CM_GU1, (signed char*)(ws + WS_WGU1), 1, 32 * id, scr, cm, wave, lane);
            else { const int n0 = 512 + 32 * (id - 176);   p0_quant_block(P.w_in, NIN, P.gains + 2 * D, CM + CM_IN, (signed char*)(ws + WS_W8IN), 3, n0, scr, cm, wave, lane); }
        }
        for (int it = gw; it < I_IN + I_D; it += NGW) {
            int r = it;
            if (r < I_IN) { const int n0 = 32 * (r % (NIN / 32)); if (inb_row(n0) >= 0) p0_transpose_item(P.w_in, D, NIN, (bf16*)(ws + WS_WIN), P.gains + 2 * D, 3, scr, r, lane); continue; } r -= I_IN;
            p0_transpose_item(P.w_d1, FF, D, (bf16*)(ws + WS_WD1), nullptr, 0, scr, r, lane);
        }
    } else {
        for (int id = vcu; id < 176 + 32; id += G) {
            if (id < 176) p0_quant_block(P.w_gu2, NGU, P.gains + 4 * D, CM + CM_GU2, (signed char*)(ws + WS_WGU2), 1, 32 * id, scr, cm, wave, lane);
            else p0_quant_block(P.w_pg, D, nullptr, CM + CM_PG, (signed char*)(ws + WS_WPG), 0, 32 * (id - 176), scr, cm, wave, lane);
        }
        for (int it = gw; it < I_D + 2 * I_AB + I_O + I_PLE; it += NGW) {
            int r = it;
            if (r < I_D)  { p0_transpose_item(P.w_d2, FF, D, (bf16*)(ws + WS_WD2), nullptr, 0, scr, r, lane); continue; } r -= I_D;
            if (r < I_AB) { p0_transpose_item(P.w_a, 512, D, (bf16*)(ws + WS_WA), nullptr, 0, scr, r, lane, 1024); continue; } r -= I_AB;
            if (r < I_AB) { p0_transpose_item(P.w_b, 512, D, (bf16*)(ws + WS_WA) + 512, nullptr, 0, scr, r, lane, 1024); continue; } r -= I_AB;
            if (r < I_O)  { p0_transpose_item(P.w_out, D, D, (bf16*)(ws + WS_WOUT), nullptr, 0, scr, r, lane); continue; } r -= I_O;
            p0_transpose_item(P.w_ple, PLE, D, (bf16*)(ws + WS_WPLE), nullptr, 0, scr, r, lane);
        }
        return;
    }
    { unsigned* dyn = (unsigned*)(ws + WS_DYN); LAS unsigned* nxs = (LAS unsigned*)(lds + RING_OFF + 12288);     const bool t0 = (wave == 0 && lane == 0);
      if (t0) nxs[0] = atomicAdd(dyn, 1u);
      __syncthreads();
      unsigned c = __builtin_amdgcn_readfirstlane(nxs[0]); int par = 1;
      while (c < (unsigned)(M / 16)) {
        unsigned nxt = 0; if (t0) nxt = atomicAdd(dyn, 1u);
        f32x4 v[2][4]; float s[2] = {0.f, 0.f}; const int m0 = (int)c * 16 + wave * 2;
#pragma unroll
        for (int u = 0; u < 2; ++u) { const GAS f32x4* xr = (const GAS f32x4*)(P.x + (size_t)(m0 + u) * D) + lane;
#pragma unroll
            for (int j = 0; j < 4; ++j) v[u][j] = xr[64 * j]; }
#pragma unroll
        for (int u = 0; u < 2; ++u) {
#pragma unroll
            for (int j = 0; j < 4; ++j) s[u] += (v[u][j].x * v[u][j].x + v[u][j].y * v[u][j].y) + (v[u][j].z * v[u][j].z + v[u][j].w * v[u][j].w);
            const int m = m0 + u; const float rstd = 1.f / sqrtf(wave_sum(s[u]) * (1.f / D) + EPS);
            row_to_i8(v[u], rstd, (signed char*)(ws + WS_C) + (size_t)m * D, (float*)(ws + WS_RS) + m, lane); }
        if (t0) nxs[par] = nxt;
        __syncthreads();
        c = __builtin_amdgcn_readfirstlane(nxs[par]); par ^= 1;
      }
    }
    const int gt = gw * 64 + lane;
    if (gt < 512) { const float a = P.lbp[gt], b = P.lbp[512 + gt]; const float mx = fmaxf(a, b); const float ea = expf(a - mx), eb = expf(b - mx); ((float*)(ws + WS_LB))[gt] = ea / (ea + eb); }
    if (gt >= 1024 && gt < 2048) { const int h = (gt - 1024) >> 7, d = (gt - 1024) & 127; int bk;
        if (d < 16) bk = d; else { bk = 16 + (int)(logf((float)d / 16.0f) / logf(8.0f) * 16.0f); if (bk > 31) bk = 31; }
        ((float*)(ws + WS_BIAST))[h * 128 + d] = P.rel[bk * 8 + h]; }
}
template <int STAGE> __device__ __forceinline__ void p0b_quant_phase(const Ptrs P, LAS unsigned char* lds, int gw, int NGW, int wave, int lane) {
    LAS float* scr = (LAS float*)(lds + RING_OFF + wave * 16384); unsigned char* ws = P.ws; const float* CM = (const float*)(ws + WS_CMAX);
    constexpr int I_GU = (D / 64) * (NGU / 32), I_IN = (D / 64) * (NIN / 32), I_O = (D / 64) * (D / 32);
    if (STAGE == 0) {
        for (int it = gw; it < I_GU + I_IN; it += NGW) {
            if (it < I_GU) p0_quant_item(P.w_gu1, NGU, P.gains + 0 * D, CM + CM_GU1, (signed char*)(ws + WS_WGU1), D, 1, scr, it, lane);
            else p0_quant_item(P.w_in, NIN, P.gains + 2 * D, CM + CM_IN, (signed char*)(ws + WS_W8IN), D, 3, scr, it - I_GU, lane);
        }
    } else {
        for (int it = gw; it < I_GU + I_O; it += NGW) {
            if (it < I_GU) p0_quant_item(P.w_gu2, NGU, P.gains + 4 * D, CM + CM_GU2, (signed char*)(ws + WS_WGU2), D, 1, scr, it, lane);
            else p0_quant_item(P.w_pg, D, nullptr, CM + CM_PG, (signed char*)(ws + WS_WPG), D, 0, scr, it - I_GU, lane);
        }
    }
}
template <bool HIN_F32, int OMODE> __device__ __forceinline__ void rowwise_phase(int gw, int NGW, int lane, const void* hin, const bf16* Y, const float* gain, float coef, bf16* hb, bf16* xn, float* outf) {
    f32x4 g[4];
#pragma unroll
    for (int j = 0; j < 4; ++j) g[j] = ((const f32x4*)gain)[lane + 64 * j] * coef;
    for (int m0 = gw; m0 < M; m0 += 2 * NGW) {
        f32x4 y[2][4], h[2][4]; float s[2] = {0.f, 0.f};
#pragma unroll
        for (int u = 0; u < 2; ++u) { const int m = m0 + u * NGW;
            const GAS v2u* yr = (const GAS v2u*)(Y + (size_t)m * D) + lane;
#pragma unroll
            for (int j = 0; j < 4; ++j) { const v2u w = yr[64 * j]; y[u][j] = (f32x4){bflo(w.x), bfhi(w.x), bflo(w.y), bfhi(w.y)}; }
            if (HIN_F32) { const GAS f32x4* hr = (const GAS f32x4*)((const float*)hin + (size_t)m * D) + lane;
#pragma unroll
                for (int j = 0; j < 4; ++j) h[u][j] = hr[64 * j]; }
            else { const GAS v2u* hr = (const GAS v2u*)((const bf16*)hin + (size_t)m * D) + lane;
#pragma unroll
                for (int j = 0; j < 4; ++j) { const v2u w = hr[64 * j]; h[u][j] = (f32x4){bflo(w.x), bfhi(w.x), bflo(w.y), bfhi(w.y)}; } }
        }
#pragma unroll
        for (int u = 0; u < 2; ++u)
#pragma unroll
            for (int j = 0; j < 4; ++j) s[u] += (y[u][j].x * y[u][j].x + y[u][j].y * y[u][j].y) + (y[u][j].z * y[u][j].z + y[u][j].w * y[u][j].w);
#pragma unroll
        for (int u = 0; u < 2; ++u) { const int m = m0 + u * NGW;
            const float rstd = 1.f / sqrtf(wave_sum(s[u]) * (1.f / D) + EPS);
            float s2 = 0.f;
#pragma unroll
            for (int j = 0; j < 4; ++j) { h[u][j] = h[u][j] + (g[j] * y[u][j]) * rstd; s2 += (h[u][j].x * h[u][j].x + h[u][j].y * h[u][j].y) + (h[u][j].z * h[u][j].z + h[u][j].w * h[u][j].w); }
            if (OMODE == 3) { GAS f32x4* ho = (GAS f32x4*)(outf + (size_t)m * D) + lane;
#pragma unroll
                for (int j = 0; j < 4; ++j) ho[64 * j] = h[u][j]; }
            if (OMODE == 1 || OMODE == 4 || OMODE == 5 || OMODE == 6) { GAS v2u* ho = (GAS v2u*)(hb + (size_t)m * D) + lane;
#pragma unroll
                for (int j = 0; j < 4; ++j) ho[64 * j] = (v2u){pk2(h[u][j].x, h[u][j].y), pk2(h[u][j].z, h[u][j].w)}; }
            if (OMODE == 4 || OMODE == 5) { const float r2 = 1.f / sqrtf(wave_sum(s2) * (1.f / D) + EPS); row_to_i8(h[u], r2, (signed char*)xn + (size_t)m * D, outf + m, lane); if (OMODE == 5 && lane == 0) outf[32768 + m] = r2; }
            if (OMODE == 6) row_to_i8(h[u], 1.0f, (signed char*)xn + (size_t)m * D, outf + m, lane);
            if (OMODE == 1 || OMODE == 2) {
                float r2 = 1.f;
                if (OMODE == 1) r2 = 1.f / sqrtf(wave_sum(s2) * (1.f / D) + EPS);
                GAS v2u* o8 = (GAS v2u*)(xn + (size_t)m * D) + lane;
#pragma unroll
                for (int j = 0; j < 4; ++j) o8[64 * j] = (v2u){pk2(h[u][j].x * r2, h[u][j].y * r2), pk2(h[u][j].z * r2, h[u][j].w * r2)};
            }
        }
    }
}
__device__ __forceinline__ int moba_list_base(int bh, int j) { return bh * LIST_PER_BH + 256 * (31 * j - (j * (j - 1)) / 2); }
__device__ __forceinline__ void moba_gating_phase(LAS unsigned char* lds, int vcu, int G, int tid, const bf16* Q, const float* KMEAN, unsigned* CNT, unsigned* LIST) {
    LAS float* km = (LAS float*)lds;
    const int lane = tid & 63;
    for (int unit = vcu; unit < BATCH * NBLK * 4; unit += G) {
        const int hp = unit & 3, b = unit >> 7; int i = (unit >> 2) & 31; if (b & 2) i = 31 - i;
        __syncthreads();
        { float kv[8];
#pragma unroll
          for (int r = 0; r < 8; ++r) { const int e = tid + 512 * r, j = e >> 7, c = e & 127; kv[r] = (e < i * 128) ? KMEAN[(size_t)(b * NBLK + j) * 512 + hp * 128 + c] : 0.f; }
#pragma unroll
          for (int r = 0; r < 8; ++r) { const int e = tid + 512 * r; if (e < i * 128) km[e] = kv[r] * (1.0f / 256.0f); } }
        __syncthreads();
        const int hh = __builtin_amdgcn_readfirstlane(tid >> 8), ql = tid & 255, m = b * SEQ + i * MBB + ql, h = 2 * hp + hh;
        float q[64];
        { const v4u* qp = (const v4u*)(Q + (size_t)m * MBW + h * MBD);
#pragma unroll
          for (int c = 0; c < 8; ++c) { const v4u w = qp[c]; q[8 * c + 0] = bflo(w.x); q[8 * c + 1] = bfhi(w.x); q[8 * c + 2] = bflo(w.y); q[8 * c + 3] = bfhi(w.y); q[8 * c + 4] = bflo(w.z); q[8 * c + 5] = bfhi(w.z); q[8 * c + 6] = bflo(w.w); q[8 * c + 7] = bfhi(w.w); } }
        float v0 = -INFINITY, v1 = -INFINITY, v2 = -INFINITY; int i0 = -1, i1 = -1, i2 = -1;
        for (int j = 0; j < i; ++j) {
            const LAS f32x4* kp = (const LAS f32x4*)(km + j * 128 + hh * 64); float s = 0.f;
#pragma unroll
            for (int c = 0; c < 16; ++c) { const f32x4 kv = kp[c]; s += q[4 * c] * kv.x; s += q[4 * c + 1] * kv.y; s += q[4 * c + 2] * kv.z; s += q[4 * c + 3] * kv.w; }
            if (s > v0) { v2 = v1; i2 = i1; v1 = v0; i1 = i0; v0 = s; i0 = j; }
            else if (s > v1) { v2 = v1; i2 = i1; v1 = s; i1 = j; }
            else if (s > v2) { v2 = s; i2 = j; }
        }
        const int bh = b * 8 + h; const unsigned tl = (unsigned)(i * MBB + ql); const unsigned long long lt = (1ull << lane) - 1ull;
        const bool nearq = (ql < 112);
        int totf = 0, totn = 0;
        for (int j = 0; j < i; ++j) {
            const bool nl = (j == i - 1) && nearq;
            const unsigned long long mf = __ballot((i0 == j || i1 == j || i2 == j) && !nl), mn = __ballot((i0 == j || i1 == j || i2 == j) && nl);
            if (lane == j) { totf = (int)__popcll(mf); totn = (int)__popcll(mn); }
        }
        unsigned basef = 0u, basen = 0u;
        if (lane < i && totf > 0) basef = atomicAdd(CNT + bh * 32 + lane, (unsigned)totf);
        if (lane < i && totn > 0) basen = atomicAdd(CNT + 1024 + bh * 32 + lane, (unsigned)totn);
        for (int j = 0; j < i; ++j) {
            const bool nl = (j == i - 1) && nearq;
            const unsigned bf_ = (unsigned)__shfl((int)basef, j), bn_ = (unsigned)__shfl((int)basen, j);
            const unsigned long long m0 = __ballot(i0 == j && !nl), m1 = __ballot(i1 == j && !nl), m2 = __ballot(i2 == j && !nl);
            const int c0 = (int)__popcll(m0), c1 = (int)__popcll(m1);
            unsigned* L = LIST + moba_list_base(bh, j) + bf_;
            if (i0 == j && !nl) L[(int)__popcll(m0 & lt)] = tl;
            if (i1 == j && !nl) L[c0 + (int)__popcll(m1 & lt)] = tl | (1u << 13);
            if (i2 == j && !nl) L[c0 + c1 + (int)__popcll(m2 & lt)] = tl | (2u << 13);
            if (j == i - 1) {
                const unsigned long long n0 = __ballot(i0 == j && nl), n1 = __ballot(i1 == j && nl), n2 = __ballot(i2 == j && nl);
                const int d0 = (int)__popcll(n0), d1 = (int)__popcll(n1);
                unsigned* LN = LIST + moba_list_base(bh, j) + (31 - j) * 256 - 1 - bn_;
                if (i0 == j && nl) LN[-(int)__popcll(n0 & lt)] = tl;
                if (i1 == j && nl) LN[-(d0 + (int)__popcll(n1 & lt))] = tl | (1u << 13);
                if (i2 == j && nl) LN[-(d0 + d1 + (int)__popcll(n2 & lt))] = tl | (2u << 13);
            }
        }
    }
    __syncthreads();
}
typedef float f32x16 __attribute__((ext_vector_type(16)));
typedef short bf16x8v __attribute__((ext_vector_type(8)));
typedef short s16x4v __attribute__((ext_vector_type(4)));
constexpr int IT_KS = 0, IT_VS = 32768, IT_VROW = 520, IT_TB = IT_VS + 64 * IT_VROW  , IT_TBN = 768, IT_INFO = IT_TB + 8 * IT_TBN * 4  , IT_STG = 91136  ;
__device__ __forceinline__ int crow16(int r, int hi) { return (r & 3) + 8 * (r >> 2) + 4 * hi; }
__device__ __forceinline__ void moba_pv_tile(const f32x16& st, int kt, int hi, int r32, const LAS unsigned char* vs, f32x16 (&o)[2]) {
#pragma unroll
    for (int s = 0; s < 2; ++s) {
        const unsigned w0 = pg8::cvt_pk_bf16(st[8 * s + 0], st[8 * s + 1]), w1 = pg8::cvt_pk_bf16(st[8 * s + 2], st[8 * s + 3]), w2 = pg8::cvt_pk_bf16(st[8 * s + 4], st[8 * s + 5]), w3 = pg8::cvt_pk_bf16(st[8 * s + 6], st[8 * s + 7]);
        const v4u w = {w0, w1, w2, w3}; const bf16x8v pf = __builtin_bit_cast(bf16x8v, w);
#pragma unroll
        for (int d = 0; d < 2; ++d) {
            const LAS unsigned char* vp = vs + (32 * d + r32) * IT_VROW + (32 * kt + 16 * s + 4 * hi) * 2;
            const s16x4v lo = *(const LAS s16x4v*)vp, hi4 = *(const LAS s16x4v*)(vp + 16);
            const bf16x8v va = {lo[0], lo[1], lo[2], lo[3], hi4[0], hi4[1], hi4[2], hi4[3]};
            o[d] = __builtin_amdgcn_mfma_f32_32x32x16_bf16(va, pf, o[d], 0, 0, 0);
        }
    }
}
__device__ __forceinline__ float moba_rowmax(const f32x16& st) {
    float ra = fmaxf(fmaxf(st[0], st[1]), st[2]), rb = fmaxf(fmaxf(st[3], st[4]), st[5]);
    ra = fmaxf(fmaxf(ra, st[6]), st[7]); rb = fmaxf(fmaxf(rb, st[8]), st[9]); ra = fmaxf(fmaxf(ra, st[10]), st[11]); rb = fmaxf(fmaxf(rb, st[12]), st[13]); ra = fmaxf(fmaxf(ra, st[14]), st[15]);
    const float rm = fmaxf(ra, rb); return fmaxf(rm, __shfl_xor(rm, 32));
}
__device__ __forceinline__ void moba_exp_sum(f32x16& st, float& lrun) {
    float ls = 0.f, ls2 = 0.f;
#pragma unroll
    for (int r = 0; r < 16; r += 2) { const float p0 = __builtin_amdgcn_exp2f(st[r]), p1 = __builtin_amdgcn_exp2f(st[r + 1]); st[r] = p0; st[r + 1] = p1; ls += p0; ls2 += p1; }
    lrun += ls + ls2;
}
__device__ __forceinline__ void moba_items_phase(LAS unsigned char* lds, int vcu, int G, int tid_in, int wave, int lane, const bf16* Q, const bf16* K, const bf16* VT, const unsigned* CNT, const unsigned* LIST,
                                                 const float* BIAST, bf16* PO0, bf16* PO1, bf16* PO2, bf16* PO3, float* PML) {
    const int r32 = lane & 31, hi = lane >> 5; int tid = tid_in;
    LAS unsigned char* ks = lds + IT_KS; LAS unsigned char* vs = lds + IT_VS; LAS float* tball = (LAS float*)(lds + IT_TB); volatile LAS int* info = (volatile LAS int*)(lds + IT_INFO);
    __syncthreads();
    { float tv[8 * IT_TBN / 512];
#pragma unroll
      for (int r = 0; r < 8 * IT_TBN / 512; ++r) { const int e = tid + 512 * r, h_ = e / IT_TBN, d_ = 512 - (e % IT_TBN); tv[r] = BIAST[h_ * 128 + (d_ > 113 ? 113 : (d_ < 0 ? 0 : d_))]; }
#pragma unroll
      for (int r = 0; r < 8 * IT_TBN / 512; ++r) { const int e = tid + 512 * r, d_ = 512 - (e % IT_TBN); tball[e] = d_ < 0 ? -INFINITY : tv[r] * 1.4426950408889634f; } }
    if (wave == 0) {
        int loc[16]; int s = 0;
#pragma unroll
        for (int e = 0; e < 16; ++e) { const int nf = (int)CNT[16 * lane + e], nn = (int)CNT[1024 + 16 * lane + e]; loc[e] = 1 + ((((nf + 31) >> 5) + ((nn + 31) >> 5) + 7) >> 3); s += loc[e]; }
        int incl = s;
#pragma unroll
        for (int o = 1; o < 64; o <<= 1) { const int t = __shfl_up(incl, o); if (lane >= o) incl += t; }
        const int excl = incl - s, total = __shfl(incl, 63);
        const int c0 = (int)(((long)vcu * total) / G), c1 = (int)(((long)(vcu + 1) * total) / G);
        if (c0 >= excl && c0 < incl) { int acc = excl; bool done = false;
#pragma unroll
            for (int e = 0; e < 16; ++e) { if (!done && c0 < acc + loc[e]) { info[0] = 16 * lane + e; info[1] = c0 - acc; done = true; } acc += loc[e]; } }
        if (lane == 0) info[2] = c1 - c0;
    }
    __syncthreads();
    int li = __builtin_amdgcn_readfirstlane(info[0]), k = __builtin_amdgcn_readfirstlane(info[1]); const int nchunk = __builtin_amdgcn_readfirstlane(info[2]);
    int loaded = -1; bool pre = false; v4u pk[4], pv[4];
    int n_tl = 0, n_rank = 0; bool n_valid = false, n_active = false;
    bool n_near = false;
#define MOBA_FETCH(LI, KK, NN) do { const int b_ = (LI) >> 8, h_ = ((LI) >> 5) & 7, j_ = (LI) & 31; const bool own_ = ((KK) == 0); const int nf_ = (NN) & 0xffff, nn_ = (NN) >> 16, itf_ = (nf_ + 31) >> 5, itn_ = (nn_ + 31) >> 5; \
        const int it_ = own_ ? wave : ((KK) - 1) * 8 + wave; n_near = !own_ && it_ >= itf_; const int start_ = (n_near ? it_ - itf_ : it_) * 32; const int cnt_ = n_near ? nn_ : nf_; \
        n_active = own_ || it_ < itf_ + itn_; n_valid = own_ || (n_active && start_ + r32 < cnt_); \
        if (n_active) { if (own_) { n_tl = j_ * MBB + start_ + r32; n_rank = 3; } \
            else { int idx_ = start_ + r32; if (idx_ >= cnt_) idx_ = cnt_ - 1; const int pos_ = n_near ? ((31 - j_) * 256 - 1 - idx_) : idx_; const unsigned e_ = LIST[moba_list_base(b_ * 8 + h_, j_) + pos_]; n_tl = (int)(e_ & 8191u); n_rank = (int)(e_ >> 13); } } } while (0)
#define MOBA_CNT(LI) (__builtin_amdgcn_readfirstlane((int)CNT[(LI)]) | (__builtin_amdgcn_readfirstlane((int)CNT[1024 + (LI)]) << 16))
#define MOBA_NCH(NN) (1 + ((((((NN) & 0xffff) + 31) >> 5) + ((((NN) >> 16) + 31) >> 5) + 7) >> 3))
    int n = (nchunk > 0) ? MOBA_CNT(li) : 0;
    if (nchunk > 0) MOBA_FETCH(li, k, n);
    for (int c = 0; c < nchunk; ++c) {
        const int b = li >> 8, h = (li >> 5) & 7, j = li & 31;
        if (li != loaded) {
            __syncthreads();
            asm volatile("" : "+v"(tid));
            if (!pre) {
#pragma unroll
                for (int r = 0; r < 4; ++r) { const int idx = tid + 512 * r, key = idx >> 3, ch = idx & 7; pk[r] = *(const v4u*)(K + (size_t)(b * SEQ + j * MBB + key) * MBW + h * MBD + ch * 8); }
#pragma unroll
                for (int r = 0; r < 4; ++r) { const int idx = tid + 512 * r, d = idx >> 5, ch = idx & 31; pv[r] = *(const v4u*)(VT + (size_t)(h * MBD + d) * M + b * SEQ + j * MBB + ch * 8); }
            }
#pragma unroll
            for (int r = 0; r < 4; ++r) { const int idx = tid + 512 * r, key = idx >> 3, ch = idx & 7;
                *(LAS v4u*)(ks + key * 128 + ((ch ^ ((key >> 1) & 7)) * 16)) = pk[r]; }
#pragma unroll
            for (int r = 0; r < 4; ++r) { const int idx = tid + 512 * r, d = idx >> 5, ch = idx & 31;
                LAS v2u* dst = (LAS v2u*)(vs + d * IT_VROW + ch * 16); dst[0] = (v2u){pv[r].x, pv[r].y}; dst[1] = (v2u){pv[r].z, pv[r].w}; }
            __syncthreads();
            loaded = li; pre = false;
        }
        const int tl = n_tl, rank = n_rank; const bool valid = n_valid, active = n_active, own = (k == 0), nearit = n_near;
        bf16x8v qf[4];
        if (active) { const bf16* qp = Q + (size_t)(b * SEQ + tl) * MBW + h * MBD + 8 * hi;
#pragma unroll
            for (int s = 0; s < 4; ++s) qf[s] = *(const bf16x8v*)(qp + 16 * s); }
        int li2 = li, k2 = k + 1; if (k2 >= MOBA_NCH(n)) { ++li2; k2 = 0; }
        int n2 = n;
        if (c + 1 < nchunk) { if (li2 != li) n2 = MOBA_CNT(li2); MOBA_FETCH(li2, k2, n2); }
        if (c + 1 < nchunk && li2 != li) {
            const int b2 = li2 >> 8, h2 = (li2 >> 5) & 7, j2 = li2 & 31; pre = true;
#pragma unroll
            for (int r = 0; r < 4; ++r) { const int idx = tid + 512 * r, key = idx >> 3, ch = idx & 7; pk[r] = *(const v4u*)(K + (size_t)(b2 * SEQ + j2 * MBB + key) * MBW + h2 * MBD + ch * 8); }
#pragma unroll
            for (int r = 0; r < 4; ++r) { const int idx = tid + 512 * r, d = idx >> 5, ch = idx & 31; pv[r] = *(const v4u*)(VT + (size_t)(h2 * MBD + d) * M + b2 * SEQ + j2 * MBB + ch * 8); }
        }
        if (active) {
            const int qin = tl & 255, bd = (tl >> 8) - j, dq = bd * 256 + qin;
            const bool general = own || nearit;
            const int ntile = own ? (wave + 1) : 8;
            const LAS float* tb = tball + h * IT_TBN;
            const size_t pair = (size_t)(b * SEQ + tl) * 8 + h;
            bf16* po = (rank == 0 ? PO0 : rank == 1 ? PO1 : rank == 2 ? PO2 : PO3) + pair * 64; float* pm = PML + ((size_t)rank * (M * 8) + pair) * 2;
#define MOBA_STORE(MR, LR) do { const float linv_ = 1.0f / (LR); LAS unsigned char* stg_ = lds + IT_STG + wave * 4864; \
                _Pragma("unroll") for (int d = 0; d < 2; ++d) _Pragma("unroll") for (int g4 = 0; g4 < 4; ++g4) { v2u w; w.x = pg8::cvt_pk_bf16(o[d][4 * g4] * linv_, o[d][4 * g4 + 1] * linv_); w.y = pg8::cvt_pk_bf16(o[d][4 * g4 + 2] * linv_, o[d][4 * g4 + 3] * linv_); \
                    *(LAS v2u*)(stg_ + r32 * 144 + (32 * d + 8 * g4 + 4 * hi) * 2) = w; } \
                if (hi == 0) { *(LAS unsigned long long*)(stg_ + 4608 + r32 * 8) = valid ? (unsigned long long)(uintptr_t)po : 0ull; if (valid) { pm[0] = (MR); pm[1] = (LR); } } \
                asm volatile("s_waitcnt lgkmcnt(0)" ::: "memory"); \
                _Pragma("unroll") for (int i_ = 0; i_ < 4; ++i_) { const int row_ = i_ * 8 + (lane >> 3), ch_ = lane & 7; const unsigned long long p_ = *(const LAS unsigned long long*)(stg_ + 4608 + row_ * 8); \
                    const v4u v_ = *(const LAS v4u*)(stg_ + row_ * 144 + ch_ * 16); if (p_) *(v4u*)((unsigned char*)(uintptr_t)p_ + ch_ * 16) = v_; } \
                asm volatile("s_waitcnt lgkmcnt(0)" ::: "memory"); } while (0)
            bool done = false;
            {
                float mhat = 0.f, lrun = 0.f; f32x16 o[2], negm;
#pragma unroll
                for (int r = 0; r < 16; ++r) { o[0][r] = 0.f; o[1][r] = 0.f; negm[r] = 0.f; }
                const LAS float* rp0 = tb + (512 - dq + 4 * hi);
#define MOBA_QK(ST, KT) do { const int key_ = 32 * (KT) + r32; \
                    _Pragma("unroll") for (int s_ = 0; s_ < 4; ++s_) { const bf16x8v ka_ = *(const LAS bf16x8v*)(ks + key_ * 128 + (((2 * s_ + hi) ^ ((key_ >> 1) & 7)) * 16)); \
                        ST = __builtin_amdgcn_mfma_f32_32x32x16_bf16(ka_, qf[s_], ST, 0, 0, 0); } } while (0)
#define MOBA_BIAS(ST, KT) do { if (general) { const LAS float* rp_ = rp0 + 32 * (KT); _Pragma("unroll") for (int r_ = 0; r_ < 16; ++r_) ST[r_] += rp_[8 * (r_ >> 2) + (r_ & 3)]; } } while (0)
                f32x16 sa = negm, sb;
                MOBA_QK(sa, 0); MOBA_BIAS(sa, 0);
                mhat = moba_rowmax(sa);
#pragma unroll
                for (int r = 0; r < 16; ++r) { sa[r] -= mhat; negm[r] = -mhat; }
#pragma unroll
                for (int kt = 0; kt < 8; kt += 2) {
                    if (kt < ntile) {
                        if (kt + 1 < ntile) { sb = negm; MOBA_QK(sb, kt + 1); }
                        moba_exp_sum(sa, lrun); moba_pv_tile(sa, kt, hi, r32, vs, o);
                        if (kt + 1 < ntile) {
                            MOBA_BIAS(sb, kt + 1);
                            if (kt + 2 < ntile) { sa = negm; MOBA_QK(sa, kt + 2); }
                            moba_exp_sum(sb, lrun); moba_pv_tile(sb, kt + 1, hi, r32, vs, o);
                            if (kt + 2 < ntile) MOBA_BIAS(sa, kt + 2);
                        }
                    }
                }
#undef MOBA_QK
#undef MOBA_BIAS
                lrun += __shfl_xor(lrun, 32);
                if (__builtin_expect(!__any(!(lrun < 1.0e30f)), 1)) { MOBA_STORE(mhat + (general ? 0.f : tb[0]), lrun); done = true; }
            }
            if (!done) {
                const int dq2 = general ? dq : 511;
                float mrun = -INFINITY, lrun = 0.f; f32x16 o[2];
#pragma unroll
                for (int r = 0; r < 16; ++r) { o[0][r] = 0.f; o[1][r] = 0.f; }
#pragma unroll
                for (int kt = 0; kt < 8; ++kt) {
                    if (kt < ntile) {
                        f32x16 st; const int key = 32 * kt + r32;
#pragma unroll
                        for (int r = 0; r < 16; ++r) st[r] = 0.f;
#pragma unroll
                        for (int s = 0; s < 4; ++s) { const bf16x8v ka = *(const LAS bf16x8v*)(ks + key * 128 + (((2 * s + hi) ^ ((key >> 1) & 7)) * 16));
                            st = __builtin_amdgcn_mfma_f32_32x32x16_bf16(ka, qf[s], st, 0, 0, 0); }
                        { const LAS float* rp = tb + (512 - dq2 + 32 * kt + 4 * hi);
#pragma unroll
                          for (int r = 0; r < 16; ++r) st[r] += rp[8 * (r >> 2) + (r & 3)]; }
                        const float mnew = fmaxf(mrun, moba_rowmax(st)), alpha = __builtin_amdgcn_exp2f(mrun - mnew);
#pragma unroll
                        for (int r = 0; r < 16; ++r) st[r] -= mnew;
                        lrun *= alpha; mrun = mnew;
#pragma unroll
                        for (int d = 0; d < 2; ++d)
#pragma unroll
                            for (int r = 0; r < 16; ++r) o[d][r] *= alpha;
                        moba_exp_sum(st, lrun);
                        moba_pv_tile(st, kt, hi, r32, vs, o);
                        asm volatile("" ::: "memory");
                    }
                }
                lrun += __shfl_xor(lrun, 32);
                MOBA_STORE(mrun, lrun);
            }
#undef MOBA_STORE
        }
        li = li2; k = k2; n = n2;
    }
#undef MOBA_FETCH
#undef MOBA_CNT
#undef MOBA_NCH
    __syncthreads();
}
__device__ __forceinline__ void moba_combine_phase(int gtid, int gthreads, const bf16* PO0, const bf16* PO1, const bf16* PO2, const bf16* PO3, const float* PML, bf16* OA) {
    for (int idx0 = gtid; idx0 < M * 8 * 8; idx0 += 4 * gthreads) {
        typedef float f32x2l __attribute__((ext_vector_type(2)));
        f32x2l ml[4][4]; v4u x[4][4];
#pragma unroll
        for (int u = 0; u < 4; ++u) { const int idx = idx0 + u * gthreads, pair = idx >> 3, c8 = idx & 7, m = pair >> 3, own = (m & (SEQ - 1)) >> 8, nv = own < 3 ? own : 3;
#pragma unroll
            for (int r = 0; r < 4; ++r) { const bool v = (r == 3) || (r < nv);
                ml[u][r] = v ? *(const f32x2l*)(PML + ((size_t)r * (M * 8) + pair) * 2) : (f32x2l){-INFINITY, 0.f};
                x[u][r] = v ? *(const v4u*)((r == 0 ? PO0 : r == 1 ? PO1 : r == 2 ? PO2 : PO3) + (size_t)pair * 64 + c8 * 8) : (v4u){0u, 0u, 0u, 0u}; }
        }
#pragma unroll
        for (int u = 0; u < 4; ++u) { const int idx = idx0 + u * gthreads, pair = idx >> 3, c8 = idx & 7, m = pair >> 3;
            const float mx = fmaxf(fmaxf(ml[u][0].x, ml[u][1].x), fmaxf(ml[u][2].x, ml[u][3].x));
            float w[4], ws = 0.f;
#pragma unroll
            for (int r = 0; r < 4; ++r) { w[r] = ml[u][r].y * __builtin_amdgcn_exp2f(ml[u][r].x - mx); ws += w[r]; }
            const float inv = 1.0f / ws; float acc[8];
#pragma unroll
            for (int e = 0; e < 8; ++e) acc[e] = 0.f;
#pragma unroll
            for (int r = 0; r < 4; ++r) { const float wr = w[r] * inv; const v4u xx = x[u][r];
                acc[0] += wr * bflo(xx.x); acc[1] += wr * bfhi(xx.x); acc[2] += wr * bflo(xx.y); acc[3] += wr * bfhi(xx.y); acc[4] += wr * bflo(xx.z); acc[5] += wr * bfhi(xx.z); acc[6] += wr * bflo(xx.w); acc[7] += wr * bfhi(xx.w); }
            v4u o; o.x = pk2(acc[0], acc[1]); o.y = pk2(acc[2], acc[3]); o.z = pk2(acc[4], acc[5]); o.w = pk2(acc[6], acc[7]);
            *(v4u*)(OA + (size_t)m * 1024 + (pair & 7) * 64 + c8 * 8) = o;
        }
    }
}
constexpr int HL_IMG = 37888, HL_QN = 0, HL_KN = 8704, HL_KT = 17408, HL_VT = 27648, HL_SB = 2 * HL_IMG  , HL_DD = HL_SB + 34816  , HL_EM = HL_DD + 1024, HL_SSQ = HL_EM + 1024, HL_END = HL_SSQ + 512;
constexpr int HL_QP = 272, HL_TP = 80;
__device__ __forceinline__ float bf1(bf16 x) { return __uint_as_float((unsigned)x << 16); }
template <int STEP> __device__ __forceinline__ void hgrn_mfma_phase(LAS unsigned char* lds, int vcu, int G, int tid, int wave, int lane, const bf16* KIN, const bf16* HI, const bf16* HQ, const bf16* HG, const float* hgw, float* HS, float* HGD, bf16* OB) {
    const int r32 = lane & 31, hi = lane >> 5, cl = lane & 15, tg = lane >> 4, ch = 16 * wave + cl;
    LAS float* ssq = (LAS float*)(lds + HL_SSQ); LAS float* hgwl = (LAS float*)(lds + HL_END);
    __syncthreads();
    if (STEP == 3 && tid < 128) hgwl[tid] = hgw[tid];
    for (int unit = vcu; unit < BATCH * HGH * HGNC; unit += G) {
        const int c = unit & 31, bh = unit >> 5, b = bh >> 2, h = bh & 3, m0 = b * SEQ + c * HGC;
        f32x16 S[4]; float Dk = 1.f;
        const int skt = (STEP == 1) ? (wave >> 1) : (wave - 4), svt0 = (STEP == 1) ? 2 * (wave & 1) : 0; constexpr int NST = (STEP == 1) ? 2 : 4;
#pragma unroll
        for (int i = 0; i < 4; ++i)
#pragma unroll
            for (int r = 0; r < 16; ++r) S[i][r] = 0.f;
        if (STEP == 3 && wave >= 4) {
#pragma unroll
            for (int i = 0; i < 4; ++i)
#pragma unroll
                for (int r = 0; r < 16; ++r) S[i][r] = HS[(size_t)unit * 16384 + (32 * skt + crow16(r, hi)) * 128 + 32 * (svt0 + i) + r32];
        }
        unsigned short rk[8], rv[8], rq[8];
#define HG_LOAD(SLAB) do { _Pragma("unroll") for (int e = 0; e < 8; ++e) { const size_t idx = (size_t)(m0 + (SLAB) * 32 + tg * 8 + e) * HGW + h * HGD_ + ch; rk[e] = KIN[idx]; rv[e] = HI[idx]; rq[e] = (STEP == 3) ? HQ[idx] : (unsigned short)0; } } while (0)
#define HG_STAGE(BUF) do { LAS unsigned char* img_ = lds + (BUF) * HL_IMG; \
            float kin_[8], cs_[8]; float run_ = 0.f; \
            _Pragma("unroll") for (int e = 0; e < 8; ++e) { kin_[e] = bf1(rk[e]); run_ += __builtin_amdgcn_logf(fmaxf(1.0f - kin_[e], 5.9604645e-8f)); cs_[e] = run_; } \
            const float g0_ = __shfl(run_, cl), g1_ = __shfl(run_, cl + 16), g2_ = __shfl(run_, cl + 32), g3_ = __shfl(run_, cl + 48); \
            const float bmid_ = g0_ + g1_, bend_ = bmid_ + g2_ + g3_, pre_ = (tg == 0) ? 0.f : (tg == 1) ? g0_ : (tg == 2) ? bmid_ : bmid_ + g2_; \
            { float kh_[8]; _Pragma("unroll") for (int e = 0; e < 8; ++e) kh_[e] = kin_[e] * __builtin_amdgcn_exp2f(bend_ - (pre_ + cs_[e])); \
              v4u w_; w_.x = pg8::cvt_pk_bf16(kh_[0], kh_[1]); w_.y = pg8::cvt_pk_bf16(kh_[2], kh_[3]); w_.z = pg8::cvt_pk_bf16(kh_[4], kh_[5]); w_.w = pg8::cvt_pk_bf16(kh_[6], kh_[7]); \
              *(LAS v4u*)(img_ + HL_KT + ch * HL_TP + tg * 16) = w_; \
              v4u x_; x_.x = (unsigned)rv[0] | ((unsigned)rv[1] << 16); x_.y = (unsigned)rv[2] | ((unsigned)rv[3] << 16); x_.z = (unsigned)rv[4] | ((unsigned)rv[5] << 16); x_.w = (unsigned)rv[6] | ((unsigned)rv[7] << 16); \
              *(LAS v4u*)(img_ + HL_VT + ch * HL_TP + tg * 16) = x_; } \
            if (STEP == 3) { _Pragma("unroll") for (int e = 0; e < 8; ++e) { const float bs_ = pre_ + cs_[e]; const int tok_ = tg * 8 + e; \
                    const float kt_ = kin_[e] * __builtin_amdgcn_exp2f(fminf(bmid_ - bs_, 100.f)), qt_ = bf1(rq[e]) * __builtin_amdgcn_exp2f(fminf(bs_ - bmid_, 100.f)); \
                    *(LAS unsigned short*)(img_ + HL_KN + tok_ * HL_QP + ch * 2) = (unsigned short)f2bf(kt_); \
                    *(LAS unsigned short*)(img_ + HL_QN + tok_ * HL_QP + ch * 2) = (unsigned short)f2bf(qt_); } } \
            if (tg == 0) { const float de_ = __builtin_amdgcn_exp2f(bend_); ((LAS float*)(lds + HL_DD))[(BUF) * 128 + ch] = de_; ((LAS float*)(lds + HL_EM))[(BUF) * 128 + ch] = __builtin_amdgcn_exp2f(bmid_); Dk *= de_; } } while (0)
        HG_LOAD(0);
        __syncthreads();
        HG_STAGE(0);
        HG_LOAD(1);
        __syncthreads();
        for (int slab = 0; slab < 8; ++slab) {
            const int buf = slab & 1, ms = m0 + slab * 32;
            const LAS unsigned char* img = lds + buf * HL_IMG; const LAS float* dd = (const LAS float*)(lds + HL_DD) + buf * 128; const LAS float* em = (const LAS float*)(lds + HL_EM) + buf * 128;
            f32x16 O; v2u gg[4];
            if (STEP == 3 && wave < 4) {
#pragma unroll
                for (int g4 = 0; g4 < 4; ++g4) gg[g4] = *(const v2u*)(HG + (size_t)(ms + r32) * HGW + h * HGD_ + 32 * wave + 8 * g4 + 4 * hi);
            }
            if (STEP == 3) {
                if (wave >= 4) {
#pragma unroll
                    for (int i = 0; i < 4; ++i)
#pragma unroll
                        for (int g4 = 0; g4 < 4; ++g4) { const int k0 = 32 * skt + 8 * g4 + 4 * hi; const f32x4 e4 = *(const LAS f32x4*)(em + k0);
                            v2u w; w.x = pg8::cvt_pk_bf16(S[i][4 * g4] * e4.x, S[i][4 * g4 + 1] * e4.y); w.y = pg8::cvt_pk_bf16(S[i][4 * g4 + 2] * e4.z, S[i][4 * g4 + 3] * e4.w);
                            *(LAS v2u*)(lds + HL_SB + (32 * (svt0 + i) + r32) * HL_QP + k0 * 2) = w; }
                } else {
                    const int vt = wave; f32x16 X;
#pragma unroll
                    for (int r = 0; r < 16; ++r) { X[r] = 0.f; O[r] = 0.f; }
#pragma unroll
                    for (int ks = 0; ks < 8; ++ks) { const bf16x8v qf = *(const LAS bf16x8v*)(img + HL_QN + r32 * HL_QP + (16 * ks + 8 * hi) * 2);
                        const bf16x8v kf = *(const LAS bf16x8v*)(img + HL_KN + r32 * HL_QP + (16 * ks + 8 * hi) * 2);
                        X = __builtin_amdgcn_mfma_f32_32x32x16_bf16(kf, qf, X, 0, 0, 0); }
#pragma unroll
                    for (int r = 0; r < 16; ++r) if (crow16(r, hi) > r32) X[r] = 0.f;
#pragma unroll
                    for (int k2 = 0; k2 < 2; ++k2) {
                        v4u w; w.x = pg8::cvt_pk_bf16(X[8 * k2 + 0], X[8 * k2 + 1]); w.y = pg8::cvt_pk_bf16(X[8 * k2 + 2], X[8 * k2 + 3]); w.z = pg8::cvt_pk_bf16(X[8 * k2 + 4], X[8 * k2 + 5]); w.w = pg8::cvt_pk_bf16(X[8 * k2 + 6], X[8 * k2 + 7]);
                        const bf16x8v xf = __builtin_bit_cast(bf16x8v, w);
                        const LAS unsigned char* vp = img + HL_VT + (32 * vt + r32) * HL_TP + (16 * k2 + 4 * hi) * 2;
                        const s16x4v lo = *(const LAS s16x4v*)vp, hi4 = *(const LAS s16x4v*)(vp + 16);
                        const bf16x8v va = {lo[0], lo[1], lo[2], lo[3], hi4[0], hi4[1], hi4[2], hi4[3]};
                        O = __builtin_amdgcn_mfma_f32_32x32x16_bf16(va, xf, O, 0, 0, 0); }
                }
                __syncthreads();
                if (wave < 4) {
                    const int vt = wave;
#pragma unroll
                    for (int ks = 0; ks < 8; ++ks) { const bf16x8v sa = *(const LAS bf16x8v*)(lds + HL_SB + (32 * vt + r32) * HL_QP + (16 * ks + 8 * hi) * 2);
                        const bf16x8v qf = *(const LAS bf16x8v*)(img + HL_QN + r32 * HL_QP + (16 * ks + 8 * hi) * 2);
                        O = __builtin_amdgcn_mfma_f32_32x32x16_bf16(sa, qf, O, 0, 0, 0); }
                    float sq = 0.f;
#pragma unroll
                    for (int r = 0; r < 16; ++r) sq += O[r] * O[r];
                    sq += __shfl_xor(sq, 32);
                    if (hi == 0) ssq[vt * 32 + r32] = sq;
                }
            }
            if (STEP == 1 || wave >= 4) {
#pragma unroll
                for (int i = 0; i < NST; ++i) {
#pragma unroll
                    for (int g4 = 0; g4 < 4; ++g4) { const f32x4 d4 = *(const LAS f32x4*)(dd + 32 * skt + 8 * g4 + 4 * hi);
                        S[i][4 * g4] *= d4.x; S[i][4 * g4 + 1] *= d4.y; S[i][4 * g4 + 2] *= d4.z; S[i][4 * g4 + 3] *= d4.w; }
#pragma unroll
                    for (int k2 = 0; k2 < 2; ++k2) { const bf16x8v ka = *(const LAS bf16x8v*)(img + HL_KT + (32 * skt + r32) * HL_TP + (16 * k2 + 8 * hi) * 2);
                        const bf16x8v vb = *(const LAS bf16x8v*)(img + HL_VT + (32 * (svt0 + i) + r32) * HL_TP + (16 * k2 + 8 * hi) * 2);
                        S[i] = __builtin_amdgcn_mfma_f32_32x32x16_bf16(ka, vb, S[i], 0, 0, 0); }
                }
            }
            if (slab < 7) { HG_STAGE(buf ^ 1); if (slab < 6) HG_LOAD(slab + 2); }
            __syncthreads();
            if (STEP == 3 && wave < 4) {
                const int vt = wave; const float tot = ssq[r32] + ssq[32 + r32] + ssq[64 + r32] + ssq[96 + r32];
                const float rstd = 1.f / sqrtf(tot * (1.f / 128.f) + EPS); const size_t orow = (size_t)(ms + r32) * 1024 + 512 + h * HGD_;
#pragma unroll
                for (int g4 = 0; g4 < 4; ++g4) { const int v0 = 32 * vt + 8 * g4 + 4 * hi; const f32x4 w4 = *(const LAS f32x4*)(hgwl + v0);
                    v2u o; o.x = pg8::cvt_pk_bf16(O[4 * g4] * rstd * w4.x * bflo(gg[g4].x), O[4 * g4 + 1] * rstd * w4.y * bfhi(gg[g4].x)); o.y = pg8::cvt_pk_bf16(O[4 * g4 + 2] * rstd * w4.z * bflo(gg[g4].y), O[4 * g4 + 3] * rstd * w4.w * bfhi(gg[g4].y));
                    *(v2u*)(OB + orow + v0) = o; }
            }
        }
#undef HG_LOAD
#undef HG_STAGE
        if (STEP == 1) {
#pragma unroll
            for (int i = 0; i < 2; ++i)
#pragma unroll
                for (int r = 0; r < 16; ++r) HS[(size_t)unit * 16384 + (32 * skt + crow16(r, hi)) * 128 + 32 * (svt0 + i) + r32] = S[i][r];
            if (tg == 0) HGD[unit * 128 + ch] = Dk;
        }
    }
    __syncthreads();
}
__device__ __forceinline__ void hgrn_scan_phase(int gtid, int gthreads, float* HS, const float* HGD) {
    for (int idx = gtid; idx < BATCH * HGH * 16384; idx += gthreads) {
        const int bh = idx >> 14, e = idx & 16383, k = e >> 7; float s = 0.f;
        float tmp[HGNC];
#pragma unroll
        for (int c = 0; c < HGNC; ++c) tmp[c] = HS[(size_t)(bh * HGNC + c) * 16384 + e];
#pragma unroll
        for (int c = 0; c < HGNC; ++c) { HS[(size_t)(bh * HGNC + c) * 16384 + e] = s; s = HGD[(bh * HGNC + c) * 128 + k] * s + tmp[c]; }
    }
}
#ifndef MASK_BITS
#define MASK_BITS 0x00ffffffu
#endif
#ifndef REP_MASK
#define REP_MASK 0u
#endif
struct Args { const float* in[16]; float* out; unsigned char* ws; unsigned mask, rep; };
typedef const __attribute__((address_space(4))) Args* KArgs;
__device__ __forceinline__ KArgs hide_args() {
#if defined(__HIP_DEVICE_COMPILE__)
    KArgs p = (KArgs)__builtin_amdgcn_kernarg_segment_ptr(); asm volatile("" : "+s"(p)); return p;
#else
    return nullptr;
#endif
}
__global__ void __launch_bounds__(NWAVES * 64, 2) mk_fwd(Args args) {
    extern __shared__ __attribute__((aligned(16))) unsigned char lds_raw[];
    LAS unsigned char* lds = (LAS unsigned char*)lds_raw;
    volatile LAS unsigned* MISC = (volatile LAS unsigned*)(lds + MISC_OFF);
    const int G = gridDim.x, bx = blockIdx.x;
    unsigned char* ws = args.ws;
    gu32* ctl = (gu32*)(ws + WS_CTL);
    for (int u = threadIdx.x; u < (LDS_BYTES - LDSCTL_OFF) / 4; u += NWAVES * 64) ((LAS unsigned*)(lds + LDSCTL_OFF))[u] = 0u;
    __syncthreads();
    XcdBarrier bar = xcd_barrier_post((unsigned*)(ctl + CW_BAR), MISC + 8);
#define GRID_BAR() xcd_barrier(bar)
#define PH(k) for (int rep_ = ((args.mask >> (k)) & 1u) + ((args.rep >> (k)) & 1u); rep_ > 0; --rep_) if (KArgs A_ = hide_args()) if (unsigned char* ws = A_->ws)
#define COORDS() int tid = threadIdx.x; asm volatile("" : "+v"(tid)); const int lane = tid & 63, wave = __builtin_amdgcn_readfirstlane(tid >> 6); \
    const int vcu = (G % 8 == 0) ? (bx % 8) * (G / 8) + bx / 8 : bx; const int gw = vcu * NWAVES + wave, NGW = G * NWAVES; (void)lane; (void)gw; (void)NGW; (void)vcu
#define MKP() Ptrs P; P.x = A_->in[0]; P.p = A_->in[1]; P.w_gu1 = A_->in[2]; P.w_d1 = A_->in[3]; P.w_in = A_->in[4]; P.w_a = A_->in[5]; P.w_b = A_->in[6]; P.w_out = A_->in[7]; \
    P.w_gu2 = A_->in[8]; P.w_d2 = A_->in[9]; P.w_ple = A_->in[10]; P.w_pg = A_->in[11]; P.gains = A_->in[12]; P.hgw = A_->in[13]; P.lbp = A_->in[14]; P.rel = A_->in[15]; P.out = A_->out; P.ws = A_->ws
#define XN ((bf16*)(ws + WS_C))
#define Hb ((bf16*)(ws + WS_A))
#define Fb ((bf16*)(ws + WS_B))
#define Yb ((bf16*)(ws + WS_A))
#define HBS ((bf16*)A_->out)
#define Qb ((bf16*)(ws + WS_Q))
#define Kb ((bf16*)(ws + WS_K))
#define VTb ((bf16*)(ws + WS_VT))
#define HQb ((bf16*)(ws + WS_HQ))
#define HIb ((bf16*)(ws + WS_HI))
#define KINb ((bf16*)(ws + WS_KIN))
#define HGb ((bf16*)(ws + WS_HG))
#define SAb ((bf16*)(ws + WS_SA))
#define SBb ((bf16*)(ws + WS_SB))
#define OAb ((bf16*)(ws + WS_OAB))
#define OBb ((bf16*)(ws + WS_OAB))
#define PBb ((bf16*)(ws + WS_PB))
#define Eb ((bf16*)(ws + WS_A))
#define KMEAN ((float*)(ws + WS_KMEAN))
#define LBt ((float*)(ws + WS_LB))
#define BIAST ((float*)(ws + WS_BIAST))
#define HS ((float*)A_->out + 16 * 1024 * 1024)
#define HGD ((float*)(ws + WS_HGD))
#define CNTb ((unsigned*)(ws + WS_CNT))
#define LISTb ((unsigned*)(ws + WS_LIST))
#define PO0b ((bf16*)(ws + WS_PO0))
#define PO1b ((bf16*)(ws + WS_PO1))
#define PO2b ((bf16*)(ws + WS_PO2))
#define PO3b ((bf16*)(ws + WS_PO3))
#define PMLb ((float*)(ws + WS_PML))

    PH(0) { COORDS(); MKP(); p0_prologue<0>(P, lds, gw, NGW, wave, lane, vcu, G); }
    GRID_BAR();
    PH(1) { pg8::Gemm g{XN, (const bf16*)(ws + WS_WGU1), M, NGU, D / 2}; pg8::StaticOrder S; S.init(M, NGU, G, bx); pg8::EpiGU8 E{Hb, FF, (const float*)(ws + WS_RS), (const float*)(ws + WS_CMAX) + CM_GU1};
      pg8::gemm_phase<pg8::EpiGU8, pg8::StaticOrder, PG8_ALIGN, PG8_SP2, true>(lds + RING_OFF, g, S, E); }
    GRID_BAR();
    PH(2) { pg8::Gemm g{Hb, (const bf16*)(ws + WS_WD1), M, D, FF}; pg8::StaticOrder S; S.init(M, D, G, bx); pg8::EpiMix<0> E{Fb, nullptr, D};
      pg8::gemm_phase<pg8::EpiMix<0>, pg8::StaticOrder, PG8_ALIGN, PG8_SP2>(lds + RING_OFF, g, S, E); }
    GRID_BAR();
    PH(3) { COORDS(); rowwise_phase<true, 5>(gw, NGW, lane, A_->in[0], Fb, A_->in[12] + 1 * D, 0.5f, HBS, XN, (float*)(ws + WS_RS)); }
    GRID_BAR();
    PH(4) { pg8::Gemm g{HBS, (const bf16*)(ws + WS_WIN), M, 512, D}; pg8::StaticOrder S; S.init(M, 512, G, bx); pg8::EpiIN E{Qb, LBt, KMEAN, (const float*)(ws + WS_R2)};
      pg8::gemm_phase<pg8::EpiIN, pg8::StaticOrder, PG8_ALIGN, PG8_SP2>(lds + RING_OFF, g, S, E); }
    PH(4) { pg8::Gemm g{XN, (const bf16*)(ws + WS_W8IN), M, 4608, D / 2}; pg8::StaticOrder S; S.init(M, 4608, G, bx);
      pg8::EpiIN8 E{SAb, SBb, HQb, KINb, HIb, HGb, Kb, LBt, (const float*)(ws + WS_RS), (const float*)(ws + WS_CMAX) + CM_IN, KMEAN};
      pg8::gemm_phase<pg8::EpiIN8, pg8::StaticOrder, PG8_ALIGN, PG8_SP2, true>(lds + RING_OFF, g, S, E); }
    PH(4) { pg8::Gemm g{(const bf16*)(ws + WS_W8IN + (size_t)4608 * D), XN, 512, M, D / 2}; pg8::StaticOrder S; S.init(512, M, G, bx);
      pg8::EpiI8<0> E{VTb, nullptr, nullptr, M, 0, (const float*)(ws + WS_CMAX) + CM_IN + 4608, (const float*)(ws + WS_RS), 1.0f / 127.0f};
      pg8::gemm_phase<pg8::EpiI8<0>, pg8::StaticOrder, PG8_ALIGN, PG8_SP2, true>(lds + RING_OFF, g, S, E); }
    GRID_BAR();
    PH(19) { COORDS(); MKP(); p0_prologue<1>(P, lds, gw, NGW, wave, lane, vcu, G); }
    PH(5) { COORDS(); moba_gating_phase(lds, vcu, G, tid, Qb, KMEAN, CNTb, LISTb); }
    PH(18) { COORDS(); hgrn_mfma_phase<1>(lds, vcu, G, tid, wave, lane, KINb, HIb, HQb, HGb, A_->in[13], HS, HGD, OBb); }
    GRID_BAR();
    PH(6) { COORDS(); hgrn_scan_phase(vcu * NWAVES * 64 + tid, G * NWAVES * 64, HS, HGD); }
    GRID_BAR();
    PH(7) { COORDS(); hgrn_mfma_phase<3>(lds, vcu, G, tid, wave, lane, KINb, HIb, HQb, HGb, A_->in[13], HS, HGD, OBb); }
    GRID_BAR();
    PH(16) { COORDS(); moba_items_phase(lds, vcu, G, tid, wave, lane, Qb, Kb, VTb, CNTb, LISTb, BIAST, PO0b, PO1b, PO2b, PO3b, PMLb); }
    GRID_BAR();
    PH(17) { COORDS(); moba_combine_phase(vcu * NWAVES * 64 + tid, G * NWAVES * 64, PO0b, PO1b, PO2b, PO3b, PMLb, OAb); }
    GRID_BAR();
    PH(8) { pg8::Gemm g{OAb, (const bf16*)(ws + WS_WA), M, D, D, 512}; pg8::HalfOrder S; S.init(M, D, G, bx); pg8::EpiMerge E{SAb, SBb, D};
      pg8::gemm_phase<pg8::EpiMerge, pg8::HalfOrder, PG8_ALIGN, PG8_SP2>(lds + RING_OFF, g, S, E); }
    GRID_BAR();
    PH(9) { pg8::Gemm g{SAb, (const bf16*)(ws + WS_WOUT), M, D, D}; pg8::StaticOrder S; S.init(M, D, G, bx); pg8::EpiMix<0> E{Yb, nullptr, D};
      pg8::gemm_phase<pg8::EpiMix<0>, pg8::StaticOrder, PG8_ALIGN, PG8_SP2>(lds + RING_OFF, g, S, E); }
    GRID_BAR();
    PH(10) { COORDS(); rowwise_phase<false, 4>(gw, NGW, lane, HBS, Yb, A_->in[12] + 3 * D, 1.0f, HBS, XN, (float*)(ws + WS_RS)); }
    GRID_BAR();
    PH(11) { pg8::Gemm g{XN, (const bf16*)(ws + WS_WGU2), M, NGU, D / 2}; pg8::StaticOrder S; S.init(M, NGU, G, bx); pg8::EpiGU8 E{Hb, FF, (const float*)(ws + WS_RS), (const float*)(ws + WS_CMAX) + CM_GU2};
      pg8::gemm_phase<pg8::EpiGU8, pg8::StaticOrder, PG8_ALIGN, PG8_SP2, true>(lds + RING_OFF, g, S, E); }
    GRID_BAR();
    PH(12) { pg8::Gemm g{Hb, (const bf16*)(ws + WS_WD2), M, D, FF}; pg8::StaticOrder S; S.init(M, D, G, bx); pg8::EpiMix<0> E{Fb, nullptr, D};
      pg8::gemm_phase<pg8::EpiMix<0>, pg8::StaticOrder, PG8_ALIGN, PG8_SP2>(lds + RING_OFF, g, S, E); }
    GRID_BAR();
    PH(13) { COORDS(); rowwise_phase<false, 6>(gw, NGW, lane, HBS, Fb, A_->in[12] + 5 * D, 0.5f, XN, (bf16*)(ws + WS_X8B), (float*)(ws + WS_RS));
        const float* pp = A_->in[1];
        for (int i0 = gw * 64 + lane; i0 < M * PLE / 8; i0 += 4 * NGW * 64) {
            f32x4 a[4], b[4];
#pragma unroll
            for (int u = 0; u < 4; ++u) { int i = i0 + u * NGW * 64; if (i >= M * PLE / 8) i = i0; a[u] = ((const f32x4*)pp)[2 * i]; b[u] = ((const f32x4*)pp)[2 * i + 1]; }
#pragma unroll
            for (int u = 0; u < 4; ++u) { int i = i0 + u * NGW * 64; if (i >= M * PLE / 8) i = i0;
                v4u o; o.x = pk2(a[u].x, a[u].y); o.y = pk2(a[u].z, a[u].w); o.z = pk2(b[u].x, b[u].y); o.w = pk2(b[u].z, b[u].w); ((v4u*)PBb)[i] = o; } } }
    GRID_BAR();
    PH(14) { pg8::Gemm g{PBb, (const bf16*)(ws + WS_WPLE), M, D, PLE}; pg8::StaticOrder S; S.init(M, D, G, bx); pg8::EpiMix<0> E{Eb, nullptr, D};
      pg8::gemm_phase<pg8::EpiMix<0>, pg8::StaticOrder, PG8_ALIGN, PG8_SP2>(lds + RING_OFF, g, S, E); }
    PH(14) { pg8::Gemm g{(const bf16*)(ws + WS_X8B), (const bf16*)(ws + WS_WPG), M, D, D / 2}; pg8::StaticOrder S; S.init(M, D, G, bx);
      pg8::EpiI8<6> E{Fb, nullptr, Eb, D, 0, (const float*)(ws + WS_RS), (const float*)(ws + WS_CMAX) + CM_PG, 1.0f / 127.0f};
      pg8::gemm_phase<pg8::EpiI8<6>, pg8::StaticOrder, PG8_ALIGN, PG8_SP2, true>(lds + RING_OFF, g, S, E); }
    GRID_BAR();
    PH(15) { COORDS(); rowwise_phase<false, 3>(gw, NGW, lane, XN, Fb, A_->in[12] + 6 * D, 1.0f, nullptr, nullptr, A_->out); }
#if defined(PROBE_GEMM)
    GRID_BAR();
    PH(24) { pg8::Gemm g{(const bf16*)(ws + WS_A), (const bf16*)(ws + WS_WD1), M, D, D}; pg8::SameOrder S{11}; pg8::EpiNull E{};
      pg8::gemm_phase<pg8::EpiNull, pg8::SameOrder, PG8_ALIGN, PG8_SP2>(lds + RING_OFF, g, S, E); }
    PH(25) { pg8::Gemm g{(const bf16*)(ws + WS_A), (const bf16*)(ws + WS_WD1), M, NGU, D}; pg8::StaticOrder S; S.init(M, NGU, G, bx); pg8::EpiNull E{};
      pg8::gemm_phase<pg8::EpiNull, pg8::StaticOrder, PG8_ALIGN, PG8_SP2>(lds + RING_OFF, g, S, E); }
#endif
}

extern "C" void kernel_launch(void* const* d_in, const int* in_sizes, int n_in, void* d_out, int out_size, void* d_ws, size_t ws_size, hipStream_t stream) {
    static int grid = 0;
    if (grid == 0) {
        if (n_in != 16 || in_sizes[0] != M * D || out_size != M * D || ws_size < WS_END) { fprintf(stderr, "kernel_launch: unexpected shapes: n_in %d in0 %d out %d ws %zu; nothing launched\n", n_in, n_in > 0 ? in_sizes[0] : -1, out_size, ws_size); grid = -1; return; }
        int dev = 0, cus = 0;
        if (hipGetDevice(&dev) != hipSuccess || hipDeviceGetAttribute(&cus, hipDeviceAttributeMultiprocessorCount, dev) != hipSuccess) { fprintf(stderr, "kernel_launch: device query failed\n"); grid = -1; return; }
        if (hipFuncSetAttribute((const void*)mk_fwd, hipFuncAttributeMaxDynamicSharedMemorySize, LDS_BYTES) != hipSuccess) { fprintf(stderr, "kernel_launch: hipFuncSetAttribute failed\n"); grid = -1; return; }
        int per_cu = 0;
        if (hipOccupancyMaxActiveBlocksPerMultiprocessor(&per_cu, (const void*)mk_fwd, NWAVES * 64, LDS_BYTES) != hipSuccess || per_cu < 1) fprintf(stderr, "kernel_launch: note: occupancy query reports %d\n", per_cu);
        (void)hipGetLastError();
        grid = cus;
    }
    if (grid < 0) return;
    if (hipMemsetAsync((char*)d_ws + WS_CTL, 0, CTL_ZERO_BYTES, stream) != hipSuccess) { fprintf(stderr, "kernel_launch: memset failed\n"); return; }
    Args a{};
    for (int i = 0; i < 16; ++i) a.in[i] = (const float*)d_in[i];
    a.out = (float*)d_out; a.ws = (unsigned char*)d_ws; a.mask = MASK_BITS; a.rep = REP_MASK;
    hipLaunchKernelGGL(mk_fwd, dim3(grid), dim3(NWAVES * 64), LDS_BYTES, stream, a);
    const hipError_t le = hipPeekAtLastError();
    if (le != hipSuccess) fprintf(stderr, "kernel_launch: launch failed: %s\n", hipGetErrorName(le));
}
```

```cpp
#include <hip/hip_runtime.h>
#include <cstdio>
#include <cstdint>
namespace pg8 {
#define PG8_LAS __attribute__((address_space(3)))
#define PG8_AUX_OFF 131584
typedef unsigned short bf16_t;
typedef short bf16x8 __attribute__((ext_vector_type(8)));
typedef float f32x4 __attribute__((ext_vector_type(4)));
typedef unsigned u32x4 __attribute__((ext_vector_type(4)));
typedef int i32x4 __attribute__((ext_vector_type(4)));
constexpr int BM = 256, BK = 64, HALF = 128, HTB = HALF * BK * 2  , STAGE_BYTES = 8 * HTB, NXCD = 8, WGM = 8;

__host__ __device__ __forceinline__ int lds_byte(int r, int c) { const int st = (r >> 4) * 2 + (c >> 5), rr = r & 15, cc = c & 31, ob = rr * 64 + cc * 2; return st * 1024 + (ob ^ (((ob >> 9) & 1) << 5)); }
__host__ __device__ __forceinline__ void stage_rc(int b, int& R, int& C) { const int st = b / 1024, sb = b % 1024, swz = sb ^ (((sb >> 9) & 1) << 5); R = (st >> 1) * 16 + swz / 64; C = (st & 1) * 32 + (swz % 64) / 2; }
__host__ __device__ __forceinline__ int perm32(int rho) { const int n = rho >> 4, i = rho & 15; return 8 * (i >> 2) + 4 * n + (i & 3); }

struct Unit { int pm, pn, half; };
struct Gemm { const bf16_t* A; const bf16_t* Bt; int M, N, K, Klen; };

struct StaticOrder {
    int nM, nN, nwg, G, c;
    __host__ __device__ void init(int M, int N, int G_, int c_) { nM = M / BM; nN = N / BM; nwg = nM * nN; G = G_; c = c_; }
    __host__ __device__ bool next(int i, Unit& u) const {
        const long L = (long)i * G + c; if (L >= nwg) return false;
        int wgid = (int)L; { const int q = nwg / NXCD, r = nwg % NXCD, xcd = wgid % NXCD, off = wgid / NXCD; wgid = (xcd < r ? xcd * (q + 1) : r * (q + 1) + (xcd - r) * q) + off; }
        const int nig = WGM * nN, gid = wgid / nig, fm = gid * WGM, gsz = (nM - fm) < WGM ? (nM - fm) : WGM;
        u.pm = fm + ((wgid % nig) % gsz); u.pn = (wgid % nig) / gsz; u.half = 0; return true;
    }
    __device__ __forceinline__ void a_ready(const Unit&) const {}
    __device__ __forceinline__ void done(const Unit&) const {}
};

struct HalfOrder : StaticOrder {
    __host__ __device__ bool next(int i, Unit& u) const { if (!StaticOrder::next(i >> 1, u)) return false; u.half = i & 1; return true; }
};

struct SameOrder { int n; __host__ __device__ bool next(int i, Unit& u) const { if (i >= n) return false; u.pm = 0; u.pn = 0; u.half = 0; return true; }
    __device__ __forceinline__ void a_ready(const Unit&) const {} __device__ __forceinline__ void done(const Unit&) const {} };

typedef float f32x2_t __attribute__((ext_vector_type(2))); typedef __bf16 bf16x2_t __attribute__((ext_vector_type(2)));
__device__ __forceinline__ unsigned cvt_pk_bf16(float lo, float hi) { f32x2_t v = {lo, hi}; bf16x2_t b = __builtin_convertvector(v, bf16x2_t); return __builtin_bit_cast(unsigned, b); }
#ifndef ST16_WT
#define ST16_WT 0
#endif
__device__ __forceinline__ void st16(void* p, u32x4 v) {
#if ST16_WT == 1
    asm volatile("global_store_dwordx4 %0, %1, off sc1\n\ts_nop 1" :: "v"(p), "v"(v) : "memory");
#elif ST16_WT == 2
    __builtin_nontemporal_store(v, (u32x4*)p);
#else
    *(u32x4*)p = v;
#endif
}
__device__ __forceinline__ void st16nt(void* p, u32x4 v) { __builtin_nontemporal_store(v, (u32x4*)p); }
__device__ __forceinline__ float sigm(float x) { return __builtin_amdgcn_rcpf(1.0f + __builtin_amdgcn_exp2f(-1.4426950408889634f * x)); }
__device__ __forceinline__ float bf_lo(unsigned w) { return __uint_as_float(w << 16); }
__device__ __forceinline__ float bf_hi(unsigned w) { return __uint_as_float(w & 0xffff0000u); }
__device__ __forceinline__ void unpack8(const u32x4 w, float (&o)[8]) { o[0] = bf_lo(w.x); o[1] = bf_hi(w.x); o[2] = bf_lo(w.y); o[3] = bf_hi(w.y); o[4] = bf_lo(w.z); o[5] = bf_hi(w.z); o[6] = bf_lo(w.w); o[7] = bf_hi(w.w); }
__device__ __forceinline__ u32x4 pack8(const float (&o)[8]) { u32x4 w; w.x = cvt_pk_bf16(o[0], o[1]); w.y = cvt_pk_bf16(o[2], o[3]); w.z = cvt_pk_bf16(o[4], o[5]); w.w = cvt_pk_bf16(o[6], o[7]); return w; }

struct EpiGU {
    static constexpr bool PERM = true, AFTER_DRAIN = false, HAS_MID = false; static constexpr bool AUX = false;
    bf16_t* H; int ldh;
    __device__ __forceinline__ void operator()(const f32x4 (&acc)[2][2][4][2], const Unit& u, int wr, int wc, int fr, int fq) const {
        const int row0 = u.pm * BM + wr * 64 + fr, col0 = u.pn * HALF + wc * 32 + 8 * fq;
#pragma unroll
        for (int ai = 0; ai < 2; ++ai)
#pragma unroll
            for (int m = 0; m < 4; ++m) { bf16_t* rowp = H + (size_t)(row0 + ai * HALF + m * 16) * ldh + col0;
                const f32x4 g0 = acc[ai][0][m][0], g1 = acc[ai][0][m][1], u0 = acc[ai][1][m][0], u1 = acc[ai][1][m][1]; float o[8];
#pragma unroll
                for (int j = 0; j < 4; ++j) { o[j] = g0[j] * sigm(g0[j]) * u0[j]; o[4 + j] = g1[j] * sigm(g1[j]) * u1[j]; }
                st16(rowp, pack8(o)); }
    }
};
struct EpiF32 {
    static constexpr bool PERM = false, AFTER_DRAIN = false, HAS_MID = false; static constexpr bool AUX = false;
    float* C; int ldc;
    __device__ __forceinline__ void operator()(const f32x4 (&acc)[2][2][4][2], const Unit& u, int wr, int wc, int fr, int fq) const {
        const int row0 = u.pm * BM + wr * 64 + fr, col0 = u.pn * BM + wc * 32 + 4 * fq;
#pragma unroll
        for (int ai = 0; ai < 2; ++ai)
#pragma unroll
            for (int m = 0; m < 4; ++m) { float* rowp = C + (size_t)(row0 + ai * HALF + m * 16) * ldc + col0;
#pragma unroll
                for (int bj = 0; bj < 2; ++bj)
#pragma unroll
                    for (int n = 0; n < 2; ++n) *(f32x4*)(rowp + bj * HALF + n * 16) = acc[ai][bj][m][n]; }
    }
};
struct EpiIN {
    static constexpr bool PERM = true, AFTER_DRAIN = false, HAS_MID = false; static constexpr bool AUX = true;
    bf16_t *Q; const float* LB; float* KMEAN; const float* R2;
    __device__ __forceinline__ const float* aux_row(const Unit& u) const { return R2 + u.pm * BM; }
    __device__ __forceinline__ const float* aux_col(const Unit& u) const { return R2 + u.pm * BM; }
    template <int MODE> __device__ __forceinline__ void body(const f32x4 (&acc)[2][2][4][2], bf16_t* base, int ldc, int row0, int cbase, int pm, int fr, const __attribute__((address_space(3))) float* aux, int wr) const {
        float rsv[2][4];
#pragma unroll
        for (int ai = 0; ai < 2; ++ai)
#pragma unroll
            for (int m = 0; m < 4; ++m) rsv[ai][m] = aux[wr * 64 + fr + ai * HALF + m * 16];
        float lbv[2][8]; float ks[2][8];
#pragma unroll
        for (int bj = 0; bj < 2; ++bj)
#pragma unroll
            for (int j = 0; j < 8; ++j) { lbv[bj][j] = (MODE == 2) ? (1.0f - LB[cbase + bj * HALF + j]) : 0.f; ks[bj][j] = 0.f; }
#pragma unroll
        for (int ai = 0; ai < 2; ++ai)
#pragma unroll
            for (int m = 0; m < 4; ++m) { const int row = row0 + ai * HALF + m * 16; const float r2 = rsv[ai][m]; bf16_t* rowp = base + (size_t)row * ldc + cbase;
#pragma unroll
                for (int bj = 0; bj < 2; ++bj) { const f32x4 v0 = acc[ai][bj][m][0], v1 = acc[ai][bj][m][1]; float o[8];
#pragma unroll
                    for (int j = 0; j < 4; ++j) { o[j] = v0[j] * r2; o[4 + j] = v1[j] * r2; }
#pragma unroll
                    for (int j = 0; j < 8; ++j) {
                        if (MODE == 1) o[j] = o[j] * sigm(o[j]);
                        if (MODE == 2) o[j] = lbv[bj][j] * sigm(-o[j]);
                        if (MODE == 4) { ks[bj][j] += o[j]; asm volatile("" : "+v"(ks[bj][j])); }
                        if (MODE == 5) o[j] *= 0.18033688011112042f; }
                    st16(rowp + bj * HALF, pack8(o)); } }
        if (MODE == 4) {
#pragma unroll
            for (int bj = 0; bj < 2; ++bj)
#pragma unroll
                for (int j = 0; j < 8; ++j) { float s = ks[bj][j]; s += __shfl_xor(s, 1); s += __shfl_xor(s, 2); s += __shfl_xor(s, 4); s += __shfl_xor(s, 8);
                    if (fr == 0) atomicAdd(KMEAN + (size_t)pm * 512 + cbase + bj * HALF + j, s); }
        }
    }
    __device__ __forceinline__ void operator()(const f32x4 (&acc)[2][2][4][2], const Unit& u, int wr, int wc, int fr, int fq, const __attribute__((address_space(3))) float* aux) const {
        const int pn = u.pn, row0 = u.pm * BM + wr * 64 + fr, cw = wc * 32 + 8 * fq;
        body<5>(acc, Q, 512, row0, pn * BM + cw, u.pm, fr, aux, wr);
    }
};
struct EpiIN8 {
    static constexpr bool PERM = true, AFTER_DRAIN = false, HAS_MID = false; static constexpr bool AUX = true;
    bf16_t *SA, *SB, *HQ, *KIN, *HI, *HG, *K; const float* LB; const float* RS; const float* CMX; float* KMEAN;
    __device__ __forceinline__ const float* aux_row(const Unit& u) const { return RS + u.pm * BM; }
    __device__ __forceinline__ const float* aux_col(const Unit& u) const { return CMX + u.pn * BM; }
    template <int MODE> __device__ __forceinline__ void body(const i32x4 (&acc)[2][2][4][2], bf16_t* base, int ldc, int row0, int cbase, int gcol, const __attribute__((address_space(3))) float* aux, int wr, int cw, int pm = 0, int fr = 0, float u8lo = 0.f, int gtile = 0) const {
        float rsv[2][4];
#pragma unroll
        for (int ai = 0; ai < 2; ++ai)
#pragma unroll
            for (int m = 0; m < 4; ++m) rsv[ai][m] = aux[wr * 64 + (row0 & 15) + ai * HALF + m * 16];
        float cf[2][8], lbv[2][8], ks[2][8];
#pragma unroll
        for (int bj = 0; bj < 2; ++bj)
#pragma unroll
            for (int j = 0; j < 8; ++j) { cf[bj][j] = aux[256 + cw + bj * HALF + j] * ((MODE >= 1 && MODE <= 3) ? (1.4426950408889634f / 127.0f) : (1.0f / 127.0f));
                lbv[bj][j] = (MODE == 2) ? (1.0f - LB[cbase + bj * HALF + j]) : 0.f; ks[bj][j] = 0.f; }
#pragma unroll
        for (int ai = 0; ai < 2; ++ai)
#pragma unroll
            for (int m = 0; m < 4; ++m) { const int row = row0 + ai * HALF + m * 16; const float rf = rsv[ai][m]; bf16_t* rowp = base + (size_t)row * ldc + cbase; u32x4 g8 = {0u, 0u, 0u, 0u};
#pragma unroll
                for (int bj = 0; bj < 2; ++bj) { const i32x4 v0 = acc[ai][bj][m][0], v1 = acc[ai][bj][m][1]; float o[8];
                    if (MODE >= 1 && MODE <= 3) {
                        float srf = (MODE == 2) ? rf : -rf; asm("" : "+v"(srf));
                        const float rfl = rf * 0.6931471805599453f;
#pragma unroll
                        for (int j = 0; j < 4; ++j) { const f32x2_t V2 = {(float)v0[j], (float)v1[j]}; const f32x2_t A = V2 * (f32x2_t){cf[bj][j], cf[bj][4 + j]}; const f32x2_t ar = A * srf;
                            f32x2_t d = {__builtin_amdgcn_exp2f(ar.x), __builtin_amdgcn_exp2f(ar.y)}; d = d + 1.0f;
                            const f32x2_t r = {__builtin_amdgcn_rcpf(d.x), __builtin_amdgcn_rcpf(d.y)};
                            f32x2_t out = r;
                            if (MODE == 1) out = A * (r * rfl);
                            if (MODE == 2) out = r * (f32x2_t){lbv[bj][j], lbv[bj][4 + j]};
                            o[j] = out.x; o[4 + j] = out.y; }
                    } else {
#pragma unroll
                        for (int j = 0; j < 4; ++j) { o[j] = (float)v0[j] * (rf * cf[bj][j]); o[4 + j] = (float)v1[j] * (rf * cf[bj][4 + j]); }
#pragma unroll
                        for (int j = 0; j < 8; ++j) {
                            if (MODE == 4) { ks[bj][j] += o[j]; asm volatile("" : "+v"(ks[bj][j])); } }
                    }
                    if (MODE == 3) {
                        unsigned lo = 0u, hi = 0u;
#pragma unroll
                        for (int j = 0; j < 4; ++j) { lo = __builtin_amdgcn_cvt_pk_u8_f32(fmaxf(o[j] * 255.0f, u8lo), j, lo); hi = __builtin_amdgcn_cvt_pk_u8_f32(fmaxf(o[4 + j] * 255.0f, u8lo), j, hi); }
                        if (bj == 0) { g8.x = lo; g8.y = hi; } else { g8.z = lo; g8.w = hi; }
                    } else st16nt(rowp + bj * HALF, pack8(o)); }
                if (MODE == 3) st16nt((unsigned char*)base + (size_t)row * 1024 + gtile + 2 * cw, g8); }
        if (MODE == 4) {
#pragma unroll
            for (int bj = 0; bj < 2; ++bj)
#pragma unroll
                for (int j = 0; j < 8; ++j) { float s = ks[bj][j]; s += __shfl_xor(s, 1); s += __shfl_xor(s, 2); s += __shfl_xor(s, 4); s += __shfl_xor(s, 8);
                    if (fr == 0) atomicAdd(KMEAN + (size_t)pm * 512 + cbase + bj * HALF + j, s); }
        }
    }
    __device__ __forceinline__ void operator()(const i32x4 (&acc)[2][2][4][2], const Unit& u, int wr, int wc, int fr, int fq, const __attribute__((address_space(3))) float* aux) const {
        const int pn = u.pn, row0 = u.pm * BM + wr * 64 + fr, cw = wc * 32 + 8 * fq, gcol = pn * BM + cw;
        if (pn >= 16) { body<4>(acc, K, 512, row0, (pn - 16) * BM + cw, gcol, aux, wr, cw, u.pm, fr); return; }
        if (pn < 4)       body<3>(acc, SA, 1024, row0, (pn)      * BM + cw, gcol, aux, wr, cw, 0, 0, 0.0f, pn * BM);
        else if (pn < 8)  body<3>(acc, SB, 1024, row0, (pn - 4)  * BM + cw, gcol, aux, wr, cw, 0, 0, 1.0f, (pn - 4) * BM);
        else if (pn < 10) body<1>(acc, HQ, 512, row0, (pn - 8)  * BM + cw, gcol, aux, wr, cw);
        else if (pn < 12) body<2>(acc, KIN, 512, row0, (pn - 10) * BM + cw, gcol, aux, wr, cw);
        else if (pn < 14) body<0>(acc, HI, 512, row0, (pn - 12) * BM + cw, gcol, aux, wr, cw);
        else              body<1>(acc, HG, 512, row0, (pn - 14) * BM + cw, gcol, aux, wr, cw);
    }
};
template <int MODE> struct EpiI8 {
    static constexpr bool PERM = true, AFTER_DRAIN = false, HAS_MID = false; static constexpr bool AUX = true;
    bf16_t* O; bf16_t* O2; const bf16_t* E; int ldc; int split; const float* RF; const float* CF; float cmul;
    __device__ __forceinline__ const float* aux_row(const Unit& u) const { return RF + u.pm * BM; }
    __device__ __forceinline__ const float* aux_col(const Unit& u) const { return CF + u.pn * BM; }
    __device__ __forceinline__ void operator()(const i32x4 (&acc)[2][2][4][2], const Unit& u, int wr, int wc, int fr, int fq, const __attribute__((address_space(3))) float* aux) const {
        const int row0 = u.pm * BM + wr * 64 + fr; int colt = u.pn * BM; bf16_t* base = O;
        if (MODE == 3 && colt >= split) { base = O2; colt -= split; }
        const int col0 = colt + wc * 32 + 8 * fq, gcol0 = u.pn * BM + wc * 32 + 8 * fq;
        float rsv[2][4];
#pragma unroll
        for (int ai = 0; ai < 2; ++ai)
#pragma unroll
            for (int m = 0; m < 4; ++m) rsv[ai][m] = aux[wr * 64 + fr + ai * HALF + m * 16];
        float cf[2][8];
#pragma unroll
        for (int bj = 0; bj < 2; ++bj)
#pragma unroll
            for (int j = 0; j < 8; ++j) cf[bj][j] = aux[256 + wc * 32 + 8 * fq + bj * HALF + j] * ((MODE == 3 || MODE == 6) ? cmul * 1.4426950408889634f : cmul);
#pragma unroll
        for (int ai = 0; ai < 2; ++ai) {
            u32x4 ew[4][2];
            if (MODE == 6) {
#pragma unroll
                for (int m = 0; m < 4; ++m)
#pragma unroll
                    for (int bj = 0; bj < 2; ++bj) ew[m][bj] = *(const u32x4*)(E + (size_t)(row0 + ai * HALF + m * 16) * ldc + col0 + bj * HALF); }
#pragma unroll
            for (int m = 0; m < 4; ++m) { const int row = row0 + ai * HALF + m * 16; const float rf = rsv[ai][m]; const size_t off = (size_t)row * ldc + col0;
#pragma unroll
                for (int bj = 0; bj < 2; ++bj) { const i32x4 v0 = acc[ai][bj][m][0], v1 = acc[ai][bj][m][1]; float o[8];
                    if (MODE == 3 || MODE == 6) {
                        float nrf = -rf; asm("" : "+v"(nrf)); float ev[8];
                        if (MODE == 6) unpack8(ew[m][bj], ev);
#pragma unroll
                        for (int j = 0; j < 4; ++j) { const f32x2_t V2 = {(float)v0[j], (float)v1[j]}; const f32x2_t ar = (V2 * (f32x2_t){cf[bj][j], cf[bj][4 + j]}) * nrf;
                            f32x2_t d = {__builtin_amdgcn_exp2f(ar.x), __builtin_amdgcn_exp2f(ar.y)}; d = d + 1.0f;
                            f32x2_t out = {__builtin_amdgcn_rcpf(d.x), __builtin_amdgcn_rcpf(d.y)};
                            if (MODE == 6) out = out * (f32x2_t){ev[j], ev[4 + j]};
                            o[j] = out.x; o[4 + j] = out.y; }
                    } else {
#pragma unroll
                        for (int j = 0; j < 4; ++j) { o[j] = (float)v0[j] * (rf * cf[bj][j]); o[4 + j] = (float)v1[j] * (rf * cf[bj][4 + j]); }
                    }
                    if (MODE == 0) st16nt(base + off + bj * HALF, pack8(o)); else st16(base + off + bj * HALF, pack8(o)); } } }
    }
};
struct EpiQ8 {
    static constexpr bool PERM = true, AFTER_DRAIN = false, HAS_MID = false; static constexpr bool AUX = false;
    unsigned char* O8; float* OS; int ldc;
    __device__ __forceinline__ void operator()(const f32x4 (&acc)[2][2][4][2], const Unit& u, int wr, int wc, int fr, int fq) const {
        const int row0 = u.pm * BM + wr * 64 + fr;
#pragma unroll
        for (int ai = 0; ai < 2; ++ai)
#pragma unroll
            for (int m = 0; m < 4; ++m) { const int row = row0 + ai * HALF + m * 16;
#pragma unroll
                for (int bj = 0; bj < 2; ++bj) { const f32x4 v0 = acc[ai][bj][m][0], v1 = acc[ai][bj][m][1]; const int c0 = u.pn * BM + bj * HALF + wc * 32 + 8 * fq;
                    float am = fmaxf(fmaxf(fmaxf(fabsf(v0[0]), fabsf(v0[1])), fmaxf(fabsf(v0[2]), fabsf(v0[3]))), fmaxf(fmaxf(fabsf(v1[0]), fabsf(v1[1])), fmaxf(fabsf(v1[2]), fabsf(v1[3]))));
                    am = fmaxf(am, __shfl_xor(am, 16)); am = fmaxf(fmaxf(am, __shfl_xor(am, 32)), 1e-30f);
                    const float qs = 127.0f / am;
                    const int a0 = (int)rintf(v0[0] * qs), a1 = (int)rintf(v0[1] * qs), a2 = (int)rintf(v0[2] * qs), a3 = (int)rintf(v0[3] * qs), b0 = (int)rintf(v1[0] * qs), b1 = (int)rintf(v1[1] * qs), b2 = (int)rintf(v1[2] * qs), b3 = (int)rintf(v1[3] * qs);
                    unsigned long long w = (unsigned long long)((unsigned)(a0 & 255) | ((unsigned)(a1 & 255) << 8) | ((unsigned)(a2 & 255) << 16) | ((unsigned)(a3 & 255) << 24))
                                         | ((unsigned long long)((unsigned)(b0 & 255) | ((unsigned)(b1 & 255) << 8) | ((unsigned)(b2 & 255) << 16) | ((unsigned)(b3 & 255) << 24)) << 32);
                    *(unsigned long long*)(O8 + (size_t)row * ldc + c0) = w;
                    if (fq == 0) OS[(size_t)row * 32 + (c0 >> 5)] = am * (1.0f / 127.0f); } }
    }
};
template <int MODE> struct EpiMix {
    static constexpr bool PERM = true, AFTER_DRAIN = false, HAS_MID = false; static constexpr bool AUX = false;
    bf16_t* T; const bf16_t* S2; int ldc;
    __device__ __forceinline__ void operator()(const f32x4 (&acc)[2][2][4][2], const Unit& u, int wr, int wc, int fr, int fq) const {
        const int row0 = u.pm * BM + wr * 64 + fr, col0 = u.pn * BM + wc * 32 + 8 * fq;
#pragma unroll
        for (int ai = 0; ai < 2; ++ai)
#pragma unroll
            for (int m = 0; m < 4; ++m) { const size_t off = (size_t)(row0 + ai * HALF + m * 16) * ldc + col0;
#pragma unroll
                for (int bj = 0; bj < 2; ++bj) { const f32x4 v0 = acc[ai][bj][m][0], v1 = acc[ai][bj][m][1]; float o[8];
#pragma unroll
                    for (int j = 0; j < 4; ++j) { o[j] = v0[j]; o[4 + j] = v1[j]; }
                    if (MODE == 1) { float t[8]; unpack8(*(const u32x4*)(T + off + bj * HALF), t);
#pragma unroll
                        for (int j = 0; j < 8; ++j) o[j] = t[j] * o[j]; }
                    if (MODE == 2) { float t[8], s[8]; unpack8(*(const u32x4*)(T + off + bj * HALF), t); unpack8(*(const u32x4*)(S2 + off + bj * HALF), s);
#pragma unroll
                        for (int j = 0; j < 8; ++j) o[j] = t[j] + s[j] * o[j]; }
                    st16(T + off + bj * HALF, pack8(o)); } }
    }
};
struct EpiPleB {
    static constexpr bool PERM = true, AFTER_DRAIN = false, HAS_MID = false; static constexpr bool AUX = false;
    const bf16_t* E; bf16_t* Y; int ldc;
    __device__ __forceinline__ void operator()(const f32x4 (&acc)[2][2][4][2], const Unit& u, int wr, int wc, int fr, int fq) const {
        const int row0 = u.pm * BM + wr * 64 + fr, col0 = u.pn * BM + wc * 32 + 8 * fq;
#pragma unroll
        for (int ai = 0; ai < 2; ++ai)
#pragma unroll
            for (int m = 0; m < 4; ++m) { const size_t off = (size_t)(row0 + ai * HALF + m * 16) * ldc + col0;
#pragma unroll
                for (int bj = 0; bj < 2; ++bj) { const f32x4 v0 = acc[ai][bj][m][0], v1 = acc[ai][bj][m][1]; float e[8], o[8]; unpack8(*(const u32x4*)(E + off + bj * HALF), e);
#pragma unroll
                    for (int j = 0; j < 4; ++j) { o[j] = sigm(v0[j]) * e[j]; o[4 + j] = sigm(v1[j]) * e[4 + j]; }
                    st16(Y + off + bj * HALF, pack8(o)); } }
    }
};

struct EpiGU8 {
    static constexpr bool PERM = true, AFTER_DRAIN = false, HAS_MID = false; static constexpr bool AUX = true;
    bf16_t* H; int ldh; const float* RS; const float* CMAX;
    __device__ __forceinline__ const float* aux_row(const Unit& u) const { return RS + u.pm * BM; }
    __device__ __forceinline__ const float* aux_col(const Unit& u) const { return CMAX + u.pn * BM; }
    __device__ __forceinline__ void operator()(const i32x4 (&acc)[2][2][4][2], const Unit& u, int wr, int wc, int fr, int fq, const __attribute__((address_space(3))) float* aux) const {
        const int row0 = u.pm * BM + wr * 64 + fr, cw = wc * 32 + 8 * fq, col0 = u.pn * HALF + cw;
        float rsv[2][4];
#pragma unroll
        for (int ai = 0; ai < 2; ++ai)
#pragma unroll
            for (int m = 0; m < 4; ++m) rsv[ai][m] = aux[wr * 64 + fr + ai * HALF + m * 16];
        float cg[8], cu[8];
#pragma unroll
        for (int j = 0; j < 8; ++j) { cg[j] = aux[256 + cw + j] * (1.4426950408889634f / 127.0f); cu[j] = aux[256 + HALF + cw + j] * (0.6931471805599453f / 127.0f); }
#pragma unroll
        for (int ai = 0; ai < 2; ++ai)
#pragma unroll
            for (int m = 0; m < 4; ++m) { const int row = row0 + ai * HALF + m * 16; const float rs = rsv[ai][m]; bf16_t* rowp = H + (size_t)row * ldh + col0;
                const i32x4 g0 = acc[ai][0][m][0], g1 = acc[ai][0][m][1], u0 = acc[ai][1][m][0], u1 = acc[ai][1][m][1]; float o[8];
                const float rs2 = rs * rs; float nrs = -rs; asm("" : "+v"(nrs));
#pragma unroll
                for (int j = 0; j < 4; ++j) {
                    const f32x2_t G2 = {(float)g0[j], (float)g1[j]}, U2 = {(float)u0[j], (float)u1[j]};
                    const f32x2_t A = G2 * (f32x2_t){cg[j], cg[4 + j]}, Uv = U2 * (f32x2_t){cu[j], cu[4 + j]};
                    const f32x2_t ar = A * nrs;
                    f32x2_t d = {__builtin_amdgcn_exp2f(ar.x), __builtin_amdgcn_exp2f(ar.y)}; d = d + 1.0f;
                    const f32x2_t r = {__builtin_amdgcn_rcpf(d.x), __builtin_amdgcn_rcpf(d.y)};
                    const f32x2_t out = (A * Uv) * (r * rs2);
                    o[j] = out.x; o[4 + j] = out.y; }
                st16nt(rowp, pack8(o)); }
    }
};

struct EpiMerge {
    static constexpr bool PERM = true, AFTER_DRAIN = false, HAS_MID = true; static constexpr bool AUX = false;
    const unsigned char* GA; const unsigned char* GB; bf16_t* O; int ldc;
    __device__ __forceinline__ static void ub8(unsigned lo, unsigned hi, float (&f)[8]) {
        f[0] = (float)(lo & 0xffu); f[1] = (float)((lo >> 8) & 0xffu); f[2] = (float)((lo >> 16) & 0xffu); f[3] = (float)(lo >> 24);
        f[4] = (float)(hi & 0xffu); f[5] = (float)((hi >> 8) & 0xffu); f[6] = (float)((hi >> 16) & 0xffu); f[7] = (float)(hi >> 24); }
    __device__ __forceinline__ void mid(f32x4 (&acc)[2][2][4][2], const Unit& u, int wr, int wc, int fr, int fq) const {
        const int row0 = u.pm * BM + wr * 64 + fr, gb0 = u.pn * BM + wc * 64 + fq * 16;
#pragma unroll
        for (int ai = 0; ai < 2; ++ai)
#pragma unroll
            for (int m = 0; m < 4; ++m) { const size_t off = (size_t)(row0 + ai * HALF + m * 16) * 1024 + gb0;
                const u32x4 ta = *(const u32x4*)(GA + off), tb = *(const u32x4*)(GB + off);
#pragma unroll
                for (int bj = 0; bj < 2; ++bj) { float fa[8], fb[8]; ub8(bj ? ta.z : ta.x, bj ? ta.w : ta.y, fa); ub8(bj ? tb.z : tb.x, bj ? tb.w : tb.y, fb);
#pragma unroll
                    for (int j = 0; j < 4; ++j) { acc[ai][bj][m][0][j] *= fa[j] * __builtin_amdgcn_rcpf(fb[j]); acc[ai][bj][m][1][j] *= fa[4 + j] * __builtin_amdgcn_rcpf(fb[4 + j]); } }
                asm volatile("" ::: "memory"); }
    }
    __device__ __forceinline__ void operator()(const f32x4 (&acc)[2][2][4][2], const Unit& u, int wr, int wc, int fr, int fq) const {
        const int row0 = u.pm * BM + wr * 64 + fr, col0 = u.pn * BM + wc * 32 + 8 * fq, gb0 = u.pn * BM + wc * 64 + fq * 16;
#pragma unroll
        for (int ai = 0; ai < 2; ++ai) {
            u32x4 tb[4];
#pragma unroll
            for (int m = 0; m < 4; ++m) tb[m] = *(const u32x4*)(GB + (size_t)(row0 + ai * HALF + m * 16) * 1024 + gb0);
#pragma unroll
            for (int m = 0; m < 4; ++m) { const size_t off = (size_t)(row0 + ai * HALF + m * 16) * ldc + col0;
#pragma unroll
                for (int bj = 0; bj < 2; ++bj) { const f32x4 v0 = acc[ai][bj][m][0], v1 = acc[ai][bj][m][1]; float s[8], o[8]; ub8(bj ? tb[m].z : tb[m].x, bj ? tb[m].w : tb[m].y, s);
#pragma unroll
                    for (int j = 0; j < 4; ++j) { o[j] = v0[j] * (s[j] * (1.0f / 255.0f)); o[4 + j] = v1[j] * (s[4 + j] * (1.0f / 255.0f)); }
                    st16(O + off + bj * HALF, pack8(o)); } } }
    }
};

struct EpiNull {
    static constexpr bool PERM = true, AFTER_DRAIN = false, HAS_MID = false; static constexpr bool AUX = false;
    template <class AT> __device__ __forceinline__ void operator()(const AT (&acc)[2][2][4][2], const Unit& u, int wr, int wc, int fr, int fq) const {
#pragma unroll
        for (int ai = 0; ai < 2; ++ai)
#pragma unroll
            for (int bj = 0; bj < 2; ++bj)
#pragma unroll
                for (int m = 0; m < 4; ++m)
#pragma unroll
                    for (int n = 0; n < 2; ++n) asm volatile("" :: "v"(acc[ai][bj][m][n]));
    }
};

template <bool I8> struct AccT { typedef f32x4 T; }; template <> struct AccT<true> { typedef i32x4 T; };
template <class Epi, class Sched, bool ALIGN_EPI = false, bool SP2 = false, bool I8 = false>
__device__ __forceinline__ void gemm_phase(PG8_LAS unsigned char* lds, const Gemm g, const Sched& S, const Epi& E) {
    int tid_ = threadIdx.x; asm volatile("" : "+v"(tid_));
    const int tid = tid_, wid = __builtin_amdgcn_readfirstlane(tid >> 6), lane = tid & 63, wr = wid >> 2, wc = wid & 3, fr = lane & 15, fq = lane >> 4;
    int K_ = g.K; asm volatile("" : "+s"(K_));
    const int K = K_, nt = (g.Klen ? g.Klen : K) / BK;
    const size_t koff = (size_t)(g.Klen ? g.Klen : K) * 2;
    unsigned voffA[2], voffB[2];
#pragma unroll
    for (int i = 0; i < 2; ++i) { int R, C; stage_rc(tid * 16 + i * 8192, R, C); const int Rb = Epi::PERM ? ((R & ~31) + perm32(R & 31)) : R;
        voffA[i] = (unsigned)(R * K + C) * 2u; voffB[i] = (unsigned)(Rb * K + C) * 2u; }
    const size_t kstep = (size_t)(BK * 2);
    const size_t hstep = (size_t)HALF * K * 2;
    const size_t tstep = 2 * hstep;
    const unsigned ldsw = (unsigned)wid * 1024u;
    PG8_LAS unsigned char* auxl = lds + PG8_AUX_OFF;
#define PG8_AUX_ISSUE(U, PAR) do { if constexpr (Epi::AUX) { const float* src_ = ((wid < 4) ? E.aux_row(U) : E.aux_col(U)) + (wid & 3) * 64 + lane; \
        __builtin_amdgcn_global_load_lds((const unsigned*)src_, (PG8_LAS unsigned*)(auxl + (PAR) * 2048 + wid * 256), 4, 0, 0); } } while (0)
    const int aoff = lds_byte(wr * 64 + fr, fq * 8), boff = lds_byte(wc * 32 + fr, fq * 8);
#define PG8_SA(b, h) (((b) * 2 + (h)) * HTB)
#define PG8_SB(b, h) ((4 + (b) * 2 + (h)) * HTB)
#define PG8_STAGE(bufoff, gbase, voff) do { _Pragma("unroll") for (int _i = 0; _i < 2; ++_i) \
        __builtin_amdgcn_global_load_lds((const unsigned*)((const char*)(gbase) + (voff)[_i]), (PG8_LAS unsigned*)(lds + (bufoff) + ldsw + _i * 8192), 16, 0, 0); } while (0)
#define PG8_LDA(dst, b, h) do { _Pragma("unroll") for (int m = 0; m < 4; ++m) _Pragma("unroll") for (int k = 0; k < 2; ++k) dst[m][k] = *(const PG8_LAS bf16x8*)(lds + PG8_SA(b, h) + aoff + m * 2048 + k * 1024); } while (0)
#define PG8_LDB(dst, b, h) do { _Pragma("unroll") for (int n = 0; n < 2; ++n) _Pragma("unroll") for (int k = 0; k < 2; ++k) dst[n][k] = *(const PG8_LAS bf16x8*)(lds + PG8_SB(b, h) + boff + n * 2048 + k * 1024); } while (0)
#define PG8_MMA(ai, bj, At, Bt) do { __builtin_amdgcn_s_setprio(1); _Pragma("unroll") for (int m = 0; m < 4; ++m) _Pragma("unroll") for (int n = 0; n < 2; ++n) _Pragma("unroll") for (int k = 0; k < 2; ++k) \
        { if constexpr (I8) acc[ai][bj][m][n] = __builtin_amdgcn_mfma_i32_16x16x64_i8(__builtin_bit_cast(i32x4, Bt[n][k]), __builtin_bit_cast(i32x4, At[m][k]), acc[ai][bj][m][n], 0, 0, 0); \
          else acc[ai][bj][m][n] = __builtin_amdgcn_mfma_f32_16x16x32_bf16(Bt[n][k], At[m][k], acc[ai][bj][m][n], 0, 0, 0); } __builtin_amdgcn_s_setprio(0); } while (0)
#define PG8_WAIT_V(n) asm volatile("s_waitcnt vmcnt(" #n ")" ::: "memory")
#define PG8_WAIT_L(n) asm volatile("s_waitcnt lgkmcnt(" #n ")" ::: "memory")
#define PG8_BAR __builtin_amdgcn_s_barrier()
#define PG8_SCHED __builtin_amdgcn_sched_barrier(0)
    Unit cur, nxt; int ui = 0;
    PG8_LAS unsigned* utab = (PG8_LAS unsigned*)(lds + PG8_AUX_OFF + 4096 + wid * 256);
    { Unit uu; const bool vv = S.next(lane, uu); utab[lane] = vv ? (0x80000000u | ((unsigned)uu.half << 24) | ((unsigned)uu.pn << 12) | (unsigned)uu.pm) : 0u; asm volatile("s_waitcnt lgkmcnt(0)" ::: "memory"); }
#define PG8_UNIT(I, U, OK) do { if ((I) < 64) { const unsigned w_ = (unsigned)__builtin_amdgcn_readfirstlane((int)utab[(I)]); OK = (w_ >> 31) != 0u; (U).pm = (int)(w_ & 0xfffu); (U).pn = (int)((w_ >> 12) & 0xfffu); (U).half = (int)((w_ >> 24) & 1u); } \
        else OK = S.next((I), (U)); } while (0)
    { bool ok0; PG8_UNIT(0, cur, ok0); if (!ok0) return; }
    typedef typename AccT<I8>::T acc_t; acc_t acc[2][2][4][2];
#pragma unroll
    for (int a = 0; a < 2; ++a)
#pragma unroll
        for (int b = 0; b < 2; ++b)
#pragma unroll
            for (int m = 0; m < 4; ++m)
#pragma unroll
                for (int n = 0; n < 2; ++n) acc[a][b][m][n] = (acc_t){0, 0, 0, 0};
    bf16x8 At[4][2], B0[2][2], B1[2][2];
    const char* cA = (const char*)g.A + (size_t)cur.pm * tstep + cur.half * koff; const char* cB = (const char*)g.Bt + (size_t)cur.pn * tstep + cur.half * koff;
    S.a_ready(cur);
    PG8_AUX_ISSUE(cur, 0);
    if constexpr (SP2) {
        PG8_STAGE(PG8_SB(0, 0), cB, voffB); PG8_STAGE(PG8_SB(0, 1), cB + hstep, voffB); PG8_STAGE(PG8_SA(0, 0), cA, voffA); PG8_STAGE(PG8_SA(0, 1), cA + hstep, voffA);
        if (wr == 1) PG8_BAR;
        PG8_WAIT_V(2); PG8_BAR;
        PG8_STAGE(PG8_SB(1, 0), cB + kstep, voffB); PG8_STAGE(PG8_SA(1, 0), cA + kstep, voffA); PG8_STAGE(PG8_SB(1, 1), cB + hstep + kstep, voffB);
        PG8_WAIT_V(6); PG8_BAR;
    } else {
        PG8_STAGE(PG8_SB(0, 0), cB, voffB); PG8_STAGE(PG8_SA(0, 0), cA, voffA); PG8_STAGE(PG8_SB(0, 1), cB + hstep, voffB); PG8_STAGE(PG8_SA(0, 1), cA + hstep, voffA);
        if (wr == 1) PG8_BAR;
        PG8_WAIT_V(4); PG8_BAR;
        PG8_STAGE(PG8_SB(1, 0), cB + kstep, voffB); PG8_STAGE(PG8_SA(1, 0), cA + kstep, voffA); PG8_STAGE(PG8_SB(1, 1), cB + hstep + kstep, voffB);
        PG8_WAIT_V(6); PG8_BAR;
    }
    for (;;) {
        bool has_next; PG8_UNIT(ui + 1, nxt, has_next);
        const char* nA = has_next ? (const char*)g.A + (size_t)nxt.pm * tstep + nxt.half * koff : cA; const char* nB = has_next ? (const char*)g.Bt + (size_t)nxt.pn * tstep + nxt.half * koff : cB;
        int t = 0;
        do {
            const bool last = (t == nt - 2);
            const char* a1 = cA + (size_t)(t + 1) * kstep;
            const char* a2 = last ? nA : cA + (size_t)(t + 2) * kstep; const char* b2 = last ? nB : cB + (size_t)(t + 2) * kstep;
            const char* a3 = a2 + kstep; const char* b3 = b2 + kstep;
            if (last && has_next) S.a_ready(nxt);
            if constexpr (SP2) {
            PG8_LDB(B0, 0, 0); PG8_LDB(B1, 0, 1); PG8_SCHED; PG8_LDA(At, 0, 0); PG8_STAGE(PG8_SA(1, 1), a1 + hstep, voffA);
            PG8_WAIT_V(8); PG8_WAIT_L(0); PG8_BAR; PG8_MMA(0, 0, At, B0); PG8_MMA(0, 1, At, B1); PG8_BAR; PG8_SCHED;
            PG8_LDA(At, 0, 1); PG8_STAGE(PG8_SB(0, 0), b2, voffB); PG8_STAGE(PG8_SB(0, 1), b2 + hstep, voffB); PG8_STAGE(PG8_SA(0, 0), a2, voffA);
            PG8_WAIT_V(8); PG8_WAIT_L(0); PG8_BAR; PG8_MMA(1, 0, At, B0); PG8_MMA(1, 1, At, B1); PG8_BAR; PG8_SCHED;
            PG8_LDB(B0, 1, 0); PG8_LDB(B1, 1, 1); PG8_SCHED; PG8_LDA(At, 1, 0); PG8_STAGE(PG8_SA(0, 1), a2 + hstep, voffA);
            PG8_WAIT_V(8); PG8_WAIT_L(0); PG8_BAR; PG8_MMA(0, 0, At, B0); PG8_MMA(0, 1, At, B1); PG8_BAR; PG8_SCHED;
            PG8_LDA(At, 1, 1); PG8_STAGE(PG8_SB(1, 0), b3, voffB); PG8_STAGE(PG8_SB(1, 1), b3 + hstep, voffB); PG8_STAGE(PG8_SA(1, 0), a3, voffA);
            PG8_WAIT_V(8); PG8_WAIT_L(0); PG8_BAR; PG8_MMA(1, 0, At, B0); PG8_MMA(1, 1, At, B1); PG8_BAR; PG8_SCHED;
            } else {
            PG8_LDB(B0, 0, 0); PG8_SCHED; PG8_LDA(At, 0, 0); PG8_STAGE(PG8_SA(1, 1), a1 + hstep, voffA);
            PG8_WAIT_L(8); PG8_BAR; PG8_WAIT_L(0); PG8_MMA(0, 0, At, B0); PG8_BAR; PG8_SCHED;
            PG8_LDB(B1, 0, 1); PG8_STAGE(PG8_SB(0, 0), b2, voffB);
            PG8_BAR; PG8_WAIT_L(0); PG8_MMA(0, 1, At, B1); PG8_BAR;
            PG8_LDA(At, 0, 1); PG8_STAGE(PG8_SA(0, 0), a2, voffA);
            PG8_BAR; PG8_WAIT_L(0); PG8_MMA(1, 0, At, B0); PG8_BAR; PG8_SCHED;
            PG8_STAGE(PG8_SB(0, 1), b2 + hstep, voffB);
            PG8_WAIT_V(6); PG8_BAR; PG8_MMA(1, 1, At, B1); PG8_BAR;
            PG8_LDB(B0, 1, 0); PG8_SCHED; PG8_LDA(At, 1, 0); PG8_STAGE(PG8_SA(0, 1), a2 + hstep, voffA);
            PG8_WAIT_L(8); PG8_BAR; PG8_WAIT_L(0); PG8_MMA(0, 0, At, B0); PG8_BAR; PG8_SCHED;
            PG8_LDB(B1, 1, 1); PG8_STAGE(PG8_SB(1, 0), b3, voffB);
            PG8_BAR; PG8_WAIT_L(0); PG8_MMA(0, 1, At, B1); PG8_BAR;
            PG8_LDA(At, 1, 1); PG8_STAGE(PG8_SA(1, 0), a3, voffA);
            PG8_BAR; PG8_WAIT_L(0); PG8_MMA(1, 0, At, B0); PG8_BAR; PG8_SCHED;
            PG8_STAGE(PG8_SB(1, 1), b3 + hstep, voffB);
            PG8_WAIT_V(6); PG8_BAR; PG8_MMA(1, 1, At, B1); PG8_BAR;
            }
            t += 2;
        } while (t < nt);
        if constexpr (ALIGN_EPI) { if (wr == 0) PG8_BAR; }
        if constexpr (Epi::HAS_MID) { if (cur.half == 0) E.mid(acc, cur, wr, wc, fr, fq); else E(acc, cur, wr, wc, fr, fq); }
        else if constexpr (Epi::AUX) { E(acc, cur, wr, wc, fr, fq, (const PG8_LAS float*)(auxl + (ui & 1) * 2048)); S.done(cur); if (has_next) PG8_AUX_ISSUE(nxt, (ui + 1) & 1); }
        else if constexpr (!Epi::AFTER_DRAIN) { E(acc, cur, wr, wc, fr, fq); S.done(cur); }
        if (!has_next) break;
        if (!(Epi::HAS_MID && nxt.half == 1)) {
            typedef unsigned long long u64x2_t __attribute__((ext_vector_type(2)));
            unsigned long long z64 = 0ull; asm volatile("" : "+v"(z64));
#pragma unroll
        for (int a = 0; a < 2; ++a)
#pragma unroll
            for (int b = 0; b < 2; ++b)
#pragma unroll
                for (int m = 0; m < 4; ++m)
#pragma unroll
                    for (int n = 0; n < 2; ++n) acc[a][b][m][n] = __builtin_bit_cast(acc_t, (u64x2_t){z64, z64});
        }
        cur = nxt; cA = nA; cB = nB; ++ui;
        if constexpr (ALIGN_EPI) { if (wr == 1) PG8_BAR; }
    }
    PG8_WAIT_V(0);
    if constexpr (!ALIGN_EPI) { if (wr == 0) PG8_BAR; }
    PG8_BAR;
    if constexpr (Epi::AFTER_DRAIN) { E.fused(acc, cur, wr, wc, fr, fq, lds, wid, lane); S.done(cur); }
#undef PG8_SA
#undef PG8_SB
#undef PG8_STAGE
#undef PG8_LDA
#undef PG8_LDB
#undef PG8_MMA
#undef PG8_WAIT_V
#undef PG8_UNIT
#undef PG8_AUX_ISSUE
#undef PG8_WAIT_L
#undef PG8_BAR
#undef PG8_SCHED
}
}
#ifndef PG8_SP2
#define PG8_SP2 true
#endif
#ifndef PG8_ALIGN
#define PG8_ALIGN true
#endif
constexpr int NWAVES = 8;
constexpr int BATCH = 4, SEQ = 8192, D = 1024, FF = 2816, NGU = 2 * FF, NIN = 5632, PLE = 256;
constexpr int M = BATCH * SEQ;
constexpr int MBH = 8, MBD = 64, MBW = 512, MBB = 256, NBLK = SEQ / MBB;
constexpr int HGH = 4, HGD_ = 128, HGW = 512, HGC = 256, HGNC = SEQ / HGC;
constexpr float EPS = 1e-6f;
constexpr size_t MiB = 1u << 20;
constexpr size_t WS_CTL = 0, CTL_ZERO_BYTES = 1 * MiB;
constexpr size_t WS_KMEAN = 512 * 1024;
constexpr size_t WS_LB = 768 * 1024, WS_BIAST = 772 * 1024;
constexpr size_t WS_WGU1 = 1 * MiB, WS_WD1 = 12 * MiB, WS_WIN = WS_WD1 + 5632 * 1024, WS_WA = WS_WIN + 11 * MiB, WS_WB = WS_WA + 1 * MiB, WS_WOUT = WS_WB + 1 * MiB,
                 WS_WGU2 = WS_WOUT + 2 * MiB, WS_WD2 = WS_WGU2 + 11 * MiB, WS_WPLE = WS_WD2 + 5632 * 1024, WS_WPG = WS_WPLE + 512 * 1024, WS_HGD = WS_WPG + 2 * MiB;
constexpr size_t WS_CMAX = 128 * 1024;
constexpr int CM_GU1 = 0, CM_GU2 = 5632, CM_IN = 11264, CM_PG = 11264 + 5120;
constexpr size_t WS_DYN = 64 * 1024;
constexpr size_t WS_CNT = 256 * 1024;
constexpr size_t WS_A = 52 * MiB;
constexpr size_t WS_Q = WS_A, WS_K = WS_A + 32 * MiB, WS_VT = WS_A + 64 * MiB, WS_HQ = WS_A + 96 * MiB, WS_HI = WS_A + 128 * MiB;
constexpr size_t WS_LIST = 212 * MiB;
constexpr size_t WS_PB = 228 * MiB;
constexpr size_t WS_SB = 228 * MiB;
constexpr size_t WS_RS = 300 * MiB;
constexpr size_t WS_R2 = WS_RS + 128 * 1024;
constexpr size_t WS_W8IN = WS_WIN + 1 * MiB;
constexpr size_t WS_X8B = WS_A + 64 * MiB;
constexpr size_t WS_PML = 292 * MiB;
constexpr size_t WS_B = 320 * MiB;
constexpr size_t WS_KIN = WS_B, WS_HG = WS_B + 32 * MiB, WS_SA = WS_B + 64 * MiB;
constexpr size_t WS_C = 448 * MiB;
constexpr size_t WS_OAB = WS_C;
constexpr size_t WS_PO0 = 260 * MiB, WS_PO1 = 416 * MiB, WS_PO3B = 302 * MiB;
constexpr size_t WS_END = 512 * MiB;
static_assert(WS_HGD + 256 * 1024 <= WS_A, "weights region");
constexpr int LIST_PER_BH = 126976;
constexpr int CW_TMO = 0, CW_CODE = 1, CW_BAR = 4096;
constexpr int RING_OFF = 0, RING_BYTES = 131072, LDSCTL_OFF = RING_BYTES, MISC_OFF = LDSCTL_OFF + 320, LDS_BYTES = 147456;
#define GAS __attribute__((address_space(1)))
#define LAS __attribute__((address_space(3)))
typedef unsigned short bf16;
typedef unsigned v4u __attribute__((ext_vector_type(4)));
typedef unsigned v2u __attribute__((ext_vector_type(2)));
typedef float f32x4 __attribute__((ext_vector_type(4)));
typedef GAS unsigned gu32;
#define RLX_AGENT __ATOMIC_RELAXED, __HIP_MEMORY_SCOPE_AGENT
#define LDS_WAIT() asm volatile("s_waitcnt lgkmcnt(0)" ::: "memory")
#define VM_WAIT() asm volatile("s_waitcnt vmcnt(0)" ::: "memory")
__device__ __forceinline__ unsigned f2bf(float f) { unsigned u = __builtin_bit_cast(unsigned, f); return (u + 0x7fffu + ((u >> 16) & 1u)) >> 16; }
__device__ __forceinline__ unsigned pk2(float lo, float hi) { return f2bf(lo) | (f2bf(hi) << 16); }
__device__ __forceinline__ float bflo(unsigned w) { return __uint_as_float(w << 16); }
__device__ __forceinline__ float bfhi(unsigned w) { return __uint_as_float(w & 0xffff0000u); }
__device__ __forceinline__ float wave_sum(float v) {
#pragma unroll
    for (int o = 1; o < 64; o <<= 1) v += __shfl_xor(v, o);
    return v;
}
__device__ __forceinline__ float wave_max(float v) {
#pragma unroll
    for (int o = 1; o < 64; o <<= 1) v = fmaxf(v, __shfl_xor(v, o));
    return v;
}
#define XB_TMO      128
#define XB_XCNT(j)  (256  + 64 * (j))
#define XB_XSUB(j)  (1280 + 64 * (j))
#define XB_XGEN(j)  (2304 + 64 * (j))
#define XB_TOP      3328
#define XB_TOPGEN   3392
#define XCD_BAR_WORDS 3456
#define XB_SPIN_CAP (1u << 18)

__device__ __forceinline__ unsigned xb_ld(unsigned* p)              { return __hip_atomic_load(p, __ATOMIC_RELAXED, __HIP_MEMORY_SCOPE_AGENT); }
__device__ __forceinline__ unsigned xb_add(unsigned* p, unsigned v) { return __hip_atomic_fetch_add(p, v, __ATOMIC_RELAXED, __HIP_MEMORY_SCOPE_AGENT); }
__device__ __forceinline__ unsigned xb_xcc_id() { return (unsigned)__builtin_amdgcn_s_getreg((3 << 11) | 20) & 0xFu; }
#define XB_SPIN(cond, bar) do { unsigned _sp = 0; while (cond) { __builtin_amdgcn_s_sleep(1); \
    if ((++_sp & 255u) == 0u) { if (xb_ld(&(bar)[XB_TMO])) break; if (_sp > XB_SPIN_CAP) { atomicAdd(&(bar)[XB_TMO], 1u); break; } } } } while (0)

struct XcdBarrier {
    unsigned* bar; unsigned x;
    volatile LAS unsigned* st;
};

__device__ __forceinline__ XcdBarrier xcd_barrier_post(unsigned* bar, volatile LAS unsigned* st) {
    XcdBarrier b; b.bar = bar; b.x = xb_xcc_id(); b.st = st;
    if (threadIdx.x == 0) (void)xb_add(&bar[XB_XCNT(b.x)], 1u);
    return b;
}
__device__ __forceinline__ void xcd_barrier_complete(unsigned* bar, unsigned x, unsigned& nloc, unsigned& nx) {
    const unsigned G = gridDim.x * gridDim.y * gridDim.z;
    unsigned sum, cnt, mine, sp = 0u;
    for (;;) {
        sum = 0u; cnt = 0u; mine = 0u;
#pragma unroll
        for (unsigned j = 0; j < 16; ++j) { const unsigned c = xb_ld(&bar[XB_XCNT(j)]); sum += c; cnt += (c > 0u) ? 1u : 0u; mine = (j == x) ? c : mine; }
        if (sum == G) break;
        __builtin_amdgcn_s_sleep(1);
        if ((++sp & 255u) == 0u) { if (xb_ld(&bar[XB_TMO])) break; if (sp > XB_SPIN_CAP) { atomicAdd(&bar[XB_TMO], 1u); break; } }
    }
    nloc = mine > 0u ? mine : 1u; nx = cnt > 0u ? cnt : 1u;
}

__device__ __forceinline__ void xcd_barrier(const XcdBarrier& b) {
    asm volatile("s_waitcnt vmcnt(0)" ::: "memory");
    __syncthreads();
    if (threadIdx.x == 0) {
        unsigned* bar = b.bar;
        __builtin_amdgcn_s_waitcnt(0);
        unsigned nloc = b.st[0], nx = b.st[1];
        if (nloc == 0u) { xcd_barrier_complete(bar, b.x, nloc, nx); b.st[0] = nloc; b.st[1] = nx; }
        const unsigned old = xb_add(&bar[XB_XSUB(b.x)], 1u);
        const unsigned gen = old / nloc;
        if (old + 1u == (gen + 1u) * nloc) {
            __builtin_amdgcn_fence(__ATOMIC_RELEASE, "agent");
            asm volatile("s_waitcnt vmcnt(0)" ::: "memory");
            const unsigned og = xb_add(&bar[XB_TOP], 1u);
            const unsigned tg = og / nx;
            if (og + 1u == (tg + 1u) * nx) xb_add(&bar[XB_TOPGEN], 1u);
            else XB_SPIN(xb_ld(&bar[XB_TOPGEN]) == tg, bar);
            __builtin_amdgcn_fence(__ATOMIC_ACQUIRE, "agent");
            xb_add(&bar[XB_XGEN(b.x)], 1u);
            asm volatile("s_waitcnt vmcnt(0)" ::: "memory");
        } else {
            XB_SPIN(xb_ld(&bar[XB_XGEN(b.x)]) == gen, bar);
            __builtin_amdgcn_fence(__ATOMIC_ACQUIRE, "agent");
            asm volatile("s_waitcnt vmcnt(0)" ::: "memory");
        }
    }
    __syncthreads();
}
__device__ __forceinline__ int inb_row(int n0) { if (n0 < 512) return n0; return -1; }
__device__ __forceinline__ int in8_row(int n0) { if (n0 >= 3584) return n0 - 3584; if (n0 >= 1536) return 2048 + (n0 - 1536); if (n0 >= 1024) return 4608 + (n0 - 1024); if (n0 >= 512) return 4096 + (n0 - 512); return -1; }
__device__ __forceinline__ int map_row(int mode, int n0);
__device__ __forceinline__ void p0_transpose_item(const float* W, int K, int N, bf16* WT, const float* gain, int mode, LAS float* scr, int item, int lane, int ldo = 0) {
    if (ldo == 0) ldo = K;
    const int nblk = N / 32, kb = item / nblk, nb = item % nblk, k0 = 64 * kb, n0 = 32 * nb;
#pragma unroll 4
    for (int i = 0; i < 32; ++i) { const int kk = 2 * i + (lane >> 5); float w = W[(size_t)(k0 + kk) * N + n0 + (lane & 31)]; if (gain) w *= gain[k0 + kk]; scr[kk * 33 + (lane & 31)] = w; }
    LDS_WAIT(); asm volatile("" ::: "memory");
    int rbase = n0;
    if (mode == 1) { if (n0 < FF) rbase = (n0 / 128) * 256 + (n0 % 128); else { const int j = n0 - FF; rbase = (j / 128) * 256 + 128 + (j % 128); } }
    if (mode == 3) rbase = inb_row(n0);
    const int c = lane & 7;
#pragma unroll
    for (int j = 0; j < 4; ++j) { const int n = (lane >> 3) + 8 * j; const LAS float* s = scr + (8 * c) * 33 + n;
        v4u o; o.x = pk2(s[0 * 33], s[1 * 33]); o.y = pk2(s[2 * 33], s[3 * 33]); o.z = pk2(s[4 * 33], s[5 * 33]); o.w = pk2(s[6 * 33], s[7 * 33]);
        *(GAS v4u*)(WT + (size_t)(rbase + n) * ldo + k0 + 8 * c) = o; }
    LDS_WAIT(); asm volatile("" ::: "memory");
}
__device__ __forceinline__ int gu_row(int n0) { if (n0 < FF) return (n0 / 128) * 256 + (n0 % 128); const int j = n0 - FF; return (j / 128) * 256 + 128 + (j % 128); }
__device__ __forceinline__ int map_row(int mode, int n0) { return mode == 1 ? gu_row(n0) : mode == 3 ? in8_row(n0) : n0; }
__device__ __forceinline__ void p0_colmax_item(const float* W, int N, const float* gain, unsigned* CMAXB, int mode, int item, int lane) {
    const int nblk = N / 32, kb = item / nblk, nb = item % nblk, k0 = 64 * kb, n0 = 32 * nb; float mx = 0.f;
#pragma unroll 8
    for (int i = 0; i < 32; ++i) { const int kk = 2 * i + (lane >> 5); mx = fmaxf(mx, fabsf(W[(size_t)(k0 + kk) * N + n0 + (lane & 31)] * (gain ? gain[k0 + kk] : 1.0f))); }
    mx = fmaxf(mx, __shfl_xor(mx, 32));
    if (lane < 32) atomicMax(CMAXB + map_row(mode, n0) + lane, __float_as_uint(mx));
}
__device__ __forceinline__ void p0_quant_item(const float* W, int N, const float* gain, const float* CMAX, signed char* W8, int K, int mode, LAS float* scr, int item, int lane) {
    const int nblk = N / 32, kb = item / nblk, nb = item % nblk, k0 = 64 * kb, n0 = 32 * nb, rbase = map_row(mode, n0);
    if (rbase < 0) return;
    const float inv = 127.0f / fmaxf(CMAX[rbase + (lane & 31)], 1e-30f);
#pragma unroll 8
    for (int i = 0; i < 32; ++i) { const int kk = 2 * i + (lane >> 5); scr[kk * 33 + (lane & 31)] = rintf(W[(size_t)(k0 + kk) * N + n0 + (lane & 31)] * (gain ? gain[k0 + kk] : 1.0f) * inv); }
    LDS_WAIT(); asm volatile("" ::: "memory");
    const int c = lane & 3;
#pragma unroll
    for (int j = 0; j < 2; ++j) { const int n = (lane >> 2) + 16 * j; const LAS float* sp = scr + (16 * c) * 33 + n; unsigned w[4];
#pragma unroll
        for (int q = 0; q < 4; ++q) { const int b0 = (int)sp[(4 * q) * 33], b1 = (int)sp[(4 * q + 1) * 33], b2 = (int)sp[(4 * q + 2) * 33], b3 = (int)sp[(4 * q + 3) * 33];
            w[q] = (unsigned)(b0 & 255) | ((unsigned)(b1 & 255) << 8) | ((unsigned)(b2 & 255) << 16) | ((unsigned)(b3 & 255) << 24); }
        *(GAS v4u*)(W8 + (size_t)(rbase + n) * K + k0 + 16 * c) = (v4u){w[0], w[1], w[2], w[3]}; }
    LDS_WAIT(); asm volatile("" ::: "memory");
}
__device__ __forceinline__ void p0_quant_block(const float* W, int N, const float* gain, float* CMAX, signed char* W8, int mode, int n0, LAS float* scr, LAS float* cm, int wave, int lane) {
    const int rbase = map_row(mode, n0); float mx = 0.f;
    LAS float* gl = scr + 64 * 33;
    gl[lane] = gain ? gain[128 * wave + lane] : 1.0f; gl[64 + lane] = gain ? gain[128 * wave + 64 + lane] : 1.0f;
    const unsigned voff = (unsigned)((lane >> 5) * N + n0 + (lane & 31));
    float wv[2][32];
#pragma unroll
    for (int sl = 0; sl < 2; ++sl)
#pragma unroll
        for (int i = 0; i < 32; ++i) { const float* rp = W + (size_t)(64 * (2 * wave + sl) + 2 * i) * N; wv[sl][i] = rp[voff]; }
    LDS_WAIT(); asm volatile("" ::: "memory");
#pragma unroll
    for (int sl = 0; sl < 2; ++sl)
#pragma unroll
        for (int i = 0; i < 32; ++i) { wv[sl][i] *= gl[sl * 64 + 2 * i + (lane >> 5)]; mx = fmaxf(mx, fabsf(wv[sl][i])); }
    mx = fmaxf(mx, __shfl_xor(mx, 32));
    __syncthreads();
    if (lane < 32) cm[wave * 32 + lane] = mx;
    __syncthreads();
    float cmx = 0.f;
#pragma unroll
    for (int w = 0; w < 8; ++w) cmx = fmaxf(cmx, cm[w * 32 + (lane & 31)]);
    if (wave == 0 && lane < 32) CMAX[rbase + lane] = cmx;
    const float inv = 127.0f / fmaxf(cmx, 1e-30f);
#pragma unroll
    for (int sl = 0; sl < 2; ++sl) { const int k0 = 64 * (2 * wave + sl);
#pragma unroll
        for (int i = 0; i < 32; ++i) { const int kk = 2 * i + (lane >> 5); scr[kk * 33 + (lane & 31)] = rintf(wv[sl][i] * inv); }
        LDS_WAIT(); asm volatile("" ::: "memory");
        const int c = lane & 3;
#pragma unroll
        for (int j = 0; j < 2; ++j) { const int n = (lane >> 2) + 16 * j; const LAS float* sp = scr + (16 * c) * 33 + n; unsigned w[4];
#pragma unroll
            for (int q = 0; q < 4; ++q) { const int b0 = (int)sp[(4 * q) * 33], b1 = (int)sp[(4 * q + 1) * 33], b2 = (int)sp[(4 * q + 2) * 33], b3 = (int)sp[(4 * q + 3) * 33];
                w[q] = (unsigned)(b0 & 255) | ((unsigned)(b1 & 255) << 8) | ((unsigned)(b2 & 255) << 16) | ((unsigned)(b3 & 255) << 24); }
            *(GAS v4u*)(W8 + (size_t)(rbase + n) * 1024 + k0 + 16 * c) = (v4u){w[0], w[1], w[2], w[3]}; }
        LDS_WAIT(); asm volatile("" ::: "memory"); }
}
__device__ __forceinline__ void row_to_i8(const f32x4 (&v)[4], float rstd, signed char* orow, float* rs, int lane) {
    float mx = 0.f;
#pragma unroll
    for (int j = 0; j < 4; ++j) mx = fmaxf(fmaxf(mx, fmaxf(fabsf(v[j].x), fabsf(v[j].y))), fmaxf(fabsf(v[j].z), fabsf(v[j].w)));
    mx = fmaxf(wave_max(mx), 1e-30f); const float inv = 127.0f / mx;
    GAS unsigned* o4 = (GAS unsigned*)orow + lane;
#pragma unroll
    for (int j = 0; j < 4; ++j) { const int b0 = (int)rintf(v[j].x * inv), b1 = (int)rintf(v[j].y * inv), b2 = (int)rintf(v[j].z * inv), b3 = (int)rintf(v[j].w * inv);
        o4[64 * j] = (unsigned)(b0 & 255) | ((unsigned)(b1 & 255) << 8) | ((unsigned)(b2 & 255) << 16) | ((unsigned)(b3 & 255) << 24); }
    if (lane == 0) *rs = mx * rstd * (1.0f / 127.0f);
}
__device__ __forceinline__ void rms_row_to_i8(const float* xrow, signed char* orow, float* rs, int lane) {
    const GAS f32x4* xr = (const GAS f32x4*)xrow + lane;
    f32x4 v[4]; float s = 0.f;
#pragma unroll
    for (int j = 0; j < 4; ++j) { v[j] = xr[64 * j]; s += (v[j].x * v[j].x + v[j].y * v[j].y) + (v[j].z * v[j].z + v[j].w * v[j].w); }
    const float rstd = 1.f / sqrtf(wave_sum(s) * (1.f / D) + EPS);
    row_to_i8(v, rstd, orow, rs, lane);
}
__device__ __forceinline__ void rms_row_to_bf16(const float* xrow, bf16* orow, int lane) {
    const GAS f32x4* xr = (const GAS f32x4*)xrow + lane;
    f32x4 v[4]; float s = 0.f;
#pragma unroll
    for (int j = 0; j < 4; ++j) { v[j] = xr[64 * j]; s += (v[j].x * v[j].x + v[j].y * v[j].y) + (v[j].z * v[j].z + v[j].w * v[j].w); }
    const float rstd = 1.f / sqrtf(wave_sum(s) * (1.f / D) + EPS);
    GAS unsigned long long* o8 = (GAS unsigned long long*)orow + lane;
#pragma unroll
    for (int j = 0; j < 4; ++j) o8[64 * j] = (unsigned long long)pk2(v[j].x * rstd, v[j].y * rstd) | ((unsigned long long)pk2(v[j].z * rstd, v[j].w * rstd) << 32);
}
struct Ptrs {
    const float *x, *p, *w_gu1, *w_d1, *w_in, *w_a, *w_b, *w_out, *w_gu2, *w_d2, *w_ple, *w_pg, *gains, *hgw, *lbp, *rel;
    float* out; unsigned char* ws;
};
template <int STAGE> __device__ __forceinline__ void p0_prologue(const Ptrs P, LAS unsigned char* lds, int gw, int NGW, int wave, int lane, int vcu, int G) {
    LAS float* scr = (LAS float*)(lds + RING_OFF + wave * 16384); LAS float* cm = (LAS float*)(lds + RING_OFF + 130048);
    unsigned char* ws = P.ws; float* CM = (float*)(ws + WS_CMAX);
    constexpr int I_D = (FF / 64) * (D / 32), I_IN = (D / 64) * (NIN / 32), I_AB = (512 / 64) * (D / 32), I_O = (D / 64) * (D / 32), I_PLE = (PLE / 64) * (D / 32);
    if (STAGE == 0) {
        for (int id = vcu; id < 176 + 160; id += G) {
            if (id < 176) p0_quant_block(P.w_gu1, NGU, P.gains + 0 * D, CM + CM_GU1, (signed char*)(ws + WS_WGU1), 1, 32 * id, scr, cm, wave, lane);
            else { const int n0 = 512 + 32 * (id - 176);   p0_quant_block(P.w_in, NIN, P.gains + 2 * D, CM + CM_IN, (signed char*)(ws + WS_W8IN), 3, n0, scr, cm, wave, lane); }
        }
        for (int it = gw; it < I_IN + I_D; it += NGW) {
            int r = it;
            if (r < I_IN) { const int n0 = 32 * (r % (NIN / 32)); if (inb_row(n0) >= 0) p0_transpose_item(P.w_in, D, NIN, (bf16*)(ws + WS_WIN), P.gains + 2 * D, 3, scr, r, lane); continue; } r -= I_IN;
            p0_transpose_item(P.w_d1, FF, D, (bf16*)(ws + WS_WD1), nullptr, 0, scr, r, lane);
        }
    } else {
        for (int id = vcu; id < 176 + 32; id += G) {
            if (id < 176) p0_quant_block(P.w_gu2, NGU, P.gains + 4 * D, CM + CM_GU2, (signed char*)(ws + WS_WGU2), 1, 32 * id, scr, cm, wave, lane);
            else p0_quant_block(P.w_pg, D, nullptr, CM + CM_PG, (signed char*)(ws + WS_WPG), 0, 32 * (id - 176), scr, cm, wave, lane);
        }
        for (int it = gw; it < I_D + 2 * I_AB + I_O + I_PLE; it += NGW) {
            int r = it;
            if (r < I_D)  { p0_transpose_item(P.w_d2, FF, D, (bf16*)(ws + WS_WD2), nullptr, 0, scr, r, lane); continue; } r -= I_D;
            if (r < I_AB) { p0_transpose_item(P.w_a, 512, D, (bf16*)(ws + WS_WA), nullptr, 0, scr, r, lane, 1024); continue; } r -= I_AB;
            if (r < I_AB) { p0_transpose_item(P.w_b, 512, D, (bf16*)(ws + WS_WA) + 512, nullptr, 0, scr, r, lane, 1024); continue; } r -= I_AB;
            if (r < I_O)  { p0_transpose_item(P.w_out, D, D, (bf16*)(ws + WS_WOUT), nullptr, 0, scr, r, lane); continue; } r -= I_O;
            p0_transpose_item(P.w_ple, PLE, D, (bf16*)(ws + WS_WPLE), nullptr, 0, scr, r, lane);
        }
        return;
    }
    { unsigned* dyn = (unsigned*)(ws + WS_DYN); LAS unsigned* nxs = (LAS unsigned*)(lds + RING_OFF + 12288);     const bool t0 = (wave == 0 && lane == 0);
      if (t0) nxs[0] = atomicAdd(dyn, 1u);
      __syncthreads();
      unsigned c = __builtin_amdgcn_readfirstlane(nxs[0]); int par = 1;
      while (c < (unsigned)(M / 16)) {
        unsigned nxt = 0; if (t0) nxt = atomicAdd(dyn, 1u);
        f32x4 v[2][4]; float s[2] = {0.f, 0.f}; const int m0 = (int)c * 16 + wave * 2;
#pragma unroll
        for (int u = 0; u < 2; ++u) { const GAS f32x4* xr = (const GAS f32x4*)(P.x + (size_t)(m0 + u) * D) + lane;
#pragma unroll
            for (int j = 0; j < 4; ++j) v[u][j] = xr[64 * j]; }
#pragma unroll
        for (int u = 0; u < 2; ++u) {
#pragma unroll
            for (int j = 0; j < 4; ++j) s[u] += (v[u][j].x * v[u][j].x + v[u][j].y * v[u][j].y) + (v[u][j].z * v[u][j].z + v[u][j].w * v[u][j].w);
            const int m = m0 + u; const float rstd = 1.f / sqrtf(wave_sum(s[u]) * (1.f / D) + EPS);
            row_to_i8(v[u], rstd, (signed char*)(ws + WS_C) + (size_t)m * D, (float*)(ws + WS_RS) + m, lane); }
        if (t0) nxs[par] = nxt;
        __syncthreads();
        c = __builtin_amdgcn_readfirstlane(nxs[par]); par ^= 1;
      }
    }
    const int gt = gw * 64 + lane;
    if (gt < 512) { const float a = P.lbp[gt], b = P.lbp[512 + gt]; const float mx = fmaxf(a, b); const float ea = expf(a - mx), eb = expf(b - mx); ((float*)(ws + WS_LB))[gt] = ea / (ea + eb); }
    if (gt >= 1024 && gt < 2048) { const int h = (gt - 1024) >> 7, d = (gt - 1024) & 127; int bk;
        if (d < 16) bk = d; else { bk = 16 + (int)(logf((float)d / 16.0f) / logf(8.0f) * 16.0f); if (bk > 31) bk = 31; }
        ((float*)(ws + WS_BIAST))[h * 128 + d] = P.rel[bk * 8 + h]; }
}
template <int STAGE> __device__ __forceinline__ void p0b_quant_phase(const Ptrs P, LAS unsigned char* lds, int gw, int NGW, int wave, int lane) {
    LAS float* scr = (LAS float*)(lds + RING_OFF + wave * 16384); unsigned char* ws = P.ws; const float* CM = (const float*)(ws + WS_CMAX);
    constexpr int I_GU = (D / 64) * (NGU / 32), I_IN = (D / 64) * (NIN / 32), I_O = (D / 64) * (D / 32);
    if (STAGE == 0) {
        for (int it = gw; it < I_GU + I_IN; it += NGW) {
            if (it < I_GU) p0_quant_item(P.w_gu1, NGU, P.gains + 0 * D, CM + CM_GU1, (signed char*)(ws + WS_WGU1), D, 1, scr, it, lane);
            else p0_quant_item(P.w_in, NIN, P.gains + 2 * D, CM + CM_IN, (signed char*)(ws + WS_W8IN), D, 3, scr, it - I_GU, lane);
        }
    } else {
        for (int it = gw; it < I_GU + I_O; it += NGW) {
            if (it < I_GU) p0_quant_item(P.w_gu2, NGU, P.gains + 4 * D, CM + CM_GU2, (signed char*)(ws + WS_WGU2), D, 1, scr, it, lane);
            else p0_quant_item(P.w_pg, D, nullptr, CM + CM_PG, (signed char*)(ws + WS_WPG), D, 0, scr, it - I_GU, lane);
        }
    }
}
template <bool HIN_F32, int OMODE, bool YQ = false> __device__ __forceinline__ void rowwise_phase(int gw, int NGW, int lane, const void* hin, const bf16* Y, const float* gain, float coef, bf16* hb, bf16* xn, float* outf, const float* ysc = nullptr) {
    f32x4 g[4];
#pragma unroll
    for (int j = 0; j < 4; ++j) g[j] = ((const f32x4*)gain)[lane + 64 * j] * coef;
    for (int m0 = gw; m0 < M; m0 += 2 * NGW) {
        f32x4 y[2][4], h[2][4]; float s[2] = {0.f, 0.f};
#pragma unroll
        for (int u = 0; u < 2; ++u) { const int m = m0 + u * NGW;
            if (YQ) { const GAS unsigned* yq = (const GAS unsigned*)((const unsigned char*)Y + (size_t)m * D) + lane; const GAS float* ys = (const GAS float*)ysc + (size_t)m * 32 + (lane >> 3);
#pragma unroll
                for (int j = 0; j < 4; ++j) { const unsigned w = yq[64 * j]; const float sc = ys[8 * j];
                    y[u][j] = (f32x4){(float)(signed char)(w & 255u) * sc, (float)(signed char)((w >> 8) & 255u) * sc, (float)(signed char)((w >> 16) & 255u) * sc, (float)(signed char)(w >> 24) * sc}; } }
            else { const GAS v2u* yr = (const GAS v2u*)(Y + (size_t)m * D) + lane;
#pragma unroll
            for (int j = 0; j < 4; ++j) { const v2u w = yr[64 * j]; y[u][j] = (f32x4){bflo(w.x), bfhi(w.x), bflo(w.y), bfhi(w.y)}; } }
            if (HIN_F32) { const GAS f32x4* hr = (const GAS f32x4*)((const float*)hin + (size_t)m * D) + lane;
#pragma unroll
                for (int j = 0; j < 4; ++j) h[u][j] = hr[64 * j]; }
            else { const GAS v2u* hr = (const GAS v2u*)((const bf16*)hin + (size_t)m * D) + lane;
#pragma unroll
                for (int j = 0; j < 4; ++j) { const v2u w = hr[64 * j]; h[u][j] = (f32x4){bflo(w.x), bfhi(w.x), bflo(w.y), bfhi(w.y)}; } }
        }
#pragma unroll
        for (int u = 0; u < 2; ++u)
#pragma unroll
            for (int j = 0; j < 4; ++j) s[u] += (y[u][j].x * y[u][j].x + y[u][j].y * y[u][j].y) + (y[u][j].z * y[u][j].z + y[u][j].w * y[u][j].w);
#pragma unroll
        for (int u = 0; u < 2; ++u) { const int m = m0 + u * NGW;
            const float rstd = 1.f / sqrtf(wave_sum(s[u]) * (1.f / D) + EPS);
            float s2 = 0.f;
#pragma unroll
            for (int j = 0; j < 4; ++j) { h[u][j] = h[u][j] + (g[j] * y[u][j]) * rstd; s2 += (h[u][j].x * h[u][j].x + h[u][j].y * h[u][j].y) + (h[u][j].z * h[u][j].z + h[u][j].w * h[u][j].w); }
            if (OMODE == 3) { GAS f32x4* ho = (GAS f32x4*)(outf + (size_t)m * D) + lane;
#pragma unroll
                for (int j = 0; j < 4; ++j) ho[64 * j] = h[u][j]; }
            if (OMODE == 1 || OMODE == 4 || OMODE == 5 || OMODE == 6) { GAS v2u* ho = (GAS v2u*)(hb + (size_t)m * D) + lane;
#pragma unroll
                for (int j = 0; j < 4; ++j) ho[64 * j] = (v2u){pk2(h[u][j].x, h[u][j].y), pk2(h[u][j].z, h[u][j].w)}; }
            if (OMODE == 4 || OMODE == 5) { const float r2 = 1.f / sqrtf(wave_sum(s2) * (1.f / D) + EPS); row_to_i8(h[u], r2, (signed char*)xn + (size_t)m * D, outf + m, lane); if (OMODE == 5 && lane == 0) outf[32768 + m] = r2; }
            if (OMODE == 6 || OMODE == 7) row_to_i8(h[u], 1.0f, (signed char*)xn + (size_t)m * D, outf + m, lane);
            if (OMODE == 1 || OMODE == 2) {
                float r2 = 1.f;
                if (OMODE == 1) r2 = 1.f / sqrtf(wave_sum(s2) * (1.f / D) + EPS);
                GAS v2u* o8 = (GAS v2u*)(xn + (size_t)m * D) + lane;
#pragma unroll
                for (int j = 0; j < 4; ++j) o8[64 * j] = (v2u){pk2(h[u][j].x * r2, h[u][j].y * r2), pk2(h[u][j].z * r2, h[u][j].w * r2)};
            }
        }
    }
}
__device__ __forceinline__ void rowwise_final_phase(int gw, int NGW, int lane, const bf16* H2, const bf16* F8, const float* fsc, const float* g5, const bf16* Y2, const float* g6, float* out) {
    f32x4 ga[4], gb[4];
#pragma unroll
    for (int j = 0; j < 4; ++j) { ga[j] = ((const f32x4*)g5)[lane + 64 * j] * 0.5f; gb[j] = ((const f32x4*)g6)[lane + 64 * j]; }
    for (int m0 = gw; m0 < M; m0 += 2 * NGW) {
        f32x4 f[2][4], h[2][4], y[2][4];
#pragma unroll
        for (int u = 0; u < 2; ++u) { const int m = m0 + u * NGW;
            const GAS unsigned* fq = (const GAS unsigned*)((const unsigned char*)F8 + (size_t)m * D) + lane; const GAS float* fs = (const GAS float*)fsc + (size_t)m * 32 + (lane >> 3);
            const GAS v2u* hr = (const GAS v2u*)(H2 + (size_t)m * D) + lane; const GAS v2u* yr = (const GAS v2u*)(Y2 + (size_t)m * D) + lane;
#pragma unroll
            for (int j = 0; j < 4; ++j) { const unsigned w = fq[64 * j]; const float sc = fs[8 * j];
                f[u][j] = (f32x4){(float)(signed char)(w & 255u) * sc, (float)(signed char)((w >> 8) & 255u) * sc, (float)(signed char)((w >> 16) & 255u) * sc, (float)(signed char)(w >> 24) * sc};
                const v2u a = hr[64 * j]; h[u][j] = (f32x4){bflo(a.x), bfhi(a.x), bflo(a.y), bfhi(a.y)};
                const v2u b = yr[64 * j]; y[u][j] = (f32x4){bflo(b.x), bfhi(b.x), bflo(b.y), bfhi(b.y)}; }
        }
#pragma unroll
        for (int u = 0; u < 2; ++u) { const int m = m0 + u * NGW; float sf = 0.f, sy = 0.f;
#pragma unroll
            for (int j = 0; j < 4; ++j) { sf += (f[u][j].x * f[u][j].x + f[u][j].y * f[u][j].y) + (f[u][j].z * f[u][j].z + f[u][j].w * f[u][j].w); sy += (y[u][j].x * y[u][j].x + y[u][j].y * y[u][j].y) + (y[u][j].z * y[u][j].z + y[u][j].w * y[u][j].w); }
            const float rf = 1.f / sqrtf(wave_sum(sf) * (1.f / D) + EPS), ry = 1.f / sqrtf(wave_sum(sy) * (1.f / D) + EPS);
            GAS f32x4* ho = (GAS f32x4*)(out + (size_t)m * D) + lane;
#pragma unroll
            for (int j = 0; j < 4; ++j) ho[64 * j] = (h[u][j] + (ga[j] * f[u][j]) * rf) + (gb[j] * y[u][j]) * ry;
        }
    }
}
__device__ __forceinline__ int moba_list_base(int bh, int j) { return bh * LIST_PER_BH + 256 * (31 * j - (j * (j - 1)) / 2); }
__device__ __forceinline__ void moba_gating_phase(LAS unsigned char* lds, int vcu, int G, int tid, const bf16* Q, const float* KMEAN, unsigned* CNT, unsigned* LIST) {
    LAS float* km = (LAS float*)lds;
    const int lane = tid & 63;
    for (int unit = vcu; unit < BATCH * NBLK * 4; unit += G) {
        const int hp = unit & 3, b = unit >> 7; int i = (unit >> 2) & 31; if (b & 2) i = 31 - i;
        const int hh = __builtin_amdgcn_readfirstlane(tid >> 8), ql = tid & 255, m = b * SEQ + i * MBB + ql, h = 2 * hp + hh;
        v4u qw[8];
        { const v4u* qp = (const v4u*)(Q + (size_t)m * MBW + h * MBD);
#pragma unroll
          for (int c = 0; c < 8; ++c) qw[c] = qp[c]; }
        __syncthreads();
        { float kv[8];
#pragma unroll
          for (int r = 0; r < 8; ++r) { const int e = tid + 512 * r, j = e >> 7, c = e & 127; kv[r] = (e < i * 128) ? KMEAN[(size_t)(b * NBLK + j) * 512 + hp * 128 + c] : 0.f; }
#pragma unroll
          for (int r = 0; r < 8; ++r) { const int e = tid + 512 * r; if (e < i * 128) km[e] = kv[r] * (1.0f / 256.0f); } }
        __syncthreads();
        float q[64];
        {
#pragma unroll
          for (int c = 0; c < 8; ++c) { const v4u w = qw[c]; q[8 * c + 0] = bflo(w.x); q[8 * c + 1] = bfhi(w.x); q[8 * c + 2] = bflo(w.y); q[8 * c + 3] = bfhi(w.y); q[8 * c + 4] = bflo(w.z); q[8 * c + 5] = bfhi(w.z); q[8 * c + 6] = bflo(w.w); q[8 * c + 7] = bfhi(w.w); } }
        float v0 = -INFINITY, v1 = -INFINITY, v2 = -INFINITY; int i0 = -1, i1 = -1, i2 = -1;
        for (int j = 0; j < i; ++j) {
            const LAS f32x4* kp = (const LAS f32x4*)(km + j * 128 + hh * 64); float s = 0.f;
#pragma unroll
            for (int c = 0; c < 16; ++c) { const f32x4 kv = kp[c]; s += q[4 * c] * kv.x; s += q[4 * c + 1] * kv.y; s += q[4 * c + 2] * kv.z; s += q[4 * c + 3] * kv.w; }
            if (s > v0) { v2 = v1; i2 = i1; v1 = v0; i1 = i0; v0 = s; i0 = j; }
            else if (s > v1) { v2 = v1; i2 = i1; v1 = s; i1 = j; }
            else if (s > v2) { v2 = s; i2 = j; }
        }
        const int bh = b * 8 + h; const unsigned tl = (unsigned)(i * MBB + ql); const unsigned long long lt = (1ull << lane) - 1ull;
        const bool nearq = (ql < 112);
        int totf = 0, totn = 0;
        for (int j = 0; j < i; ++j) {
            const bool nl = (j == i - 1) && nearq;
            const unsigned long long mf = __ballot((i0 == j || i1 == j || i2 == j) && !nl), mn = __ballot((i0 == j || i1 == j || i2 == j) && nl);
            if (lane == j) { totf = (int)__popcll(mf); totn = (int)__popcll(mn); }
        }
        unsigned basef = 0u, basen = 0u;
        if (lane < i && totf > 0) basef = atomicAdd(CNT + bh * 32 + lane, (unsigned)totf);
        if (lane < i && totn > 0) basen = atomicAdd(CNT + 1024 + bh * 32 + lane, (unsigned)totn);
        for (int j = 0; j < i; ++j) {
            const bool nl = (j == i - 1) && nearq;
            const unsigned bf_ = (unsigned)__shfl((int)basef, j), bn_ = (unsigned)__shfl((int)basen, j);
            const unsigned long long m0 = __ballot(i0 == j && !nl), m1 = __ballot(i1 == j && !nl), m2 = __ballot(i2 == j && !nl);
            const int c0 = (int)__popcll(m0), c1 = (int)__popcll(m1);
            unsigned* L = LIST + moba_list_base(bh, j) + bf_;
            if (i0 == j && !nl) L[(int)__popcll(m0 & lt)] = tl;
            if (i1 == j && !nl) L[c0 + (int)__popcll(m1 & lt)] = tl | (1u << 13);
            if (i2 == j && !nl) L[c0 + c1 + (int)__popcll(m2 & lt)] = tl | (2u << 13);
            if (j == i - 1) {
                const unsigned long long n0 = __ballot(i0 == j && nl), n1 = __ballot(i1 == j && nl), n2 = __ballot(i2 == j && nl);
                const int d0 = (int)__popcll(n0), d1 = (int)__popcll(n1);
                unsigned* LN = LIST + moba_list_base(bh, j) + (31 - j) * 256 - 1 - bn_;
                if (i0 == j && nl) LN[-(int)__popcll(n0 & lt)] = tl;
                if (i1 == j && nl) LN[-(d0 + (int)__popcll(n1 & lt))] = tl | (1u << 13);
                if (i2 == j && nl) LN[-(d0 + d1 + (int)__popcll(n2 & lt))] = tl | (2u << 13);
            }
        }
    }
    __syncthreads();
}
typedef float f32x16 __attribute__((ext_vector_type(16)));
typedef short bf16x8v __attribute__((ext_vector_type(8)));
typedef short s16x4v __attribute__((ext_vector_type(4)));
constexpr int IT_KS = 0, IT_VS = 32768, IT_VROW = 520, IT_TB = IT_VS + 64 * IT_VROW  , IT_TBN = 768, IT_INFO = IT_TB + 8 * IT_TBN * 4  , IT_STG = 91136  ;
__device__ __forceinline__ int crow16(int r, int hi) { return (r & 3) + 8 * (r >> 2) + 4 * hi; }
__device__ __forceinline__ void moba_pv_tile(const f32x16& st, int kt, int hi, int r32, const LAS unsigned char* vs, f32x16 (&o)[2]) {
#pragma unroll
    for (int s = 0; s < 2; ++s) {
        const unsigned w0 = pg8::cvt_pk_bf16(st[8 * s + 0], st[8 * s + 1]), w1 = pg8::cvt_pk_bf16(st[8 * s + 2], st[8 * s + 3]), w2 = pg8::cvt_pk_bf16(st[8 * s + 4], st[8 * s + 5]), w3 = pg8::cvt_pk_bf16(st[8 * s + 6], st[8 * s + 7]);
        const v4u w = {w0, w1, w2, w3}; const bf16x8v pf = __builtin_bit_cast(bf16x8v, w);
#pragma unroll
        for (int d = 0; d < 2; ++d) {
            const LAS unsigned char* vp = vs + (32 * d + r32) * IT_VROW + (32 * kt + 16 * s + 4 * hi) * 2;
            const s16x4v lo = *(const LAS s16x4v*)vp, hi4 = *(const LAS s16x4v*)(vp + 16);
            const bf16x8v va = {lo[0], lo[1], lo[2], lo[3], hi4[0], hi4[1], hi4[2], hi4[3]};
            o[d] = __builtin_amdgcn_mfma_f32_32x32x16_bf16(va, pf, o[d], 0, 0, 0);
        }
    }
}
__device__ __forceinline__ float moba_rowmax(const f32x16& st) {
    float ra = fmaxf(fmaxf(st[0], st[1]), st[2]), rb = fmaxf(fmaxf(st[3], st[4]), st[5]);
    ra = fmaxf(fmaxf(ra, st[6]), st[7]); rb = fmaxf(fmaxf(rb, st[8]), st[9]); ra = fmaxf(fmaxf(ra, st[10]), st[11]); rb = fmaxf(fmaxf(rb, st[12]), st[13]); ra = fmaxf(fmaxf(ra, st[14]), st[15]);
    const float rm = fmaxf(ra, rb); return fmaxf(rm, __shfl_xor(rm, 32));
}
__device__ __forceinline__ void moba_exp_sum(f32x16& st, float& lrun) {
    float ls = 0.f, ls2 = 0.f;
#pragma unroll
    for (int r = 0; r < 16; r += 2) { const float p0 = __builtin_amdgcn_exp2f(st[r]), p1 = __builtin_amdgcn_exp2f(st[r + 1]); st[r] = p0; st[r + 1] = p1; ls += p0; ls2 += p1;
        asm("" : "+v"(ls)); }
    lrun += ls + ls2;
}
__device__ __forceinline__ void moba_items_phase(LAS unsigned char* lds, int vcu, int G, int tid_in, int wave, int lane, const bf16* Q, const bf16* K, const bf16* VT, const unsigned* CNT, const unsigned* LIST,
                                                 const float* BIAST, bf16* PO0, bf16* PO1, bf16* PO2, bf16* PO3, bf16* PO3C, float* PML) {
    const int r32 = lane & 31, hi = lane >> 5; int tid = tid_in;
    LAS unsigned char* ks = lds + IT_KS; LAS unsigned char* vs = lds + IT_VS; LAS float* tball = (LAS float*)(lds + IT_TB); volatile LAS int* info = (volatile LAS int*)(lds + IT_INFO);
    __syncthreads();
    v4u cq[8];
#pragma unroll
    for (int e = 0; e < 8; ++e) cq[e] = (v4u){0u, 0u, 0u, 0u};
    if (wave == 0) {
#pragma unroll
        for (int e = 0; e < 4; ++e) { cq[e] = ((const v4u*)CNT)[4 * lane + e]; cq[4 + e] = ((const v4u*)(CNT + 1024))[4 * lane + e]; } }
    { float tv[8 * IT_TBN / 512];
#pragma unroll
      for (int r = 0; r < 8 * IT_TBN / 512; ++r) { const int e = tid + 512 * r, h_ = e / IT_TBN, d_ = 512 - (e % IT_TBN); tv[r] = BIAST[h_ * 128 + (d_ > 113 ? 113 : (d_ < 0 ? 0 : d_))]; }
#pragma unroll
      for (int r = 0; r < 8 * IT_TBN / 512; ++r) { const int e = tid + 512 * r, d_ = 512 - (e % IT_TBN); tball[e] = d_ < 0 ? -INFINITY : tv[r] * 1.4426950408889634f; } }
    if (wave == 0) {
        int loc[16]; int s = 0;
#pragma unroll
        for (int e = 0; e < 16; ++e) { const int nf = (int)cq[e >> 2][e & 3], nn = (int)cq[4 + (e >> 2)][e & 3]; loc[e] = 1 + ((((nf + 31) >> 5) + ((nn + 31) >> 5) + 7) >> 3); s += loc[e]; }
        int incl = s;
#pragma unroll
        for (int o = 1; o < 64; o <<= 1) { const int t = __shfl_up(incl, o); if (lane >= o) incl += t; }
        const int excl = incl - s, total = __shfl(incl, 63);
        const int c0 = (int)(((long)vcu * total) / G), c1 = (int)(((long)(vcu + 1) * total) / G);
        if (c0 >= excl && c0 < incl) { int acc = excl; bool done = false;
#pragma unroll
            for (int e = 0; e < 16; ++e) { if (!done && c0 < acc + loc[e]) { info[0] = 16 * lane + e; info[1] = c0 - acc; done = true; } acc += loc[e]; } }
        if (lane == 0) info[2] = c1 - c0;
    }
    __syncthreads();
    int li = __builtin_amdgcn_readfirstlane(info[0]), k = __builtin_amdgcn_readfirstlane(info[1]); const int nchunk = __builtin_amdgcn_readfirstlane(info[2]);
    int loaded = -1; bool pre = false; v4u pk[4], pv[4];
    int n_tl = 0, n_rank = 0; bool n_valid = false, n_active = false;
    bool n_near = false;
#define MOBA_FETCH(LI, KK, NN) do { const int b_ = (LI) >> 8, h_ = ((LI) >> 5) & 7, j_ = (LI) & 31; const bool own_ = ((KK) == 0); const int nf_ = (NN) & 0xffff, nn_ = (NN) >> 16, itf_ = (nf_ + 31) >> 5, itn_ = (nn_ + 31) >> 5; \
        const int it_ = own_ ? wave : ((KK) - 1) * 8 + wave; n_near = !own_ && it_ >= itf_; const int start_ = (n_near ? it_ - itf_ : it_) * 32; const int cnt_ = n_near ? nn_ : nf_; \
        n_active = own_ || it_ < itf_ + itn_; n_valid = own_ || (n_active && start_ + r32 < cnt_); \
        if (n_active) { if (own_) { n_tl = j_ * MBB + start_ + r32; n_rank = 3; } \
            else { int idx_ = start_ + r32; if (idx_ >= cnt_) idx_ = cnt_ - 1; const int pos_ = n_near ? ((31 - j_) * 256 - 1 - idx_) : idx_; const unsigned e_ = LIST[moba_list_base(b_ * 8 + h_, j_) + pos_]; n_tl = (int)(e_ & 8191u); n_rank = (int)(e_ >> 13); } } } while (0)
#define MOBA_CNT(LI) (__builtin_amdgcn_readfirstlane((int)CNT[(LI)]) | (__builtin_amdgcn_readfirstlane((int)CNT[1024 + (LI)]) << 16))
#define MOBA_NCH(NN) (1 + ((((((NN) & 0xffff) + 31) >> 5) + ((((NN) >> 16) + 31) >> 5) + 7) >> 3))
    int n = (nchunk > 0) ? MOBA_CNT(li) : 0;
    if (nchunk > 0) MOBA_FETCH(li, k, n);
    for (int c = 0; c < nchunk; ++c) {
        const int b = li >> 8, h = (li >> 5) & 7, j = li & 31;
        if (li != loaded) {
            __syncthreads();
            asm volatile("" : "+v"(tid));
            if (!pre) {
#pragma unroll
                for (int r = 0; r < 4; ++r) { const int idx = tid + 512 * r, key = idx >> 3, ch = idx & 7; pk[r] = *(const v4u*)(K + (size_t)(b * SEQ + j * MBB + key) * MBW + h * MBD + ch * 8); }
#pragma unroll
                for (int r = 0; r < 4; ++r) { const int idx = tid + 512 * r, d = idx >> 5, ch = idx & 31; pv[r] = *(const v4u*)(VT + (size_t)(h * MBD + d) * M + b * SEQ + j * MBB + ch * 8); }
            }
#pragma unroll
            for (int r = 0; r < 4; ++r) { const int idx = tid + 512 * r, key = idx >> 3, ch = idx & 7;
                *(LAS v4u*)(ks + key * 128 + ((ch ^ ((key >> 1) & 7)) * 16)) = pk[r]; }
#pragma unroll
            for (int r = 0; r < 4; ++r) { const int idx = tid + 512 * r, d = idx >> 5, ch = idx & 31;
                LAS v2u* dst = (LAS v2u*)(vs + d * IT_VROW + ch * 16); dst[0] = (v2u){pv[r].x, pv[r].y}; dst[1] = (v2u){pv[r].z, pv[r].w}; }
            __syncthreads();
            loaded = li; pre = false;
        }
        const int tl = n_tl, rank = n_rank; const bool valid = n_valid, active = n_active, own = (k == 0), nearit = n_near;
        bf16x8v qf[4];
        if (active) { const bf16* qp = Q + (size_t)(b * SEQ + tl) * MBW + h * MBD + 8 * hi;
#pragma unroll
            for (int s = 0; s < 4; ++s) qf[s] = *(const bf16x8v*)(qp + 16 * s); }
        int li2 = li, k2 = k + 1; if (k2 >= MOBA_NCH(n)) { ++li2; k2 = 0; }
        int n2 = n;
        if (c + 1 < nchunk) { if (li2 != li) n2 = MOBA_CNT(li2); MOBA_FETCH(li2, k2, n2); }
        if (c + 1 < nchunk && li2 != li) {
            const int b2 = li2 >> 8, h2 = (li2 >> 5) & 7, j2 = li2 & 31; pre = true;
#pragma unroll
            for (int r = 0; r < 4; ++r) { const int idx = tid + 512 * r, key = idx >> 3, ch = idx & 7; pk[r] = *(const v4u*)(K + (size_t)(b2 * SEQ + j2 * MBB + key) * MBW + h2 * MBD + ch * 8); }
#pragma unroll
            for (int r = 0; r < 4; ++r) { const int idx = tid + 512 * r, d = idx >> 5, ch = idx & 31; pv[r] = *(const v4u*)(VT + (size_t)(h2 * MBD + d) * M + b2 * SEQ + j2 * MBB + ch * 8); }
        }
        if (active) {
            const int qin = tl & 255, bd = (tl >> 8) - j, dq = bd * 256 + qin;
            const bool general = own || nearit;
            const int ntile = own ? (wave + 1) : 8;
            const LAS float* tb = tball + h * IT_TBN;
            const size_t pair = (size_t)(b * SEQ + tl) * 8 + h;
            bf16* po = (rank == 0 ? PO0 : rank == 1 ? PO1 : rank == 2 ? PO2 : (pair < M * 4 ? PO3 : PO3C)) + pair * 64; float* pm = PML + ((size_t)rank * (M * 8) + pair) * 2;
#define MOBA_STORE(MR, LR) do { const float linv_ = 1.0f / (LR); LAS unsigned char* stg_ = lds + IT_STG + wave * 4864; \
                _Pragma("unroll") for (int d = 0; d < 2; ++d) _Pragma("unroll") for (int g4 = 0; g4 < 4; ++g4) { v2u w; w.x = pg8::cvt_pk_bf16(o[d][4 * g4] * linv_, o[d][4 * g4 + 1] * linv_); w.y = pg8::cvt_pk_bf16(o[d][4 * g4 + 2] * linv_, o[d][4 * g4 + 3] * linv_); \
                    *(LAS v2u*)(stg_ + r32 * 144 + (32 * d + 8 * g4 + 4 * hi) * 2) = w; } \
                if (hi == 0) { *(LAS unsigned long long*)(stg_ + 4608 + r32 * 8) = valid ? (unsigned long long)(uintptr_t)po : 0ull; if (valid) { pm[0] = (MR); pm[1] = (LR); } } \
                asm volatile("s_waitcnt lgkmcnt(0)" ::: "memory"); \
                _Pragma("unroll") for (int i_ = 0; i_ < 4; ++i_) { const int row_ = i_ * 8 + (lane >> 3), ch_ = lane & 7; const unsigned long long p_ = *(const LAS unsigned long long*)(stg_ + 4608 + row_ * 8); \
                    const v4u v_ = *(const LAS v4u*)(stg_ + row_ * 144 + ch_ * 16); if (p_) *(v4u*)((unsigned char*)(uintptr_t)p_ + ch_ * 16) = v_; } \
                asm volatile("s_waitcnt lgkmcnt(0)" ::: "memory"); } while (0)
            bool done = false;
            {
                float mhat = 0.f, lrun = 0.f; f32x16 o[2], negm;
#pragma unroll
                for (int r = 0; r < 16; ++r) { o[0][r] = 0.f; o[1][r] = 0.f; negm[r] = 0.f; }
                const LAS float* rp0 = tb + (512 - dq + 4 * hi);
#define MOBA_QK(ST, KT) do { const int key_ = 32 * (KT) + r32; \
                    _Pragma("unroll") for (int s_ = 0; s_ < 4; ++s_) { const bf16x8v ka_ = *(const LAS bf16x8v*)(ks + key_ * 128 + (((2 * s_ + hi) ^ ((key_ >> 1) & 7)) * 16)); \
                        ST = __builtin_amdgcn_mfma_f32_32x32x16_bf16(ka_, qf[s_], ST, 0, 0, 0); } } while (0)
#define MOBA_BIAS(ST, KT) do { if (general) { const LAS float* rp_ = rp0 + 32 * (KT); _Pragma("unroll") for (int r_ = 0; r_ < 16; ++r_) { float t_ = ST[r_] + rp_[8 * (r_ >> 2) + (r_ & 3)]; if (!(r_ & 1)) asm("" : "+v"(t_));   ST[r_] = t_; } } } while (0)
                f32x16 sa = negm, sb;
                MOBA_QK(sa, 0); MOBA_BIAS(sa, 0);
                mhat = moba_rowmax(sa);
#pragma unroll
                for (int r = 0; r < 16; ++r) { sa[r] -= mhat; negm[r] = -mhat; }
#pragma unroll
                for (int kt = 0; kt < 8; kt += 2) {
                    if (kt < ntile) {
                        if (kt + 1 < ntile) { sb = negm; MOBA_QK(sb, kt + 1); }
                        moba_exp_sum(sa, lrun); moba_pv_tile(sa, kt, hi, r32, vs, o);
                        if (kt + 1 < ntile) {
                            MOBA_BIAS(sb, kt + 1);
                            if (kt + 2 < ntile) { sa = negm; MOBA_QK(sa, kt + 2); }
                            moba_exp_sum(sb, lrun); moba_pv_tile(sb, kt + 1, hi, r32, vs, o);
                            if (kt + 2 < ntile) MOBA_BIAS(sa, kt + 2);
                        }
                    }
                }
#undef MOBA_QK
#undef MOBA_BIAS
                lrun += __shfl_xor(lrun, 32);
                if (__builtin_expect(!__any(!(lrun < 1.0e30f)), 1)) { MOBA_STORE(mhat + (general ? 0.f : tb[0]), lrun); done = true; }
            }
            if (!done) {
                const int dq2 = general ? dq : 511;
                float mrun = -INFINITY, lrun = 0.f; f32x16 o[2];
#pragma unroll
                for (int r = 0; r < 16; ++r) { o[0][r] = 0.f; o[1][r] = 0.f; }
#pragma unroll
                for (int kt = 0; kt < 8; ++kt) {
                    if (kt < ntile) {
                        f32x16 st; const int key = 32 * kt + r32;
#pragma unroll
                        for (int r = 0; r < 16; ++r) st[r] = 0.f;
#pragma unroll
                        for (int s = 0; s < 4; ++s) { const bf16x8v ka = *(const LAS bf16x8v*)(ks + key * 128 + (((2 * s + hi) ^ ((key >> 1) & 7)) * 16));
                            st = __builtin_amdgcn_mfma_f32_32x32x16_bf16(ka, qf[s], st, 0, 0, 0); }
                        { const LAS float* rp = tb + (512 - dq2 + 32 * kt + 4 * hi);
#pragma unroll
                          for (int r = 0; r < 16; ++r) st[r] += rp[8 * (r >> 2) + (r & 3)]; }
                        const float mnew = fmaxf(mrun, moba_rowmax(st)), alpha = __builtin_amdgcn_exp2f(mrun - mnew);
#pragma unroll
                        for (int r = 0; r < 16; ++r) st[r] -= mnew;
                        lrun *= alpha; mrun = mnew;
#pragma unroll
                        for (int d = 0; d < 2; ++d)
#pragma unroll
                            for (int r = 0; r < 16; ++r) o[d][r] *= alpha;
                        moba_exp_sum(st, lrun);
                        moba_pv_tile(st, kt, hi, r32, vs, o);
                        asm volatile("" ::: "memory");
                    }
                }
                lrun += __shfl_xor(lrun, 32);
                MOBA_STORE(mrun, lrun);
            }
#undef MOBA_STORE
        }
        li = li2; k = k2; n = n2;
    }
#undef MOBA_FETCH
#undef MOBA_CNT
#undef MOBA_NCH
    __syncthreads();
}
__device__ __forceinline__ void moba_combine_phase(int gtid, int gthreads, const bf16* PO0, const bf16* PO1, const bf16* PO2, const bf16* PO3, const bf16* PO3C, const float* PML, bf16* OA) {
    for (int idx0 = gtid; idx0 < M * 8 * 8; idx0 += 4 * gthreads) {
        typedef float f32x2l __attribute__((ext_vector_type(2)));
        f32x2l ml[4][4]; v4u x[4][4];
#pragma unroll
        for (int u = 0; u < 4; ++u) { const int idx = idx0 + u * gthreads, pair = idx >> 3, c8 = idx & 7, m = pair >> 3, own = (m & (SEQ - 1)) >> 8, nv = own < 3 ? own : 3;
#pragma unroll
            for (int r = 0; r < 4; ++r) { const bool v = (r == 3) || (r < nv);
                ml[u][r] = v ? *(const f32x2l*)(PML + ((size_t)r * (M * 8) + pair) * 2) : (f32x2l){-INFINITY, 0.f};
                x[u][r] = v ? *(const v4u*)((r == 0 ? PO0 : r == 1 ? PO1 : r == 2 ? PO2 : (pair < M * 4 ? PO3 : PO3C)) + (size_t)pair * 64 + c8 * 8) : (v4u){0u, 0u, 0u, 0u}; }
        }
#pragma unroll
        for (int u = 0; u < 4; ++u) { const int idx = idx0 + u * gthreads, pair = idx >> 3, c8 = idx & 7, m = pair >> 3;
            const float mx = fmaxf(fmaxf(ml[u][0].x, ml[u][1].x), fmaxf(ml[u][2].x, ml[u][3].x));
            float w[4], ws = 0.f;
#pragma unroll
            for (int r = 0; r < 4; ++r) { w[r] = ml[u][r].y * __builtin_amdgcn_exp2f(ml[u][r].x - mx); ws += w[r]; }
            const float inv = 1.0f / ws; float acc[8];
#pragma unroll
            for (int e = 0; e < 8; ++e) acc[e] = 0.f;
#pragma unroll
            for (int r = 0; r < 4; ++r) { const float wr = w[r] * inv; const v4u xx = x[u][r];
                acc[0] += wr * bflo(xx.x); acc[1] += wr * bfhi(xx.x); acc[2] += wr * bflo(xx.y); acc[3] += wr * bfhi(xx.y); acc[4] += wr * bflo(xx.z); acc[5] += wr * bfhi(xx.z); acc[6] += wr * bflo(xx.w); acc[7] += wr * bfhi(xx.w); }
            v4u o; o.x = pk2(acc[0], acc[1]); o.y = pk2(acc[2], acc[3]); o.z = pk2(acc[4], acc[5]); o.w = pk2(acc[6], acc[7]);
            *(v4u*)(OA + (size_t)m * 1024 + (pair & 7) * 64 + c8 * 8) = o;
        }
    }
}
constexpr int HL_IMG = 37888, HL_QN = 0, HL_KN = 8704, HL_KT = 17408, HL_VT = 27648, HL_SB = 2 * HL_IMG  , HL_DD = HL_SB + 34816  , HL_EM = HL_DD + 1024, HL_SSQ = HL_EM + 1024, HL_END = HL_SSQ + 512;
constexpr int HL_QP = 272, HL_TP = 80;
__device__ __forceinline__ float bf1(bf16 x) { return __uint_as_float((unsigned)x << 16); }
template <int STEP> __device__ __forceinline__ void hgrn_mfma_phase(LAS unsigned char* lds, int vcu, int G, int tid, int wave, int lane, const bf16* KIN, const bf16* HI, const bf16* HQ, const bf16* HG, const float* hgw, bf16* HS, float* HGD, bf16* OB) {
    const int r32 = lane & 31, hi = lane >> 5, cl = lane & 15, tg = lane >> 4, ch = 16 * wave + cl;
    LAS float* ssq = (LAS float*)(lds + HL_SSQ); LAS float* hgwl = (LAS float*)(lds + HL_END);
    __syncthreads();
    if (STEP == 3 && tid < 128) hgwl[tid] = hgw[tid];
    for (int unit = vcu; unit < BATCH * HGH * HGNC; unit += G) {
        const int c = unit & 31, bh = unit >> 5, b = bh >> 2, h = bh & 3, m0 = b * SEQ + c * HGC;
        f32x16 S[4]; float Dk = 1.f;
        const int skt = (STEP == 1) ? (wave >> 1) : (wave - 4), svt0 = (STEP == 1) ? 2 * (wave & 1) : 0; constexpr int NST = (STEP == 1) ? 2 : 4;
#pragma unroll
        for (int i = 0; i < 4; ++i)
#pragma unroll
            for (int r = 0; r < 16; ++r) S[i][r] = 0.f;
        if (STEP == 3 && wave >= 4) {
#pragma unroll
            for (int i = 0; i < 4; ++i)
#pragma unroll
                for (int r = 0; r < 16; ++r) S[i][r] = bf1(HS[(size_t)unit * 16384 + (32 * skt + crow16(r, hi)) * 128 + 32 * (svt0 + i) + r32]);
        }
        unsigned short rk[8], rv[8], rq[8];
#define HG_LOAD(SLAB) do { _Pragma("unroll") for (int e = 0; e < 8; ++e) { const size_t idx = (size_t)(m0 + (SLAB) * 32 + tg * 8 + e) * HGW + h * HGD_ + ch; rk[e] = KIN[idx]; rv[e] = HI[idx]; rq[e] = (STEP == 3) ? HQ[idx] : (unsigned short)0; } } while (0)
#define HG_STAGE(BUF) do { LAS unsigned char* img_ = lds + (BUF) * HL_IMG; \
            float kin_[8], cs_[8]; float run_ = 0.f; \
            _Pragma("unroll") for (int e = 0; e < 8; ++e) { kin_[e] = bf1(rk[e]); run_ += __builtin_amdgcn_logf(fmaxf(1.0f - kin_[e], 5.9604645e-8f)); cs_[e] = run_; } \
            const float g0_ = __shfl(run_, cl), g1_ = __shfl(run_, cl + 16), g2_ = __shfl(run_, cl + 32), g3_ = __shfl(run_, cl + 48); \
            const float bmid_ = g0_ + g1_, bend_ = bmid_ + g2_ + g3_, pre_ = (tg == 0) ? 0.f : (tg == 1) ? g0_ : (tg == 2) ? bmid_ : bmid_ + g2_; \
            { float kh_[8]; _Pragma("unroll") for (int e = 0; e < 8; ++e) kh_[e] = kin_[e] * __builtin_amdgcn_exp2f(bend_ - (pre_ + cs_[e])); \
              v4u w_; w_.x = pg8::cvt_pk_bf16(kh_[0], kh_[1]); w_.y = pg8::cvt_pk_bf16(kh_[2], kh_[3]); w_.z = pg8::cvt_pk_bf16(kh_[4], kh_[5]); w_.w = pg8::cvt_pk_bf16(kh_[6], kh_[7]); \
              *(LAS v4u*)(img_ + HL_KT + ch * HL_TP + tg * 16) = w_; \
              v4u x_; x_.x = (unsigned)rv[0] | ((unsigned)rv[1] << 16); x_.y = (unsigned)rv[2] | ((unsigned)rv[3] << 16); x_.z = (unsigned)rv[4] | ((unsigned)rv[5] << 16); x_.w = (unsigned)rv[6] | ((unsigned)rv[7] << 16); \
              *(LAS v4u*)(img_ + HL_VT + ch * HL_TP + tg * 16) = x_; } \
            if (STEP == 3) { _Pragma("unroll") for (int e = 0; e < 8; ++e) { const float bs_ = pre_ + cs_[e]; const int tok_ = tg * 8 + e; \
                    const float kt_ = kin_[e] * __builtin_amdgcn_exp2f(fminf(bmid_ - bs_, 100.f)), qt_ = bf1(rq[e]) * __builtin_amdgcn_exp2f(fminf(bs_ - bmid_, 100.f)); \
                    *(LAS unsigned short*)(img_ + HL_KN + tok_ * HL_QP + ch * 2) = (unsigned short)f2bf(kt_); \
                    *(LAS unsigned short*)(img_ + HL_QN + tok_ * HL_QP + ch * 2) = (unsigned short)f2bf(qt_); } } \
            if (tg == 0) { const float de_ = __builtin_amdgcn_exp2f(bend_); ((LAS float*)(lds + HL_DD))[(BUF) * 128 + ch] = de_; ((LAS float*)(lds + HL_EM))[(BUF) * 128 + ch] = __builtin_amdgcn_exp2f(bmid_); Dk *= de_; } } while (0)
        HG_LOAD(0);
        __syncthreads();
        HG_STAGE(0);
        HG_LOAD(1);
        __syncthreads();
        for (int slab = 0; slab < 8; ++slab) {
            const int buf = slab & 1, ms = m0 + slab * 32;
            const LAS unsigned char* img = lds + buf * HL_IMG; const LAS float* dd = (const LAS float*)(lds + HL_DD) + buf * 128; const LAS float* em = (const LAS float*)(lds + HL_EM) + buf * 128;
            f32x16 O; v2u gg[4];
            if (STEP == 3 && wave < 4) {
#pragma unroll
                for (int g4 = 0; g4 < 4; ++g4) gg[g4] = *(const v2u*)(HG + (size_t)(ms + r32) * HGW + h * HGD_ + 32 * wave + 8 * g4 + 4 * hi);
            }
            if (STEP == 3) {
                if (wave >= 4) {
#pragma unroll
                    for (int i = 0; i < 4; ++i)
#pragma unroll
                        for (int g4 = 0; g4 < 4; ++g4) { const int k0 = 32 * skt + 8 * g4 + 4 * hi; const f32x4 e4 = *(const LAS f32x4*)(em + k0);
                            v2u w; w.x = pg8::cvt_pk_bf16(S[i][4 * g4] * e4.x, S[i][4 * g4 + 1] * e4.y); w.y = pg8::cvt_pk_bf16(S[i][4 * g4 + 2] * e4.z, S[i][4 * g4 + 3] * e4.w);
                            *(LAS v2u*)(lds + HL_SB + (32 * (svt0 + i) + r32) * HL_QP + k0 * 2) = w; }
                } else {
                    const int vt = wave; f32x16 X;
#pragma unroll
                    for (int r = 0; r < 16; ++r) { X[r] = 0.f; O[r] = 0.f; }
#pragma unroll
                    for (int ks = 0; ks < 8; ++ks) { const bf16x8v qf = *(const LAS bf16x8v*)(img + HL_QN + r32 * HL_QP + (16 * ks + 8 * hi) * 2);
                        const bf16x8v kf = *(const LAS bf16x8v*)(img + HL_KN + r32 * HL_QP + (16 * ks + 8 * hi) * 2);
                        X = __builtin_amdgcn_mfma_f32_32x32x16_bf16(kf, qf, X, 0, 0, 0); }
#pragma unroll
                    for (int r = 0; r < 16; ++r) if (crow16(r, hi) > r32) X[r] = 0.f;
#pragma unroll
                    for (int k2 = 0; k2 < 2; ++k2) {
                        v4u w; w.x = pg8::cvt_pk_bf16(X[8 * k2 + 0], X[8 * k2 + 1]); w.y = pg8::cvt_pk_bf16(X[8 * k2 + 2], X[8 * k2 + 3]); w.z = pg8::cvt_pk_bf16(X[8 * k2 + 4], X[8 * k2 + 5]); w.w = pg8::cvt_pk_bf16(X[8 * k2 + 6], X[8 * k2 + 7]);
                        const bf16x8v xf = __builtin_bit_cast(bf16x8v, w);
                        const LAS unsigned char* vp = img + HL_VT + (32 * vt + r32) * HL_TP + (16 * k2 + 4 * hi) * 2;
                        const s16x4v lo = *(const LAS s16x4v*)vp, hi4 = *(const LAS s16x4v*)(vp + 16);
                        const bf16x8v va = {lo[0], lo[1], lo[2], lo[3], hi4[0], hi4[1], hi4[2], hi4[3]};
                        O = __builtin_amdgcn_mfma_f32_32x32x16_bf16(va, xf, O, 0, 0, 0); }
                }
                __syncthreads();
                if (wave < 4) {
                    const int vt = wave;
#pragma unroll
                    for (int ks = 0; ks < 8; ++ks) { const bf16x8v sa = *(const LAS bf16x8v*)(lds + HL_SB + (32 * vt + r32) * HL_QP + (16 * ks + 8 * hi) * 2);
                        const bf16x8v qf = *(const LAS bf16x8v*)(img + HL_QN + r32 * HL_QP + (16 * ks + 8 * hi) * 2);
                        O = __builtin_amdgcn_mfma_f32_32x32x16_bf16(sa, qf, O, 0, 0, 0); }
                    float sq = 0.f;
#pragma unroll
                    for (int r = 0; r < 16; ++r) sq += O[r] * O[r];
                    sq += __shfl_xor(sq, 32);
                    if (hi == 0) ssq[vt * 32 + r32] = sq;
                }
            }
            if (STEP == 1 || wave >= 4) {
#pragma unroll
                for (int i = 0; i < NST; ++i) {
#pragma unroll
                    for (int g4 = 0; g4 < 4; ++g4) { const f32x4 d4 = *(const LAS f32x4*)(dd + 32 * skt + 8 * g4 + 4 * hi);
                        S[i][4 * g4] *= d4.x; S[i][4 * g4 + 1] *= d4.y; S[i][4 * g4 + 2] *= d4.z; S[i][4 * g4 + 3] *= d4.w; }
#pragma unroll
                    for (int k2 = 0; k2 < 2; ++k2) { const bf16x8v ka = *(const LAS bf16x8v*)(img + HL_KT + (32 * skt + r32) * HL_TP + (16 * k2 + 8 * hi) * 2);
                        const bf16x8v vb = *(const LAS bf16x8v*)(img + HL_VT + (32 * (svt0 + i) + r32) * HL_TP + (16 * k2 + 8 * hi) * 2);
                        S[i] = __builtin_amdgcn_mfma_f32_32x32x16_bf16(ka, vb, S[i], 0, 0, 0); }
                }
            }
            if (slab < 7) { HG_STAGE(buf ^ 1); if (slab < 6) HG_LOAD(slab + 2); }
            __syncthreads();
            if (STEP == 3 && wave < 4) {
                const int vt = wave; const float tot = ssq[r32] + ssq[32 + r32] + ssq[64 + r32] + ssq[96 + r32];
                const float rstd = 1.f / sqrtf(tot * (1.f / 128.f) + EPS); const size_t orow = (size_t)(ms + r32) * 1024 + 512 + h * HGD_;
#pragma unroll
                for (int g4 = 0; g4 < 4; ++g4) { const int v0 = 32 * vt + 8 * g4 + 4 * hi; const f32x4 w4 = *(const LAS f32x4*)(hgwl + v0);
                    v2u o; o.x = pg8::cvt_pk_bf16(O[4 * g4] * rstd * w4.x * bflo(gg[g4].x), O[4 * g4 + 1] * rstd * w4.y * bfhi(gg[g4].x)); o.y = pg8::cvt_pk_bf16(O[4 * g4 + 2] * rstd * w4.z * bflo(gg[g4].y), O[4 * g4 + 3] * rstd * w4.w * bfhi(gg[g4].y));
                    *(v2u*)(OB + orow + v0) = o; }
            }
        }
#undef HG_LOAD
#undef HG_STAGE
        if (STEP == 1) {
#pragma unroll
            for (int i = 0; i < 2; ++i)
#pragma unroll
                for (int r = 0; r < 16; ++r) HS[(size_t)unit * 16384 + (32 * skt + crow16(r, hi)) * 128 + 32 * (svt0 + i) + r32] = (bf16)f2bf(S[i][r]);
            if (tg == 0) HGD[unit * 128 + ch] = Dk;
        }
    }
    __syncthreads();
}
constexpr int H1_IMG = 20480, H1_VT = 10240;
__device__ __forceinline__ void hgrn1_sfx_phase(LAS unsigned char* lds, int vcu, int G, int tid, int wave, int lane, const bf16* KIN, const bf16* HI, bf16* HS, float* HGD) {
    const int r32 = lane & 31, hi = lane >> 5, cl = lane & 15, tg = lane >> 4, ch = 16 * wave + cl;
    const int skt = wave >> 1, svt0 = 2 * (wave & 1);
    __syncthreads();
    for (int unit = vcu; unit < BATCH * HGH * HGNC; unit += G) {
        const int c = unit & 31, bh = unit >> 5, m0 = (bh >> 2) * SEQ + c * HGC, hh = bh & 3;
        f32x16 S[2]; float Rs = 0.f;
#pragma unroll
        for (int i = 0; i < 2; ++i)
#pragma unroll
            for (int r = 0; r < 16; ++r) S[i][r] = 0.f;
        unsigned short rk[8], rv[8];
#define H1_LOAD(SLAB) do { _Pragma("unroll") for (int e = 0; e < 8; ++e) { const size_t idx = (size_t)(m0 + (SLAB) * 32 + tg * 8 + e) * HGW + hh * HGD_ + ch; rk[e] = KIN[idx]; rv[e] = HI[idx]; } } while (0)
#define H1_STAGE(BUF) do { LAS unsigned char* img_ = lds + (BUF) * H1_IMG; \
            float kin_[8], lg_[8], sx_[8]; \
            _Pragma("unroll") for (int e = 0; e < 8; ++e) { kin_[e] = bf1(rk[e]); lg_[e] = __builtin_amdgcn_logf(fmaxf(1.0f - kin_[e], 5.9604645e-8f)); } \
            sx_[7] = 0.f; _Pragma("unroll") for (int e = 6; e >= 0; --e) sx_[e] = sx_[e + 1] + lg_[e + 1];     \
            const float run_ = sx_[0] + lg_[0]; \
            const float g1_ = __shfl(run_, cl + 16), g2_ = __shfl(run_, cl + 32), g3_ = __shfl(run_, cl + 48), g0_ = __shfl(run_, cl); \
            const float post_ = Rs + ((tg == 3) ? 0.f : (tg == 2) ? g3_ : (tg == 1) ? g2_ + g3_ : g1_ + g2_ + g3_);     \
            { float kh_[8]; _Pragma("unroll") for (int e = 0; e < 8; ++e) kh_[e] = kin_[e] * __builtin_amdgcn_exp2f(post_ + sx_[e]); \
              v4u w_; w_.x = pg8::cvt_pk_bf16(kh_[0], kh_[1]); w_.y = pg8::cvt_pk_bf16(kh_[2], kh_[3]); w_.z = pg8::cvt_pk_bf16(kh_[4], kh_[5]); w_.w = pg8::cvt_pk_bf16(kh_[6], kh_[7]); \
              *(LAS v4u*)(img_ + ch * HL_TP + tg * 16) = w_; \
              v4u x_; x_.x = (unsigned)rv[0] | ((unsigned)rv[1] << 16); x_.y = (unsigned)rv[2] | ((unsigned)rv[3] << 16); x_.z = (unsigned)rv[4] | ((unsigned)rv[5] << 16); x_.w = (unsigned)rv[6] | ((unsigned)rv[7] << 16); \
              *(LAS v4u*)(img_ + H1_VT + ch * HL_TP + tg * 16) = x_; } \
            Rs += (g0_ + g1_) + (g2_ + g3_); } while (0)
        H1_LOAD(7);
        __syncthreads();
        H1_STAGE(0);
        H1_LOAD(6);
        __syncthreads();
        for (int it = 0; it < 8; ++it) {
            const int buf = it & 1;
            const LAS unsigned char* img = lds + buf * H1_IMG;
#pragma unroll
            for (int i = 0; i < 2; ++i)
#pragma unroll
                for (int k2 = 0; k2 < 2; ++k2) { const bf16x8v ka = *(const LAS bf16x8v*)(img + (32 * skt + r32) * HL_TP + (16 * k2 + 8 * hi) * 2);
                    const bf16x8v vb = *(const LAS bf16x8v*)(img + H1_VT + (32 * (svt0 + i) + r32) * HL_TP + (16 * k2 + 8 * hi) * 2);
                    S[i] = __builtin_amdgcn_mfma_f32_32x32x16_bf16(ka, vb, S[i], 0, 0, 0); }
            if (it < 7) { H1_STAGE(buf ^ 1); if (it < 6) H1_LOAD(5 - it); }
            __syncthreads();
        }
#undef H1_LOAD
#undef H1_STAGE
#pragma unroll
        for (int i = 0; i < 2; ++i)
#pragma unroll
            for (int r = 0; r < 16; ++r) HS[(size_t)unit * 16384 + (32 * skt + crow16(r, hi)) * 128 + 32 * (svt0 + i) + r32] = (bf16)f2bf(S[i][r]);
        if (tg == 0) HGD[unit * 128 + ch] = __builtin_amdgcn_exp2f(Rs);
    }
    __syncthreads();
}
__device__ __forceinline__ void hgrn_scan_phase(int gtid, int gthreads, bf16* HS, const float* HGD) {
    for (int idx = gtid; idx < BATCH * HGH * 8192; idx += gthreads) {
        const int bh = idx >> 13, e = (idx & 8191) * 2, k = e >> 7; float s0 = 0.f, s1 = 0.f;
        unsigned tmp[HGNC]; float dk[HGNC];
#pragma unroll
        for (int c = 0; c < HGNC; ++c) { tmp[c] = *(const unsigned*)(HS + (size_t)(bh * HGNC + c) * 16384 + e); dk[c] = HGD[(bh * HGNC + c) * 128 + k]; }
#pragma unroll
        for (int c = 0; c < HGNC; ++c) { *(unsigned*)(HS + (size_t)(bh * HGNC + c) * 16384 + e) = pk2(s0, s1); s0 = dk[c] * s0 + bflo(tmp[c]); s1 = dk[c] * s1 + bfhi(tmp[c]); }
    }
}
#ifndef MASK_BITS
#define MASK_BITS 0x00ffffffu
#endif
#ifndef REP_MASK
#define REP_MASK 0u
#endif
struct Args { const float* in[16]; float* out; unsigned char* ws; unsigned mask, rep; };
typedef const __attribute__((address_space(4))) Args* KArgs;
__device__ __forceinline__ KArgs hide_args() {
#if defined(__HIP_DEVICE_COMPILE__)
    KArgs p = (KArgs)__builtin_amdgcn_kernarg_segment_ptr(); asm volatile("" : "+s"(p)); return p;
#else
    return nullptr;
#endif
}
__global__ void __launch_bounds__(NWAVES * 64, 2) mk_fwd(Args args) {
    extern __shared__ __attribute__((aligned(16))) unsigned char lds_raw[];
    LAS unsigned char* lds = (LAS unsigned char*)lds_raw;
    volatile LAS unsigned* MISC = (volatile LAS unsigned*)(lds + MISC_OFF);
    const int G = gridDim.x, bx = blockIdx.x;
    unsigned char* ws = args.ws;
    gu32* ctl = (gu32*)(ws + WS_CTL);
    for (int u = threadIdx.x; u < (LDS_BYTES - LDSCTL_OFF) / 4; u += NWAVES * 64) ((LAS unsigned*)(lds + LDSCTL_OFF))[u] = 0u;
    __syncthreads();
    XcdBarrier bar = xcd_barrier_post((unsigned*)(ctl + CW_BAR), MISC + 8);
#define GRID_BAR() xcd_barrier(bar)
#define PH(k) for (int rep_ = ((args.mask >> (k)) & 1u) + ((args.rep >> (k)) & 1u); rep_ > 0; --rep_) if (KArgs A_ = hide_args()) if (unsigned char* ws = A_->ws)
#define COORDS() int tid = threadIdx.x; asm volatile("" : "+v"(tid)); const int lane = tid & 63, wave = __builtin_amdgcn_readfirstlane(tid >> 6); \
    const int vcu = (G % 8 == 0) ? (bx % 8) * (G / 8) + bx / 8 : bx; const int gw = vcu * NWAVES + wave, NGW = G * NWAVES; (void)lane; (void)gw; (void)NGW; (void)vcu
#define MKP() Ptrs P; P.x = A_->in[0]; P.p = A_->in[1]; P.w_gu1 = A_->in[2]; P.w_d1 = A_->in[3]; P.w_in = A_->in[4]; P.w_a = A_->in[5]; P.w_b = A_->in[6]; P.w_out = A_->in[7]; \
    P.w_gu2 = A_->in[8]; P.w_d2 = A_->in[9]; P.w_ple = A_->in[10]; P.w_pg = A_->in[11]; P.gains = A_->in[12]; P.hgw = A_->in[13]; P.lbp = A_->in[14]; P.rel = A_->in[15]; P.out = A_->out; P.ws = A_->ws
#define QSC(p) ((float*)((unsigned char*)(p) + 32 * MiB))
#define H2W ((bf16*)(ws + WS_SA))
#define XN ((bf16*)(ws + WS_C))
#define Hb ((bf16*)(ws + WS_A))
#define Fb ((bf16*)(ws + WS_B))
#define Yb ((bf16*)(ws + WS_A))
#define HBS ((bf16*)A_->out)
#define Qb ((bf16*)(ws + WS_Q))
#define Kb ((bf16*)(ws + WS_K))
#define VTb ((bf16*)(ws + WS_VT))
#define HQb ((bf16*)(ws + WS_HQ))
#define HIb ((bf16*)(ws + WS_HI))
#define KINb ((bf16*)(ws + WS_KIN))
#define HGb ((bf16*)(ws + WS_HG))
#define SAb ((bf16*)(ws + WS_SA))
#define MRGb ((bf16*)(ws + WS_KIN))
#define SBb ((bf16*)(ws + WS_SB))
#define OAb ((bf16*)(ws + WS_OAB))
#define OBb ((bf16*)(ws + WS_OAB))
#define PBb ((bf16*)(ws + WS_PB))
#define Eb ((bf16*)(ws + WS_A))
#define KMEAN ((float*)(ws + WS_KMEAN))
#define LBt ((float*)(ws + WS_LB))
#define BIAST ((float*)(ws + WS_BIAST))
#define HS ((bf16*)((float*)A_->out + 16 * 1024 * 1024))
#define HGD ((float*)(ws + WS_HGD))
#define CNTb ((unsigned*)(ws + WS_CNT))
#define LISTb ((unsigned*)(ws + WS_LIST))
#define PO0b ((bf16*)(ws + WS_PO0))
#define PO1b ((bf16*)(ws + WS_PO1))
#define PO2b ((bf16*)((unsigned char*)A_->out + 80 * MiB))
#define PO3b ((bf16*)((unsigned char*)A_->out + 112 * MiB))
#define PO3c ((bf16*)(ws + WS_PO3B - 16 * MiB))
#define PMLb ((float*)(ws + WS_PML))

    PH(0) { COORDS(); MKP(); p0_prologue<0>(P, lds, gw, NGW, wave, lane, vcu, G); }
    GRID_BAR();
    PH(1) { pg8::Gemm g{XN, (const bf16*)(ws + WS_WGU1), M, NGU, D / 2}; pg8::StaticOrder S; S.init(M, NGU, G, bx); pg8::EpiGU8 E{Hb, FF, (const float*)(ws + WS_RS), (const float*)(ws + WS_CMAX) + CM_GU1};
      pg8::gemm_phase<pg8::EpiGU8, pg8::StaticOrder, PG8_ALIGN, PG8_SP2, true>(lds + RING_OFF, g, S, E); }
    GRID_BAR();
    PH(2) { pg8::Gemm g{Hb, (const bf16*)(ws + WS_WD1), M, D, FF}; pg8::StaticOrder S; S.init(M, D, G, bx); pg8::EpiQ8 E{(unsigned char*)Fb, QSC(Fb), D};
      pg8::gemm_phase<pg8::EpiQ8, pg8::StaticOrder, PG8_ALIGN, PG8_SP2>(lds + RING_OFF, g, S, E); }
    GRID_BAR();
    PH(3) { COORDS(); rowwise_phase<true, 5, true>(gw, NGW, lane, A_->in[0], Fb, A_->in[12] + 1 * D, 0.5f, HBS, XN, (float*)(ws + WS_RS), QSC(Fb)); }
    GRID_BAR();
    PH(4) { pg8::Gemm g{HBS, (const bf16*)(ws + WS_WIN), M, 512, D}; pg8::StaticOrder S; S.init(M, 512, G, bx); pg8::EpiIN E{Qb, LBt, KMEAN, (const float*)(ws + WS_R2)};
      pg8::gemm_phase<pg8::EpiIN, pg8::StaticOrder, PG8_ALIGN, PG8_SP2>(lds + RING_OFF, g, S, E); }
    PH(4) { pg8::Gemm g{XN, (const bf16*)(ws + WS_W8IN), M, 4608, D / 2}; pg8::StaticOrder S; S.init(M, 4608, G, bx);
      pg8::EpiIN8 E{SAb, SBb, HQb, KINb, HIb, HGb, Kb, LBt, (const float*)(ws + WS_RS), (const float*)(ws + WS_CMAX) + CM_IN, KMEAN};
      pg8::gemm_phase<pg8::EpiIN8, pg8::StaticOrder, PG8_ALIGN, PG8_SP2, true>(lds + RING_OFF, g, S, E); }
    PH(4) { pg8::Gemm g{(const bf16*)(ws + WS_W8IN + (size_t)4608 * D), XN, 512, M, D / 2}; pg8::StaticOrder S; S.init(512, M, G, bx);
      pg8::EpiI8<0> E{VTb, nullptr, nullptr, M, 0, (const float*)(ws + WS_CMAX) + CM_IN + 4608, (const float*)(ws + WS_RS), 1.0f / 127.0f};
      pg8::gemm_phase<pg8::EpiI8<0>, pg8::StaticOrder, PG8_ALIGN, PG8_SP2, true>(lds + RING_OFF, g, S, E); }
    GRID_BAR();
    PH(5) { COORDS(); moba_gating_phase(lds, vcu, G, tid, Qb, KMEAN, CNTb, LISTb); }
    PH(18) { COORDS(); hgrn1_sfx_phase(lds, vcu, G, tid, wave, lane, KINb, HIb, HS, HGD); }
    GRID_BAR();
    PH(6) { COORDS(); hgrn_scan_phase(vcu * NWAVES * 64 + tid, G * NWAVES * 64, HS, HGD); }
    PH(16) { COORDS(); moba_items_phase(lds, vcu, G, tid, wave, lane, Qb, Kb, VTb, CNTb, LISTb, BIAST, PO0b, PO1b, PO2b, PO3b, PO3c, PMLb); }
    PH(19) { COORDS(); MKP(); p0_prologue<1>(P, lds, gw, NGW, wave, lane, vcu, G); }
    GRID_BAR();
    PH(7) { COORDS(); hgrn_mfma_phase<3>(lds, vcu, G, tid, wave, lane, KINb, HIb, HQb, HGb, A_->in[13], HS, HGD, OBb); }
    PH(17) { COORDS(); moba_combine_phase(vcu * NWAVES * 64 + tid, G * NWAVES * 64, PO0b, PO1b, PO2b, PO3b, PO3c, PMLb, OAb); }
    GRID_BAR();
    PH(8) { pg8::Gemm g{OAb, (const bf16*)(ws + WS_WA), M, D, D, 512}; pg8::HalfOrder S; S.init(M, D, G, bx); pg8::EpiMerge E{(const unsigned char*)SAb, (const unsigned char*)SBb, MRGb, D};
      pg8::gemm_phase<pg8::EpiMerge, pg8::HalfOrder, PG8_ALIGN, PG8_SP2>(lds + RING_OFF, g, S, E); }
    GRID_BAR();
    PH(9) { pg8::Gemm g{MRGb, (const bf16*)(ws + WS_WOUT), M, D, D}; pg8::StaticOrder S; S.init(M, D, G, bx); pg8::EpiQ8 E{(unsigned char*)Yb, QSC(Yb), D};
      pg8::gemm_phase<pg8::EpiQ8, pg8::StaticOrder, PG8_ALIGN, PG8_SP2>(lds + RING_OFF, g, S, E); }
    GRID_BAR();
    PH(10) { COORDS(); rowwise_phase<false, 4, true>(gw, NGW, lane, HBS, Yb, A_->in[12] + 3 * D, 1.0f, H2W, XN, (float*)(ws + WS_RS), QSC(Yb)); }
    GRID_BAR();
    PH(11) { pg8::Gemm g{XN, (const bf16*)(ws + WS_WGU2), M, NGU, D / 2}; pg8::StaticOrder S; S.init(M, NGU, G, bx); pg8::EpiGU8 E{Hb, FF, (const float*)(ws + WS_RS), (const float*)(ws + WS_CMAX) + CM_GU2};
      pg8::gemm_phase<pg8::EpiGU8, pg8::StaticOrder, PG8_ALIGN, PG8_SP2, true>(lds + RING_OFF, g, S, E); }
    GRID_BAR();
    PH(12) { pg8::Gemm g{Hb, (const bf16*)(ws + WS_WD2), M, D, FF}; pg8::StaticOrder S; S.init(M, D, G, bx); pg8::EpiQ8 E{(unsigned char*)Fb, QSC(Fb), D};
      pg8::gemm_phase<pg8::EpiQ8, pg8::StaticOrder, PG8_ALIGN, PG8_SP2>(lds + RING_OFF, g, S, E); }
    GRID_BAR();
    PH(13) { COORDS(); rowwise_phase<false, 7, true>(gw, NGW, lane, H2W, Fb, A_->in[12] + 5 * D, 0.5f, nullptr, (bf16*)(ws + WS_X8B), (float*)(ws + WS_RS), QSC(Fb));
        const float* pp = A_->in[1];
        for (int i0 = gw * 64 + lane; i0 < M * PLE / 8; i0 += 4 * NGW * 64) {
            f32x4 a[4], b[4];
#pragma unroll
            for (int u = 0; u < 4; ++u) { int i = i0 + u * NGW * 64; if (i >= M * PLE / 8) i = i0; a[u] = ((const f32x4*)pp)[2 * i]; b[u] = ((const f32x4*)pp)[2 * i + 1]; }
#pragma unroll
            for (int u = 0; u < 4; ++u) { int i = i0 + u * NGW * 64; if (i >= M * PLE / 8) i = i0;
                v4u o; o.x = pk2(a[u].x, a[u].y); o.y = pk2(a[u].z, a[u].w); o.z = pk2(b[u].x, b[u].y); o.w = pk2(b[u].z, b[u].w); ((v4u*)PBb)[i] = o; } } }
    GRID_BAR();
    PH(14) { pg8::Gemm g{PBb, (const bf16*)(ws + WS_WPLE), M, D, PLE}; pg8::StaticOrder S; S.init(M, D, G, bx); pg8::EpiMix<0> E{Eb, nullptr, D};
      pg8::gemm_phase<pg8::EpiMix<0>, pg8::StaticOrder, PG8_ALIGN, PG8_SP2>(lds + RING_OFF, g, S, E); }
    PH(14) { pg8::Gemm g{(const bf16*)(ws + WS_X8B), (const bf16*)(ws + WS_WPG), M, D, D / 2}; pg8::StaticOrder S; S.init(M, D, G, bx);
      pg8::EpiI8<6> E{Eb, nullptr, Eb, D, 0, (const float*)(ws + WS_RS), (const float*)(ws + WS_CMAX) + CM_PG, 1.0f / 127.0f};
      pg8::gemm_phase<pg8::EpiI8<6>, pg8::StaticOrder, PG8_ALIGN, PG8_SP2, true>(lds + RING_OFF, g, S, E); }
    GRID_BAR();
    PH(15) { COORDS(); rowwise_final_phase(gw, NGW, lane, H2W, Fb, QSC(Fb), A_->in[12] + 5 * D, Eb, A_->in[12] + 6 * D, A_->out); }
#if defined(PROBE_GEMM)
    GRID_BAR();
    PH(24) { pg8::Gemm g{(const bf16*)(ws + WS_A), (const bf16*)(ws + WS_WD1), M, D, D}; pg8::SameOrder S{11}; pg8::EpiNull E{};
      pg8::gemm_phase<pg8::EpiNull, pg8::SameOrder, PG8_ALIGN, PG8_SP2>(lds + RING_OFF, g, S, E); }
    PH(25) { pg8::Gemm g{(const bf16*)(ws + WS_A), (const bf16*)(ws + WS_WD1), M, NGU, D}; pg8::StaticOrder S; S.init(M, NGU, G, bx); pg8::EpiNull E{};
      pg8::gemm_phase<pg8::EpiNull, pg8::StaticOrder, PG8_ALIGN, PG8_SP2>(lds + RING_OFF, g, S, E); }
#endif
}

extern "C" void kernel_launch(void* const* d_in, const int* in_sizes, int n_in, void* d_out, int out_size, void* d_ws, size_t ws_size, hipStream_t stream) {
    static int grid = 0;
    if (grid == 0) {
        if (n_in != 16 || in_sizes[0] != M * D || out_size != M * D || ws_size < WS_END) { fprintf(stderr, "kernel_launch: unexpected shapes: n_in %d in0 %d out %d ws %zu; nothing launched\n", n_in, n_in > 0 ? in_sizes[0] : -1, out_size, ws_size); grid = -1; return; }
        int dev = 0, cus = 0;
        if (hipGetDevice(&dev) != hipSuccess || hipDeviceGetAttribute(&cus, hipDeviceAttributeMultiprocessorCount, dev) != hipSuccess) { fprintf(stderr, "kernel_launch: device query failed\n"); grid = -1; return; }
        if (hipFuncSetAttribute((const void*)mk_fwd, hipFuncAttributeMaxDynamicSharedMemorySize, LDS_BYTES) != hipSuccess) { fprintf(stderr, "kernel_launch: hipFuncSetAttribute failed\n"); grid = -1; return; }
        int per_cu = 0;
        if (hipOccupancyMaxActiveBlocksPerMultiprocessor(&per_cu, (const void*)mk_fwd, NWAVES * 64, LDS_BYTES) != hipSuccess || per_cu < 1) fprintf(stderr, "kernel_launch: note: occupancy query reports %d\n", per_cu);
        (void)hipGetLastError();
        grid = cus;
    }
    if (grid < 0) return;
    if (hipMemsetAsync((char*)d_ws + WS_CTL, 0, CTL_ZERO_BYTES, stream) != hipSuccess) { fprintf(stderr, "kernel_launch: memset failed\n"); return; }
    Args a{};
    for (int i = 0; i < 16; ++i) a.in[i] = (const float*)d_in[i];
    a.out = (float*)d_out; a.ws = (unsigned char*)d_ws; a.mask = MASK_BITS; a.rep = REP_MASK;
    hipLaunchKernelGGL(mk_fwd, dim3(grid), dim3(NWAVES * 64), LDS_BYTES, stream, a);
    const hipError_t le = hipPeekAtLastError();
    if (le != hipSuccess) fprintf(stderr, "kernel_launch: launch failed: %s\n", hipGetErrorName(le));
}
```
